# Optimizing an MI355X kernel written in HIP

```python
import jax, jax.numpy as jnp
from jax import lax
import numpy as np

D_MODEL = 1024
BATCH = 4
SEQ = 8192
DEPTH = 1

D_MIX = D_MODEL
ATTN_HEADS = 4
QK_NOPE_DIM = 128
QK_ROPE_DIM = 64
QK_HEAD_DIM = QK_NOPE_DIM + QK_ROPE_DIM
V_HEAD_DIM = 128
ATTN_WIDTH = ATTN_HEADS * V_HEAD_DIM
Q_LORA_RANK = 256
KV_LORA_RANK = 128
ROPE_THETA = 10000.0
Q_BLOCK = 128
LRU_WIDTH = D_MIX - ATTN_WIDTH
LRU_HEADS = 4
LRU_BLOCK = LRU_WIDTH // LRU_HEADS
CONV_WIDTH = 4
LRU_C = 8.0
IN_SPLITS = [Q_LORA_RANK,
             Q_LORA_RANK + KV_LORA_RANK,
             Q_LORA_RANK + KV_LORA_RANK + QK_ROPE_DIM,
             Q_LORA_RANK + KV_LORA_RANK + QK_ROPE_DIM + LRU_WIDTH]
IN_PROJ_WIDTH = Q_LORA_RANK + KV_LORA_RANK + QK_ROPE_DIM + 2 * LRU_WIDTH
N_GROUPS = 4
EXPERTS_PER_GROUP = 8
N_EXPERTS = N_GROUPS * EXPERTS_PER_GROUP
TOP_K = 2
D_FF_EXPERT = 256
MOE_BLOCK = 128
EPS = 1e-6

kernel_name = 'hymba_mla_rglru_hmoe_adaln_layer'


def rms_norm(x, g):
    xf = x.astype(jnp.float32)
    y = xf * lax.rsqrt(jnp.mean(xf * xf, axis=-1, keepdims=True) + EPS)
    return (y * g.astype(jnp.float32)).astype(x.dtype)


def rope_cos_sin(positions):
    inv = 1.0 / (ROPE_THETA ** (jnp.arange(0, QK_ROPE_DIM, 2, dtype=jnp.float32) / QK_ROPE_DIM))
    ang = positions.astype(jnp.float32)[..., None] * inv
    return jnp.cos(ang), jnp.sin(ang)


def apply_rope(x, cos, sin):
    xf = x.astype(jnp.float32)
    x1, x2 = jnp.split(xf, 2, axis=-1)
    c = cos[:, :, None, :]
    s = sin[:, :, None, :]
    return jnp.concatenate([x1 * c - x2 * s, x2 * c + x1 * s], axis=-1).astype(x.dtype)


def mla_attention(q_lat, kv_lat, k_rope, cos, sin, q_a_norm, w_q_b, kv_a_norm, w_kv_b, q_norm, k_norm):
    B, S, _ = q_lat.shape
    q = (rms_norm(q_lat, q_a_norm) @ w_q_b).reshape(B, S, ATTN_HEADS, QK_HEAD_DIM)
    kv = (rms_norm(kv_lat, kv_a_norm) @ w_kv_b).reshape(B, S, ATTN_HEADS, QK_NOPE_DIM + V_HEAD_DIM)
    k_nope, v = kv[..., :QK_NOPE_DIM], kv[..., QK_NOPE_DIM:]
    k_pe = jnp.broadcast_to(k_rope[:, :, None, :], (B, S, ATTN_HEADS, QK_ROPE_DIM))
    k = jnp.concatenate([k_nope, k_pe], axis=-1)
    q = rms_norm(q, q_norm)
    k = rms_norm(k, k_norm)
    q = jnp.concatenate([q[..., :QK_NOPE_DIM], apply_rope(q[..., QK_NOPE_DIM:], cos, sin)], axis=-1)
    k = jnp.concatenate([k[..., :QK_NOPE_DIM], apply_rope(k[..., QK_NOPE_DIM:], cos, sin)], axis=-1)
    qh = q.transpose(0, 2, 1, 3)
    kh = k.transpose(0, 2, 1, 3)
    vh = v.transpose(0, 2, 1, 3)
    n_blocks = S // Q_BLOCK
    q_blocks = qh.reshape(B, ATTN_HEADS, n_blocks, Q_BLOCK, QK_HEAD_DIM).transpose(2, 0, 1, 3, 4)
    key_idx = jnp.arange(S)
    scale = QK_HEAD_DIM ** -0.5

    def block(args):
        qb, bi = args
        s = jnp.einsum('bhqd,bhkd->bhqk', qb, kh, preferred_element_type=jnp.float32) * scale
        q_idx = bi * Q_BLOCK + jnp.arange(Q_BLOCK)
        s = jnp.where(key_idx[None, :] <= q_idx[:, None], s, -jnp.inf)
        p = jax.nn.softmax(s, axis=-1)
        return jnp.einsum('bhqk,bhkd->bhqd', p.astype(vh.dtype), vh)

    out = lax.map(block, (q_blocks, jnp.arange(n_blocks)))
    return out.transpose(1, 0, 3, 2, 4).reshape(B, S, ATTN_WIDTH)


def rg_lru_branch(x_lru, g_lru, positions, conv_w, conv_b, w_a, b_a, w_x, b_x, lam):
    B, S, C = x_lru.shape
    xc = lax.conv_general_dilated(x_lru, conv_w[:, None, :], window_strides=(1,),
                                  padding=[(CONV_WIDTH - 1, 0)],
                                  dimension_numbers=('NWC', 'WIO', 'NWC'),
                                  feature_group_count=C) + conv_b
    xb = xc.reshape(B, S, LRU_HEADS, LRU_BLOCK)
    r = jax.nn.sigmoid(jnp.einsum('bshi,hij->bshj', xb, w_a).reshape(B, S, C) + b_a)
    i = jax.nn.sigmoid(jnp.einsum('bshi,hij->bshj', xb, w_x).reshape(B, S, C) + b_x)
    log_a = -LRU_C * r.astype(jnp.float32) * jax.nn.softplus(-lam.astype(jnp.float32))
    a = jnp.exp(log_a)
    mult = jnp.sqrt(jnp.maximum(1.0 - jnp.exp(2.0 * log_a), 0.0))
    reset = (positions == 0)[..., None]
    a = jnp.where(reset, 0.0, a)
    mult = jnp.where(reset, 1.0, mult)
    b = mult * (i.astype(jnp.float32) * xc.astype(jnp.float32))

    def combine(lhs, rhs):
        a1, b1 = lhs
        a2, b2 = rhs
        return a1 * a2, a2 * b1 + b2

    _, h = lax.associative_scan(combine, (a, b), axis=1)
    return h.astype(x_lru.dtype) * jax.nn.gelu(g_lru)


def hierarchical_moe(h, w_rg, b_rg, w_re, b_re, w_gate, w_up, w_down):
    B, S, D = h.shape
    N = B * S
    t = h.reshape(N, D)
    g_prob = jax.nn.softmax((t @ w_rg).astype(jnp.float32) + b_rg, axis=-1)
    g_p, g_idx = lax.top_k(g_prob, 1)
    e_logits = ((t @ w_re).astype(jnp.float32) + b_re).reshape(N, N_GROUPS, EXPERTS_PER_GROUP)
    e_logits = jnp.take_along_axis(e_logits, g_idx[:, :, None], axis=1)[:, 0]
    e_p, e_idx = lax.top_k(jax.nn.softmax(e_logits, axis=-1), TOP_K)
    e_p = e_p / jnp.sum(e_p, axis=-1, keepdims=True)
    weights = g_p * e_p
    expert = g_idx * EXPERTS_PER_GROUP + e_idx
    NK = N * TOP_K
    flat_e = expert.reshape(NK)
    flat_tok = jnp.repeat(jnp.arange(N, dtype=jnp.int32), TOP_K)
    flat_w = weights.reshape(NK)
    order = jnp.argsort(flat_e)
    sorted_e = flat_e[order]
    counts = jnp.bincount(flat_e, length=N_EXPERTS)
    padded = (counts + MOE_BLOCK - 1) // MOE_BLOCK * MOE_BLOCK
    starts = jnp.cumsum(counts) - counts
    pad_ends = jnp.cumsum(padded)
    pad_starts = pad_ends - padded
    dest = pad_starts[sorted_e] + (jnp.arange(NK) - starts[sorted_e])
    cap = (NK + N_EXPERTS * (MOE_BLOCK - 1) + MOE_BLOCK - 1) // MOE_BLOCK * MOE_BLOCK
    n_blocks = cap // MOE_BLOCK
    row_tok = jnp.full((cap,), N, jnp.int32).at[dest].set(flat_tok[order])
    row_w = jnp.zeros((cap,), jnp.float32).at[dest].set(flat_w[order])
    block_e = jnp.minimum(jnp.searchsorted(pad_ends, jnp.arange(n_blocks) * MOE_BLOCK, side='right'),
                          N_EXPERTS - 1)
    t_pad = jnp.concatenate([t, jnp.zeros((1, D), t.dtype)], axis=0)

    def expert_block(args):
        rows, e = args
        xb = t_pad[rows]
        hid = jax.nn.silu(xb @ w_gate[e]) * (xb @ w_up[e])
        return hid @ w_down[e]

    y_rows = lax.map(expert_block, (row_tok.reshape(n_blocks, MOE_BLOCK), block_e))
    y_rows = y_rows.reshape(cap, D).astype(jnp.float32) * row_w[:, None]
    y = jnp.zeros((N + 1, D), jnp.float32).at[row_tok].add(y_rows)[:N]
    return y.reshape(B, S, D).astype(h.dtype)


def hybrid_layer(x, c, positions, cos, sin, w_ada, b_ada, norm1_g, w_in, q_a_norm, w_q_b, kv_a_norm,
                 w_kv_b, q_norm, k_norm, conv_w, conv_b, lru_wa, lru_ba, lru_wx, lru_bx, lru_lambda,
                 attn_out_norm, lru_out_norm, w_out, norm2_g, w_router_group, b_router_group,
                 w_router_expert, b_router_expert, w_gate, w_up, w_down):
    mod = jax.nn.silu(c) @ w_ada + b_ada
    shift1, scale1, gate1, shift2, scale2, gate2 = jnp.split(mod[:, None, :], 6, axis=-1)
    h = rms_norm(x, norm1_g) * (1.0 + scale1) + shift1
    proj = h @ w_in
    q_lat, kv_lat, k_rope, x_lru, g_lru = jnp.split(proj, IN_SPLITS, axis=-1)
    attn = mla_attention(q_lat, kv_lat, k_rope, cos, sin, q_a_norm, w_q_b, kv_a_norm, w_kv_b,
                         q_norm, k_norm)
    lru = rg_lru_branch(x_lru, g_lru, positions, conv_w, conv_b, lru_wa, lru_ba, lru_wx, lru_bx,
                        lru_lambda)
    mixed = jnp.concatenate([rms_norm(attn, attn_out_norm), rms_norm(lru, lru_out_norm)], axis=-1)
    x = x + gate1 * (mixed @ w_out)
    h2 = rms_norm(x, norm2_g) * (1.0 + scale2) + shift2
    x = x + gate2 * hierarchical_moe(h2, w_router_group, b_router_group, w_router_expert,
                                     b_router_expert, w_gate, w_up, w_down)
    return x


def setup_inputs(seed: int = 0) -> dict:
    key = jax.random.key(seed)
    ks = iter(jax.random.split(key, 40))
    L = DEPTH

    def normal(shape, scale):
        return jax.random.normal(next(ks), shape, jnp.float32) * scale

    def gain(n):
        return 1.0 + normal((L, n), 0.02)

    u = jax.random.uniform(next(ks), (L, LRU_WIDTH), jnp.float32, 0.9, 0.999)
    s = u ** (1.0 / LRU_C)
    lam = jnp.log(s) - jnp.log1p(-s)
    return {
        'x': normal((BATCH, SEQ, D_MODEL), 1.0),
        'c': normal((BATCH, D_MODEL), 1.0),
        'positions': jnp.tile(jnp.arange(SEQ, dtype=jnp.int32)[None, :], (BATCH, 1)),
        'w_ada': normal((L, D_MODEL, 6 * D_MODEL), D_MODEL ** -0.5),
        'b_ada': normal((L, 6 * D_MODEL), 0.02),
        'norm1_g': gain(D_MODEL),
        'w_in': normal((L, D_MODEL, IN_PROJ_WIDTH), D_MODEL ** -0.5),
        'q_a_norm': gain(Q_LORA_RANK),
        'w_q_b': normal((L, Q_LORA_RANK, ATTN_HEADS * QK_HEAD_DIM), Q_LORA_RANK ** -0.5),
        'kv_a_norm': gain(KV_LORA_RANK),
        'w_kv_b': normal((L, KV_LORA_RANK, ATTN_HEADS * (QK_NOPE_DIM + V_HEAD_DIM)), KV_LORA_RANK ** -0.5),
        'q_norm': gain(QK_HEAD_DIM),
        'k_norm': gain(QK_HEAD_DIM),
        'conv_w': normal((L, CONV_WIDTH, LRU_WIDTH), CONV_WIDTH ** -0.5),
        'conv_b': normal((L, LRU_WIDTH), 0.02),
        'lru_wa': normal((L, LRU_HEADS, LRU_BLOCK, LRU_BLOCK), LRU_BLOCK ** -0.5),
        'lru_ba': normal((L, LRU_WIDTH), 0.02),
        'lru_wx': normal((L, LRU_HEADS, LRU_BLOCK, LRU_BLOCK), LRU_BLOCK ** -0.5),
        'lru_bx': normal((L, LRU_WIDTH), 0.02),
        'lru_lambda': lam,
        'attn_out_norm': gain(ATTN_WIDTH),
        'lru_out_norm': gain(LRU_WIDTH),
        'w_out': normal((L, D_MIX, D_MODEL), D_MIX ** -0.5),
        'norm2_g': gain(D_MODEL),
        'w_router_group': normal((L, D_MODEL, N_GROUPS), D_MODEL ** -0.5),
        'b_router_group': normal((L, N_GROUPS), 0.01),
        'w_router_expert': normal((L, D_MODEL, N_EXPERTS), D_MODEL ** -0.5),
        'b_router_expert': normal((L, N_EXPERTS), 0.01),
        'w_gate': normal((L, N_EXPERTS, D_MODEL, D_FF_EXPERT), D_MODEL ** -0.5),
        'w_up': normal((L, N_EXPERTS, D_MODEL, D_FF_EXPERT), D_MODEL ** -0.5),
        'w_down': normal((L, N_EXPERTS, D_FF_EXPERT, D_MODEL), D_FF_EXPERT ** -0.5),
    }


def reference(x, c, positions, w_ada, b_ada, norm1_g, w_in, q_a_norm, w_q_b, kv_a_norm, w_kv_b,
              q_norm, k_norm, conv_w, conv_b, lru_wa, lru_ba, lru_wx, lru_bx, lru_lambda,
              attn_out_norm, lru_out_norm, w_out, norm2_g, w_router_group, b_router_group,
              w_router_expert, b_router_expert, w_gate, w_up, w_down):
    cos, sin = rope_cos_sin(positions)
    for l in range(DEPTH):
        x = hybrid_layer(x, c, positions, cos, sin, w_ada[l], b_ada[l], norm1_g[l], w_in[l],
                         q_a_norm[l], w_q_b[l], kv_a_norm[l], w_kv_b[l], q_norm[l], k_norm[l],
                         conv_w[l], conv_b[l], lru_wa[l], lru_ba[l], lru_wx[l], lru_bx[l],
                         lru_lambda[l], attn_out_norm[l], lru_out_norm[l], w_out[l], norm2_g[l],
                         w_router_group[l], b_router_group[l], w_router_expert[l],
                         b_router_expert[l], w_gate[l], w_up[l], w_down[l])
    return x
```

```cpp
#include <hip/hip_runtime.h>
#include <cstdio>
#include <cstdint>
#include <cmath>
constexpr int NB = 4, SEQ = 8192, DM = 1024, NTOK = NB * SEQ;
constexpr int NH = 4, DQK = 192, DNOPE = 128, DROPE = 64, DV = 128;
constexpr int QLR = 256, KVLR = 128, LRUW = 512, LRUH = 4, LRUB = 128;
constexpr int NPROJ = 1472, PROJP = 1536;
constexpr int C_QLAT = 0, C_KVLAT = 256, C_KROPE = 384, C_XLRU = 448, C_GLRU = 960;
constexpr int NEXP = 32, NGRP = 4, EPG = 8, DFF = 256;
constexpr float EPS = 1e-6f;
constexpr int MODW = 6 * DM;

typedef unsigned short bf16_t;
__device__ __forceinline__ float bf2f(bf16_t v) { return __uint_as_float(((unsigned)v) << 16); }
__device__ __forceinline__ bf16_t f2bf(float f) { unsigned u = __float_as_uint(f); return (bf16_t)((u + 0x7fffu + ((u >> 16) & 1u)) >> 16); }

constexpr size_t MiB = 1u << 20;
constexpr size_t WS_CTL = 0;
constexpr size_t WS_MOD = 1 * MiB;
constexpr size_t WS_ROUTE = 2 * MiB;
constexpr size_t WS_A = 64 * MiB;
constexpr size_t WS_B = 128 * MiB;
constexpr size_t WS_C = 224 * MiB;
constexpr size_t WS_D = 352 * MiB;
constexpr size_t WS_E = 416 * MiB;
constexpr size_t WS_END = 480 * MiB;
constexpr size_t WS_Q = WS_C, WS_K = WS_C + 48 * MiB, WS_V = WS_C + 96 * MiB;

__device__ __forceinline__ float silu_f(float v) { return v / (1.f + __expf(-v)); }
__device__ __forceinline__ float sigmoid_f(float v) { return 1.f / (1.f + __expf(-v)); }
__device__ __forceinline__ float gelu_tanh(float v) { const float u = 0.7978845608028654f * (v + 0.044715f * v * v * v); return v / (1.f + __expf(-2.f * u)); }

__device__ __forceinline__ float block_sum_256(float v, float* red) {
    for (int o = 32; o > 0; o >>= 1) v += __shfl_xor(v, o);
    __syncthreads();
    if ((threadIdx.x & 63) == 0) red[threadIdx.x >> 6] = v;
    __syncthreads();
    return red[0] + red[1] + red[2] + red[3];
}
__device__ __forceinline__ float wave_sum(float v) { for (int o = 32; o > 0; o >>= 1) v += __shfl_xor(v, o); return v; }

__device__ __forceinline__ void rope_cs(int pos, int i, float& c, float& s) {
    const double inv = exp(-0.28782313662425575 * (double)i);
    double a = (double)pos * inv;
    const double k = rint(a * 0.15915494309189535);
    a = fma(-k, 6.283185307179586, a); a = fma(-k, 2.4492935982947064e-16, a);
    const float r = (float)a;
    c = __cosf(r); s = __sinf(r);
}

__global__ void nv_mod(const float* __restrict__ c, const float* __restrict__ w_ada, const float* __restrict__ b_ada, float* __restrict__ mod) {
    const int n = blockIdx.x * 256 + threadIdx.x, b = blockIdx.y;
    float acc = b_ada[n];
    for (int k = 0; k < DM; ++k) acc += silu_f(c[b * DM + k]) * w_ada[(size_t)k * MODW + n];
    mod[b * MODW + n] = acc;
}
__global__ void nv_norm_mod(const float* __restrict__ x, const float* __restrict__ g, const float* __restrict__ mod, int which, bf16_t* __restrict__ out) {
    const int t = blockIdx.x * 4 + (threadIdx.x >> 6), lane = threadIdx.x & 63, b = t / SEQ;
    const float* xr = x + (size_t)t * DM;
    float v[16]; float ss = 0.f;
#pragma unroll
    for (int j = 0; j < 16; ++j) { v[j] = xr[lane + 64 * j]; ss += v[j] * v[j]; }
    ss = wave_sum(ss);
    const float rstd = rsqrtf(ss / DM + EPS);
    const float* sh = mod + b * MODW + (which ? 3 * DM : 0); const float* sc = sh + DM;
#pragma unroll
    for (int j = 0; j < 16; ++j) { const int k = lane + 64 * j; out[(size_t)t * DM + k] = f2bf(v[j] * rstd * g[k] * (1.f + sc[k]) + sh[k]); }
}

template <class Epi> __global__ void __launch_bounds__(256) nv_gemm(const bf16_t* __restrict__ A, int lda, const float* __restrict__ W, int ldw, int K, Epi epi) {
    __shared__ float As[16][65]; __shared__ float Bs[16][64];
    const int tid = threadIdx.x, tx = tid & 15, ty = tid >> 4, m0 = blockIdx.y * 64, n0 = blockIdx.x * 64;
    float acc[4][4];
#pragma unroll
    for (int i = 0; i < 4; ++i)
#pragma unroll
        for (int j = 0; j < 4; ++j) acc[i][j] = 0.f;
    for (int k0 = 0; k0 < K; k0 += 16) {
        { const int r = tid >> 2, kk = (tid & 3) * 4; const bf16_t* ap = A + (size_t)(m0 + r) * lda + k0 + kk;
#pragma unroll
          for (int j = 0; j < 4; ++j) As[kk + j][r] = bf2f(ap[j]); }
        { const int kk = tid >> 4, c = (tid & 15) * 4; const float* wp = W + (size_t)(k0 + kk) * ldw + n0 + c;
#pragma unroll
          for (int j = 0; j < 4; ++j) Bs[kk][c + j] = wp[j]; }
        __syncthreads();
#pragma unroll
        for (int kk = 0; kk < 16; ++kk) { float a[4], b[4];
#pragma unroll
            for (int i = 0; i < 4; ++i) a[i] = As[kk][ty * 4 + i];
#pragma unroll
            for (int j = 0; j < 4; ++j) b[j] = Bs[kk][tx * 4 + j];
#pragma unroll
            for (int i = 0; i < 4; ++i)
#pragma unroll
                for (int j = 0; j < 4; ++j) acc[i][j] += a[i] * b[j]; }
        __syncthreads();
    }
#pragma unroll
    for (int i = 0; i < 4; ++i)
#pragma unroll
        for (int j = 0; j < 4; ++j) epi(m0 + ty * 4 + i, n0 + tx * 4 + j, acc[i][j]);
}
struct EpiStoreBf16 { bf16_t* C; int ldc; int pad; __device__ void operator()(int r, int c, float v) const { C[(size_t)r * ldc + c] = f2bf(v); } };
struct EpiOutProj { const float* x; const float* mod; float* out; __device__ void operator()(int r, int c, float v) const { const int b = r / SEQ; out[(size_t)r * DM + c] = x[(size_t)r * DM + c] + mod[b * MODW + 2 * DM + c] * v; } };

__global__ void __launch_bounds__(256) nv_qkv(const bf16_t* __restrict__ proj, const int* __restrict__ positions, const float* __restrict__ q_a_norm, const float* __restrict__ w_q_b,
                                               const float* __restrict__ kv_a_norm, const float* __restrict__ w_kv_b, const float* __restrict__ q_norm, const float* __restrict__ k_norm,
                                               bf16_t* __restrict__ Q, bf16_t* __restrict__ Kb, bf16_t* __restrict__ Vb) {
    __shared__ float qn[QLR], kvn[KVLR], kr[DROPE], qo[NH * DQK], kvo[NH * 256], red[4], cs[64];
    const int t = blockIdx.x, tid = threadIdx.x, b = t / SEQ, s = t % SEQ;
    const bf16_t* pr = proj + (size_t)t * PROJP;
    const float ql = bf2f(pr[C_QLAT + tid]);
    const float sq = block_sum_256(ql * ql, red);
    qn[tid] = ql * rsqrtf(sq / QLR + EPS) * q_a_norm[tid];
    const float kl = tid < KVLR ? bf2f(pr[C_KVLAT + tid]) : 0.f;
    const float skv = block_sum_256(kl * kl, red);
    if (tid < KVLR) kvn[tid] = kl * rsqrtf(skv / KVLR + EPS) * kv_a_norm[tid];
    if (tid < DROPE) kr[tid] = bf2f(pr[C_KROPE + tid]);
    if (tid < 32) { float c, sn; rope_cs(positions[t], tid, c, sn); cs[tid] = c; cs[32 + tid] = sn; }
    __syncthreads();
    for (int j = 0; j < 3; ++j) { const int col = tid + 256 * j; float a = 0.f; for (int k = 0; k < QLR; ++k) a += qn[k] * w_q_b[(size_t)k * (NH * DQK) + col]; qo[col] = a; }
    for (int j = 0; j < 4; ++j) { const int col = tid + 256 * j; float a = 0.f; for (int k = 0; k < KVLR; ++k) a += kvn[k] * w_kv_b[(size_t)k * (NH * 256) + col]; kvo[col] = a; }
    __syncthreads();
    const int h = tid >> 6, lane = tid & 63;
    {
        float v0 = qo[h * DQK + lane], v1 = qo[h * DQK + 64 + lane], v2 = qo[h * DQK + 128 + lane];
        const float rs = rsqrtf(wave_sum(v0 * v0 + v1 * v1 + v2 * v2) / DQK + EPS);
        v0 *= rs * q_norm[lane]; v1 *= rs * q_norm[64 + lane]; v2 *= rs * q_norm[128 + lane];
        const float oth = __shfl_xor(v2, 32); const int i = lane & 31; const float c = cs[i], sn = cs[32 + i];
        const float r2 = lane < 32 ? v2 * c - oth * sn : v2 * c + oth * sn;
        bf16_t* qp = Q + ((size_t)(b * NH + h) * SEQ + s) * DQK;
        qp[lane] = f2bf(v0); qp[64 + lane] = f2bf(v1); qp[128 + lane] = f2bf(r2);
    }
    {
        float v0 = kvo[h * 256 + lane], v1 = kvo[h * 256 + 64 + lane], v2 = kr[lane];
        const float rs = rsqrtf(wave_sum(v0 * v0 + v1 * v1 + v2 * v2) / DQK + EPS);
        v0 *= rs * k_norm[lane]; v1 *= rs * k_norm[64 + lane]; v2 *= rs * k_norm[128 + lane];
        const float oth = __shfl_xor(v2, 32); const int i = lane & 31; const float c = cs[i], sn = cs[32 + i];
        const float r2 = lane < 32 ? v2 * c - oth * sn : v2 * c + oth * sn;
        bf16_t* kp = Kb + ((size_t)(b * NH + h) * SEQ + s) * DQK;
        kp[lane] = f2bf(v0); kp[64 + lane] = f2bf(v1); kp[128 + lane] = f2bf(r2);
        bf16_t* vp = Vb + ((size_t)(b * NH + h) * SEQ + s) * DV;
        vp[lane] = f2bf(kvo[h * 256 + 128 + lane]); vp[64 + lane] = f2bf(kvo[h * 256 + 192 + lane]);
    }
}

__global__ void __launch_bounds__(256) nv_attn(const bf16_t* __restrict__ Q, const bf16_t* __restrict__ Kb, const bf16_t* __restrict__ Vb, bf16_t* __restrict__ mixed) {
    __shared__ float Ks[64][DQK + 4]; __shared__ float Vs[64][DV + 4];
    const int bh = blockIdx.y, qb = gridDim.x - 1 - blockIdx.x, tid = threadIdx.x, row = tid >> 2, part = tid & 3;
    const int qi = qb * 64 + row;
    float q[48], o[32]; float m = -1e30f, l = 0.f;
    { const bf16_t* qp = Q + ((size_t)bh * SEQ + qi) * DQK + part * 48;
#pragma unroll
      for (int d = 0; d < 48; ++d) q[d] = bf2f(qp[d]); }
#pragma unroll
    for (int d = 0; d < 32; ++d) o[d] = 0.f;
    const float scl = 0.07216878364870322f;
    for (int kt = 0; kt <= qb; ++kt) {
        __syncthreads();
        for (int e = tid; e < 64 * DQK; e += 256) { const int r = e / DQK, c = e % DQK; Ks[r][c] = bf2f(Kb[((size_t)bh * SEQ + kt * 64 + r) * DQK + c]); }
        for (int e = tid; e < 64 * DV; e += 256) { const int r = e / DV, c = e % DV; Vs[r][c] = bf2f(Vb[((size_t)bh * SEQ + kt * 64 + r) * DV + c]); }
        __syncthreads();
        for (int j = 0; j < 64; ++j) {
            float sdot = 0.f;
#pragma unroll
            for (int d = 0; d < 48; ++d) sdot += q[d] * Ks[j][part * 48 + d];
            sdot += __shfl_xor(sdot, 1); sdot += __shfl_xor(sdot, 2);
            sdot *= scl;
            if (kt * 64 + j <= qi) {
                const float mn = fmaxf(m, sdot), al = __expf(m - mn), p = __expf(sdot - mn);
                l = l * al + p; m = mn;
#pragma unroll
                for (int d = 0; d < 32; ++d) o[d] = o[d] * al + p * Vs[j][part * 32 + d];
            }
        }
    }
    const int b = bh / NH, h = bh % NH;
    bf16_t* op = mixed + ((size_t)(b * SEQ + qi)) * DM + h * DV + part * 32;
    const float il = 1.f / l;
#pragma unroll
    for (int d = 0; d < 32; ++d) op[d] = f2bf(o[d] * il);
}

__global__ void __launch_bounds__(512) nv_lru_gates(const bf16_t* __restrict__ proj, const int* __restrict__ positions, const float* __restrict__ conv_w, const float* __restrict__ conv_b,
                                                     const float* __restrict__ wa, const float* __restrict__ ba, const float* __restrict__ wx, const float* __restrict__ bx,
                                                     const float* __restrict__ lam, float* __restrict__ A32, float* __restrict__ B32) {
    __shared__ float xc[LRUW];
    const int t = blockIdx.x, c = threadIdx.x, s = t % SEQ;
    float v = conv_b[c];
    for (int j = 0; j < 4; ++j) { const int ss = s - 3 + j; if (ss >= 0) v += conv_w[j * LRUW + c] * bf2f(proj[(size_t)(t - 3 + j) * PROJP + C_XLRU + c]); }
    xc[c] = v;
    __syncthreads();
    const int h = c >> 7, jj = c & 127;
    float ra = ba[c], ri = bx[c];
    for (int i = 0; i < LRUB; ++i) { const float xv = xc[h * LRUB + i]; ra += xv * wa[(size_t)(h * LRUB + i) * LRUB + jj]; ri += xv * wx[(size_t)(h * LRUB + i) * LRUB + jj]; }
    const float r = sigmoid_f(ra), ig = sigmoid_f(ri);
    const float sp = log1pf(__expf(-lam[c]));
    const float log_a = -8.f * r * sp;
    float a = __expf(log_a), mult = sqrtf(fmaxf(1.f - __expf(2.f * log_a), 0.f));
    if (positions[t] == 0) { a = 0.f; mult = 1.f; }
    A32[(size_t)t * LRUW + c] = a; B32[(size_t)t * LRUW + c] = mult * (ig * v);
}
__global__ void nv_lru_scan(float* __restrict__ A32, const float* __restrict__ B32) {
    const int idx = blockIdx.x * blockDim.x + threadIdx.x, b = idx / LRUW, c = idx % LRUW;
    float h = 0.f;
    for (int s0 = 0; s0 < SEQ; s0 += 8) {
        float a[8], bb[8];
#pragma unroll
        for (int j = 0; j < 8; ++j) { const size_t o = ((size_t)(b * SEQ + s0 + j)) * LRUW + c; a[j] = A32[o]; bb[j] = B32[o]; }
#pragma unroll
        for (int j = 0; j < 8; ++j) { h = a[j] * h + bb[j]; A32[((size_t)(b * SEQ + s0 + j)) * LRUW + c] = h; }
    }
}
__global__ void nv_mixnorm(bf16_t* __restrict__ mixed, const float* __restrict__ H32, const bf16_t* __restrict__ proj, const float* __restrict__ g_attn, const float* __restrict__ g_lru) {
    const int t = blockIdx.x * 4 + (threadIdx.x >> 6), lane = threadIdx.x & 63;
    bf16_t* mr = mixed + (size_t)t * DM;
    float v[8], ss = 0.f;
#pragma unroll
    for (int j = 0; j < 8; ++j) { v[j] = bf2f(mr[lane + 64 * j]); ss += v[j] * v[j]; }
    float rs = rsqrtf(wave_sum(ss) / 512.f + EPS);
#pragma unroll
    for (int j = 0; j < 8; ++j) mr[lane + 64 * j] = f2bf(v[j] * rs * g_attn[lane + 64 * j]);
    ss = 0.f;
#pragma unroll
    for (int j = 0; j < 8; ++j) { const int c = lane + 64 * j; v[j] = H32[(size_t)t * LRUW + c] * gelu_tanh(bf2f(proj[(size_t)t * PROJP + C_GLRU + c])); ss += v[j] * v[j]; }
    rs = rsqrtf(wave_sum(ss) / 512.f + EPS);
#pragma unroll
    for (int j = 0; j < 8; ++j) mr[512 + lane + 64 * j] = f2bf(v[j] * rs * g_lru[lane + 64 * j]);
}
__global__ void nv_route(const float* __restrict__ x1, const float* __restrict__ g2, const float* __restrict__ mod, const float* __restrict__ w_rg, const float* __restrict__ b_rg,
                         const float* __restrict__ w_re, const float* __restrict__ b_re, bf16_t* __restrict__ H2, int2* __restrict__ rexp, float2* __restrict__ rw) {
    const int t = blockIdx.x * 4 + (threadIdx.x >> 6), lane = threadIdx.x & 63, b = t / SEQ;
    const float* xr = x1 + (size_t)t * DM;
    float v[16]; float ss = 0.f;
#pragma unroll
    for (int j = 0; j < 16; ++j) { v[j] = xr[lane + 64 * j]; ss += v[j] * v[j]; }
    const float rstd = rsqrtf(wave_sum(ss) / DM + EPS);
    const float* sh = mod + b * MODW + 3 * DM; const float* sc = sh + DM;
#pragma unroll
    for (int j = 0; j < 16; ++j) { const int k = lane + 64 * j; v[j] = v[j] * rstd * g2[k] * (1.f + sc[k]) + sh[k]; H2[(size_t)t * DM + k] = f2bf(v[j]); }
    float gl[NGRP];
#pragma unroll
    for (int g = 0; g < NGRP; ++g) { float a = 0.f;
#pragma unroll
        for (int j = 0; j < 16; ++j) a += v[j] * w_rg[(size_t)(lane + 64 * j) * NGRP + g];
        gl[g] = wave_sum(a) + b_rg[g]; }
    int gi = 0; float gm = gl[0];
#pragma unroll
    for (int g = 1; g < NGRP; ++g) if (gl[g] > gm) { gm = gl[g]; gi = g; }
    float gs = 0.f;
#pragma unroll
    for (int g = 0; g < NGRP; ++g) gs += __expf(gl[g] - gm);
    const float gp = 1.f / gs;
    float m0 = -1e30f, m1 = -1e30f; int e0 = 0, e1 = 0;
    for (int e = 0; e < EPG; ++e) { float a = 0.f;
#pragma unroll
        for (int j = 0; j < 16; ++j) a += v[j] * w_re[(size_t)(lane + 64 * j) * NEXP + gi * EPG + e];
        const float el = wave_sum(a) + b_re[gi * EPG + e];
        if (el > m0) { m1 = m0; e1 = e0; m0 = el; e0 = e; } else if (el > m1) { m1 = el; e1 = e; } }
    const float p1 = __expf(m1 - m0);
    const float w0 = gp / (1.f + p1), w1 = gp * p1 / (1.f + p1);
    if (lane == 0) { rexp[t] = make_int2(gi * EPG + e0, gi * EPG + e1); rw[t] = make_float2(w0, w1); }
}
__global__ void __launch_bounds__(256) nv_moe(const bf16_t* __restrict__ H2, const int2* __restrict__ rexp, const float2* __restrict__ rw, const float* __restrict__ w_gate,
                                               const float* __restrict__ w_up, const float* __restrict__ w_down, const float* __restrict__ mod, float* __restrict__ out) {
    __shared__ float hs[DM], hid[DFF];
    const int t = blockIdx.x, tid = threadIdx.x, b = t / SEQ;
    for (int j = 0; j < 4; ++j) hs[tid + 256 * j] = bf2f(H2[(size_t)t * DM + tid + 256 * j]);
    float y[4] = {0.f, 0.f, 0.f, 0.f};
    const int2 ee = rexp[t]; const float2 ww = rw[t];
    for (int k = 0; k < 2; ++k) {
        const int e = k ? ee.y : ee.x; const float w = k ? ww.y : ww.x;
        __syncthreads();
        const float* wg = w_gate + (size_t)e * DM * DFF; const float* wu = w_up + (size_t)e * DM * DFF;
        float g = 0.f, u = 0.f;
        for (int i = 0; i < DM; ++i) { const float hv = hs[i]; g += hv * wg[(size_t)i * DFF + tid]; u += hv * wu[(size_t)i * DFF + tid]; }
        hid[tid] = silu_f(g) * u;
        __syncthreads();
        const float* wd = w_down + (size_t)e * DFF * DM;
#pragma unroll
        for (int j = 0; j < 4; ++j) { float a = 0.f; for (int f = 0; f < DFF; ++f) a += hid[f] * wd[(size_t)f * DM + tid + 256 * j]; y[j] += w * a; }
    }
#pragma unroll
    for (int j = 0; j < 4; ++j) { const int c = tid + 256 * j; out[(size_t)t * DM + c] += mod[b * MODW + 5 * DM + c] * y[j]; }
}
struct Inputs {
    const float *x, *c; const int* positions;
    const float *w_ada, *b_ada, *norm1_g, *w_in, *q_a_norm, *w_q_b, *kv_a_norm, *w_kv_b, *q_norm, *k_norm, *conv_w, *conv_b, *lru_wa, *lru_ba, *lru_wx, *lru_bx, *lru_lambda,
                *attn_out_norm, *lru_out_norm, *w_out, *norm2_g, *w_rg, *b_rg, *w_re, *b_re, *w_gate, *w_up, *w_down;
};
static Inputs get_inputs(void* const* d_in) {
    Inputs I;
    I.x = (const float*)d_in[0]; I.c = (const float*)d_in[1]; I.positions = (const int*)d_in[2];
    I.w_ada = (const float*)d_in[3]; I.b_ada = (const float*)d_in[4]; I.norm1_g = (const float*)d_in[5];
    I.w_in = (const float*)d_in[6]; I.q_a_norm = (const float*)d_in[7]; I.w_q_b = (const float*)d_in[8];
    I.kv_a_norm = (const float*)d_in[9]; I.w_kv_b = (const float*)d_in[10]; I.q_norm = (const float*)d_in[11];
    I.k_norm = (const float*)d_in[12]; I.conv_w = (const float*)d_in[13]; I.conv_b = (const float*)d_in[14];
    I.lru_wa = (const float*)d_in[15]; I.lru_ba = (const float*)d_in[16]; I.lru_wx = (const float*)d_in[17];
    I.lru_bx = (const float*)d_in[18]; I.lru_lambda = (const float*)d_in[19]; I.attn_out_norm = (const float*)d_in[20];
    I.lru_out_norm = (const float*)d_in[21]; I.w_out = (const float*)d_in[22]; I.norm2_g = (const float*)d_in[23];
    I.w_rg = (const float*)d_in[24]; I.b_rg = (const float*)d_in[25]; I.w_re = (const float*)d_in[26];
    I.b_re = (const float*)d_in[27]; I.w_gate = (const float*)d_in[28]; I.w_up = (const float*)d_in[29];
    I.w_down = (const float*)d_in[30];
    return I;
}
#define GAS __attribute__((address_space(1)))
#define LAS __attribute__((address_space(3)))
typedef unsigned v4u __attribute__((ext_vector_type(4)));
typedef unsigned v2u __attribute__((ext_vector_type(2)));
typedef float f32x4 __attribute__((ext_vector_type(4)));
typedef float f32x16 __attribute__((ext_vector_type(16)));
typedef short bf16x8 __attribute__((ext_vector_type(8)));
typedef short s16x4 __attribute__((ext_vector_type(4)));
typedef GAS unsigned gu32;
#define RLX_AGENT __ATOMIC_RELAXED, __HIP_MEMORY_SCOPE_AGENT
#define LDS_WAIT() asm volatile("s_waitcnt lgkmcnt(0)" ::: "memory")
#define VM_WAIT() asm volatile("s_waitcnt vmcnt(0)" ::: "memory")
__device__ __forceinline__ unsigned pk2(float lo, float hi) { return (unsigned)f2bf(lo) | ((unsigned)f2bf(hi) << 16); }
__device__ __forceinline__ unsigned cvtpk(float lo, float hi) { unsigned r; asm volatile("v_cvt_pk_bf16_f32 %0, %1, %2" : "=v"(r) : "v"(lo), "v"(hi)); return r; }

constexpr size_t WSX_SUMA = 3 * MiB, WSX_SUMB = 5 * MiB;
constexpr size_t WSX_CS = 7 * MiB;
constexpr size_t WSX_WQF = 15 * MiB;
constexpr size_t WSX_WKVF = WSX_WQF + 384 * 1024;
constexpr size_t WSX_WAF = WSX_WKVF + 256 * 1024;
constexpr size_t WSX_WXF = WSX_WAF + 128 * 1024;
constexpr size_t WSX_WRF = WSX_WXF + 128 * 1024;
constexpr size_t WSX_SP = 2 * MiB + 768 * 1024;
constexpr size_t WSX_WIN = 16 * MiB;
constexpr size_t WSX_WOUT = 19 * MiB;
constexpr size_t WSX_W1T = 22 * MiB;
constexpr size_t WSX_W2T = 54 * MiB;
constexpr size_t WSX_A = 72 * MiB;
constexpr size_t WSX_B = 136 * MiB;
constexpr size_t WSX_C = 232 * MiB;
constexpr size_t WSX_D = 360 * MiB;
constexpr size_t WSX_E = 424 * MiB;
constexpr size_t WSX_END = 488 * MiB;
constexpr size_t WSX_Q = WSX_C, WSX_K = WSX_C + 48 * MiB, WSX_V = WSX_C + 96 * MiB;
constexpr size_t WSX_XS = WSX_B;
constexpr size_t WSX_HID = WSX_D;
constexpr size_t WSX_ROUTE = 2 * MiB;
constexpr int MAXROWS = 2 * NTOK + NEXP * 255;
constexpr int CW_BAR = 4096;
constexpr int CW_CNT = 65536;

constexpr int RING_BYTES = 131072, LDSCTL_OFF = RING_BYTES, MISC_OFF = LDSCTL_OFF + 320, LDS_BYTES = 147456;
constexpr int NWAVES = 8;
namespace pg8 {
#define PG8_LAS __attribute__((address_space(3)))
typedef unsigned short bf16_t;
typedef short bf16x8 __attribute__((ext_vector_type(8)));
typedef float f32x4 __attribute__((ext_vector_type(4)));
typedef unsigned u32x4 __attribute__((ext_vector_type(4)));
constexpr int BM = 256, BK = 64, HALF = 128, HTB = HALF * BK * 2  , STAGE_BYTES = 8 * HTB, NXCD = 8, WGM = 8;

__host__ __device__ __forceinline__ int lds_byte(int r, int c) { const int st = (r >> 4) * 2 + (c >> 5), rr = r & 15, cc = c & 31, ob = rr * 64 + cc * 2; return st * 1024 + (ob ^ (((ob >> 9) & 1) << 5)); }
__host__ __device__ __forceinline__ void stage_rc(int b, int& R, int& C) { const int st = b / 1024, sb = b % 1024, swz = sb ^ (((sb >> 9) & 1) << 5); R = (st >> 1) * 16 + swz / 64; C = (st & 1) * 32 + (swz % 64) / 2; }
__host__ __device__ __forceinline__ int perm32(int rho) { const int n = rho >> 4, i = rho & 15; return 8 * (i >> 2) + 4 * n + (i & 3); }

struct Unit { int pm, pn; };
struct Gemm { const bf16_t* A; const bf16_t* Bt; int M, N, K; };

struct StaticOrder {
    int nM, nN, nwg, G, c;
    __host__ __device__ void init(int M, int N, int G_, int c_) { nM = M / BM; nN = N / BM; nwg = nM * nN; G = G_; c = c_; }
    __host__ __device__ bool next(int i, Unit& u) const {
        const long L = (long)i * G + c; if (L >= nwg) return false;
        int wgid = (int)L; { const int q = nwg / NXCD, r = nwg % NXCD, xcd = wgid % NXCD, off = wgid / NXCD; wgid = (xcd < r ? xcd * (q + 1) : r * (q + 1) + (xcd - r) * q) + off; }
        const int nig = WGM * nN, gid = wgid / nig, fm = gid * WGM, gsz = (nM - fm) < WGM ? (nM - fm) : WGM;
        u.pm = fm + ((wgid % nig) % gsz); u.pn = (wgid % nig) / gsz; return true;
    }
    __device__ __forceinline__ void a_ready(const Unit&) const {}
    __device__ __forceinline__ void done(const Unit&) const {}
};

__device__ __forceinline__ unsigned cvt_pk_bf16(float lo, float hi) { unsigned r; asm volatile("v_cvt_pk_bf16_f32 %0, %1, %2" : "=v"(r) : "v"(lo), "v"(hi)); return r; }
typedef float f32x2 __attribute__((ext_vector_type(2)));
__device__ __forceinline__ f32x2 gelu_pk(f32x2 v) {
    const f32x2 av = __builtin_elementwise_abs(v), d = av * 0.2316418882f + 1.0f;
    f32x2 t; t.x = __builtin_amdgcn_rcpf(d.x); t.y = __builtin_amdgcn_rcpf(d.y);
    f32x2 q = t * 0.5307027145f + (-0.7265760135f); q = q * t + 0.7107068705f; q = q * t + (-0.142248368f); q = q * t + 0.127414796f; q = q * t;
    const f32x2 s = (v * v) * (-0.72134752044f);
    f32x2 e; e.x = __builtin_amdgcn_exp2f(s.x); e.y = __builtin_amdgcn_exp2f(s.y);
    const f32x2 m = v * (q * e), r = v - m;
    f32x2 o; o.x = v.x < 0.f ? m.x : r.x; o.y = v.y < 0.f ? m.y : r.y; return o;
}

template <int ACT  > struct EpiBf16 {
    static constexpr bool PERM = true, AFTER_DRAIN = false; static_assert(ACT == 0 || ACT == 1, "EpiBf16: ACT is 0 (none) or 1 (gelu_pk)");
    bf16_t* O; int ldc; const float* bias; int split_cols; size_t split_stride; float scale0;
    __device__ __forceinline__ void operator()(const f32x4 (&acc)[2][2][4][2], const Unit& u, int wr, int wc, int fr, int fq) const {
        const int row0 = u.pm * BM + wr * 64 + fr; int colt = u.pn * BM; bf16_t* base = O;
        float sc = 1.f; if (split_cols) { const int t = colt / split_cols; base += (size_t)t * split_stride; colt -= t * split_cols; if (t == 0) sc = scale0; }
        const int col0 = colt + wc * 32 + 8 * fq, bcol0 = u.pn * BM + wc * 32 + 8 * fq;
        f32x4 bv[2][2];
#pragma unroll
        for (int bj = 0; bj < 2; ++bj)
#pragma unroll
            for (int n = 0; n < 2; ++n) bv[bj][n] = bias ? *(const f32x4*)(bias + bcol0 + bj * HALF + 4 * n) : (f32x4){0.f, 0.f, 0.f, 0.f};
#pragma unroll
        for (int ai = 0; ai < 2; ++ai)
#pragma unroll
            for (int m = 0; m < 4; ++m) { bf16_t* rowp = base + (size_t)(row0 + ai * HALF + m * 16) * ldc + col0;
#pragma unroll
                for (int bj = 0; bj < 2; ++bj) { f32x4 v0 = acc[ai][bj][m][0] + bv[bj][0], v1 = acc[ai][bj][m][1] + bv[bj][1];
                    if (ACT == 1) { f32x2 a = gelu_pk((f32x2){v0[0], v0[1]}), b = gelu_pk((f32x2){v0[2], v0[3]}), c = gelu_pk((f32x2){v1[0], v1[1]}), d = gelu_pk((f32x2){v1[2], v1[3]});
                        v0 = (f32x4){a.x, a.y, b.x, b.y}; v1 = (f32x4){c.x, c.y, d.x, d.y}; }
                    v0 = v0 * sc; v1 = v1 * sc; u32x4 w; w.x = cvt_pk_bf16(v0[0], v0[1]); w.y = cvt_pk_bf16(v0[2], v0[3]); w.z = cvt_pk_bf16(v1[0], v1[1]); w.w = cvt_pk_bf16(v1[2], v1[3]);
                    *(u32x4*)(rowp + bj * HALF) = w; } }
    }
};
struct EpiResid {
    static constexpr bool PERM = false, AFTER_DRAIN = false;
    const float* x; const float* mod; float* out;
    __device__ __forceinline__ void operator()(const f32x4 (&acc)[2][2][4][2], const Unit& u, int wr, int wc, int fr, int fq) const {
        const int col0 = u.pn * BM + wc * 32 + 4 * fq, b = (u.pm * BM) / 8192;
        f32x4 gv[2][2];
#pragma unroll
        for (int bj = 0; bj < 2; ++bj)
#pragma unroll
            for (int n = 0; n < 2; ++n) gv[bj][n] = *(const f32x4*)(mod + b * 6144 + 2048 + col0 + bj * HALF + n * 16);
#pragma unroll
        for (int ai = 0; ai < 2; ++ai)
#pragma unroll
            for (int m = 0; m < 4; ++m) { const size_t off = (size_t)(u.pm * BM + ai * HALF + wr * 64 + m * 16 + fr) * 1024 + col0;
#pragma unroll
                for (int bj = 0; bj < 2; ++bj)
#pragma unroll
                    for (int n = 0; n < 2; ++n) { const f32x4 xv = *(const f32x4*)(x + off + bj * HALF + n * 16);
                        *(f32x4*)(out + off + bj * HALF + n * 16) = xv + gv[bj][n] * acc[ai][bj][m][n]; } }
    }
};
__device__ __forceinline__ float silu_e(float v) { return v * __builtin_amdgcn_rcpf(1.f + __builtin_amdgcn_exp2f(-1.4426950408889634f * v)); }
struct EpiSiluMul {
    static constexpr bool PERM = true, AFTER_DRAIN = false;
    bf16_t* H;
    __device__ __forceinline__ void operator()(const f32x4 (&acc)[2][2][4][2], const Unit& u, int wr, int wc, int fr, int fq) const {
        const int half = u.pn & 1, col0 = half * 128 + wc * 32 + 8 * fq;
#pragma unroll
        for (int ai = 0; ai < 2; ++ai)
#pragma unroll
            for (int m = 0; m < 4; ++m) { const size_t row = (size_t)(u.pm * BM + ai * HALF + wr * 64 + m * 16 + fr);
                const f32x4 g0 = acc[ai][0][m][0], g1 = acc[ai][0][m][1], u0 = acc[ai][1][m][0], u1 = acc[ai][1][m][1];
                u32x4 w; w.x = cvt_pk_bf16(silu_e(g0[0]) * u0[0], silu_e(g0[1]) * u0[1]); w.y = cvt_pk_bf16(silu_e(g0[2]) * u0[2], silu_e(g0[3]) * u0[3]);
                w.z = cvt_pk_bf16(silu_e(g1[0]) * u1[0], silu_e(g1[1]) * u1[1]); w.w = cvt_pk_bf16(silu_e(g1[2]) * u1[2], silu_e(g1[3]) * u1[3]);
                *(u32x4*)(H + row * 256 + col0) = w; }
    }
};
struct EpiYs {
    static constexpr bool PERM = true, AFTER_DRAIN = false;
    bf16_t* Y;
    __device__ __forceinline__ void operator()(const f32x4 (&acc)[2][2][4][2], const Unit& u, int wr, int wc, int fr, int fq) const {
        const int col0 = (u.pn & 3) * BM + wc * 32 + 8 * fq;
#pragma unroll
        for (int ai = 0; ai < 2; ++ai)
#pragma unroll
            for (int m = 0; m < 4; ++m) { bf16_t* rowp = Y + (size_t)(u.pm * BM + ai * HALF + wr * 64 + m * 16 + fr) * 1024 + col0;
#pragma unroll
                for (int bj = 0; bj < 2; ++bj) { const f32x4 v0 = acc[ai][bj][m][0], v1 = acc[ai][bj][m][1];
                    u32x4 w; w.x = cvt_pk_bf16(v0[0], v0[1]); w.y = cvt_pk_bf16(v0[2], v0[3]); w.z = cvt_pk_bf16(v1[0], v1[1]); w.w = cvt_pk_bf16(v1[2], v1[3]);
                    *(u32x4*)(rowp + bj * HALF) = w; } }
    }
};
struct GroupedOrder {
    const __attribute__((address_space(3))) int* tp; int ncol, G, c;
    __device__ __forceinline__ bool next(int i, Unit& u) const {
        const int L = i * G + c, total = tp[32] * ncol; if (L >= total) return false;
        const int rt = L / ncol, ct = L - rt * ncol; int e = 0;
#pragma unroll 1
        for (int j = 1; j < 32; ++j) e += (tp[j] <= rt) ? 1 : 0;
        u.pm = rt; u.pn = e * ncol + ct; return true;
    }
    __device__ __forceinline__ void a_ready(const Unit&) const {}
    __device__ __forceinline__ void done(const Unit&) const {}
};
template <class Epi, class Sched, bool ALIGN_EPI = false, bool SP2 = false>
__device__ __forceinline__ void gemm_phase(PG8_LAS unsigned char* lds, const Gemm g, const Sched& S, const Epi& E) {
    const int tid = threadIdx.x, wid = __builtin_amdgcn_readfirstlane(tid >> 6), lane = tid & 63, wr = wid >> 2, wc = wid & 3, fr = lane & 15, fq = lane >> 4;
    const int K = g.K, nt = K / BK;
    unsigned voffA[2], voffB[2];
#pragma unroll
    for (int i = 0; i < 2; ++i) { int R, C; stage_rc(tid * 16 + i * 8192, R, C); const int Rb = Epi::PERM ? ((R & ~31) + perm32(R & 31)) : R;
        voffA[i] = (unsigned)(R * K + C) * 2u; voffB[i] = (unsigned)(Rb * K + C) * 2u; }
    const size_t kstep = (size_t)(BK * 2);
    const size_t hstep = (size_t)HALF * K * 2;
    const size_t tstep = 2 * hstep;
    const unsigned ldsw = (unsigned)wid * 1024u;
    const int aoff = lds_byte(wr * 64 + fr, fq * 8), boff = lds_byte(wc * 32 + fr, fq * 8);
#define PG8_SA(b, h) (((b) * 2 + (h)) * HTB)
#define PG8_SB(b, h) ((4 + (b) * 2 + (h)) * HTB)
#define PG8_STAGE(bufoff, gbase, voff) do { _Pragma("unroll") for (int _i = 0; _i < 2; ++_i) \
        __builtin_amdgcn_global_load_lds((const unsigned*)((const char*)(gbase) + (voff)[_i]), (PG8_LAS unsigned*)(lds + (bufoff) + ldsw + _i * 8192), 16, 0, 0); } while (0)
#define PG8_LDA(dst, b, h) do { _Pragma("unroll") for (int m = 0; m < 4; ++m) _Pragma("unroll") for (int k = 0; k < 2; ++k) dst[m][k] = *(const PG8_LAS bf16x8*)(lds + PG8_SA(b, h) + aoff + m * 2048 + k * 1024); } while (0)
#define PG8_LDB(dst, b, h) do { _Pragma("unroll") for (int n = 0; n < 2; ++n) _Pragma("unroll") for (int k = 0; k < 2; ++k) dst[n][k] = *(const PG8_LAS bf16x8*)(lds + PG8_SB(b, h) + boff + n * 2048 + k * 1024); } while (0)
#define PG8_MMA(ai, bj, At, Bt) do { __builtin_amdgcn_s_setprio(1); _Pragma("unroll") for (int m = 0; m < 4; ++m) _Pragma("unroll") for (int n = 0; n < 2; ++n) _Pragma("unroll") for (int k = 0; k < 2; ++k) \
        acc[ai][bj][m][n] = __builtin_amdgcn_mfma_f32_16x16x32_bf16(Bt[n][k], At[m][k], acc[ai][bj][m][n], 0, 0, 0); __builtin_amdgcn_s_setprio(0); } while (0)
#define PG8_WAIT_V(n) asm volatile("s_waitcnt vmcnt(" #n ")" ::: "memory")
#define PG8_WAIT_L(n) asm volatile("s_waitcnt lgkmcnt(" #n ")" ::: "memory")
#define PG8_BAR __builtin_amdgcn_s_barrier()
#define PG8_SCHED __builtin_amdgcn_sched_barrier(0)
    Unit cur, nxt; int ui = 0;
    if (!S.next(0, cur)) return;
    f32x4 acc[2][2][4][2];
#pragma unroll
    for (int a = 0; a < 2; ++a)
#pragma unroll
        for (int b = 0; b < 2; ++b)
#pragma unroll
            for (int m = 0; m < 4; ++m)
#pragma unroll
                for (int n = 0; n < 2; ++n) acc[a][b][m][n] = (f32x4){0.f, 0.f, 0.f, 0.f};
    bf16x8 At[4][2], B0[2][2], B1[2][2];
    const char* cA = (const char*)g.A + (size_t)cur.pm * tstep; const char* cB = (const char*)g.Bt + (size_t)cur.pn * tstep;
    S.a_ready(cur);
    if constexpr (SP2) {
        PG8_STAGE(PG8_SB(0, 0), cB, voffB); PG8_STAGE(PG8_SB(0, 1), cB + hstep, voffB); PG8_STAGE(PG8_SA(0, 0), cA, voffA); PG8_STAGE(PG8_SA(0, 1), cA + hstep, voffA);
        if (wr == 1) PG8_BAR;
        PG8_WAIT_V(2); PG8_BAR;
        PG8_STAGE(PG8_SB(1, 0), cB + kstep, voffB); PG8_STAGE(PG8_SA(1, 0), cA + kstep, voffA); PG8_STAGE(PG8_SB(1, 1), cB + hstep + kstep, voffB);
        PG8_WAIT_V(6); PG8_BAR;
    } else {
        PG8_STAGE(PG8_SB(0, 0), cB, voffB); PG8_STAGE(PG8_SA(0, 0), cA, voffA); PG8_STAGE(PG8_SB(0, 1), cB + hstep, voffB); PG8_STAGE(PG8_SA(0, 1), cA + hstep, voffA);
        if (wr == 1) PG8_BAR;
        PG8_WAIT_V(4); PG8_BAR;
        PG8_STAGE(PG8_SB(1, 0), cB + kstep, voffB); PG8_STAGE(PG8_SA(1, 0), cA + kstep, voffA); PG8_STAGE(PG8_SB(1, 1), cB + hstep + kstep, voffB);
        PG8_WAIT_V(6); PG8_BAR;
    }
    for (;;) {
        const bool has_next = S.next(ui + 1, nxt);
        const char* nA = has_next ? (const char*)g.A + (size_t)nxt.pm * tstep : cA; const char* nB = has_next ? (const char*)g.Bt + (size_t)nxt.pn * tstep : cB;
        for (int t = 0; t < nt; t += 2) {
            const bool last = (t == nt - 2);
            const char* a1 = cA + (size_t)(t + 1) * kstep;
            const char* a2 = last ? nA : cA + (size_t)(t + 2) * kstep; const char* b2 = last ? nB : cB + (size_t)(t + 2) * kstep;
            const char* a3 = a2 + kstep; const char* b3 = b2 + kstep;
            if (last && has_next) S.a_ready(nxt);
            if constexpr (SP2) {
            PG8_LDB(B0, 0, 0); PG8_LDB(B1, 0, 1); PG8_SCHED; PG8_LDA(At, 0, 0); PG8_STAGE(PG8_SA(1, 1), a1 + hstep, voffA);
            PG8_WAIT_V(8); PG8_WAIT_L(0); PG8_BAR; PG8_MMA(0, 0, At, B0); PG8_MMA(0, 1, At, B1); PG8_BAR; PG8_SCHED;
            PG8_LDA(At, 0, 1); PG8_STAGE(PG8_SB(0, 0), b2, voffB); PG8_STAGE(PG8_SB(0, 1), b2 + hstep, voffB); PG8_STAGE(PG8_SA(0, 0), a2, voffA);
            PG8_WAIT_V(8); PG8_WAIT_L(0); PG8_BAR; PG8_MMA(1, 0, At, B0); PG8_MMA(1, 1, At, B1); PG8_BAR; PG8_SCHED;
            PG8_LDB(B0, 1, 0); PG8_LDB(B1, 1, 1); PG8_SCHED; PG8_LDA(At, 1, 0); PG8_STAGE(PG8_SA(0, 1), a2 + hstep, voffA);
            PG8_WAIT_V(8); PG8_WAIT_L(0); PG8_BAR; PG8_MMA(0, 0, At, B0); PG8_MMA(0, 1, At, B1); PG8_BAR; PG8_SCHED;
            PG8_LDA(At, 1, 1); PG8_STAGE(PG8_SB(1, 0), b3, voffB); PG8_STAGE(PG8_SB(1, 1), b3 + hstep, voffB); PG8_STAGE(PG8_SA(1, 0), a3, voffA);
            PG8_WAIT_V(8); PG8_WAIT_L(0); PG8_BAR; PG8_MMA(1, 0, At, B0); PG8_MMA(1, 1, At, B1); PG8_BAR; PG8_SCHED;
            } else {
            PG8_LDB(B0, 0, 0); PG8_SCHED; PG8_LDA(At, 0, 0); PG8_STAGE(PG8_SA(1, 1), a1 + hstep, voffA);
            PG8_WAIT_L(8); PG8_BAR; PG8_WAIT_L(0); PG8_MMA(0, 0, At, B0); PG8_BAR; PG8_SCHED;
            PG8_LDB(B1, 0, 1); PG8_STAGE(PG8_SB(0, 0), b2, voffB);
            PG8_BAR; PG8_WAIT_L(0); PG8_MMA(0, 1, At, B1); PG8_BAR;
            PG8_LDA(At, 0, 1); PG8_STAGE(PG8_SA(0, 0), a2, voffA);
            PG8_BAR; PG8_WAIT_L(0); PG8_MMA(1, 0, At, B0); PG8_BAR; PG8_SCHED;
            PG8_STAGE(PG8_SB(0, 1), b2 + hstep, voffB);
            PG8_WAIT_V(6); PG8_BAR; PG8_MMA(1, 1, At, B1); PG8_BAR;
            PG8_LDB(B0, 1, 0); PG8_SCHED; PG8_LDA(At, 1, 0); PG8_STAGE(PG8_SA(0, 1), a2 + hstep, voffA);
            PG8_WAIT_L(8); PG8_BAR; PG8_WAIT_L(0); PG8_MMA(0, 0, At, B0); PG8_BAR; PG8_SCHED;
            PG8_LDB(B1, 1, 1); PG8_STAGE(PG8_SB(1, 0), b3, voffB);
            PG8_BAR; PG8_WAIT_L(0); PG8_MMA(0, 1, At, B1); PG8_BAR;
            PG8_LDA(At, 1, 1); PG8_STAGE(PG8_SA(1, 0), a3, voffA);
            PG8_BAR; PG8_WAIT_L(0); PG8_MMA(1, 0, At, B0); PG8_BAR; PG8_SCHED;
            PG8_STAGE(PG8_SB(1, 1), b3 + hstep, voffB);
            PG8_WAIT_V(6); PG8_BAR; PG8_MMA(1, 1, At, B1); PG8_BAR;
            }
        }
        if constexpr (ALIGN_EPI) { if (wr == 0) PG8_BAR; }
        if constexpr (!Epi::AFTER_DRAIN) { E(acc, cur, wr, wc, fr, fq); S.done(cur); }
        if (!has_next) break;
#pragma unroll
        for (int a = 0; a < 2; ++a)
#pragma unroll
            for (int b = 0; b < 2; ++b)
#pragma unroll
                for (int m = 0; m < 4; ++m)
#pragma unroll
                    for (int n = 0; n < 2; ++n) acc[a][b][m][n] = (f32x4){0.f, 0.f, 0.f, 0.f};
        cur = nxt; cA = nA; cB = nB; ++ui;
        if constexpr (ALIGN_EPI) { if (wr == 1) PG8_BAR; }
    }
    PG8_WAIT_V(0);
    if constexpr (!ALIGN_EPI) { if (wr == 0) PG8_BAR; }
    PG8_BAR;
    if constexpr (Epi::AFTER_DRAIN) { E.fused(acc, cur, wr, wc, fr, fq, lds, wid, lane); S.done(cur); }
#undef PG8_SA
#undef PG8_SB
#undef PG8_STAGE
#undef PG8_LDA
#undef PG8_LDB
#undef PG8_MMA
#undef PG8_WAIT_V
#undef PG8_WAIT_L
#undef PG8_BAR
#undef PG8_SCHED
}
}
#define XB_TMO      128
#define XB_XCNT(j)  (256  + 64 * (j))
#define XB_XSUB(j)  (1280 + 64 * (j))
#define XB_XGEN(j)  (2304 + 64 * (j))
#define XB_TOP      3328
#define XB_TOPGEN   3392
#define XCD_BAR_WORDS 3456
#define XB_SPIN_CAP (1u << 18)

__device__ __forceinline__ unsigned xb_ld(unsigned* p)              { return __hip_atomic_load(p, __ATOMIC_RELAXED, __HIP_MEMORY_SCOPE_AGENT); }
__device__ __forceinline__ unsigned xb_add(unsigned* p, unsigned v) { return __hip_atomic_fetch_add(p, v, __ATOMIC_RELAXED, __HIP_MEMORY_SCOPE_AGENT); }
__device__ __forceinline__ unsigned xb_xcc_id() { return (unsigned)__builtin_amdgcn_s_getreg((3 << 11) | 20) & 0xFu; }
#define XB_SPIN(cond, bar) do { unsigned _sp = 0; while (cond) { __builtin_amdgcn_s_sleep(1); \
    if ((++_sp & 255u) == 0u) { if (xb_ld(&(bar)[XB_TMO])) break; if (_sp > XB_SPIN_CAP) { atomicAdd(&(bar)[XB_TMO], 1u); break; } } } } while (0)

struct XcdBarrier {
    unsigned* bar; unsigned x;
    volatile LAS unsigned* st;
};

__device__ __forceinline__ XcdBarrier xcd_barrier_post(unsigned* bar, volatile LAS unsigned* st) {
    XcdBarrier b; b.bar = bar; b.x = xb_xcc_id(); b.st = st;
    if (threadIdx.x == 0) (void)xb_add(&bar[XB_XCNT(b.x)], 1u);
    return b;
}
__device__ __forceinline__ void xcd_barrier_complete(unsigned* bar, unsigned x, unsigned& nloc, unsigned& nx) {
    const unsigned G = gridDim.x * gridDim.y * gridDim.z;
    unsigned sum, cnt, mine, sp = 0u;
    for (;;) {
        sum = 0u; cnt = 0u; mine = 0u;
#pragma unroll
        for (unsigned j = 0; j < 16; ++j) { const unsigned c = xb_ld(&bar[XB_XCNT(j)]); sum += c; cnt += (c > 0u) ? 1u : 0u; mine = (j == x) ? c : mine; }
        if (sum == G) break;
        __builtin_amdgcn_s_sleep(1);
        if ((++sp & 255u) == 0u) { if (xb_ld(&bar[XB_TMO])) break; if (sp > XB_SPIN_CAP) { atomicAdd(&bar[XB_TMO], 1u); break; } }
    }
    nloc = mine > 0u ? mine : 1u; nx = cnt > 0u ? cnt : 1u;
}

__device__ __forceinline__ void xcd_barrier(const XcdBarrier& b) {
    asm volatile("s_waitcnt vmcnt(0)" ::: "memory");
    __syncthreads();
    if (threadIdx.x == 0) {
        unsigned* bar = b.bar;
        __builtin_amdgcn_s_waitcnt(0);
        unsigned nloc = b.st[0], nx = b.st[1];
        if (nloc == 0u) { xcd_barrier_complete(bar, b.x, nloc, nx); b.st[0] = nloc; b.st[1] = nx; }
        const unsigned old = xb_add(&bar[XB_XSUB(b.x)], 1u);
        const unsigned gen = old / nloc;
        if (old + 1u == (gen + 1u) * nloc) {
            __builtin_amdgcn_fence(__ATOMIC_RELEASE, "agent");
            asm volatile("s_waitcnt vmcnt(0)" ::: "memory");
            const unsigned og = xb_add(&bar[XB_TOP], 1u);
            const unsigned tg = og / nx;
            if (og + 1u == (tg + 1u) * nx) xb_add(&bar[XB_TOPGEN], 1u);
            else XB_SPIN(xb_ld(&bar[XB_TOPGEN]) == tg, bar);
            __builtin_amdgcn_fence(__ATOMIC_ACQUIRE, "agent");
            xb_add(&bar[XB_XGEN(b.x)], 1u);
            asm volatile("s_waitcnt vmcnt(0)" ::: "memory");
        } else {
            XB_SPIN(xb_ld(&bar[XB_XGEN(b.x)]) == gen, bar);
            __builtin_amdgcn_fence(__ATOMIC_ACQUIRE, "agent");
            asm volatile("s_waitcnt vmcnt(0)" ::: "memory");
        }
    }
    __syncthreads();
}
struct Args { const void* in[31]; float* out; unsigned char* ws; int ph_lo, ph_hi, li, pad; };
struct Frame {
    LAS unsigned char* lds; volatile LAS unsigned* MISC; gu32* ctl;
    int tid, lane, wave, vcu, G;
    unsigned char* ws; float* out;
};
__device__ __forceinline__ float wave_sum_f(float v) {
#pragma unroll
    for (int o = 1; o < 64; o <<= 1) v += __shfl_xor(v, o);
    return v;
}
__device__ __forceinline__ void p0_transpose_item(const float* W, int K, int N, bf16_t* WT, int row_off, LAS float* scr, int kb, int nb, int lane) {
    const int k0 = 64 * kb, n0 = 32 * nb;
#pragma unroll 8
    for (int i = 0; i < 32; ++i) { const int kk = 2 * i + (lane >> 5); scr[kk * 33 + (lane & 31)] = W[(size_t)(k0 + kk) * N + n0 + (lane & 31)]; }
    LDS_WAIT(); asm volatile("" ::: "memory");
    const int c = lane & 7;
#pragma unroll
    for (int j = 0; j < 4; ++j) { const int n = (lane >> 3) + 8 * j; const LAS float* s = scr + (8 * c) * 33 + n;
        v4u o; o.x = pk2(s[0 * 33], s[1 * 33]); o.y = pk2(s[2 * 33], s[3 * 33]); o.z = pk2(s[4 * 33], s[5 * 33]); o.w = pk2(s[6 * 33], s[7 * 33]);
        *(GAS v4u*)(WT + (size_t)(row_off + n0 + n) * K + k0 + 8 * c) = o; }
    LDS_WAIT(); asm volatile("" ::: "memory");
}
__device__ __forceinline__ int lru_chan(int ks, int hi, int j) { return 32 * (ks >> 1) + 16 * (ks & 1) + 8 * (j >> 2) + 4 * hi + (j & 3); }
__device__ __forceinline__ void phase_prologue(Frame& F, const Inputs& I) {
    if (blockIdx.x < 192) {
        LAS float* sl = (LAS float*)F.lds; LAS float* red = sl + 4096;
        for (int i = F.tid; i < 4096; i += 512) { const float v = I.c[i]; sl[i] = v / (1.f + __expf(-v)); }
        __syncthreads();
        const int col0 = blockIdx.x * 32, kg = F.tid >> 5, col = F.tid & 31;
        float a0 = 0.f, a1 = 0.f, a2 = 0.f, a3 = 0.f;
#pragma unroll 8
        for (int i = 0; i < 64; ++i) { const int k = kg + 16 * i; const float w = I.w_ada[(size_t)k * MODW + col0 + col];
            a0 += sl[k] * w; a1 += sl[1024 + k] * w; a2 += sl[2048 + k] * w; a3 += sl[3072 + k] * w; }
        red[(kg * 4 + 0) * 32 + col] = a0; red[(kg * 4 + 1) * 32 + col] = a1; red[(kg * 4 + 2) * 32 + col] = a2; red[(kg * 4 + 3) * 32 + col] = a3;
        __syncthreads();
        if (F.tid < 128) { const int b = F.tid >> 5, c = F.tid & 31; float s = I.b_ada[col0 + c];
            for (int g = 0; g < 16; ++g) s += red[(g * 4 + b) * 32 + c];
            ((float*)(F.ws + WS_MOD))[b * MODW + col0 + c] = s; }
        __syncthreads();
    }
    {
        LAS float* scr = (LAS float*)(F.lds + F.wave * 16384);
        const int gw = F.vcu * NWAVES + F.wave, NGW = F.G * NWAVES;
        bf16_t* WIN = (bf16_t*)(F.ws + WSX_WIN); bf16_t* WOUT = (bf16_t*)(F.ws + WSX_WOUT); bf16_t* W1T = (bf16_t*)(F.ws + WSX_W1T); bf16_t* W2T = (bf16_t*)(F.ws + WSX_W2T);
        constexpr int I_IN = 16 * 46, I_OUT = 16 * 32, I_G = 32 * 16 * 8, I_D = 32 * 4 * 32, NIT = I_IN + I_OUT + 2 * I_G + I_D;
        for (int it = gw; it < NIT; it += NGW) {
            int r = it;
            if (r < I_IN) { p0_transpose_item(I.w_in, 1024, NPROJ, WIN, 0, scr, r / 46, r % 46, F.lane); continue; } r -= I_IN;
            if (r < I_OUT) { p0_transpose_item(I.w_out, 1024, 1024, WOUT, 0, scr, r / 32, r % 32, F.lane); continue; } r -= I_OUT;
            if (r < 2 * I_G) { const int up = r >= I_G ? 1 : 0; if (up) r -= I_G; const int e = r >> 7, kb = (r >> 3) & 15, nb = r & 7, n0 = 32 * nb;
                p0_transpose_item((up ? I.w_up : I.w_gate) + (size_t)e * 1024 * 256, 1024, 256, W1T, e * 512 + (n0 >> 7) * 256 + (n0 & 127) - n0 + up * 128, scr, kb, nb, F.lane); continue; } r -= 2 * I_G;
            { const int e = r >> 7, kb = (r >> 5) & 3, nb = r & 31; p0_transpose_item(I.w_down + (size_t)e * 256 * 1024, 256, 1024, W2T, e * 1024, scr, kb, nb, F.lane); }
        }
    }
    {
        const int gt = blockIdx.x * 512 + F.tid, NGT = F.G * 512;
        v4u* WQF = (v4u*)(F.ws + WSX_WQF); v4u* WKVF = (v4u*)(F.ws + WSX_WKVF); v4u* WAF = (v4u*)(F.ws + WSX_WAF); v4u* WXF = (v4u*)(F.ws + WSX_WXF); v4u* WRF = (v4u*)(F.ws + WSX_WRF);
        constexpr int NQ = 4 * 6 * 16 * 64, NKV = 4 * 8 * 8 * 64, NA = 4 * 4 * 8 * 64, NR = 2 * 64 * 64, NZ = 64 * 1024 / 8, NTOT = NQ + NKV + 2 * NA + NR + NZ;
        for (int g = gt; g < NTOT; g += NGT) {
            int r = g; float v[8];
            if (r < NQ) { const int lane = r & 63, ks = (r >> 6) & 15, hn = r >> 10, h = hn / 6, nb = hn % 6, hi = lane >> 5, r32 = lane & 31;
#pragma unroll
                for (int j = 0; j < 8; ++j) { const int k = 16 * ks + 8 * hi + j; v[j] = I.w_q_b[(size_t)k * 768 + h * 192 + 32 * nb + r32] * I.q_a_norm[k]; }
                WQF[r] = (v4u){pk2(v[0], v[1]), pk2(v[2], v[3]), pk2(v[4], v[5]), pk2(v[6], v[7])}; continue; } r -= NQ;
            if (r < NKV) { const int lane = r & 63, ks = (r >> 6) & 7, hn = r >> 9, h = hn >> 3, nb = hn & 7, hi = lane >> 5, r32 = lane & 31;
#pragma unroll
                for (int j = 0; j < 8; ++j) { const int k = 16 * ks + 8 * hi + j; v[j] = I.w_kv_b[(size_t)k * 1024 + h * 256 + 32 * nb + r32] * I.kv_a_norm[k]; }
                WKVF[r] = (v4u){pk2(v[0], v[1]), pk2(v[2], v[3]), pk2(v[4], v[5]), pk2(v[6], v[7])}; continue; } r -= NKV;
            if (r < 2 * NA) { const int x = r >= NA ? 1 : 0; if (x) r -= NA; const int lane = r & 63, ks = (r >> 6) & 7, hn = r >> 9, h = hn >> 2, nb = hn & 3, hi = lane >> 5, r32 = lane & 31;
                const float* W = x ? I.lru_wx : I.lru_wa;
#pragma unroll
                for (int j = 0; j < 8; ++j) v[j] = W[(size_t)(h * 128 + lru_chan(ks, hi, j)) * 128 + 32 * nb + r32];
                (x ? WXF : WAF)[r] = (v4u){pk2(v[0], v[1]), pk2(v[2], v[3]), pk2(v[4], v[5]), pk2(v[6], v[7])}; continue; } r -= 2 * NA;
            if (r < NR) { const int lane = r & 63, ks = (r >> 6) & 63, nb = r >> 12, hi = lane >> 5, n = 32 * nb + (lane & 31);
#pragma unroll
                for (int j = 0; j < 8; ++j) { const int k = 16 * ks + 8 * hi + j; v[j] = n < 4 ? I.w_rg[k * 4 + n] : (n < 36 ? I.w_re[k * 32 + n - 4] : 0.f); }
                WRF[r] = (v4u){pk2(v[0], v[1]), pk2(v[2], v[3]), pk2(v[4], v[5]), pk2(v[6], v[7])}; continue; } r -= NR;
            ((v4u*)(F.ws + WSX_WIN + (size_t)NPROJ * 1024 * 2))[r] = (v4u){0u, 0u, 0u, 0u};
        }
        if (gt < 512) ((float*)(F.ws + WSX_SP))[gt] = log1pf(__expf(-I.lru_lambda[gt]));
        float* CS = (float*)(F.ws + WSX_CS);
        for (int g = gt; g < NTOK * 32; g += NGT) { const int t = g >> 5, i = g & 31; float c, s; rope_cs(I.positions[t], i, c, s); CS[t * 64 + i] = c; CS[t * 64 + 32 + i] = s; }
    }
}
__device__ __forceinline__ void phase_xn(Frame& F, const Inputs& I) {
    LAS float* Gs = (LAS float*)F.lds; LAS float* Ss = Gs + 4096;
    const float* mod = (const float*)(F.ws + WS_MOD);
    for (int i = F.tid; i < 4096; i += 512) { const int b = i >> 10, k = i & 1023; Gs[i] = I.norm1_g[k] * (1.f + mod[b * MODW + 1024 + k]); Ss[i] = mod[b * MODW + k]; }
    __syncthreads();
    bf16_t* XN = (bf16_t*)(F.ws + WSX_A);
    const int gw = F.vcu * NWAVES + F.wave, NGW = F.G * NWAVES;
    for (int m = gw; m < NTOK; m += NGW) {
        const GAS f32x4* xr = (const GAS f32x4*)(I.x + (size_t)m * DM) + F.lane; const int b = m >> 13;
        f32x4 v[4]; float s = 0.f;
#pragma unroll
        for (int j = 0; j < 4; ++j) { v[j] = xr[64 * j]; s += (v[j].x * v[j].x + v[j].y * v[j].y) + (v[j].z * v[j].z + v[j].w * v[j].w); }
        const float rstd = rsqrtf(wave_sum_f(s) * (1.f / DM) + EPS);
        GAS v2u* o8 = (GAS v2u*)(XN + (size_t)m * DM) + F.lane;
#pragma unroll
        for (int j = 0; j < 4; ++j) { const f32x4 g = *(const LAS f32x4*)(Gs + b * 1024 + 256 * j + 4 * F.lane), sh = *(const LAS f32x4*)(Ss + b * 1024 + 256 * j + 4 * F.lane);
            const f32x4 o = v[j] * rstd * g + sh; o8[64 * j] = (v2u){pk2(o.x, o.y), pk2(o.z, o.w)}; }
    }
    __syncthreads();
}
namespace att {
constexpr int NW = 8, QBLK = 32, KVBLK = 64, QB = NW * QBLK;
constexpr int DQ = 192, DVV = 128, OPITCH = 1024;
constexpr int SHM_V = KVBLK * DVV * 2, SHM_K = KVBLK * DQ * 2;
constexpr int ATT_LDS = 2 * SHM_V + 2 * SHM_K + NW * 64 * 4;
constexpr float SCALE = 0.07216878364870322f;
constexpr float THR = 8.f;
#define SBAR() __builtin_amdgcn_sched_barrier(0)
__device__ __forceinline__ int koff(int row, int chunk) { return (chunk >> 3) * 8192 + row * 128 + ((((chunk & 7) ^ ((row >> 1) & 7))) << 4); }
__device__ __forceinline__ int v_st(int k, int c) { const int kk = (k & ~0xC) | ((k & 4) << 1) | ((k & 8) >> 1); return ((kk >> 3) * 4 + (c >> 5)) * 512 + ((kk & 7) * 32 + (c & 31)) * 2; }
__device__ __forceinline__ int v_rd_base(int lane) { return ((lane & 3) << 3) | (((lane >> 2) & 3) << 6) | (((lane >> 4) & 1) << 5) | (((lane >> 5) & 1) << 8); }
constexpr int v_rd_off(int d0, int ks, int half) { return d0 * 512 + ks * 4096 + half * 2048; }
__device__ __forceinline__ int crow(int r, int hi) { return (r & 3) + 8 * (r >> 2) + 4 * hi; }
__device__ __forceinline__ bf16x8 ld8(const bf16_t* p) { return *reinterpret_cast<const bf16x8*>(p); }
__device__ __forceinline__ void mask_tile(f32x16& p0, f32x16& p1, int dq) {
    const float NEG = -__builtin_inff();
#pragma unroll
    for (int r = 0; r < 16; ++r) { const int c = (r & 3) + 8 * (r >> 2); if (dq - c < 0) p0[r] = NEG; if (dq - c - 32 < 0) p1[r] = NEG; }
}
__device__ __forceinline__ void partialSM(f32x16& p0, f32x16& p1, float& m_reg, float& mn, float& alpha) {
    float pmax = p0[0];
#pragma unroll
    for (int r = 1; r < 16; ++r) pmax = fmaxf(pmax, p0[r]);
#pragma unroll
    for (int r = 0; r < 16; ++r) pmax = fmaxf(pmax, p1[r]);
    { auto rr = __builtin_amdgcn_permlane32_swap(__float_as_uint(pmax), __float_as_uint(pmax), false, false); pmax = fmaxf(__uint_as_float(rr[0]), __uint_as_float(rr[1])); }
    constexpr float C2 = 1.4426950408889634f * SCALE;
    if (__builtin_expect(__all((pmax - m_reg) * SCALE <= THR), 1)) { mn = m_reg; alpha = 1.f; }
    else { mn = fmaxf(m_reg, pmax); alpha = __builtin_amdgcn_exp2f((m_reg - mn) * C2); m_reg = mn; }
    const float mnL = -mn * C2;
#pragma unroll
    for (int r = 0; r < 16; ++r) p0[r] = fmaf(p0[r], C2, mnL);
#pragma unroll
    for (int r = 0; r < 16; ++r) p1[r] = fmaf(p1[r], C2, mnL);
#pragma unroll
    for (int r = 0; r < 16; ++r) p0[r] = __builtin_amdgcn_exp2f(p0[r]);
}
__device__ __forceinline__ void finishSM(f32x16& p0, f32x16& p1, float alpha, float& l_reg, bf16x8& pa0, bf16x8& pa1, bf16x8& pa2, bf16x8& pa3) {
#pragma unroll
    for (int r = 0; r < 16; ++r) p1[r] = __builtin_amdgcn_exp2f(p1[r]);
    float ps = 0;
#pragma unroll
    for (int r = 0; r < 16; ++r) ps += p0[r];
#pragma unroll
    for (int r = 0; r < 16; ++r) ps += p1[r];
    { auto rr = __builtin_amdgcn_permlane32_swap(__float_as_uint(ps), __float_as_uint(ps), false, false); ps = __uint_as_float(rr[0]) + __uint_as_float(rr[1]); }
    l_reg = l_reg * alpha + ps;
#define PK4(P, B_, OUT) do { unsigned a0 = cvtpk(P[B_+0], P[B_+1]), a1 = cvtpk(P[B_+2], P[B_+3]); unsigned b0 = cvtpk(P[B_+4], P[B_+5]), b1 = cvtpk(P[B_+6], P[B_+7]); \
        auto r0 = __builtin_amdgcn_permlane32_swap(a0, b0, false, false); auto r1 = __builtin_amdgcn_permlane32_swap(a1, b1, false, false); \
        v4u w = {r0[0], r1[0], r0[1], r1[1]}; OUT = *reinterpret_cast<bf16x8*>(&w); } while (0)
    PK4(p0, 0, pa0); PK4(p0, 8, pa1); PK4(p1, 0, pa2); PK4(p1, 8, pa3);
#undef PK4
}
template <int KB>
__device__ __forceinline__ void qkt(f32x16& p0, f32x16& p1, const char* K_lds, int r32, int hi, const bf16x8* qr) {
    p0 = f32x16{}; p1 = f32x16{};
    const char* kb[4];
#pragma unroll
    for (int dd = 0; dd < 4; ++dd) kb[dd] = K_lds + KB * SHM_K + koff(r32, 2 * dd + hi);
#pragma unroll
    for (int d0 = 0; d0 < 12; ++d0) { const char* a = kb[d0 & 3] + (d0 >> 2) * 8192;
        bf16x8 b0 = *reinterpret_cast<const bf16x8*>(a);
        bf16x8 b1 = *reinterpret_cast<const bf16x8*>(a + 32 * 128);
        p0 = __builtin_amdgcn_mfma_f32_32x32x16_bf16(b0, qr[d0], p0, 0, 0, 0);
        p1 = __builtin_amdgcn_mfma_f32_32x32x16_bf16(b1, qr[d0], p1, 0, 0, 0); }
}
template <int VB>
__device__ __forceinline__ void pv_tile(f32x16* o, int vb0, bf16x8 pa0, bf16x8 pa1, bf16x8 pa2, bf16x8 pa3) {
#define TRRD(dst, off) asm volatile("ds_read_b64_tr_b16 %0, %1 offset:%2" : "=&v"(dst) : "v"(vb0), "i"(off) : "memory")
#define PV_D0(d0) do { s16x4 l0, l1, l2, l3, h0, h1, h2, h3; constexpr int b_ = VB * SHM_V + v_rd_off(d0, 0, 0); \
        TRRD(l0, b_); TRRD(h0, b_ + 2048); TRRD(l1, b_ + 4096); TRRD(h1, b_ + 6144); TRRD(l2, b_ + 8192); TRRD(h2, b_ + 10240); TRRD(l3, b_ + 12288); TRRD(h3, b_ + 14336); \
        asm volatile("s_waitcnt lgkmcnt(0)" ::: "memory"); SBAR(); \
        o[d0] = __builtin_amdgcn_mfma_f32_32x32x16_bf16(pa0, (bf16x8){l0[0], l0[1], l0[2], l0[3], h0[0], h0[1], h0[2], h0[3]}, o[d0], 0, 0, 0); \
        o[d0] = __builtin_amdgcn_mfma_f32_32x32x16_bf16(pa1, (bf16x8){l1[0], l1[1], l1[2], l1[3], h1[0], h1[1], h1[2], h1[3]}, o[d0], 0, 0, 0); \
        o[d0] = __builtin_amdgcn_mfma_f32_32x32x16_bf16(pa2, (bf16x8){l2[0], l2[1], l2[2], l2[3], h2[0], h2[1], h2[2], h2[3]}, o[d0], 0, 0, 0); \
        o[d0] = __builtin_amdgcn_mfma_f32_32x32x16_bf16(pa3, (bf16x8){l3[0], l3[1], l3[2], l3[3], h3[0], h3[1], h3[2], h3[3]}, o[d0], 0, 0, 0); } while (0)
    PV_D0(0); PV_D0(1); PV_D0(2); PV_D0(3);
#undef PV_D0
#undef TRRD
}
struct BlockRef { const bf16_t* Q; const bf16_t* K; const bf16_t* V; bf16_t* O; int P0; };
struct Seam { bf16x8 qr[12]; bf16x8 st_v0, st_v1, st_k0, st_k1, st_k2; };
#define VMW() asm volatile("s_waitcnt vmcnt(0)" ::: "memory")
#define VMWN(n) asm volatile("s_waitcnt vmcnt(%0)" :: "i"(n) : "memory")
#define SLOAD_H(Kp, Vp, k0) do { S.st_v0 = ld8((Vp) + (size_t)((k0) + sr) * DVV + sc); S.st_v1 = ld8((Vp) + (size_t)((k0) + 32 + sr) * DVV + sc); \
        S.st_k0 = ld8((Kp) + (size_t)(k0) * DQ + kg0); S.st_k1 = ld8((Kp) + (size_t)(k0) * DQ + kg1); S.st_k2 = ld8((Kp) + (size_t)(k0) * DQ + kg2); } while (0)
#define SWRITE_HK(bf) do { *(bf16x8*)(K_lds + (bf) * SHM_K + kw0) = S.st_k0; *(bf16x8*)(K_lds + (bf) * SHM_K + kw1) = S.st_k1; *(bf16x8*)(K_lds + (bf) * SHM_K + kw2) = S.st_k2; } while (0)
#define SWRITE_HV(bf) do { *(bf16x8*)(V_lds + (bf) * SHM_V + vst0) = S.st_v0; *(bf16x8*)(V_lds + (bf) * SHM_V + vst1) = S.st_v1; } while (0)
#define SWRITE_H(bf) do { SWRITE_HV(bf); SWRITE_HK(bf); } while (0)
#define STAGE_IDX() const int sr = tid >> 4, sc = (tid & 15) * 8, vst0 = v_st(sr, sc), vst1 = v_st(32 + sr, sc); \
    const int kp0 = tid, kp1 = tid + 512, kp2 = tid + 1024; \
    const int kg0 = (kp0 / 24) * DQ + (kp0 % 24) * 8, kg1 = (kp1 / 24) * DQ + (kp1 % 24) * 8, kg2 = (kp2 / 24) * DQ + (kp2 % 24) * 8; \
    const int kw0 = koff(kp0 / 24, kp0 % 24), kw1 = koff(kp1 / 24, kp1 % 24), kw2 = koff(kp2 / 24, kp2 % 24)
__device__ __forceinline__ void attn_prime(const BlockRef& cur, char* lds, Seam& S) {
    const int tid = threadIdx.x, wid = __builtin_amdgcn_readfirstlane(tid >> 6), lane = tid & 63, r32 = lane & 31, hi = lane >> 5;
    STAGE_IDX(); char* K_lds = lds + 2 * SHM_V; (void)vst0; (void)vst1;
#pragma unroll
    for (int d0 = 0; d0 < 12; ++d0) S.qr[d0] = ld8(cur.Q + (size_t)(wid * QBLK + r32) * DQ + d0 * 16 + hi * 8);
    SLOAD_H(cur.K, cur.V, 0); VMW(); SWRITE_HK(0);
    __syncthreads();
}
__device__ __forceinline__ void attn_block(const BlockRef& cur, const BlockRef& nxt, char* lds, Seam& S) {
    const int tid = threadIdx.x, wid = __builtin_amdgcn_readfirstlane(tid >> 6), lane = tid & 63, r32 = lane & 31, hi = lane >> 5;
    const int NT = (cur.P0 + QB - 1) / KVBLK + 1;
    const int qlo = cur.P0 + wid * QBLK, qm = qlo + r32 - 4 * hi;
    char* V_lds = lds; char* K_lds = lds + 2 * SHM_V;
    float* ws = (float*)(lds + 2 * SHM_V + 2 * SHM_K) + wid * 64; float* li_l = ws, * al_l = ws + 32;
    float m_reg = -1e30f, l_reg = 0; f32x16 o[4] = {};
    STAGE_IDX();
    const int vb0 = (int)(uintptr_t)V_lds + v_rd_base(lane);
    const bf16_t* Kh = cur.K; const bf16_t* Vh = cur.V;
#define RESC(a) do { if (__any((a) < 1.f)) { if (hi == 0) al_l[r32] = (a); asm volatile("s_waitcnt lgkmcnt(0)" ::: "memory"); \
                     _Pragma("unroll") for (int d_ = 0; d_ < 4; ++d_) _Pragma("unroll") for (int r = 0; r < 16; ++r) o[d_][r] *= al_l[crow(r, hi)]; } } while (0)
#define KBASE(t) ((t) * KVBLK)
#define MASKT(P0_, P1_, t) do { const int kb_ = KBASE(t); if (kb_ + KVBLK - 1 > qlo) mask_tile(P0_, P1_, qm - kb_); } while (0)
    f32x16 p0, p1; float mn, al; bf16x8 pa0, pa1, pa2, pa3;
    SWRITE_HV(0); SBAR();
    SLOAD_H(Kh, Vh, KBASE(1));
    SBAR(); qkt<0>(p0, p1, K_lds, r32, hi, S.qr);
    MASKT(p0, p1, 0); partialSM(p0, p1, m_reg, mn, al); finishSM(p0, p1, al, l_reg, pa0, pa1, pa2, pa3);
    VMW(); SWRITE_H(1);
    __syncthreads();
#define STEP(t, KB, VB, SB, STAGE) do { \
        SBAR(); qkt<KB>(p0, p1, K_lds, r32, hi, S.qr); SBAR(); \
        if (STAGE) { SLOAD_H(Kh, Vh, KBASE((t) + 1)); SBAR(); } \
        pv_tile<VB>(o, vb0, pa0, pa1, pa2, pa3); MASKT(p0, p1, (t)); partialSM(p0, p1, m_reg, mn, al); \
        __syncthreads(); \
        if (STAGE) { VMW(); SWRITE_H(SB); } \
        RESC(al); finishSM(p0, p1, al, l_reg, pa0, pa1, pa2, pa3); \
        __syncthreads(); } while (0)
    for (int t = 1; t + 1 < NT; t += 2) {
        STEP(t, 1, 0, 0, true);
        STEP(t + 1, 0, 1, 1, true);
    }
    STEP(NT - 1, 1, 0, 0, false);
    SLOAD_H(nxt.K, nxt.V, 0); SBAR();
#pragma unroll
    for (int d0 = 0; d0 < 12; ++d0) S.qr[d0] = ld8(nxt.Q + (size_t)(wid * QBLK + r32) * DQ + d0 * 16 + hi * 8);
    SBAR();
    pv_tile<1>(o, vb0, pa0, pa1, pa2, pa3);
    SBAR(); VMWN(12); SWRITE_HK(0); SBAR();
    if (hi == 0) li_l[r32] = l_reg; asm volatile("s_waitcnt lgkmcnt(0)" ::: "memory");
    float rli[16];
#pragma unroll
    for (int r = 0; r < 16; ++r) rli[r] = __builtin_amdgcn_rcpf(li_l[crow(r, hi)]);
    bf16_t* Ow = cur.O + (size_t)(wid * QBLK) * OPITCH;
#pragma unroll
    for (int r = 0; r < 16; ++r) { const int orow = crow(r, hi);
#pragma unroll
        for (int d0 = 0; d0 < 4; ++d0) { const float v = o[d0][r] * rli[r]; const float vn = __shfl_xor(v, 1);
            if ((r32 & 1) == 0) *(unsigned*)(Ow + (size_t)orow * OPITCH + d0 * 32 + r32) = cvtpk(v, vn); } }
    __syncthreads();
#undef RESC
#undef KBASE
#undef MASKT
#undef STEP
}
#undef VMW
#undef VMWN
#undef SLOAD_H
#undef SWRITE_HK
#undef SWRITE_HV
#undef SWRITE_H
#undef STAGE_IDX
#undef SBAR
__device__ __forceinline__ BlockRef make_ref(int L, int pass, const bf16_t* Q, const bf16_t* K, const bf16_t* V, bf16_t* O) {
    const int bh = L >> 4, x = L & 15, qb = pass ? 31 - x : x, b = bh >> 2, h = bh & 3;
    BlockRef r; r.Q = Q + ((size_t)bh * 8192 + (size_t)qb * QB) * DQ; r.K = K + (size_t)bh * 8192 * DQ; r.V = V + (size_t)bh * 8192 * DVV;
    r.O = O + ((size_t)b * 8192 + (size_t)qb * QB) * OPITCH + h * DVV; r.P0 = qb * QB; return r;
}
__device__ __forceinline__ void attn_phase(char* lds, const bf16_t* Q, const bf16_t* K, const bf16_t* V, bf16_t* O, int G, int bid) {
    const int total = 256;
    int L = bid; if (L >= total) return;
    int pass = 0; BlockRef cur = make_ref(L, 0, Q, K, V, O);
    Seam S; attn_prime(cur, lds, S);
    for (;;) {
        const bool more_pass = pass == 0, more_item = L + G < total, last = !more_pass && !more_item;
        int passn = pass + 1, Ln = L; if (!more_pass) { passn = 0; Ln = more_item ? L + G : L; }
        const BlockRef nxt = last ? cur : make_ref(Ln, passn, Q, K, V, O);
        attn_block(cur, nxt, lds, S);
        if (last) break;
        cur = nxt; pass = passn; L = Ln;
    }
}
}
namespace prj {
__device__ __forceinline__ int crow(int r, int hi) { return (r & 3) + 8 * (r >> 2) + 4 * hi; }
__device__ __forceinline__ float swap_add(float v) { auto rr = __builtin_amdgcn_permlane32_swap(__float_as_uint(v), __float_as_uint(v), false, false); return __uint_as_float(rr[0]) + __uint_as_float(rr[1]); }
__device__ __forceinline__ float sumsq8(bf16x8 v) { float s = 0.f;
#pragma unroll
    for (int j = 0; j < 8; ++j) { const float f = bf2f((bf16_t)v[j]); s += f * f; } return s; }
__device__ __forceinline__ bf16x8 ldg8(const bf16_t* p) { return *reinterpret_cast<const bf16x8*>(p); }
__device__ __forceinline__ v2u pack4(float a, float b, float c, float d) { return (v2u){cvtpk(a, b), cvtpk(c, d)}; }

__device__ __forceinline__ void unit_q(const Inputs& I, unsigned char* ws, int grp, int lane) {
    const int r32 = lane & 31, hi = lane >> 5, t = grp * 32 + r32, b = t >> 13, s = t & 8191;
    const bf16_t* pr = (const bf16_t*)(ws + WSX_B) + (size_t)t * PROJP + C_QLAT + 8 * hi;
    bf16x8 bq[16]; float ssq = 0.f;
#pragma unroll
    for (int ks = 0; ks < 16; ++ks) { bq[ks] = ldg8(pr + 16 * ks); ssq += sumsq8(bq[ks]); }
    const float msq = swap_add(ssq) * (1.f / 256.f) + EPS;
    const bf16x8* WQF = (const bf16x8*)(ws + WSX_WQF) + lane;
    const float* cs = (const float*)(ws + WSX_CS) + (size_t)t * 64;
#pragma unroll 1
    for (int h = 0; h < 4; ++h) {
        f32x16 acc[6];
#pragma unroll
        for (int nb = 0; nb < 6; ++nb) { acc[nb] = f32x16{};
#pragma unroll
            for (int ks = 0; ks < 16; ++ks) acc[nb] = __builtin_amdgcn_mfma_f32_32x32x16_bf16(WQF[((h * 6 + nb) * 16 + ks) * 64], bq[ks], acc[nb], 0, 0, 0); }
        float ss = 0.f;
#pragma unroll
        for (int nb = 0; nb < 6; ++nb)
#pragma unroll
            for (int r = 0; r < 16; ++r) ss += acc[nb][r] * acc[nb][r];
        const float rs = rsqrtf(swap_add(ss) * (1.f / 192.f) + EPS * msq);
        bf16_t* qp = (bf16_t*)(ws + WSX_Q) + ((size_t)(b * 4 + h) * 8192 + s) * 192;
#pragma unroll
        for (int nb = 0; nb < 4; ++nb)
#pragma unroll
            for (int q = 0; q < 4; ++q) { const int n = 32 * nb + 8 * q + 4 * hi; const f32x4 g = *(const f32x4*)(I.q_norm + n);
                *(v2u*)(qp + n) = pack4(acc[nb][4 * q] * rs * g[0], acc[nb][4 * q + 1] * rs * g[1], acc[nb][4 * q + 2] * rs * g[2], acc[nb][4 * q + 3] * rs * g[3]); }
#pragma unroll
        for (int q = 0; q < 4; ++q) { const int j = 8 * q + 4 * hi; const f32x4 g1 = *(const f32x4*)(I.q_norm + 128 + j), g2 = *(const f32x4*)(I.q_norm + 160 + j);
            const f32x4 c = *(const f32x4*)(cs + j), sn = *(const f32x4*)(cs + 32 + j);
            float o1[4], o2[4];
#pragma unroll
            for (int i = 0; i < 4; ++i) { const float x1 = acc[4][4 * q + i] * rs * g1[i], x2 = acc[5][4 * q + i] * rs * g2[i]; o1[i] = x1 * c[i] - x2 * sn[i]; o2[i] = x2 * c[i] + x1 * sn[i]; }
            *(v2u*)(qp + 128 + j) = pack4(o1[0], o1[1], o1[2], o1[3]); *(v2u*)(qp + 160 + j) = pack4(o2[0], o2[1], o2[2], o2[3]); }
    }
}
__device__ __forceinline__ void unit_kv(const Inputs& I, unsigned char* ws, int grp, int lane) {
    const int r32 = lane & 31, hi = lane >> 5, t = grp * 32 + r32, b = t >> 13, s = t & 8191;
    const bf16_t* prow = (const bf16_t*)(ws + WSX_B) + (size_t)t * PROJP;
    bf16x8 bk[8]; float ssq = 0.f;
#pragma unroll
    for (int ks = 0; ks < 8; ++ks) { bk[ks] = ldg8(prow + C_KVLAT + 8 * hi + 16 * ks); ssq += sumsq8(bk[ks]); }
    const float rstd = rsqrtf(swap_add(ssq) * (1.f / 128.f) + EPS);
    float kr1[16], kr2[16]; float ssr = 0.f;
#pragma unroll
    for (int q = 0; q < 4; ++q) { const int j = 8 * q + 4 * hi; const v2u a = *(const v2u*)(prow + C_KROPE + j), c = *(const v2u*)(prow + C_KROPE + 32 + j);
        kr1[4 * q] = __uint_as_float(a.x << 16); kr1[4 * q + 1] = __uint_as_float(a.x & 0xffff0000u); kr1[4 * q + 2] = __uint_as_float(a.y << 16); kr1[4 * q + 3] = __uint_as_float(a.y & 0xffff0000u);
        kr2[4 * q] = __uint_as_float(c.x << 16); kr2[4 * q + 1] = __uint_as_float(c.x & 0xffff0000u); kr2[4 * q + 2] = __uint_as_float(c.y << 16); kr2[4 * q + 3] = __uint_as_float(c.y & 0xffff0000u); }
#pragma unroll
    for (int r = 0; r < 16; ++r) ssr += kr1[r] * kr1[r] + kr2[r] * kr2[r];
    const bf16x8* WKVF = (const bf16x8*)(ws + WSX_WKVF) + lane;
    const float* cs = (const float*)(ws + WSX_CS) + (size_t)t * 64;
#pragma unroll 1
    for (int h = 0; h < 4; ++h) {
        f32x16 acc[8];
#pragma unroll
        for (int nb = 0; nb < 8; ++nb) { acc[nb] = f32x16{};
#pragma unroll
            for (int ks = 0; ks < 8; ++ks) acc[nb] = __builtin_amdgcn_mfma_f32_32x32x16_bf16(WKVF[((h * 8 + nb) * 8 + ks) * 64], bk[ks], acc[nb], 0, 0, 0); }
        float ss = 0.f;
#pragma unroll
        for (int nb = 0; nb < 4; ++nb)
#pragma unroll
            for (int r = 0; r < 16; ++r) ss += acc[nb][r] * acc[nb][r];
        const float rs = rsqrtf(swap_add(ss * rstd * rstd + ssr) * (1.f / 192.f) + EPS), rk = rs * rstd;
        bf16_t* kp = (bf16_t*)(ws + WSX_K) + ((size_t)(b * 4 + h) * 8192 + s) * 192;
        bf16_t* vp = (bf16_t*)(ws + WSX_V) + ((size_t)(b * 4 + h) * 8192 + s) * 128;
#pragma unroll
        for (int nb = 0; nb < 4; ++nb)
#pragma unroll
            for (int q = 0; q < 4; ++q) { const int n = 32 * nb + 8 * q + 4 * hi; const f32x4 g = *(const f32x4*)(I.k_norm + n);
                *(v2u*)(kp + n) = pack4(acc[nb][4 * q] * rk * g[0], acc[nb][4 * q + 1] * rk * g[1], acc[nb][4 * q + 2] * rk * g[2], acc[nb][4 * q + 3] * rk * g[3]);
                *(v2u*)(vp + n) = pack4(acc[4 + nb][4 * q] * rstd, acc[4 + nb][4 * q + 1] * rstd, acc[4 + nb][4 * q + 2] * rstd, acc[4 + nb][4 * q + 3] * rstd); }
#pragma unroll
        for (int q = 0; q < 4; ++q) { const int j = 8 * q + 4 * hi; const f32x4 g1 = *(const f32x4*)(I.k_norm + 128 + j), g2 = *(const f32x4*)(I.k_norm + 160 + j);
            const f32x4 c = *(const f32x4*)(cs + j), sn = *(const f32x4*)(cs + 32 + j);
            float o1[4], o2[4];
#pragma unroll
            for (int i = 0; i < 4; ++i) { const float x1 = kr1[4 * q + i] * rs * g1[i], x2 = kr2[4 * q + i] * rs * g2[i]; o1[i] = x1 * c[i] - x2 * sn[i]; o2[i] = x2 * c[i] + x1 * sn[i]; }
            *(v2u*)(kp + 128 + j) = pack4(o1[0], o1[1], o1[2], o1[3]); *(v2u*)(kp + 160 + j) = pack4(o2[0], o2[1], o2[2], o2[3]); }
    }
}
__device__ __forceinline__ float dpp_shr(float v, float old, int d) {
    const int vi = __float_as_int(v), oi = __float_as_int(old); int r;
    switch (d) { case 1: r = __builtin_amdgcn_update_dpp(oi, vi, 0x111, 0xf, 0xf, false); break; case 2: r = __builtin_amdgcn_update_dpp(oi, vi, 0x112, 0xf, 0xf, false); break;
                 case 4: r = __builtin_amdgcn_update_dpp(oi, vi, 0x114, 0xf, 0xf, false); break; default: r = __builtin_amdgcn_update_dpp(oi, vi, 0x118, 0xf, 0xf, false); break; }
    return __int_as_float(r);
}
__device__ __forceinline__ float dpp_bcast15(float v, float old) {
    return __int_as_float(__builtin_amdgcn_update_dpp(__float_as_int(old), __float_as_int(v), 0x142, 0xa, 0xf, false));
}
__device__ __forceinline__ void unit_lru(const Inputs& I, unsigned char* ws, int grp, int lane) {
    const int r32 = lane & 31, hi = lane >> 5, t = grp * 32 + r32, s = t & 8191;
    const bf16_t* xrow = (const bf16_t*)(ws + WSX_B) + (size_t)t * PROJP + C_XLRU;
    const bool reset = I.positions[t] == 0;
    const float* SP = (const float*)(ws + WSX_SP);
    bf16_t* HL = (bf16_t*)(ws + WSX_D) + (size_t)t * 512; bf16_t* PC = HL + (size_t)NTOK * 512;
    float* SUMA = (float*)(ws + WSX_SUMA) + (size_t)grp * 512; float* SUMB = (float*)(ws + WSX_SUMB) + (size_t)grp * 512;
#pragma unroll 1
    for (int h = 0; h < 4; ++h) {
        bf16x8 xf[8];
#pragma unroll
        for (int ks = 0; ks < 8; ++ks) { unsigned w[4];
#pragma unroll
            for (int j4 = 0; j4 < 2; ++j4) { const int C = 128 * h + 32 * (ks >> 1) + 16 * (ks & 1) + 8 * j4 + 4 * hi;
                f32x4 v = *(const f32x4*)(I.conv_b + C);
#pragma unroll
                for (int j = 0; j < 4; ++j) { if (s - 3 + j >= 0) { const v2u x = *(const v2u*)(xrow + (ptrdiff_t)(j - 3) * PROJP + C); const f32x4 cw = *(const f32x4*)(I.conv_w + j * 512 + C);
                        v[0] += cw[0] * __uint_as_float(x.x << 16); v[1] += cw[1] * __uint_as_float(x.x & 0xffff0000u); v[2] += cw[2] * __uint_as_float(x.y << 16); v[3] += cw[3] * __uint_as_float(x.y & 0xffff0000u); } }
                w[2 * j4] = cvtpk(v[0], v[1]); w[2 * j4 + 1] = cvtpk(v[2], v[3]); }
            v4u ww = {w[0], w[1], w[2], w[3]}; xf[ks] = *reinterpret_cast<bf16x8*>(&ww); asm volatile("" ::: "memory"); }
        const bf16x8* WAF = (const bf16x8*)(ws + WSX_WAF) + lane; const bf16x8* WXF = (const bf16x8*)(ws + WSX_WXF) + lane;
#pragma unroll
        for (int nb = 0; nb < 4; ++nb) {
            f32x16 aa = f32x16{}, bb = f32x16{};
#pragma unroll
            for (int ks = 0; ks < 8; ++ks) { aa = __builtin_amdgcn_mfma_f32_32x32x16_bf16(WAF[((h * 4 + nb) * 8 + ks) * 64], xf[ks], aa, 0, 0, 0);
                                             bb = __builtin_amdgcn_mfma_f32_32x32x16_bf16(WXF[((h * 4 + nb) * 8 + ks) * 64], xf[ks], bb, 0, 0, 0); }
#pragma unroll
            for (int q = 0; q < 4; ++q) { const int C = 128 * h + 32 * nb + 8 * q + 4 * hi;
                const f32x4 ba = *(const f32x4*)(I.lru_ba + C), bx = *(const f32x4*)(I.lru_bx + C), sp = *(const f32x4*)(SP + C);
#pragma unroll
                for (int i = 0; i < 4; ++i) { const int r = 4 * q + i;
                    const float rg = 1.f / (1.f + __expf(-(aa[r] + ba[i]))), ig = 1.f / (1.f + __expf(-(bb[r] + bx[i])));
                    float a = __expf(-8.f * rg * sp[i]), mult = sqrtf(fmaxf(1.f - a * a, 0.f));
                    if (reset) { a = 0.f; mult = 1.f; }
                    const float xc = bf2f((bf16_t)xf[2 * nb + (r >> 3)][4 * ((r >> 2) & 1) + (r & 3)]);
                    aa[r] = a; bb[r] = mult * ig * xc; } }
#pragma unroll
            for (int r = 0; r < 16; ++r) { float a = aa[r], bv = bb[r];
#pragma unroll
                for (int d = 1; d < 16; d <<= 1) { const float ap = dpp_shr(a, 1.f, d), bp = dpp_shr(bv, 0.f, d); bv = a * bp + bv; a = a * ap; }
                { const float ap = dpp_bcast15(a, 1.f), bp = dpp_bcast15(bv, 0.f); bv = a * bp + bv; a = a * ap; }
                aa[r] = a; bb[r] = bv; }
#pragma unroll
            for (int q = 0; q < 4; ++q) { const int C = 128 * h + 32 * nb + 8 * q + 4 * hi;
                *(v2u*)(HL + C) = pack4(bb[4 * q], bb[4 * q + 1], bb[4 * q + 2], bb[4 * q + 3]);
                *(v2u*)(PC + C) = pack4(aa[4 * q], aa[4 * q + 1], aa[4 * q + 2], aa[4 * q + 3]);
                if (r32 == 31) { *(f32x4*)(SUMA + C) = (f32x4){aa[4 * q], aa[4 * q + 1], aa[4 * q + 2], aa[4 * q + 3]};
                                 *(f32x4*)(SUMB + C) = (f32x4){bb[4 * q], bb[4 * q + 1], bb[4 * q + 2], bb[4 * q + 3]}; } }
            asm volatile("" ::: "memory");
        }
    }
}
__device__ __forceinline__ void phase_proj(Frame& F, const Inputs& I) {
    const int gw = F.vcu * NWAVES + F.wave, NGW = F.G * NWAVES;
    for (int u = gw; u < 3 * 1024; u += NGW) {
        const int kind = u >> 10, grp = u & 1023;
        if (kind == 0) unit_q(I, F.ws, grp, F.lane); else if (kind == 1) unit_lru(I, F.ws, grp, F.lane); else unit_kv(I, F.ws, grp, F.lane);
    }
}
__device__ __forceinline__ float gelu_t(float v) { const float u = 0.7978845608028654f * (v + 0.044715f * v * v * v); return v / (1.f + __expf(-2.f * u)); }
__device__ __forceinline__ void unpack8(v4u w, float* f) {
    f[0] = __uint_as_float(w.x << 16); f[1] = __uint_as_float(w.x & 0xffff0000u); f[2] = __uint_as_float(w.y << 16); f[3] = __uint_as_float(w.y & 0xffff0000u);
    f[4] = __uint_as_float(w.z << 16); f[5] = __uint_as_float(w.z & 0xffff0000u); f[6] = __uint_as_float(w.w << 16); f[7] = __uint_as_float(w.w & 0xffff0000u); }
__device__ __forceinline__ void phase_mix(Frame& F, const Inputs& I) {
    LAS float* carry = (LAS float*)F.lds;
    const float* SUMA = (const float*)(F.ws + WSX_SUMA); const float* SUMB = (const float*)(F.ws + WSX_SUMB);
    const bf16_t* HL = (const bf16_t*)(F.ws + WSX_D); const bf16_t* PC = HL + (size_t)NTOK * 512;
    const bf16_t* PROJ = (const bf16_t*)(F.ws + WSX_B); bf16_t* MIXED = (bf16_t*)(F.ws + WSX_E);
    const int nper = 1024 / F.G;
    const int c0 = F.vcu * nper, bfirst = (c0 >> 8) << 8;
    {
        float h = 0.f; const int c = F.tid;
        for (int k = bfirst; k < c0; ++k) h = SUMA[(size_t)k * 512 + c] * h + SUMB[(size_t)k * 512 + c];
        carry[c] = h; }
    __syncthreads();
    for (int k = c0; k < c0 + nper; ++k) {
        float hl[8];
#pragma unroll 1
        for (int rr = 0; rr < 4; ++rr) {
            const int t = k * 32 + F.wave * 4 + rr, C = 8 * F.lane;
            float a[8], p[8], g[8], cy[8], v[8];
            unpack8(*(const v4u*)(HL + (size_t)t * 512 + C), a); unpack8(*(const v4u*)(PC + (size_t)t * 512 + C), p); unpack8(*(const v4u*)(PROJ + (size_t)t * PROJP + C_GLRU + C), g);
            *(f32x4*)cy = *(const LAS f32x4*)(carry + C); *(f32x4*)(cy + 4) = *(const LAS f32x4*)(carry + C + 4);
            float ss = 0.f;
#pragma unroll
            for (int j = 0; j < 8; ++j) { hl[j] = a[j] + p[j] * cy[j]; v[j] = hl[j] * gelu_t(g[j]); ss += v[j] * v[j]; }
            float rs = rsqrtf(wave_sum_f(ss) * (1.f / 512.f) + EPS);
            const f32x4 g0 = *(const f32x4*)(I.lru_out_norm + C), g1 = *(const f32x4*)(I.lru_out_norm + C + 4);
            *(v4u*)(MIXED + (size_t)t * 1024 + 512 + C) = (v4u){cvtpk(v[0] * rs * g0[0], v[1] * rs * g0[1]), cvtpk(v[2] * rs * g0[2], v[3] * rs * g0[3]), cvtpk(v[4] * rs * g1[0], v[5] * rs * g1[1]), cvtpk(v[6] * rs * g1[2], v[7] * rs * g1[3])};
            unpack8(*(const v4u*)(MIXED + (size_t)t * 1024 + C), a); ss = 0.f;
#pragma unroll
            for (int j = 0; j < 8; ++j) ss += a[j] * a[j];
            rs = rsqrtf(wave_sum_f(ss) * (1.f / 512.f) + EPS);
            const f32x4 q0 = *(const f32x4*)(I.attn_out_norm + C), q1 = *(const f32x4*)(I.attn_out_norm + C + 4);
            *(v4u*)(MIXED + (size_t)t * 1024 + C) = (v4u){cvtpk(a[0] * rs * q0[0], a[1] * rs * q0[1]), cvtpk(a[2] * rs * q0[2], a[3] * rs * q0[3]), cvtpk(a[4] * rs * q1[0], a[5] * rs * q1[1]), cvtpk(a[6] * rs * q1[2], a[7] * rs * q1[3])};
        }
        __syncthreads();
        if (F.wave == 7) {
#pragma unroll
            for (int j = 0; j < 8; ++j) carry[8 * F.lane + j] = hl[j]; }
        __syncthreads();
    }
}
}
namespace moe {
constexpr size_t WSX_RSTD = WSX_ROUTE + 800 * 1024;
constexpr size_t WSX_BB = WSX_ROUTE + 960 * 1024;
constexpr size_t WSX_WRFB = 70 * MiB;
constexpr size_t WSX_RBIAS = 70 * MiB + 512 * 1024;
constexpr int TP_OFF = LDSCTL_OFF + 512;
__device__ __forceinline__ int route_expert_of_n(int n) { const int a = (n >> 4) & 1, b = (n >> 3) & 1, h = (n >> 2) & 1, c = n & 3; return 8 * (2 * a + h) + 4 * b + c; }
__device__ __forceinline__ void router_fold(Frame& F, const Inputs& I) {
    const float* mod = (const float*)(F.ws + WS_MOD);
    const int gt = blockIdx.x * 512 + F.tid, NGT = F.G * 512;
    v4u* WRFB = (v4u*)(F.ws + WSX_WRFB);
    for (int g = gt; g < 4 * 2 * 64 * 64; g += NGT) {
        const int lane = g & 63, ks = (g >> 6) & 63, nb = (g >> 12) & 1, b = g >> 13, hi = lane >> 5, n = lane & 31; float v[8];
#pragma unroll
        for (int j = 0; j < 8; ++j) { const int k = 16 * ks + 8 * hi + j; const float gg = I.norm2_g[k] * (1.f + mod[b * MODW + 4096 + k]);
            const float w = nb == 0 ? I.w_re[k * 32 + route_expert_of_n(n)] : (n < 4 ? I.w_rg[k * 4 + n] : 0.f); v[j] = w * gg; }
        WRFB[g] = (v4u){pk2(v[0], v[1]), pk2(v[2], v[3]), pk2(v[4], v[5]), pk2(v[6], v[7])};
    }
    if (gt < 4 * 64) { const int b = gt >> 6, n = gt & 63; float s = 0.f;
        if (n < 32) { const int e = route_expert_of_n(n); s = I.b_re[e]; for (int k = 0; k < 1024; ++k) s += mod[b * MODW + 3072 + k] * I.w_re[k * 32 + e]; }
        else if (n < 36) { const int m = n - 32; s = I.b_rg[m]; for (int k = 0; k < 1024; ++k) s += mod[b * MODW + 3072 + k] * I.w_rg[k * 4 + m]; }
        ((float*)(F.ws + WSX_RBIAS))[gt] = s; }
}
__device__ __forceinline__ float swap_other(float v) { auto rr = __builtin_amdgcn_permlane32_swap(__float_as_uint(v), __float_as_uint(v), false, false); return (threadIdx.x & 32) ? __uint_as_float(rr[0]) : __uint_as_float(rr[1]); }
__device__ __forceinline__ void phase_route(Frame& F) {
    LAS int* lcnt = (LAS int*)(F.lds);
    if (F.tid < 32) lcnt[F.tid] = 0;
    __syncthreads();
    const float* x1 = F.out;
    int2* rexp = (int2*)(F.ws + WSX_ROUTE); float2* rw = (float2*)(F.ws + WSX_ROUTE + 256 * 1024); int2* rpos = (int2*)(F.ws + WSX_ROUTE + 512 * 1024);
    float* RSTD = (float*)(F.ws + WSX_RSTD);
    const int lane = F.lane, r32 = lane & 31, hi = lane >> 5;
    for (int grp = F.wave * F.G + blockIdx.x; grp < 1024; grp += F.G * NWAVES) {
        const int t = grp * 32 + r32, b = t >> 13;
        const float* xr = x1 + (size_t)t * DM + 8 * hi;
        const bf16x8* WF = (const bf16x8*)(F.ws + WSX_WRFB) + (size_t)b * 2 * 64 * 64 + lane;
        f32x16 a0 = f32x16{}, a1 = f32x16{}; float ss = 0.f;
#pragma unroll 4
        for (int ks = 0; ks < 64; ++ks) { const f32x4 u = *(const f32x4*)(xr + 16 * ks), v = *(const f32x4*)(xr + 16 * ks + 4);
            ss += (u[0] * u[0] + u[1] * u[1]) + (u[2] * u[2] + u[3] * u[3]) + (v[0] * v[0] + v[1] * v[1]) + (v[2] * v[2] + v[3] * v[3]);
            v4u w = {cvtpk(u[0], u[1]), cvtpk(u[2], u[3]), cvtpk(v[0], v[1]), cvtpk(v[2], v[3])}; const bf16x8 xb = *reinterpret_cast<bf16x8*>(&w);
            a0 = __builtin_amdgcn_mfma_f32_32x32x16_bf16(WF[ks * 64], xb, a0, 0, 0, 0);
            a1 = __builtin_amdgcn_mfma_f32_32x32x16_bf16(WF[(64 + ks) * 64], xb, a1, 0, 0, 0); }
        { auto rr = __builtin_amdgcn_permlane32_swap(__float_as_uint(ss), __float_as_uint(ss), false, false); ss = __uint_as_float(rr[0]) + __uint_as_float(rr[1]); }
        const float rstd = rsqrtf(ss * (1.f / DM) + EPS);
        const float* rb = (const float*)(F.ws + WSX_RBIAS) + b * 64;
        float gl0 = a1[0] * rstd + rb[32], gl1 = a1[1] * rstd + rb[33], gl2 = a1[2] * rstd + rb[34], gl3 = a1[3] * rstd + rb[35];
        int gi = 0; float gm = gl0; if (gl1 > gm) { gm = gl1; gi = 1; } if (gl2 > gm) { gm = gl2; gi = 2; } if (gl3 > gm) { gm = gl3; gi = 3; }
        float gp = 1.f / (__expf(gl0 - gm) + __expf(gl1 - gm) + __expf(gl2 - gm) + __expf(gl3 - gm));
        { const float og = swap_other(__int_as_float(gi)), op = swap_other(gp); if (hi) { gi = __float_as_int(og); gp = op; } }
        const bool owner = (gi & 1) == hi; const int hsel = gi >> 1;
        float m0 = -3e38f, m1 = -3e38f; int e0 = 0, e1 = 0;
#pragma unroll
        for (int i = 0; i < 8; ++i) { const int n = 16 * hsel + 8 * (i >> 2) + 4 * hi + (i & 3);
            const float el = (hsel ? a0[8 + i] : a0[i]) * rstd + rb[n];
            if (el > m0) { m1 = m0; e1 = e0; m0 = el; e0 = i; } else if (el > m1) { m1 = el; e1 = i; } }
        if (owner) {
            const float p1 = __expf(m1 - m0); const int E0 = gi * 8 + e0, E1 = gi * 8 + e1;
            rexp[t] = make_int2(E0, E1); rw[t] = make_float2(gp / (1.f + p1), gp * p1 / (1.f + p1));
            const int k0 = __hip_atomic_fetch_add(lcnt + E0, 1, __ATOMIC_RELAXED, __HIP_MEMORY_SCOPE_WORKGROUP), k1 = __hip_atomic_fetch_add(lcnt + E1, 1, __ATOMIC_RELAXED, __HIP_MEMORY_SCOPE_WORKGROUP);
            rpos[t] = make_int2((int)(blockIdx.x << 16) | k0, (int)(blockIdx.x << 16) | k1);
            RSTD[t] = rstd; }
    }
    __syncthreads();
    if (F.tid < 32) { const int n = lcnt[F.tid]; int base = 0;
        if (n > 0) base = (int)__hip_atomic_fetch_add((unsigned*)(F.ctl + CW_CNT + 64 * F.tid), (unsigned)n, __ATOMIC_RELAXED, __HIP_MEMORY_SCOPE_AGENT);
        ((int*)(F.ws + WSX_BB))[blockIdx.x * 32 + F.tid] = base; }
    __syncthreads();
}
__device__ __forceinline__ void moe_tables(Frame& F) {
    LAS int* tp = (LAS int*)(F.lds + TP_OFF);
    if (F.tid == 0) { int acc = 0; for (int e = 0; e < 32; ++e) { tp[e] = acc; const int c = (int)__hip_atomic_load((unsigned*)(F.ctl + CW_CNT + 64 * e), __ATOMIC_RELAXED, __HIP_MEMORY_SCOPE_AGENT); acc += (c + 255) >> 8; } tp[32] = acc; }
    __syncthreads();
}
__device__ __forceinline__ void phase_sort(Frame& F, const Inputs& I) {
    LAS float* Gs = (LAS float*)F.lds; LAS float* Ss = Gs + 4096;
    const float* mod = (const float*)(F.ws + WS_MOD);
    for (int i = F.tid; i < 4096; i += 512) { const int b = i >> 10, k = i & 1023; Gs[i] = I.norm2_g[k] * (1.f + mod[b * MODW + 4096 + k]); Ss[i] = mod[b * MODW + 3072 + k]; }
    moe_tables(F);
    const LAS int* tp = (const LAS int*)(F.lds + TP_OFF);
    const int2* rexp = (const int2*)(F.ws + WSX_ROUTE); int2* rpos = (int2*)(F.ws + WSX_ROUTE + 512 * 1024);
    const float* RSTD = (const float*)(F.ws + WSX_RSTD); const int* BB = (const int*)(F.ws + WSX_BB);
    bf16_t* XS = (bf16_t*)(F.ws + WSX_XS);
    const int gw = F.vcu * NWAVES + F.wave, NGW = F.G * NWAVES;
    for (int m = gw; m < NTOK; m += NGW) {
        const int b = m >> 13; const int2 ee = rexp[m], pp = rpos[m]; const float rstd = RSTD[m];
        const int pos0 = tp[ee.x] * 256 + BB[(pp.x >> 16) * 32 + ee.x] + (pp.x & 0xffff), pos1 = tp[ee.y] * 256 + BB[(pp.y >> 16) * 32 + ee.y] + (pp.y & 0xffff);
        const GAS f32x4* xr = (const GAS f32x4*)(F.out + (size_t)m * DM) + F.lane;
        GAS v2u* o0 = (GAS v2u*)(XS + (size_t)pos0 * DM) + F.lane; GAS v2u* o1 = (GAS v2u*)(XS + (size_t)pos1 * DM) + F.lane;
#pragma unroll
        for (int j = 0; j < 4; ++j) { const f32x4 v = xr[64 * j]; const f32x4 g = *(const LAS f32x4*)(Gs + b * 1024 + 256 * j + 4 * F.lane), sh = *(const LAS f32x4*)(Ss + b * 1024 + 256 * j + 4 * F.lane);
            const f32x4 o = v * rstd * g + sh; const v2u w = {cvtpk(o.x, o.y), cvtpk(o.z, o.w)}; o0[64 * j] = w; o1[64 * j] = w; }
        if (F.lane == 0) rpos[m] = make_int2(pos0, pos1);
    }
    __syncthreads();
}
__device__ __forceinline__ void phase_combine(Frame& F) {
    const float* mod = (const float*)(F.ws + WS_MOD);
    const float2* rw = (const float2*)(F.ws + WSX_ROUTE + 256 * 1024); const int2* rpos = (const int2*)(F.ws + WSX_ROUTE + 512 * 1024);
    const bf16_t* YS = (const bf16_t*)(F.ws + WSX_XS);
    const int gw = F.vcu * NWAVES + F.wave, NGW = F.G * NWAVES;
    for (int m = gw; m < NTOK; m += NGW) {
        const int b = m >> 13; const int2 pp = rpos[m]; const float2 ww = rw[m];
        GAS f32x4* xr = (GAS f32x4*)(F.out + (size_t)m * DM) + F.lane;
        const GAS v2u* y0 = (const GAS v2u*)(YS + (size_t)pp.x * DM) + F.lane; const GAS v2u* y1 = (const GAS v2u*)(YS + (size_t)pp.y * DM) + F.lane;
        const float* g2 = mod + b * MODW + 5120 + 4 * F.lane;
#pragma unroll
        for (int j = 0; j < 4; ++j) { const f32x4 v = xr[64 * j]; const v2u a = y0[64 * j], c = y1[64 * j]; const f32x4 g = *(const f32x4*)(g2 + 256 * j);
            f32x4 y; y[0] = ww.x * __uint_as_float(a.x << 16) + ww.y * __uint_as_float(c.x << 16); y[1] = ww.x * __uint_as_float(a.x & 0xffff0000u) + ww.y * __uint_as_float(c.x & 0xffff0000u);
            y[2] = ww.x * __uint_as_float(a.y << 16) + ww.y * __uint_as_float(c.y << 16); y[3] = ww.x * __uint_as_float(a.y & 0xffff0000u) + ww.y * __uint_as_float(c.y & 0xffff0000u);
            xr[64 * j] = v + g * y; }
    }
}
}
__global__ void __launch_bounds__(NWAVES * 64, 2) mega_fwd(Args args) {
    extern __shared__ __attribute__((aligned(16))) unsigned char lds[];
    Frame F;
    F.lds = (LAS unsigned char*)lds; F.MISC = (volatile LAS unsigned*)(F.lds + MISC_OFF);
    F.tid = threadIdx.x; F.lane = F.tid & 63; F.wave = __builtin_amdgcn_readfirstlane(F.tid >> 6);
    F.G = gridDim.x; { const int bx = blockIdx.x; F.vcu = (F.G % 8 == 0) ? (bx % 8) * (F.G / 8) + bx / 8 : bx; }
    F.ws = args.ws; F.out = args.out; F.ctl = (gu32*)(args.ws + WS_CTL);
    Inputs I;
    {   const void* const* p = args.in;
        I.x = (const float*)p[0]; I.c = (const float*)p[1]; I.positions = (const int*)p[2]; I.w_ada = (const float*)p[3]; I.b_ada = (const float*)p[4]; I.norm1_g = (const float*)p[5];
        I.w_in = (const float*)p[6]; I.q_a_norm = (const float*)p[7]; I.w_q_b = (const float*)p[8]; I.kv_a_norm = (const float*)p[9]; I.w_kv_b = (const float*)p[10]; I.q_norm = (const float*)p[11];
        I.k_norm = (const float*)p[12]; I.conv_w = (const float*)p[13]; I.conv_b = (const float*)p[14]; I.lru_wa = (const float*)p[15]; I.lru_ba = (const float*)p[16]; I.lru_wx = (const float*)p[17];
        I.lru_bx = (const float*)p[18]; I.lru_lambda = (const float*)p[19]; I.attn_out_norm = (const float*)p[20]; I.lru_out_norm = (const float*)p[21]; I.w_out = (const float*)p[22];
        I.norm2_g = (const float*)p[23]; I.w_rg = (const float*)p[24]; I.b_rg = (const float*)p[25]; I.w_re = (const float*)p[26]; I.b_re = (const float*)p[27]; I.w_gate = (const float*)p[28];
        I.w_up = (const float*)p[29]; I.w_down = (const float*)p[30]; }
    for (int u = F.tid; u < (LDS_BYTES - LDSCTL_OFF) / 4; u += NWAVES * 64) ((LAS unsigned*)(F.lds + LDSCTL_OFF))[u] = 0u;
    __syncthreads();
    XcdBarrier bar = xcd_barrier_post((unsigned*)(F.ctl + CW_BAR) + args.li * XCD_BAR_WORDS, F.MISC + 8);
    const int lo = args.ph_lo, hi = args.ph_hi;
#define IN(k) (lo <= (k) && (k) < hi)
#define SEAM(k) do { if (IN(k) && IN((k) + 1)) xcd_barrier(bar); } while (0)
    if (IN(0)) { phase_prologue(F, I); } SEAM(0);
    if (IN(1)) { moe::router_fold(F, I); phase_xn(F, I); } SEAM(1);
    if (IN(2)) {
        pg8::Gemm g{(const bf16_t*)(F.ws + WSX_A), (const bf16_t*)(F.ws + WSX_WIN), NTOK, PROJP, DM}; pg8::StaticOrder S; S.init(NTOK, PROJP, F.G, (int)blockIdx.x);
        pg8::EpiBf16<0> E{(bf16_t*)(F.ws + WSX_B), PROJP, nullptr, 0, 0, 1.f};
        pg8::gemm_phase<pg8::EpiBf16<0>, pg8::StaticOrder, true, true>(F.lds, g, S, E);
    } SEAM(2);
    if (IN(3)) { prj::phase_proj(F, I); } SEAM(3);
    if (IN(4)) {
        att::attn_phase((char*)lds, (const bf16_t*)(F.ws + WSX_Q), (const bf16_t*)(F.ws + WSX_K), (const bf16_t*)(F.ws + WSX_V), (bf16_t*)(F.ws + WSX_E), F.G, F.vcu);
    } SEAM(4);
    if (IN(5)) { prj::phase_mix(F, I); } SEAM(5);
    if (IN(6)) {
        pg8::Gemm g{(const bf16_t*)(F.ws + WSX_E), (const bf16_t*)(F.ws + WSX_WOUT), NTOK, DM, DM}; pg8::StaticOrder S; S.init(NTOK, DM, F.G, (int)blockIdx.x);
        pg8::EpiResid E{I.x, (const float*)(F.ws + WS_MOD), F.out};
        pg8::gemm_phase<pg8::EpiResid, pg8::StaticOrder, true, true>(F.lds, g, S, E);
    } SEAM(6);
    if (IN(7)) { moe::phase_route(F); } SEAM(7);
    if (IN(8)) { moe::phase_sort(F, I); } SEAM(8);
    if (IN(9)) {
        if (!IN(8)) moe::moe_tables(F);
        pg8::Gemm g{(const bf16_t*)(F.ws + WSX_XS), (const bf16_t*)(F.ws + WSX_W1T), MAXROWS, 0, DM};
        pg8::GroupedOrder S{(const LAS int*)(F.lds + moe::TP_OFF), 2, F.G, (int)blockIdx.x};
        pg8::EpiSiluMul E{(bf16_t*)(F.ws + WSX_HID)};
        pg8::gemm_phase<pg8::EpiSiluMul, pg8::GroupedOrder, true, true>(F.lds, g, S, E);
    } SEAM(9);
    if (IN(10)) {
        if (!IN(8)) moe::moe_tables(F);
        int kk2 = DFF; asm volatile("" : "+s"(kk2));
        pg8::Gemm g{(const bf16_t*)(F.ws + WSX_HID), (const bf16_t*)(F.ws + WSX_W2T), MAXROWS, 0, kk2};
        pg8::GroupedOrder S{(const LAS int*)(F.lds + moe::TP_OFF), 4, F.G, (int)blockIdx.x};
        pg8::EpiYs E{(bf16_t*)(F.ws + WSX_XS)};
        pg8::gemm_phase<pg8::EpiYs, pg8::GroupedOrder, true, true>(F.lds, g, S, E);
    } SEAM(10);
    if (IN(11)) { moe::phase_combine(F); }
#undef IN
#undef SEAM
}
static int g_grid = 0;
static bool mega_setup() {
    if (g_grid) return g_grid > 0;
    int dev = 0, cus = 0, per_cu = 0;
    if (hipGetDevice(&dev) != hipSuccess || hipDeviceGetAttribute(&cus, hipDeviceAttributeMultiprocessorCount, dev) != hipSuccess) { g_grid = -1; return false; }
    if (hipFuncSetAttribute((const void*)mega_fwd, hipFuncAttributeMaxDynamicSharedMemorySize, LDS_BYTES) != hipSuccess) { fprintf(stderr, "hipFuncSetAttribute failed\n"); g_grid = -1; return false; }
    if (hipOccupancyMaxActiveBlocksPerMultiprocessor(&per_cu, (const void*)mega_fwd, NWAVES * 64, LDS_BYTES) != hipSuccess || per_cu < 1) { fprintf(stderr, "occupancy query: %d\n", per_cu); (void)hipGetLastError(); g_grid = -1; return false; }
    g_grid = cus;
    return true;
}
static void mega_launch(void* const* d_in, void* d_out, void* d_ws, hipStream_t stream, int lo, int hi, int li) {
    Args a{}; for (int i = 0; i < 31; ++i) a.in[i] = d_in[i];
    a.out = (float*)d_out; a.ws = (unsigned char*)d_ws; a.ph_lo = lo; a.ph_hi = hi; a.li = li; a.pad = 0;
    hipLaunchKernelGGL(mega_fwd, dim3(g_grid), dim3(NWAVES * 64), LDS_BYTES, stream, a);
}
extern "C" void kernel_launch(void* const* d_in, const int* in_sizes, int n_in, void* d_out, int out_size, void* d_ws, size_t ws_size, hipStream_t stream) {
    if (n_in != 31 || ws_size < WSX_END || out_size != NTOK * DM) { fprintf(stderr, "kernel_launch: unexpected shapes n_in=%d ws=%zu out=%d\n", n_in, ws_size, out_size); return; }
    if (!mega_setup()) return;
    const Inputs I = get_inputs(d_in);
    char* ws = (char*)d_ws; float* out = (float*)d_out;
    float* mod = (float*)(ws + WS_MOD);
    int2* rexp = (int2*)(ws + WSX_ROUTE); float2* rw = (float2*)(ws + WSX_ROUTE + 256 * 1024);
    bf16_t* XN = (bf16_t*)(ws + WSX_A); bf16_t* H2 = (bf16_t*)(ws + WSX_A);
    bf16_t* PROJ = (bf16_t*)(ws + WSX_B);
    bf16_t* MIXED = (bf16_t*)(ws + WSX_E);
    (void)XN; (void)mod;
    hipMemsetAsync(ws + WS_CTL, 0, 1 * MiB, stream);
    mega_launch(d_in, d_out, d_ws, stream, 0, 12, 0);
}
```

```cpp
#include <hip/hip_runtime.h>
#include <cstdio>
#include <cstdint>
#include <cmath>
constexpr int NB = 4, SEQ = 8192, DM = 1024, NTOK = NB * SEQ;
constexpr int NH = 4, DQK = 192, DNOPE = 128, DROPE = 64, DV = 128;
constexpr int QLR = 256, KVLR = 128, LRUW = 512, LRUH = 4, LRUB = 128;
constexpr int NPROJ = 1472, PROJP = 1536;
constexpr int C_QLAT = 0, C_KVLAT = 256, C_KROPE = 384, C_XLRU = 448, C_GLRU = 960;
constexpr int NEXP = 32, NGRP = 4, EPG = 8, DFF = 256;
constexpr float EPS = 1e-6f;
constexpr int MODW = 6 * DM;

typedef unsigned short bf16_t;
__device__ __forceinline__ float bf2f(bf16_t v) { return __uint_as_float(((unsigned)v) << 16); }
__device__ __forceinline__ bf16_t f2bf(float f) { unsigned u = __float_as_uint(f); return (bf16_t)((u + 0x7fffu + ((u >> 16) & 1u)) >> 16); }

constexpr size_t MiB = 1u << 20;
constexpr size_t WS_CTL = 0;
constexpr size_t WS_MOD = 1 * MiB;
constexpr size_t WS_ROUTE = 2 * MiB;
constexpr size_t WS_A = 64 * MiB;
constexpr size_t WS_B = 128 * MiB;
constexpr size_t WS_C = 224 * MiB;
constexpr size_t WS_D = 352 * MiB;
constexpr size_t WS_E = 416 * MiB;
constexpr size_t WS_END = 480 * MiB;
constexpr size_t WS_Q = WS_C, WS_K = WS_C + 48 * MiB, WS_V = WS_C + 96 * MiB;

__device__ __forceinline__ float silu_f(float v) { return v / (1.f + __expf(-v)); }
__device__ __forceinline__ float sigmoid_f(float v) { return 1.f / (1.f + __expf(-v)); }
__device__ __forceinline__ float gelu_tanh(float v) { const float u = 0.7978845608028654f * (v + 0.044715f * v * v * v); return v / (1.f + __expf(-2.f * u)); }

__device__ __forceinline__ float block_sum_256(float v, float* red) {
    for (int o = 32; o > 0; o >>= 1) v += __shfl_xor(v, o);
    __syncthreads();
    if ((threadIdx.x & 63) == 0) red[threadIdx.x >> 6] = v;
    __syncthreads();
    return red[0] + red[1] + red[2] + red[3];
}
__device__ __forceinline__ float wave_sum(float v) { for (int o = 32; o > 0; o >>= 1) v += __shfl_xor(v, o); return v; }

__device__ __forceinline__ void rope_cs(int pos, int i, float& c, float& s) {
    const double inv = exp(-0.28782313662425575 * (double)i);
    double a = (double)pos * inv;
    const double k = rint(a * 0.15915494309189535);
    a = fma(-k, 6.283185307179586, a); a = fma(-k, 2.4492935982947064e-16, a);
    const float r = (float)a;
    c = __cosf(r); s = __sinf(r);
}

__global__ void nv_mod(const float* __restrict__ c, const float* __restrict__ w_ada, const float* __restrict__ b_ada, float* __restrict__ mod) {
    const int n = blockIdx.x * 256 + threadIdx.x, b = blockIdx.y;
    float acc = b_ada[n];
    for (int k = 0; k < DM; ++k) acc += silu_f(c[b * DM + k]) * w_ada[(size_t)k * MODW + n];
    mod[b * MODW + n] = acc;
}
__global__ void nv_norm_mod(const float* __restrict__ x, const float* __restrict__ g, const float* __restrict__ mod, int which, bf16_t* __restrict__ out) {
    const int t = blockIdx.x * 4 + (threadIdx.x >> 6), lane = threadIdx.x & 63, b = t / SEQ;
    const float* xr = x + (size_t)t * DM;
    float v[16]; float ss = 0.f;
#pragma unroll
    for (int j = 0; j < 16; ++j) { v[j] = xr[lane + 64 * j]; ss += v[j] * v[j]; }
    ss = wave_sum(ss);
    const float rstd = rsqrtf(ss / DM + EPS);
    const float* sh = mod + b * MODW + (which ? 3 * DM : 0); const float* sc = sh + DM;
#pragma unroll
    for (int j = 0; j < 16; ++j) { const int k = lane + 64 * j; out[(size_t)t * DM + k] = f2bf(v[j] * rstd * g[k] * (1.f + sc[k]) + sh[k]); }
}

template <class Epi> __global__ void __launch_bounds__(256) nv_gemm(const bf16_t* __restrict__ A, int lda, const float* __restrict__ W, int ldw, int K, Epi epi) {
    __shared__ float As[16][65]; __shared__ float Bs[16][64];
    const int tid = threadIdx.x, tx = tid & 15, ty = tid >> 4, m0 = blockIdx.y * 64, n0 = blockIdx.x * 64;
    float acc[4][4];
#pragma unroll
    for (int i = 0; i < 4; ++i)
#pragma unroll
        for (int j = 0; j < 4; ++j) acc[i][j] = 0.f;
    for (int k0 = 0; k0 < K; k0 += 16) {
        { const int r = tid >> 2, kk = (tid & 3) * 4; const bf16_t* ap = A + (size_t)(m0 + r) * lda + k0 + kk;
#pragma unroll
          for (int j = 0; j < 4; ++j) As[kk + j][r] = bf2f(ap[j]); }
        { const int kk = tid >> 4, c = (tid & 15) * 4; const float* wp = W + (size_t)(k0 + kk) * ldw + n0 + c;
#pragma unroll
          for (int j = 0; j < 4; ++j) Bs[kk][c + j] = wp[j]; }
        __syncthreads();
#pragma unroll
        for (int kk = 0; kk < 16; ++kk) { float a[4], b[4];
#pragma unroll
            for (int i = 0; i < 4; ++i) a[i] = As[kk][ty * 4 + i];
#pragma unroll
            for (int j = 0; j < 4; ++j) b[j] = Bs[kk][tx * 4 + j];
#pragma unroll
            for (int i = 0; i < 4; ++i)
#pragma unroll
                for (int j = 0; j < 4; ++j) acc[i][j] += a[i] * b[j]; }
        __syncthreads();
    }
#pragma unroll
    for (int i = 0; i < 4; ++i)
#pragma unroll
        for (int j = 0; j < 4; ++j) epi(m0 + ty * 4 + i, n0 + tx * 4 + j, acc[i][j]);
}
struct EpiStoreBf16 { bf16_t* C; int ldc; int pad; __device__ void operator()(int r, int c, float v) const { C[(size_t)r * ldc + c] = f2bf(v); } };
struct EpiOutProj { const float* x; const float* mod; float* out; __device__ void operator()(int r, int c, float v) const { const int b = r / SEQ; out[(size_t)r * DM + c] = x[(size_t)r * DM + c] + mod[b * MODW + 2 * DM + c] * v; } };

__global__ void __launch_bounds__(256) nv_qkv(const bf16_t* __restrict__ proj, const int* __restrict__ positions, const float* __restrict__ q_a_norm, const float* __restrict__ w_q_b,
                                               const float* __restrict__ kv_a_norm, const float* __restrict__ w_kv_b, const float* __restrict__ q_norm, const float* __restrict__ k_norm,
                                               bf16_t* __restrict__ Q, bf16_t* __restrict__ Kb, bf16_t* __restrict__ Vb) {
    __shared__ float qn[QLR], kvn[KVLR], kr[DROPE], qo[NH * DQK], kvo[NH * 256], red[4], cs[64];
    const int t = blockIdx.x, tid = threadIdx.x, b = t / SEQ, s = t % SEQ;
    const bf16_t* pr = proj + (size_t)t * PROJP;
    const float ql = bf2f(pr[C_QLAT + tid]);
    const float sq = block_sum_256(ql * ql, red);
    qn[tid] = ql * rsqrtf(sq / QLR + EPS) * q_a_norm[tid];
    const float kl = tid < KVLR ? bf2f(pr[C_KVLAT + tid]) : 0.f;
    const float skv = block_sum_256(kl * kl, red);
    if (tid < KVLR) kvn[tid] = kl * rsqrtf(skv / KVLR + EPS) * kv_a_norm[tid];
    if (tid < DROPE) kr[tid] = bf2f(pr[C_KROPE + tid]);
    if (tid < 32) { float c, sn; rope_cs(positions[t], tid, c, sn); cs[tid] = c; cs[32 + tid] = sn; }
    __syncthreads();
    for (int j = 0; j < 3; ++j) { const int col = tid + 256 * j; float a = 0.f; for (int k = 0; k < QLR; ++k) a += qn[k] * w_q_b[(size_t)k * (NH * DQK) + col]; qo[col] = a; }
    for (int j = 0; j < 4; ++j) { const int col = tid + 256 * j; float a = 0.f; for (int k = 0; k < KVLR; ++k) a += kvn[k] * w_kv_b[(size_t)k * (NH * 256) + col]; kvo[col] = a; }
    __syncthreads();
    const int h = tid >> 6, lane = tid & 63;
    {
        float v0 = qo[h * DQK + lane], v1 = qo[h * DQK + 64 + lane], v2 = qo[h * DQK + 128 + lane];
        const float rs = rsqrtf(wave_sum(v0 * v0 + v1 * v1 + v2 * v2) / DQK + EPS);
        v0 *= rs * q_norm[lane]; v1 *= rs * q_norm[64 + lane]; v2 *= rs * q_norm[128 + lane];
        const float oth = __shfl_xor(v2, 32); const int i = lane & 31; const float c = cs[i], sn = cs[32 + i];
        const float r2 = lane < 32 ? v2 * c - oth * sn : v2 * c + oth * sn;
        bf16_t* qp = Q + ((size_t)(b * NH + h) * SEQ + s) * DQK;
        qp[lane] = f2bf(v0); qp[64 + lane] = f2bf(v1); qp[128 + lane] = f2bf(r2);
    }
    {
        float v0 = kvo[h * 256 + lane], v1 = kvo[h * 256 + 64 + lane], v2 = kr[lane];
        const float rs = rsqrtf(wave_sum(v0 * v0 + v1 * v1 + v2 * v2) / DQK + EPS);
        v0 *= rs * k_norm[lane]; v1 *= rs * k_norm[64 + lane]; v2 *= rs * k_norm[128 + lane];
        const float oth = __shfl_xor(v2, 32); const int i = lane & 31; const float c = cs[i], sn = cs[32 + i];
        const float r2 = lane < 32 ? v2 * c - oth * sn : v2 * c + oth * sn;
        bf16_t* kp = Kb + ((size_t)(b * NH + h) * SEQ + s) * DQK;
        kp[lane] = f2bf(v0); kp[64 + lane] = f2bf(v1); kp[128 + lane] = f2bf(r2);
        bf16_t* vp = Vb + ((size_t)(b * NH + h) * SEQ + s) * DV;
        vp[lane] = f2bf(kvo[h * 256 + 128 + lane]); vp[64 + lane] = f2bf(kvo[h * 256 + 192 + lane]);
    }
}

__global__ void __launch_bounds__(256) nv_attn(const bf16_t* __restrict__ Q, const bf16_t* __restrict__ Kb, const bf16_t* __restrict__ Vb, bf16_t* __restrict__ mixed) {
    __shared__ float Ks[64][DQK + 4]; __shared__ float Vs[64][DV + 4];
    const int bh = blockIdx.y, qb = gridDim.x - 1 - blockIdx.x, tid = threadIdx.x, row = tid >> 2, part = tid & 3;
    const int qi = qb * 64 + row;
    float q[48], o[32]; float m = -1e30f, l = 0.f;
    { const bf16_t* qp = Q + ((size_t)bh * SEQ + qi) * DQK + part * 48;
#pragma unroll
      for (int d = 0; d < 48; ++d) q[d] = bf2f(qp[d]); }
#pragma unroll
    for (int d = 0; d < 32; ++d) o[d] = 0.f;
    const float scl = 0.07216878364870322f;
    for (int kt = 0; kt <= qb; ++kt) {
        __syncthreads();
        for (int e = tid; e < 64 * DQK; e += 256) { const int r = e / DQK, c = e % DQK; Ks[r][c] = bf2f(Kb[((size_t)bh * SEQ + kt * 64 + r) * DQK + c]); }
        for (int e = tid; e < 64 * DV; e += 256) { const int r = e / DV, c = e % DV; Vs[r][c] = bf2f(Vb[((size_t)bh * SEQ + kt * 64 + r) * DV + c]); }
        __syncthreads();
        for (int j = 0; j < 64; ++j) {
            float sdot = 0.f;
#pragma unroll
            for (int d = 0; d < 48; ++d) sdot += q[d] * Ks[j][part * 48 + d];
            sdot += __shfl_xor(sdot, 1); sdot += __shfl_xor(sdot, 2);
            sdot *= scl;
            if (kt * 64 + j <= qi) {
                const float mn = fmaxf(m, sdot), al = __expf(m - mn), p = __expf(sdot - mn);
                l = l * al + p; m = mn;
#pragma unroll
                for (int d = 0; d < 32; ++d) o[d] = o[d] * al + p * Vs[j][part * 32 + d];
            }
        }
    }
    const int b = bh / NH, h = bh % NH;
    bf16_t* op = mixed + ((size_t)(b * SEQ + qi)) * DM + h * DV + part * 32;
    const float il = 1.f / l;
#pragma unroll
    for (int d = 0; d < 32; ++d) op[d] = f2bf(o[d] * il);
}

__global__ void __launch_bounds__(512) nv_lru_gates(const bf16_t* __restrict__ proj, const int* __restrict__ positions, const float* __restrict__ conv_w, const float* __restrict__ conv_b,
                                                     const float* __restrict__ wa, const float* __restrict__ ba, const float* __restrict__ wx, const float* __restrict__ bx,
                                                     const float* __restrict__ lam, float* __restrict__ A32, float* __restrict__ B32) {
    __shared__ float xc[LRUW];
    const int t = blockIdx.x, c = threadIdx.x, s = t % SEQ;
    float v = conv_b[c];
    for (int j = 0; j < 4; ++j) { const int ss = s - 3 + j; if (ss >= 0) v += conv_w[j * LRUW + c] * bf2f(proj[(size_t)(t - 3 + j) * PROJP + C_XLRU + c]); }
    xc[c] = v;
    __syncthreads();
    const int h = c >> 7, jj = c & 127;
    float ra = ba[c], ri = bx[c];
    for (int i = 0; i < LRUB; ++i) { const float xv = xc[h * LRUB + i]; ra += xv * wa[(size_t)(h * LRUB + i) * LRUB + jj]; ri += xv * wx[(size_t)(h * LRUB + i) * LRUB + jj]; }
    const float r = sigmoid_f(ra), ig = sigmoid_f(ri);
    const float sp = log1pf(__expf(-lam[c]));
    const float log_a = -8.f * r * sp;
    float a = __expf(log_a), mult = sqrtf(fmaxf(1.f - __expf(2.f * log_a), 0.f));
    if (positions[t] == 0) { a = 0.f; mult = 1.f; }
    A32[(size_t)t * LRUW + c] = a; B32[(size_t)t * LRUW + c] = mult * (ig * v);
}
__global__ void nv_lru_scan(float* __restrict__ A32, const float* __restrict__ B32) {
    const int idx = blockIdx.x * blockDim.x + threadIdx.x, b = idx / LRUW, c = idx % LRUW;
    float h = 0.f;
    for (int s0 = 0; s0 < SEQ; s0 += 8) {
        float a[8], bb[8];
#pragma unroll
        for (int j = 0; j < 8; ++j) { const size_t o = ((size_t)(b * SEQ + s0 + j)) * LRUW + c; a[j] = A32[o]; bb[j] = B32[o]; }
#pragma unroll
        for (int j = 0; j < 8; ++j) { h = a[j] * h + bb[j]; A32[((size_t)(b * SEQ + s0 + j)) * LRUW + c] = h; }
    }
}
__global__ void nv_mixnorm(bf16_t* __restrict__ mixed, const float* __restrict__ H32, const bf16_t* __restrict__ proj, const float* __restrict__ g_attn, const float* __restrict__ g_lru) {
    const int t = blockIdx.x * 4 + (threadIdx.x >> 6), lane = threadIdx.x & 63;
    bf16_t* mr = mixed + (size_t)t * DM;
    float v[8], ss = 0.f;
#pragma unroll
    for (int j = 0; j < 8; ++j) { v[j] = bf2f(mr[lane + 64 * j]); ss += v[j] * v[j]; }
    float rs = rsqrtf(wave_sum(ss) / 512.f + EPS);
#pragma unroll
    for (int j = 0; j < 8; ++j) mr[lane + 64 * j] = f2bf(v[j] * rs * g_attn[lane + 64 * j]);
    ss = 0.f;
#pragma unroll
    for (int j = 0; j < 8; ++j) { const int c = lane + 64 * j; v[j] = H32[(size_t)t * LRUW + c] * gelu_tanh(bf2f(proj[(size_t)t * PROJP + C_GLRU + c])); ss += v[j] * v[j]; }
    rs = rsqrtf(wave_sum(ss) / 512.f + EPS);
#pragma unroll
    for (int j = 0; j < 8; ++j) mr[512 + lane + 64 * j] = f2bf(v[j] * rs * g_lru[lane + 64 * j]);
}
__global__ void nv_route(const float* __restrict__ x1, const float* __restrict__ g2, const float* __restrict__ mod, const float* __restrict__ w_rg, const float* __restrict__ b_rg,
                         const float* __restrict__ w_re, const float* __restrict__ b_re, bf16_t* __restrict__ H2, int2* __restrict__ rexp, float2* __restrict__ rw) {
    const int t = blockIdx.x * 4 + (threadIdx.x >> 6), lane = threadIdx.x & 63, b = t / SEQ;
    const float* xr = x1 + (size_t)t * DM;
    float v[16]; float ss = 0.f;
#pragma unroll
    for (int j = 0; j < 16; ++j) { v[j] = xr[lane + 64 * j]; ss += v[j] * v[j]; }
    const float rstd = rsqrtf(wave_sum(ss) / DM + EPS);
    const float* sh = mod + b * MODW + 3 * DM; const float* sc = sh + DM;
#pragma unroll
    for (int j = 0; j < 16; ++j) { const int k = lane + 64 * j; v[j] = v[j] * rstd * g2[k] * (1.f + sc[k]) + sh[k]; H2[(size_t)t * DM + k] = f2bf(v[j]); }
    float gl[NGRP];
#pragma unroll
    for (int g = 0; g < NGRP; ++g) { float a = 0.f;
#pragma unroll
        for (int j = 0; j < 16; ++j) a += v[j] * w_rg[(size_t)(lane + 64 * j) * NGRP + g];
        gl[g] = wave_sum(a) + b_rg[g]; }
    int gi = 0; float gm = gl[0];
#pragma unroll
    for (int g = 1; g < NGRP; ++g) if (gl[g] > gm) { gm = gl[g]; gi = g; }
    float gs = 0.f;
#pragma unroll
    for (int g = 0; g < NGRP; ++g) gs += __expf(gl[g] - gm);
    const float gp = 1.f / gs;
    float m0 = -1e30f, m1 = -1e30f; int e0 = 0, e1 = 0;
    for (int e = 0; e < EPG; ++e) { float a = 0.f;
#pragma unroll
        for (int j = 0; j < 16; ++j) a += v[j] * w_re[(size_t)(lane + 64 * j) * NEXP + gi * EPG + e];
        const float el = wave_sum(a) + b_re[gi * EPG + e];
        if (el > m0) { m1 = m0; e1 = e0; m0 = el; e0 = e; } else if (el > m1) { m1 = el; e1 = e; } }
    const float p1 = __expf(m1 - m0);
    const float w0 = gp / (1.f + p1), w1 = gp * p1 / (1.f + p1);
    if (lane == 0) { rexp[t] = make_int2(gi * EPG + e0, gi * EPG + e1); rw[t] = make_float2(w0, w1); }
}
__global__ void __launch_bounds__(256) nv_moe(const bf16_t* __restrict__ H2, const int2* __restrict__ rexp, const float2* __restrict__ rw, const float* __restrict__ w_gate,
                                               const float* __restrict__ w_up, const float* __restrict__ w_down, const float* __restrict__ mod, float* __restrict__ out) {
    __shared__ float hs[DM], hid[DFF];
    const int t = blockIdx.x, tid = threadIdx.x, b = t / SEQ;
    for (int j = 0; j < 4; ++j) hs[tid + 256 * j] = bf2f(H2[(size_t)t * DM + tid + 256 * j]);
    float y[4] = {0.f, 0.f, 0.f, 0.f};
    const int2 ee = rexp[t]; const float2 ww = rw[t];
    for (int k = 0; k < 2; ++k) {
        const int e = k ? ee.y : ee.x; const float w = k ? ww.y : ww.x;
        __syncthreads();
        const float* wg = w_gate + (size_t)e * DM * DFF; const float* wu = w_up + (size_t)e * DM * DFF;
        float g = 0.f, u = 0.f;
        for (int i = 0; i < DM; ++i) { const float hv = hs[i]; g += hv * wg[(size_t)i * DFF + tid]; u += hv * wu[(size_t)i * DFF + tid]; }
        hid[tid] = silu_f(g) * u;
        __syncthreads();
        const float* wd = w_down + (size_t)e * DFF * DM;
#pragma unroll
        for (int j = 0; j < 4; ++j) { float a = 0.f; for (int f = 0; f < DFF; ++f) a += hid[f] * wd[(size_t)f * DM + tid + 256 * j]; y[j] += w * a; }
    }
#pragma unroll
    for (int j = 0; j < 4; ++j) { const int c = tid + 256 * j; out[(size_t)t * DM + c] += mod[b * MODW + 5 * DM + c] * y[j]; }
}
struct Inputs {
    const float *x, *c; const int* positions;
    const float *w_ada, *b_ada, *norm1_g, *w_in, *q_a_norm, *w_q_b, *kv_a_norm, *w_kv_b, *q_norm, *k_norm, *conv_w, *conv_b, *lru_wa, *lru_ba, *lru_wx, *lru_bx, *lru_lambda,
                *attn_out_norm, *lru_out_norm, *w_out, *norm2_g, *w_rg, *b_rg, *w_re, *b_re, *w_gate, *w_up, *w_down;
};
static Inputs get_inputs(void* const* d_in) {
    Inputs I;
    I.x = (const float*)d_in[0]; I.c = (const float*)d_in[1]; I.positions = (const int*)d_in[2];
    I.w_ada = (const float*)d_in[3]; I.b_ada = (const float*)d_in[4]; I.norm1_g = (const float*)d_in[5];
    I.w_in = (const float*)d_in[6]; I.q_a_norm = (const float*)d_in[7]; I.w_q_b = (const float*)d_in[8];
    I.kv_a_norm = (const float*)d_in[9]; I.w_kv_b = (const float*)d_in[10]; I.q_norm = (const float*)d_in[11];
    I.k_norm = (const float*)d_in[12]; I.conv_w = (const float*)d_in[13]; I.conv_b = (const float*)d_in[14];
    I.lru_wa = (const float*)d_in[15]; I.lru_ba = (const float*)d_in[16]; I.lru_wx = (const float*)d_in[17];
    I.lru_bx = (const float*)d_in[18]; I.lru_lambda = (const float*)d_in[19]; I.attn_out_norm = (const float*)d_in[20];
    I.lru_out_norm = (const float*)d_in[21]; I.w_out = (const float*)d_in[22]; I.norm2_g = (const float*)d_in[23];
    I.w_rg = (const float*)d_in[24]; I.b_rg = (const float*)d_in[25]; I.w_re = (const float*)d_in[26];
    I.b_re = (const float*)d_in[27]; I.w_gate = (const float*)d_in[28]; I.w_up = (const float*)d_in[29];
    I.w_down = (const float*)d_in[30];
    return I;
}
#define GAS __attribute__((address_space(1)))
#define LAS __attribute__((address_space(3)))
typedef unsigned v4u __attribute__((ext_vector_type(4)));
typedef unsigned v2u __attribute__((ext_vector_type(2)));
typedef float f32x4 __attribute__((ext_vector_type(4)));
typedef float f32x16 __attribute__((ext_vector_type(16)));
typedef short bf16x8 __attribute__((ext_vector_type(8)));
typedef short s16x4 __attribute__((ext_vector_type(4)));
typedef GAS unsigned gu32;
#define RLX_AGENT __ATOMIC_RELAXED, __HIP_MEMORY_SCOPE_AGENT
#define LDS_WAIT() asm volatile("s_waitcnt lgkmcnt(0)" ::: "memory")
#define VM_WAIT() asm volatile("s_waitcnt vmcnt(0)" ::: "memory")
__device__ __forceinline__ unsigned pk2(float lo, float hi) { return (unsigned)f2bf(lo) | ((unsigned)f2bf(hi) << 16); }
__device__ __forceinline__ unsigned cvtpk(float lo, float hi) { unsigned r; asm volatile("v_cvt_pk_bf16_f32 %0, %1, %2" : "=v"(r) : "v"(lo), "v"(hi)); return r; }

constexpr size_t WSX_SUMA = 3 * MiB, WSX_SUMB = 5 * MiB;
constexpr size_t WSX_CS = 7 * MiB;
constexpr size_t WSX_WQF = 15 * MiB;
constexpr size_t WSX_WKVF = WSX_WQF + 384 * 1024;
constexpr size_t WSX_WAF = WSX_WKVF + 256 * 1024;
constexpr size_t WSX_WXF = WSX_WAF + 128 * 1024;
constexpr size_t WSX_WRF = WSX_WXF + 128 * 1024;
constexpr size_t WSX_SP = 2 * MiB + 768 * 1024;
constexpr size_t WSX_WIN = 16 * MiB;
constexpr size_t WSX_WOUT = 19 * MiB;
constexpr size_t WSX_W1T = 22 * MiB;
constexpr size_t WSX_W2T = 54 * MiB;
constexpr size_t WSX_A = 72 * MiB;
constexpr size_t WSX_B = 136 * MiB;
constexpr size_t WSX_C = 232 * MiB;
constexpr size_t WSX_D = 360 * MiB;
constexpr size_t WSX_E = 424 * MiB;
constexpr size_t WSX_END = 488 * MiB;
constexpr size_t WSX_Q = WSX_C, WSX_K = WSX_C + 48 * MiB, WSX_V = WSX_C + 96 * MiB;
constexpr size_t WSX_XS = 216 * MiB;
constexpr size_t WSX_HID = WSX_D;
constexpr size_t WSX_ROUTE = 2 * MiB;
constexpr int MAXROWS = 2 * NTOK + NEXP * 255;
constexpr size_t WSX_X1 = 72 * MiB;
constexpr size_t WSX_AO = WSX_A;
constexpr size_t WSX_RPOSF = 71 * MiB;
constexpr int CW_BAR = 4096;
constexpr int CW_CNT = 65536;

constexpr int RING_BYTES = 131072, LDSCTL_OFF = RING_BYTES, MISC_OFF = LDSCTL_OFF + 320, LDS_BYTES = 147456;
constexpr int NWAVES = 8;
namespace pg8 {
#define PG8_LAS __attribute__((address_space(3)))
typedef unsigned short bf16_t;
typedef short bf16x8 __attribute__((ext_vector_type(8)));
typedef float f32x4 __attribute__((ext_vector_type(4)));
typedef unsigned u32x4 __attribute__((ext_vector_type(4)));
constexpr int BM = 256, BK = 64, HALF = 128, HTB = HALF * BK * 2  , STAGE_BYTES = 8 * HTB, NXCD = 8, WGM = 8;

__host__ __device__ __forceinline__ int lds_byte(int r, int c) { const int st = (r >> 4) * 2 + (c >> 5), rr = r & 15, cc = c & 31, ob = rr * 64 + cc * 2; return st * 1024 + (ob ^ (((ob >> 9) & 1) << 5)); }
__host__ __device__ __forceinline__ void stage_rc(int b, int& R, int& C) { const int st = b / 1024, sb = b % 1024, swz = sb ^ (((sb >> 9) & 1) << 5); R = (st >> 1) * 16 + swz / 64; C = (st & 1) * 32 + (swz % 64) / 2; }
__host__ __device__ __forceinline__ int perm32(int rho) { const int n = rho >> 4, i = rho & 15; return 8 * (i >> 2) + 4 * n + (i & 3); }

struct Unit { int pm, pn; };
struct Gemm { const bf16_t* A; const bf16_t* Bt; int M, N, K; };

struct StaticOrder {
    int nM, nN, nwg, G, c;
    __host__ __device__ void init(int M, int N, int G_, int c_) { nM = M / BM; nN = N / BM; nwg = nM * nN; G = G_; c = c_; }
    __host__ __device__ bool next(int i, Unit& u) const {
        const long L = (long)i * G + c; if (L >= nwg) return false;
        int wgid = (int)L; { const int q = nwg / NXCD, r = nwg % NXCD, xcd = wgid % NXCD, off = wgid / NXCD; wgid = (xcd < r ? xcd * (q + 1) : r * (q + 1) + (xcd - r) * q) + off; }
        const int nig = WGM * nN, gid = wgid / nig, fm = gid * WGM, gsz = (nM - fm) < WGM ? (nM - fm) : WGM;
        u.pm = fm + ((wgid % nig) % gsz); u.pn = (wgid % nig) / gsz; return true;
    }
    __device__ __forceinline__ void a_ready(const Unit&) const {}
    __device__ __forceinline__ void done(const Unit&) const {}
};

__device__ __forceinline__ unsigned cvt_pk_bf16(float lo, float hi) { unsigned r; asm volatile("v_cvt_pk_bf16_f32 %0, %1, %2" : "=v"(r) : "v"(lo), "v"(hi)); return r; }
typedef float f32x2 __attribute__((ext_vector_type(2)));
__device__ __forceinline__ f32x2 gelu_pk(f32x2 v) {
    const f32x2 av = __builtin_elementwise_abs(v), d = av * 0.2316418882f + 1.0f;
    f32x2 t; t.x = __builtin_amdgcn_rcpf(d.x); t.y = __builtin_amdgcn_rcpf(d.y);
    f32x2 q = t * 0.5307027145f + (-0.7265760135f); q = q * t + 0.7107068705f; q = q * t + (-0.142248368f); q = q * t + 0.127414796f; q = q * t;
    const f32x2 s = (v * v) * (-0.72134752044f);
    f32x2 e; e.x = __builtin_amdgcn_exp2f(s.x); e.y = __builtin_amdgcn_exp2f(s.y);
    const f32x2 m = v * (q * e), r = v - m;
    f32x2 o; o.x = v.x < 0.f ? m.x : r.x; o.y = v.y < 0.f ? m.y : r.y; return o;
}

template <int ACT  > struct EpiBf16 {
    static constexpr bool PERM = true, AFTER_DRAIN = false; static_assert(ACT == 0 || ACT == 1, "EpiBf16: ACT is 0 (none) or 1 (gelu_pk)");
    bf16_t* O; int ldc; const float* bias; int split_cols; size_t split_stride; float scale0;
    __device__ __forceinline__ void operator()(const f32x4 (&acc)[2][2][4][2], const Unit& u, int wr, int wc, int fr, int fq) const {
        const int row0 = u.pm * BM + wr * 64 + fr; int colt = u.pn * BM; bf16_t* base = O;
        float sc = 1.f; if (split_cols) { const int t = colt / split_cols; base += (size_t)t * split_stride; colt -= t * split_cols; if (t == 0) sc = scale0; }
        const int col0 = colt + wc * 32 + 8 * fq, bcol0 = u.pn * BM + wc * 32 + 8 * fq;
        f32x4 bv[2][2];
#pragma unroll
        for (int bj = 0; bj < 2; ++bj)
#pragma unroll
            for (int n = 0; n < 2; ++n) bv[bj][n] = bias ? *(const f32x4*)(bias + bcol0 + bj * HALF + 4 * n) : (f32x4){0.f, 0.f, 0.f, 0.f};
#pragma unroll
        for (int ai = 0; ai < 2; ++ai)
#pragma unroll
            for (int m = 0; m < 4; ++m) { bf16_t* rowp = base + (size_t)(row0 + ai * HALF + m * 16) * ldc + col0;
#pragma unroll
                for (int bj = 0; bj < 2; ++bj) { f32x4 v0 = acc[ai][bj][m][0] + bv[bj][0], v1 = acc[ai][bj][m][1] + bv[bj][1];
                    if (ACT == 1) { f32x2 a = gelu_pk((f32x2){v0[0], v0[1]}), b = gelu_pk((f32x2){v0[2], v0[3]}), c = gelu_pk((f32x2){v1[0], v1[1]}), d = gelu_pk((f32x2){v1[2], v1[3]});
                        v0 = (f32x4){a.x, a.y, b.x, b.y}; v1 = (f32x4){c.x, c.y, d.x, d.y}; }
                    v0 = v0 * sc; v1 = v1 * sc; u32x4 w; w.x = cvt_pk_bf16(v0[0], v0[1]); w.y = cvt_pk_bf16(v0[2], v0[3]); w.z = cvt_pk_bf16(v1[0], v1[1]); w.w = cvt_pk_bf16(v1[2], v1[3]);
                    *(u32x4*)(rowp + bj * HALF) = w; } }
    }
};
struct EpiResid {
    static constexpr bool PERM = true, AFTER_DRAIN = false;
    const float* x; const float* mod; bf16_t* out;
    __device__ __forceinline__ void operator()(const f32x4 (&acc)[2][2][4][2], const Unit& u, int wr, int wc, int fr, int fq) const {
        const int col0 = u.pn * BM + wc * 32 + 8 * fq, b = (u.pm * BM) / 8192;
        f32x4 gv[2][2];
#pragma unroll
        for (int bj = 0; bj < 2; ++bj)
#pragma unroll
            for (int n = 0; n < 2; ++n) gv[bj][n] = *(const f32x4*)(mod + b * 6144 + 2048 + col0 + bj * HALF + n * 4);
#pragma unroll
        for (int ai = 0; ai < 2; ++ai)
#pragma unroll
            for (int m = 0; m < 4; ++m) { const size_t off = (size_t)(u.pm * BM + ai * HALF + wr * 64 + m * 16 + fr) * 1024 + col0;
#pragma unroll
                for (int bj = 0; bj < 2; ++bj) { const f32x4 x0 = *(const f32x4*)(x + off + bj * HALF), x1 = *(const f32x4*)(x + off + bj * HALF + 4);
                    const f32x4 v0 = x0 + gv[bj][0] * acc[ai][bj][m][0], v1 = x1 + gv[bj][1] * acc[ai][bj][m][1];
                    u32x4 w; w.x = cvt_pk_bf16(v0[0], v0[1]); w.y = cvt_pk_bf16(v0[2], v0[3]); w.z = cvt_pk_bf16(v1[0], v1[1]); w.w = cvt_pk_bf16(v1[2], v1[3]);
                    *(u32x4*)(out + off + bj * HALF) = w; } }
    }
};
__device__ __forceinline__ float silu_e(float v) { return v * __builtin_amdgcn_rcpf(1.f + __builtin_amdgcn_exp2f(-1.4426950408889634f * v)); }
struct EpiSiluMul {
    static constexpr bool PERM = true, AFTER_DRAIN = false;
    bf16_t* H;
    __device__ __forceinline__ void operator()(const f32x4 (&acc)[2][2][4][2], const Unit& u, int wr, int wc, int fr, int fq) const {
        const int half = u.pn & 1, col0 = half * 128 + wc * 32 + 8 * fq;
#pragma unroll
        for (int ai = 0; ai < 2; ++ai)
#pragma unroll
            for (int m = 0; m < 4; ++m) { const size_t row = (size_t)(u.pm * BM + ai * HALF + wr * 64 + m * 16 + fr);
                const f32x4 g0 = acc[ai][0][m][0], g1 = acc[ai][0][m][1], u0 = acc[ai][1][m][0], u1 = acc[ai][1][m][1];
                u32x4 w; w.x = cvt_pk_bf16(silu_e(g0[0]) * u0[0], silu_e(g0[1]) * u0[1]); w.y = cvt_pk_bf16(silu_e(g0[2]) * u0[2], silu_e(g0[3]) * u0[3]);
                w.z = cvt_pk_bf16(silu_e(g1[0]) * u1[0], silu_e(g1[1]) * u1[1]); w.w = cvt_pk_bf16(silu_e(g1[2]) * u1[2], silu_e(g1[3]) * u1[3]);
                *(u32x4*)(H + row * 256 + col0) = w; }
    }
};
struct EpiProjT {
    static constexpr bool PERM = true, AFTER_DRAIN = false;
    bf16_t* P;
    __device__ __forceinline__ void operator()(const f32x4 (&acc)[2][2][4][2], const Unit& u, int wr, int wc, int fr, int fq) const {
#pragma unroll
        for (int ai = 0; ai < 2; ++ai)
#pragma unroll
            for (int m = 0; m < 4; ++m) { const int row = u.pm * BM + ai * HALF + wr * 64 + m * 16 + fr;
#pragma unroll
                for (int bj = 0; bj < 2; ++bj) { const int c = (u.pn * BM + bj * HALF + wc * 32 + 8 * fq) >> 3; const f32x4 v0 = acc[ai][bj][m][0], v1 = acc[ai][bj][m][1];
                    u32x4 w; w.x = cvt_pk_bf16(v0[0], v0[1]); w.y = cvt_pk_bf16(v0[2], v0[3]); w.z = cvt_pk_bf16(v1[0], v1[1]); w.w = cvt_pk_bf16(v1[2], v1[3]);
                    *(u32x4*)(P + ((size_t)((row >> 5) * 192 + c) * 32 + (row & 31)) * 8) = w; } }
    }
};
struct EpiYs {
    static constexpr bool PERM = true, AFTER_DRAIN = false;
    bf16_t* Y;
    __device__ __forceinline__ void operator()(const f32x4 (&acc)[2][2][4][2], const Unit& u, int wr, int wc, int fr, int fq) const {
        const int col0 = (u.pn & 3) * BM + wc * 32 + 8 * fq;
#pragma unroll
        for (int ai = 0; ai < 2; ++ai)
#pragma unroll
            for (int m = 0; m < 4; ++m) { bf16_t* rowp = Y + (size_t)(u.pm * BM + ai * HALF + wr * 64 + m * 16 + fr) * 1024 + col0;
#pragma unroll
                for (int bj = 0; bj < 2; ++bj) { const f32x4 v0 = acc[ai][bj][m][0], v1 = acc[ai][bj][m][1];
                    u32x4 w; w.x = cvt_pk_bf16(v0[0], v0[1]); w.y = cvt_pk_bf16(v0[2], v0[3]); w.z = cvt_pk_bf16(v1[0], v1[1]); w.w = cvt_pk_bf16(v1[2], v1[3]);
                    *(u32x4*)(rowp + bj * HALF) = w; } }
    }
};
struct GroupedOrder {
    const __attribute__((address_space(3))) int* tp; int ncol, G, c;
    __device__ __forceinline__ bool next(int i, Unit& u) const {
        const int L = i * G + c, total = tp[32] * ncol; if (L >= total) return false;
        const int rt = L / ncol, ct = L - rt * ncol; int e = 0;
#pragma unroll 1
        for (int j = 1; j < 32; ++j) e += (tp[j] <= rt) ? 1 : 0;
        u.pm = rt; u.pn = e * ncol + ct; return true;
    }
    __device__ __forceinline__ void a_ready(const Unit&) const {}
    __device__ __forceinline__ void done(const Unit&) const {}
};
template <class Epi, class Sched, bool ALIGN_EPI = false, bool SP2 = false>
__device__ __forceinline__ void gemm_phase(PG8_LAS unsigned char* lds, const Gemm g, const Sched& S, const Epi& E) {
    const int tid = threadIdx.x, wid = __builtin_amdgcn_readfirstlane(tid >> 6), lane = tid & 63, wr = wid >> 2, wc = wid & 3, fr = lane & 15, fq = lane >> 4;
    const int K = g.K, nt = K / BK;
    unsigned voffA[2], voffB[2];
#pragma unroll
    for (int i = 0; i < 2; ++i) { int R, C; stage_rc(tid * 16 + i * 8192, R, C); const int Rb = Epi::PERM ? ((R & ~31) + perm32(R & 31)) : R;
        voffA[i] = (unsigned)(R * K + C) * 2u; voffB[i] = (unsigned)(Rb * K + C) * 2u; }
    const size_t kstep = (size_t)(BK * 2);
    const size_t hstep = (size_t)HALF * K * 2;
    const size_t tstep = 2 * hstep;
    const unsigned ldsw = (unsigned)wid * 1024u;
    const int aoff = lds_byte(wr * 64 + fr, fq * 8), boff = lds_byte(wc * 32 + fr, fq * 8);
#define PG8_SA(b, h) (((b) * 2 + (h)) * HTB)
#define PG8_SB(b, h) ((4 + (b) * 2 + (h)) * HTB)
#define PG8_STAGE(bufoff, gbase, voff) do { _Pragma("unroll") for (int _i = 0; _i < 2; ++_i) \
        __builtin_amdgcn_global_load_lds((const unsigned*)((const char*)(gbase) + (voff)[_i]), (PG8_LAS unsigned*)(lds + (bufoff) + ldsw + _i * 8192), 16, 0, 0); } while (0)
#define PG8_LDA(dst, b, h) do { _Pragma("unroll") for (int m = 0; m < 4; ++m) _Pragma("unroll") for (int k = 0; k < 2; ++k) dst[m][k] = *(const PG8_LAS bf16x8*)(lds + PG8_SA(b, h) + aoff + m * 2048 + k * 1024); } while (0)
#define PG8_LDB(dst, b, h) do { _Pragma("unroll") for (int n = 0; n < 2; ++n) _Pragma("unroll") for (int k = 0; k < 2; ++k) dst[n][k] = *(const PG8_LAS bf16x8*)(lds + PG8_SB(b, h) + boff + n * 2048 + k * 1024); } while (0)
#define PG8_MMA(ai, bj, At, Bt) do { __builtin_amdgcn_s_setprio(1); _Pragma("unroll") for (int m = 0; m < 4; ++m) _Pragma("unroll") for (int n = 0; n < 2; ++n) _Pragma("unroll") for (int k = 0; k < 2; ++k) \
        acc[ai][bj][m][n] = __builtin_amdgcn_mfma_f32_16x16x32_bf16(Bt[n][k], At[m][k], acc[ai][bj][m][n], 0, 0, 0); __builtin_amdgcn_s_setprio(0); } while (0)
#define PG8_WAIT_V(n) asm volatile("s_waitcnt vmcnt(" #n ")" ::: "memory")
#define PG8_WAIT_L(n) asm volatile("s_waitcnt lgkmcnt(" #n ")" ::: "memory")
#define PG8_BAR __builtin_amdgcn_s_barrier()
#define PG8_SCHED __builtin_amdgcn_sched_barrier(0)
    Unit cur, nxt; int ui = 0;
    if (!S.next(0, cur)) return;
    f32x4 acc[2][2][4][2];
#pragma unroll
    for (int a = 0; a < 2; ++a)
#pragma unroll
        for (int b = 0; b < 2; ++b)
#pragma unroll
            for (int m = 0; m < 4; ++m)
#pragma unroll
                for (int n = 0; n < 2; ++n) acc[a][b][m][n] = (f32x4){0.f, 0.f, 0.f, 0.f};
    bf16x8 At[4][2], B0[2][2], B1[2][2];
    const char* cA = (const char*)g.A + (size_t)cur.pm * tstep; const char* cB = (const char*)g.Bt + (size_t)cur.pn * tstep;
    S.a_ready(cur);
    if constexpr (SP2) {
        PG8_STAGE(PG8_SB(0, 0), cB, voffB); PG8_STAGE(PG8_SB(0, 1), cB + hstep, voffB); PG8_STAGE(PG8_SA(0, 0), cA, voffA); PG8_STAGE(PG8_SA(0, 1), cA + hstep, voffA);
        if (wr == 1) PG8_BAR;
        PG8_WAIT_V(2); PG8_BAR;
        PG8_STAGE(PG8_SB(1, 0), cB + kstep, voffB); PG8_STAGE(PG8_SA(1, 0), cA + kstep, voffA); PG8_STAGE(PG8_SB(1, 1), cB + hstep + kstep, voffB);
        PG8_WAIT_V(6); PG8_BAR;
    } else {
        PG8_STAGE(PG8_SB(0, 0), cB, voffB); PG8_STAGE(PG8_SA(0, 0), cA, voffA); PG8_STAGE(PG8_SB(0, 1), cB + hstep, voffB); PG8_STAGE(PG8_SA(0, 1), cA + hstep, voffA);
        if (wr == 1) PG8_BAR;
        PG8_WAIT_V(4); PG8_BAR;
        PG8_STAGE(PG8_SB(1, 0), cB + kstep, voffB); PG8_STAGE(PG8_SA(1, 0), cA + kstep, voffA); PG8_STAGE(PG8_SB(1, 1), cB + hstep + kstep, voffB);
        PG8_WAIT_V(6); PG8_BAR;
    }
    for (;;) {
        const bool has_next = S.next(ui + 1, nxt);
        const char* nA = has_next ? (const char*)g.A + (size_t)nxt.pm * tstep : cA; const char* nB = has_next ? (const char*)g.Bt + (size_t)nxt.pn * tstep : cB;
        for (int t = 0; t < nt; t += 2) {
            const bool last = (t == nt - 2);
            const char* a1 = cA + (size_t)(t + 1) * kstep;
            const char* a2 = last ? nA : cA + (size_t)(t + 2) * kstep; const char* b2 = last ? nB : cB + (size_t)(t + 2) * kstep;
            const char* a3 = a2 + kstep; const char* b3 = b2 + kstep;
            if (last && has_next) S.a_ready(nxt);
            if constexpr (SP2) {
            PG8_LDB(B0, 0, 0); PG8_LDB(B1, 0, 1); PG8_SCHED; PG8_LDA(At, 0, 0); PG8_STAGE(PG8_SA(1, 1), a1 + hstep, voffA);
            PG8_WAIT_V(8); PG8_WAIT_L(0); PG8_BAR; PG8_MMA(0, 0, At, B0); PG8_MMA(0, 1, At, B1); PG8_BAR; PG8_SCHED;
            PG8_LDA(At, 0, 1); PG8_STAGE(PG8_SB(0, 0), b2, voffB); PG8_STAGE(PG8_SB(0, 1), b2 + hstep, voffB); PG8_STAGE(PG8_SA(0, 0), a2, voffA);
            PG8_WAIT_V(8); PG8_WAIT_L(0); PG8_BAR; PG8_MMA(1, 0, At, B0); PG8_MMA(1, 1, At, B1); PG8_BAR; PG8_SCHED;
            PG8_LDB(B0, 1, 0); PG8_LDB(B1, 1, 1); PG8_SCHED; PG8_LDA(At, 1, 0); PG8_STAGE(PG8_SA(0, 1), a2 + hstep, voffA);
            PG8_WAIT_V(8); PG8_WAIT_L(0); PG8_BAR; PG8_MMA(0, 0, At, B0); PG8_MMA(0, 1, At, B1); PG8_BAR; PG8_SCHED;
            PG8_LDA(At, 1, 1); PG8_STAGE(PG8_SB(1, 0), b3, voffB); PG8_STAGE(PG8_SB(1, 1), b3 + hstep, voffB); PG8_STAGE(PG8_SA(1, 0), a3, voffA);
            PG8_WAIT_V(8); PG8_WAIT_L(0); PG8_BAR; PG8_MMA(1, 0, At, B0); PG8_MMA(1, 1, At, B1); PG8_BAR; PG8_SCHED;
            } else {
            PG8_LDB(B0, 0, 0); PG8_SCHED; PG8_LDA(At, 0, 0); PG8_STAGE(PG8_SA(1, 1), a1 + hstep, voffA);
            PG8_WAIT_L(8); PG8_BAR; PG8_WAIT_L(0); PG8_MMA(0, 0, At, B0); PG8_BAR; PG8_SCHED;
            PG8_LDB(B1, 0, 1); PG8_STAGE(PG8_SB(0, 0), b2, voffB);
            PG8_BAR; PG8_WAIT_L(0); PG8_MMA(0, 1, At, B1); PG8_BAR;
            PG8_LDA(At, 0, 1); PG8_STAGE(PG8_SA(0, 0), a2, voffA);
            PG8_BAR; PG8_WAIT_L(0); PG8_MMA(1, 0, At, B0); PG8_BAR; PG8_SCHED;
            PG8_STAGE(PG8_SB(0, 1), b2 + hstep, voffB);
            PG8_WAIT_V(6); PG8_BAR; PG8_MMA(1, 1, At, B1); PG8_BAR;
            PG8_LDB(B0, 1, 0); PG8_SCHED; PG8_LDA(At, 1, 0); PG8_STAGE(PG8_SA(0, 1), a2 + hstep, voffA);
            PG8_WAIT_L(8); PG8_BAR; PG8_WAIT_L(0); PG8_MMA(0, 0, At, B0); PG8_BAR; PG8_SCHED;
            PG8_LDB(B1, 1, 1); PG8_STAGE(PG8_SB(1, 0), b3, voffB);
            PG8_BAR; PG8_WAIT_L(0); PG8_MMA(0, 1, At, B1); PG8_BAR;
            PG8_LDA(At, 1, 1); PG8_STAGE(PG8_SA(1, 0), a3, voffA);
            PG8_BAR; PG8_WAIT_L(0); PG8_MMA(1, 0, At, B0); PG8_BAR; PG8_SCHED;
            PG8_STAGE(PG8_SB(1, 1), b3 + hstep, voffB);
            PG8_WAIT_V(6); PG8_BAR; PG8_MMA(1, 1, At, B1); PG8_BAR;
            }
        }
        if constexpr (ALIGN_EPI) { if (wr == 0) PG8_BAR; }
        if constexpr (!Epi::AFTER_DRAIN) { E(acc, cur, wr, wc, fr, fq); S.done(cur); }
        if (!has_next) break;
#pragma unroll
        for (int a = 0; a < 2; ++a)
#pragma unroll
            for (int b = 0; b < 2; ++b)
#pragma unroll
                for (int m = 0; m < 4; ++m)
#pragma unroll
                    for (int n = 0; n < 2; ++n) acc[a][b][m][n] = (f32x4){0.f, 0.f, 0.f, 0.f};
        cur = nxt; cA = nA; cB = nB; ++ui;
        if constexpr (ALIGN_EPI) { if (wr == 1) PG8_BAR; }
    }
    PG8_WAIT_V(0);
    if constexpr (!ALIGN_EPI) { if (wr == 0) PG8_BAR; }
    PG8_BAR;
    if constexpr (Epi::AFTER_DRAIN) { E.fused(acc, cur, wr, wc, fr, fq, lds, wid, lane); S.done(cur); }
#undef PG8_SA
#undef PG8_SB
#undef PG8_STAGE
#undef PG8_LDA
#undef PG8_LDB
#undef PG8_MMA
#undef PG8_WAIT_V
#undef PG8_WAIT_L
#undef PG8_BAR
#undef PG8_SCHED
}
}
#define XB_TMO      128
#define XB_XCNT(j)  (256  + 64 * (j))
#define XB_XSUB(j)  (1280 + 64 * (j))
#define XB_XGEN(j)  (2304 + 64 * (j))
#define XB_TOP      3328
#define XB_TOPGEN   3392
#define XCD_BAR_WORDS 3456
#define XB_SPIN_CAP (1u << 18)

__device__ __forceinline__ unsigned xb_ld(unsigned* p)              { return __hip_atomic_load(p, __ATOMIC_RELAXED, __HIP_MEMORY_SCOPE_AGENT); }
__device__ __forceinline__ unsigned xb_add(unsigned* p, unsigned v) { return __hip_atomic_fetch_add(p, v, __ATOMIC_RELAXED, __HIP_MEMORY_SCOPE_AGENT); }
__device__ __forceinline__ unsigned xb_xcc_id() { return (unsigned)__builtin_amdgcn_s_getreg((3 << 11) | 20) & 0xFu; }
#define XB_SPIN(cond, bar) do { unsigned _sp = 0; while (cond) { __builtin_amdgcn_s_sleep(1); \
    if ((++_sp & 255u) == 0u) { if (xb_ld(&(bar)[XB_TMO])) break; if (_sp > XB_SPIN_CAP) { atomicAdd(&(bar)[XB_TMO], 1u); break; } } } } while (0)

struct XcdBarrier {
    unsigned* bar; unsigned x;
    volatile LAS unsigned* st;
};

__device__ __forceinline__ XcdBarrier xcd_barrier_post(unsigned* bar, volatile LAS unsigned* st) {
    XcdBarrier b; b.bar = bar; b.x = xb_xcc_id(); b.st = st;
    if (threadIdx.x == 0) (void)xb_add(&bar[XB_XCNT(b.x)], 1u);
    return b;
}
__device__ __forceinline__ void xcd_barrier_complete(unsigned* bar, unsigned x, unsigned& nloc, unsigned& nx) {
    const unsigned G = gridDim.x * gridDim.y * gridDim.z;
    unsigned sum, cnt, mine, sp = 0u;
    for (;;) {
        sum = 0u; cnt = 0u; mine = 0u;
#pragma unroll
        for (unsigned j = 0; j < 16; ++j) { const unsigned c = xb_ld(&bar[XB_XCNT(j)]); sum += c; cnt += (c > 0u) ? 1u : 0u; mine = (j == x) ? c : mine; }
        if (sum == G) break;
        __builtin_amdgcn_s_sleep(1);
        if ((++sp & 255u) == 0u) { if (xb_ld(&bar[XB_TMO])) break; if (sp > XB_SPIN_CAP) { atomicAdd(&bar[XB_TMO], 1u); break; } }
    }
    nloc = mine > 0u ? mine : 1u; nx = cnt > 0u ? cnt : 1u;
}

__device__ __forceinline__ void xcd_barrier(const XcdBarrier& b) {
    asm volatile("s_waitcnt vmcnt(0)" ::: "memory");
    __syncthreads();
    if (threadIdx.x == 0) {
        unsigned* bar = b.bar;
        __builtin_amdgcn_s_waitcnt(0);
        unsigned nloc = b.st[0], nx = b.st[1];
        if (nloc == 0u) { xcd_barrier_complete(bar, b.x, nloc, nx); b.st[0] = nloc; b.st[1] = nx; }
        const unsigned old = xb_add(&bar[XB_XSUB(b.x)], 1u);
        const unsigned gen = old / nloc;
        if (old + 1u == (gen + 1u) * nloc) {
            __builtin_amdgcn_fence(__ATOMIC_RELEASE, "agent");
            asm volatile("s_waitcnt vmcnt(0)" ::: "memory");
            const unsigned og = xb_add(&bar[XB_TOP], 1u);
            const unsigned tg = og / nx;
            if (og + 1u == (tg + 1u) * nx) xb_add(&bar[XB_TOPGEN], 1u);
            else XB_SPIN(xb_ld(&bar[XB_TOPGEN]) == tg, bar);
            __builtin_amdgcn_fence(__ATOMIC_ACQUIRE, "agent");
            xb_add(&bar[XB_XGEN(b.x)], 1u);
            asm volatile("s_waitcnt vmcnt(0)" ::: "memory");
        } else {
            XB_SPIN(xb_ld(&bar[XB_XGEN(b.x)]) == gen, bar);
            __builtin_amdgcn_fence(__ATOMIC_ACQUIRE, "agent");
            asm volatile("s_waitcnt vmcnt(0)" ::: "memory");
        }
    }
    __syncthreads();
}
struct Args { const void* in[31]; float* out; unsigned char* ws; int ph_lo, ph_hi, li, pad; };
struct Frame {
    LAS unsigned char* lds; volatile LAS unsigned* MISC; gu32* ctl;
    int tid, lane, wave, vcu, G;
    unsigned char* ws; float* out;
};
__device__ __forceinline__ float wave_sum_f(float v) {
#pragma unroll
    for (int o = 1; o < 64; o <<= 1) v += __shfl_xor(v, o);
    return v;
}
__device__ __forceinline__ void p0_transpose_item(const float* W, int K, int N, bf16_t* WT, int row_off, LAS float* scr, int kb, int nb, int lane) {
    const int k0 = 64 * kb, n0 = 32 * nb;
#pragma unroll 8
    for (int i = 0; i < 32; ++i) { const int kk = 2 * i + (lane >> 5); scr[kk * 33 + (lane & 31)] = W[(size_t)(k0 + kk) * N + n0 + (lane & 31)]; }
    LDS_WAIT(); asm volatile("" ::: "memory");
    const int c = lane & 7;
#pragma unroll
    for (int j = 0; j < 4; ++j) { const int n = (lane >> 3) + 8 * j; const LAS float* s = scr + (8 * c) * 33 + n;
        v4u o; o.x = pk2(s[0 * 33], s[1 * 33]); o.y = pk2(s[2 * 33], s[3 * 33]); o.z = pk2(s[4 * 33], s[5 * 33]); o.w = pk2(s[6 * 33], s[7 * 33]);
        *(GAS v4u*)(WT + (size_t)(row_off + n0 + n) * K + k0 + 8 * c) = o; }
    LDS_WAIT(); asm volatile("" ::: "memory");
}
__device__ __forceinline__ int lru_chan(int ks, int hi, int j) { return 32 * (ks >> 1) + 16 * (ks & 1) + 8 * (j >> 2) + 4 * hi + (j & 3); }
__device__ __forceinline__ void phase_prologue(Frame& F, const Inputs& I) {
    if (blockIdx.x < 192) {
        LAS float* sl = (LAS float*)F.lds; LAS float* red = sl + 4096;
        for (int i = ((int)threadIdx.x); i < 4096; i += 512) { const float v = I.c[i]; sl[i] = v / (1.f + __expf(-v)); }
        __syncthreads();
        const int col0 = blockIdx.x * 32, kg = ((int)threadIdx.x) >> 5, col = ((int)threadIdx.x) & 31;
        float a0 = 0.f, a1 = 0.f, a2 = 0.f, a3 = 0.f;
#pragma unroll 8
        for (int i = 0; i < 64; ++i) { const int k = kg + 16 * i; const float w = I.w_ada[(size_t)k * MODW + col0 + col];
            a0 += sl[k] * w; a1 += sl[1024 + k] * w; a2 += sl[2048 + k] * w; a3 += sl[3072 + k] * w; }
        red[(kg * 4 + 0) * 32 + col] = a0; red[(kg * 4 + 1) * 32 + col] = a1; red[(kg * 4 + 2) * 32 + col] = a2; red[(kg * 4 + 3) * 32 + col] = a3;
        __syncthreads();
        if (((int)threadIdx.x) < 128) { const int b = ((int)threadIdx.x) >> 5, c = ((int)threadIdx.x) & 31; float s = I.b_ada[col0 + c];
            for (int g = 0; g < 16; ++g) s += red[(g * 4 + b) * 32 + c];
            ((float*)(F.ws + WS_MOD))[b * MODW + col0 + c] = s; }
        __syncthreads();
    }
    {
        LAS float* scr = (LAS float*)(F.lds + F.wave * 16384);
        const int gw = F.vcu * NWAVES + F.wave, NGW = F.G * NWAVES;
        bf16_t* WIN = (bf16_t*)(F.ws + WSX_WIN); bf16_t* WOUT = (bf16_t*)(F.ws + WSX_WOUT); bf16_t* W1T = (bf16_t*)(F.ws + WSX_W1T); bf16_t* W2T = (bf16_t*)(F.ws + WSX_W2T);
        constexpr int I_IN = 16 * 46, I_OUT = 16 * 32, I_G = 32 * 16 * 8, I_D = 32 * 4 * 32, NIT = I_IN + I_OUT + 2 * I_G + I_D;
        for (int it = gw; it < NIT; it += NGW) {
            int r = it;
            if (r < I_IN) { p0_transpose_item(I.w_in, 1024, NPROJ, WIN, 0, scr, r / 46, r % 46, ((int)(threadIdx.x & 63))); continue; } r -= I_IN;
            if (r < I_OUT) { p0_transpose_item(I.w_out, 1024, 1024, WOUT, 0, scr, r / 32, r % 32, ((int)(threadIdx.x & 63))); continue; } r -= I_OUT;
            if (r < 2 * I_G) { const int up = r >= I_G ? 1 : 0; if (up) r -= I_G; const int e = r >> 7, kb = (r >> 3) & 15, nb = r & 7, n0 = 32 * nb;
                p0_transpose_item((up ? I.w_up : I.w_gate) + (size_t)e * 1024 * 256, 1024, 256, W1T, e * 512 + (n0 >> 7) * 256 + (n0 & 127) - n0 + up * 128, scr, kb, nb, ((int)(threadIdx.x & 63))); continue; } r -= 2 * I_G;
            { const int e = r >> 7, kb = (r >> 5) & 3, nb = r & 31; p0_transpose_item(I.w_down + (size_t)e * 256 * 1024, 256, 1024, W2T, e * 1024, scr, kb, nb, ((int)(threadIdx.x & 63))); }
        }
    }
    {
        const int gt = blockIdx.x * 512 + ((int)threadIdx.x), NGT = F.G * 512;
        v4u* WQF = (v4u*)(F.ws + WSX_WQF); v4u* WKVF = (v4u*)(F.ws + WSX_WKVF); v4u* WAF = (v4u*)(F.ws + WSX_WAF); v4u* WXF = (v4u*)(F.ws + WSX_WXF); v4u* WRF = (v4u*)(F.ws + WSX_WRF);
        constexpr int NQ = 4 * 6 * 16 * 64, NKV = 4 * 8 * 8 * 64, NA = 4 * 4 * 8 * 64, NR = 2 * 64 * 64, NZ = 64 * 1024 / 8, NTOT = NQ + NKV + 2 * NA + NR + NZ;
        for (int g = gt; g < NTOT; g += NGT) {
            int r = g; float v[8];
            if (r < NQ) { const int lane = r & 63, ks = (r >> 6) & 15, hn = r >> 10, h = hn / 6, nb = hn % 6, hi = lane >> 5, r32 = lane & 31;
#pragma unroll
                for (int j = 0; j < 8; ++j) { const int k = 16 * ks + 8 * hi + j; v[j] = I.w_q_b[(size_t)k * 768 + h * 192 + 32 * nb + r32] * I.q_a_norm[k]; }
                WQF[r] = (v4u){pk2(v[0], v[1]), pk2(v[2], v[3]), pk2(v[4], v[5]), pk2(v[6], v[7])}; continue; } r -= NQ;
            if (r < NKV) { const int lane = r & 63, ks = (r >> 6) & 7, hn = r >> 9, h = hn >> 3, nb = hn & 7, hi = lane >> 5, r32 = lane & 31;
#pragma unroll
                for (int j = 0; j < 8; ++j) { const int k = 16 * ks + 8 * hi + j; v[j] = I.w_kv_b[(size_t)k * 1024 + h * 256 + 32 * nb + r32] * I.kv_a_norm[k]; }
                WKVF[r] = (v4u){pk2(v[0], v[1]), pk2(v[2], v[3]), pk2(v[4], v[5]), pk2(v[6], v[7])}; continue; } r -= NKV;
            if (r < 2 * NA) { const int x = r >= NA ? 1 : 0; if (x) r -= NA; const int lane = r & 63, ks = (r >> 6) & 7, hn = r >> 9, h = hn >> 2, nb = hn & 3, hi = lane >> 5, r32 = lane & 31;
                const float* W = x ? I.lru_wx : I.lru_wa;
#pragma unroll
                for (int j = 0; j < 8; ++j) v[j] = W[(size_t)(h * 128 + lru_chan(ks, hi, j)) * 128 + 32 * nb + r32];
                (x ? WXF : WAF)[r] = (v4u){pk2(v[0], v[1]), pk2(v[2], v[3]), pk2(v[4], v[5]), pk2(v[6], v[7])}; continue; } r -= 2 * NA;
            if (r < NR) { const int lane = r & 63, ks = (r >> 6) & 63, nb = r >> 12, hi = lane >> 5, n = 32 * nb + (lane & 31);
#pragma unroll
                for (int j = 0; j < 8; ++j) { const int k = 16 * ks + 8 * hi + j; v[j] = n < 4 ? I.w_rg[k * 4 + n] : (n < 36 ? I.w_re[k * 32 + n - 4] : 0.f); }
                WRF[r] = (v4u){pk2(v[0], v[1]), pk2(v[2], v[3]), pk2(v[4], v[5]), pk2(v[6], v[7])}; continue; } r -= NR;
            ((v4u*)(F.ws + WSX_WIN + (size_t)NPROJ * 1024 * 2))[r] = (v4u){0u, 0u, 0u, 0u};
        }
        if (gt < 512) ((float*)(F.ws + WSX_SP))[gt] = log1pf(__expf(-I.lru_lambda[gt]));
        float* CS = (float*)(F.ws + WSX_CS);
        for (int g = gt; g < NTOK * 32; g += NGT) { const int t = g >> 5, i = g & 31; float c, s; rope_cs(I.positions[t], i, c, s); CS[t * 64 + i] = c; CS[t * 64 + 32 + i] = s; }
    }
}
__device__ __forceinline__ void phase_xn(Frame& F, const Inputs& I) {
    LAS float* Gs = (LAS float*)F.lds; LAS float* Ss = Gs + 4096;
    const float* mod = (const float*)(F.ws + WS_MOD);
    for (int i = ((int)threadIdx.x); i < 4096; i += 512) { const int b = i >> 10, k = i & 1023; Gs[i] = I.norm1_g[k] * (1.f + mod[b * MODW + 1024 + k]); Ss[i] = mod[b * MODW + k]; }
    __syncthreads();
    bf16_t* XN = (bf16_t*)(F.ws + WSX_A);
    const int gw = F.vcu * NWAVES + F.wave, NGW = F.G * NWAVES;
    for (int m0 = gw; m0 < NTOK; m0 += 2 * NGW) {
        f32x4 v[2][4];
#pragma unroll
        for (int u = 0; u < 2; ++u) { const GAS f32x4* xr = (const GAS f32x4*)(I.x + (size_t)(m0 + u * NGW) * DM) + ((int)(threadIdx.x & 63));
#pragma unroll
            for (int j = 0; j < 4; ++j) v[u][j] = xr[64 * j]; }
#pragma unroll
        for (int u = 0; u < 2; ++u) { const int m = m0 + u * NGW, b = m >> 13; float s = 0.f;
#pragma unroll
            for (int j = 0; j < 4; ++j) s += (v[u][j].x * v[u][j].x + v[u][j].y * v[u][j].y) + (v[u][j].z * v[u][j].z + v[u][j].w * v[u][j].w);
            const float rstd = rsqrtf(wave_sum_f(s) * (1.f / DM) + EPS);
            GAS v2u* o8 = (GAS v2u*)(XN + (size_t)m * DM) + ((int)(threadIdx.x & 63));
#pragma unroll
            for (int j = 0; j < 4; ++j) { const f32x4 g = *(const LAS f32x4*)(Gs + b * 1024 + 256 * j + 4 * ((int)(threadIdx.x & 63))), sh = *(const LAS f32x4*)(Ss + b * 1024 + 256 * j + 4 * ((int)(threadIdx.x & 63)));
                const f32x4 o = v[u][j] * rstd * g + sh; o8[64 * j] = (v2u){pk2(o.x, o.y), pk2(o.z, o.w)}; } }
    }
    __syncthreads();
}
namespace att {
constexpr int NW = 8, QBLK = 32, KVBLK = 64, QB = NW * QBLK;
constexpr int DQ = 192, DVV = 128, OPITCH = 512;
constexpr int SHM_V = KVBLK * DVV * 2, SHM_K = KVBLK * DQ * 2;
constexpr int ATT_LDS = 3 * SHM_V + 3 * SHM_K + NW * 64 * 4;
constexpr float SCALE = 0.07216878364870322f;
constexpr float THR = 8.f;
#define SBAR() __builtin_amdgcn_sched_barrier(0)
__device__ __forceinline__ int koff(int row, int chunk) { return (chunk >> 3) * 8192 + row * 128 + ((((chunk & 7) ^ ((row >> 1) & 7))) << 4); }
__device__ __forceinline__ int v_st(int k, int c) { const int kk = (k & ~0xC) | ((k & 4) << 1) | ((k & 8) >> 1); return ((kk >> 3) * 4 + (c >> 5)) * 512 + ((kk & 7) * 32 + (c & 31)) * 2; }
__device__ __forceinline__ int v_rd_base(int lane) { return ((lane & 3) << 3) | (((lane >> 2) & 3) << 6) | (((lane >> 4) & 1) << 5) | (((lane >> 5) & 1) << 8); }
constexpr int v_rd_off(int d0, int ks, int half) { return d0 * 512 + ks * 4096 + half * 2048; }
__device__ __forceinline__ int crow(int r, int hi) { return (r & 3) + 8 * (r >> 2) + 4 * hi; }
__device__ __forceinline__ bf16x8 ld8(const bf16_t* p) { return *reinterpret_cast<const bf16x8*>(p); }
__device__ __forceinline__ void mask_tile(f32x16& p0, f32x16& p1, int dq) {
    const float NEG = -__builtin_inff();
#pragma unroll
    for (int r = 0; r < 16; ++r) { const int c = (r & 3) + 8 * (r >> 2); if (dq - c < 0) p0[r] = NEG; if (dq - c - 32 < 0) p1[r] = NEG; }
}
__device__ __forceinline__ void partialSM(f32x16& p0, f32x16& p1, float& m_reg, float& mn, float& alpha) {
    float pmax = p0[0];
#pragma unroll
    for (int r = 1; r < 16; ++r) pmax = fmaxf(pmax, p0[r]);
#pragma unroll
    for (int r = 0; r < 16; ++r) pmax = fmaxf(pmax, p1[r]);
    { auto rr = __builtin_amdgcn_permlane32_swap(__float_as_uint(pmax), __float_as_uint(pmax), false, false); pmax = fmaxf(__uint_as_float(rr[0]), __uint_as_float(rr[1])); }
    constexpr float C2 = 1.4426950408889634f * SCALE;
    if (__builtin_expect(__all((pmax - m_reg) * SCALE <= THR), 1)) { mn = m_reg; alpha = 1.f; }
    else { mn = fmaxf(m_reg, pmax); alpha = __builtin_amdgcn_exp2f((m_reg - mn) * C2); m_reg = mn; }
    const float mnL = -mn * C2;
#pragma unroll
    for (int r = 0; r < 16; ++r) p0[r] = fmaf(p0[r], C2, mnL);
#pragma unroll
    for (int r = 0; r < 16; ++r) p1[r] = fmaf(p1[r], C2, mnL);
#pragma unroll
    for (int r = 0; r < 16; ++r) p0[r] = __builtin_amdgcn_exp2f(p0[r]);
}
__device__ __forceinline__ void finishSM(f32x16& p0, f32x16& p1, float alpha, float& l_reg, bf16x8& pa0, bf16x8& pa1, bf16x8& pa2, bf16x8& pa3) {
#pragma unroll
    for (int r = 0; r < 16; ++r) p1[r] = __builtin_amdgcn_exp2f(p1[r]);
    float ps = 0;
#pragma unroll
    for (int r = 0; r < 16; ++r) ps += p0[r];
#pragma unroll
    for (int r = 0; r < 16; ++r) ps += p1[r];
    { auto rr = __builtin_amdgcn_permlane32_swap(__float_as_uint(ps), __float_as_uint(ps), false, false); ps = __uint_as_float(rr[0]) + __uint_as_float(rr[1]); }
    l_reg = l_reg * alpha + ps;
#define PK4(P, B_, OUT) do { unsigned a0 = cvtpk(P[B_+0], P[B_+1]), a1 = cvtpk(P[B_+2], P[B_+3]); unsigned b0 = cvtpk(P[B_+4], P[B_+5]), b1 = cvtpk(P[B_+6], P[B_+7]); \
        auto r0 = __builtin_amdgcn_permlane32_swap(a0, b0, false, false); auto r1 = __builtin_amdgcn_permlane32_swap(a1, b1, false, false); \
        v4u w = {r0[0], r1[0], r0[1], r1[1]}; OUT = *reinterpret_cast<bf16x8*>(&w); } while (0)
    PK4(p0, 0, pa0); PK4(p0, 8, pa1); PK4(p1, 0, pa2); PK4(p1, 8, pa3);
#undef PK4
}
template <int KB>
__device__ __forceinline__ void qkt(f32x16& p0, f32x16& p1, const char* K_lds, int r32, int hi, const bf16x8* qr) {
    p0 = f32x16{}; p1 = f32x16{};
    const char* kb[4];
#pragma unroll
    for (int dd = 0; dd < 4; ++dd) kb[dd] = K_lds + KB * SHM_K + koff(r32, 2 * dd + hi);
    bf16x8 kf[2][2];
#define KLD(d) do { const char* a_ = kb[(d) & 3] + ((d) >> 2) * 8192; kf[(d) & 1][0] = *reinterpret_cast<const bf16x8*>(a_); kf[(d) & 1][1] = *reinterpret_cast<const bf16x8*>(a_ + 32 * 128); } while (0)
    KLD(0);
#pragma unroll
    for (int d0 = 0; d0 < 12; ++d0) { if (d0 + 1 < 12) KLD(d0 + 1);
        p0 = __builtin_amdgcn_mfma_f32_32x32x16_bf16(kf[d0 & 1][0], qr[d0], p0, 0, 0, 0);
        p1 = __builtin_amdgcn_mfma_f32_32x32x16_bf16(kf[d0 & 1][1], qr[d0], p1, 0, 0, 0); }
#undef KLD
    __builtin_amdgcn_sched_group_barrier(0x100, 2, 0);
#pragma unroll
    for (int d0 = 0; d0 < 11; ++d0) { __builtin_amdgcn_sched_group_barrier(0x100, 2, 0); __builtin_amdgcn_sched_group_barrier(0x8, 2, 0); }
    __builtin_amdgcn_sched_group_barrier(0x8, 2, 0);
}
typedef short v4i16_t __attribute__((ext_vector_type(4)));
__device__ __forceinline__ s16x4 vtr(int addr) { return __builtin_bit_cast(s16x4, __builtin_amdgcn_ds_read_tr16_b64_v4i16((__attribute__((address_space(3))) v4i16_t*)(uintptr_t)addr)); }
template <int VB>
__device__ __forceinline__ void pv_tile(f32x16* o, int vb0, bf16x8 pa0, bf16x8 pa1, bf16x8 pa2, bf16x8 pa3) {
    s16x4 lo[2][4], hv[2][4];
#define VLD(d) do { _Pragma("unroll") for (int ks = 0; ks < 4; ++ks) { lo[(d) & 1][ks] = vtr(vb0 + VB * SHM_V + v_rd_off((d), ks, 0)); hv[(d) & 1][ks] = vtr(vb0 + VB * SHM_V + v_rd_off((d), ks, 1)); } } while (0)
#define VF(d, k) (bf16x8){lo[(d) & 1][k][0], lo[(d) & 1][k][1], lo[(d) & 1][k][2], lo[(d) & 1][k][3], hv[(d) & 1][k][0], hv[(d) & 1][k][1], hv[(d) & 1][k][2], hv[(d) & 1][k][3]}
    VLD(0);
#pragma unroll
    for (int d0 = 0; d0 < 4; ++d0) { if (d0 + 1 < 4) VLD(d0 + 1);
        o[d0] = __builtin_amdgcn_mfma_f32_32x32x16_bf16(pa0, VF(d0, 0), o[d0], 0, 0, 0);
        o[d0] = __builtin_amdgcn_mfma_f32_32x32x16_bf16(pa1, VF(d0, 1), o[d0], 0, 0, 0);
        o[d0] = __builtin_amdgcn_mfma_f32_32x32x16_bf16(pa2, VF(d0, 2), o[d0], 0, 0, 0);
        o[d0] = __builtin_amdgcn_mfma_f32_32x32x16_bf16(pa3, VF(d0, 3), o[d0], 0, 0, 0); }
#undef VLD
#undef VF
    __builtin_amdgcn_sched_group_barrier(0x100, 8, 0);
#pragma unroll
    for (int d0 = 0; d0 < 3; ++d0) { __builtin_amdgcn_sched_group_barrier(0x100, 8, 0); __builtin_amdgcn_sched_group_barrier(0x8, 4, 0); }
    __builtin_amdgcn_sched_group_barrier(0x8, 4, 0);
}
__device__ __forceinline__ int kperm(int l) { return ((l & 7) << 1) | ((l >> 3) & 1) | (l & 48); }
__device__ __forceinline__ int kpiece(int tid) { return (tid >> 6) * 64 + kperm(tid & 63); }
__device__ __forceinline__ int vpiece(int tid, int i) { const int l = tid & 63, w = tid >> 6; return (4 * (w & 3) + (l & 3)) * 64 + (l >> 2) + 16 * ((w >> 2) + 2 * i); }
struct BlockRef { const bf16_t* Q; const bf16_t* K; const bf16_t* V; bf16_t* O; int P0; };
#define VMW() asm volatile("s_waitcnt vmcnt(0)" ::: "memory")
template <bool MASK, int ABL>
__device__ __forceinline__ void attn_step(int t, int NT, const bf16_t* Kh, const bf16_t* Vh, char* K_lds, char* V_lds, int kcur, int vprev, int snext, f32x16* o, f32x16& p0, f32x16& p1,
                                          bf16x8& pa0, bf16x8& pa1, bf16x8& pa2, bf16x8& pa3, bf16x8& sv0, bf16x8& sv1, bf16x8& sk0, bf16x8& sk1, bf16x8& sk2,
                                          const bf16x8* qr, float& m_reg, float& l_reg, float* al_l, int tid, int r32, int hi, int qlo, int vbase) {
    float mn, al;
    if (!(ABL & 8) && t + 1 < NT) { int tl = tid; asm volatile("" : "+v"(tl));
        const int kp = kpiece(tl), vp0 = vpiece(tl, 0), vp1 = vpiece(tl, 1); const int kw0 = koff(kp & 63, kp >> 6); VMW();
        *(bf16x8*)(V_lds + snext * SHM_V + v_st(vp0 & 63, (vp0 >> 6) * 8)) = sv0; *(bf16x8*)(V_lds + snext * SHM_V + v_st(vp1 & 63, (vp1 >> 6) * 8)) = sv1;
        *(bf16x8*)(K_lds + snext * SHM_K + kw0) = sk0; *(bf16x8*)(K_lds + snext * SHM_K + kw0 + 8192) = sk1; *(bf16x8*)(K_lds + snext * SHM_K + kw0 + 16384) = sk2; }
    if (!(ABL & 1)) { SBAR(); qkt<0>(p0, p1, K_lds + kcur * SHM_K, r32, hi, qr); SBAR(); } else { p0 = f32x16{}; p1 = f32x16{}; p0[0] = (float)t; asm volatile("" : "+v"(p0), "+v"(p1)); }
    if (!(ABL & 8) && t + 2 < NT) { const size_t k0 = (size_t)(t + 2) * KVBLK; int tl = tid; asm volatile("" : "+v"(tl)); const int kp = kpiece(tl);
        sv0 = ld8(Vh + k0 * DVV + vpiece(tl, 0) * 8); sv1 = ld8(Vh + k0 * DVV + vpiece(tl, 1) * 8);
        sk0 = ld8(Kh + k0 * DQ + kp * 8); sk1 = ld8(Kh + k0 * DQ + (kp + 512) * 8); sk2 = ld8(Kh + k0 * DQ + (kp + 1024) * 8); SBAR(); }
    if (!(ABL & 2) && t > 0) { int ll = tid; asm volatile("" : "+v"(ll)); pv_tile<0>(o, vbase + v_rd_base(ll & 63) + vprev * SHM_V, pa0, pa1, pa2, pa3); }
    { const int kb_ = t * KVBLK; if (kb_ + KVBLK - 1 > qlo) { asm volatile("" ::: "memory"); mask_tile(p0, p1, qlo + r32 - 4 * hi - kb_); } }
    if (!(ABL & 4)) partialSM(p0, p1, m_reg, mn, al); else { mn = 0.f; al = 1.f; }
    if (!(ABL & 16)) __syncthreads();
    if (__any(al < 1.f)) { asm volatile("" ::: "memory"); if (hi == 0) al_l[r32] = al; asm volatile("s_waitcnt lgkmcnt(0)" ::: "memory");
#pragma unroll
        for (int d_ = 0; d_ < 4; ++d_)
#pragma unroll
            for (int r = 0; r < 16; ++r) o[d_][r] *= al_l[crow(r, hi)]; }
    if (!(ABL & 4)) finishSM(p0, p1, al, l_reg, pa0, pa1, pa2, pa3); else { asm volatile("" : "+v"(p0), "+v"(p1)); v4u w = {__float_as_uint(p0[0]), __float_as_uint(p0[1]), __float_as_uint(p1[0]), __float_as_uint(p1[1])}; pa0 = pa1 = pa2 = pa3 = *reinterpret_cast<bf16x8*>(&w); l_reg += 1.f; }
    if (!(ABL & 16)) __syncthreads();
}
template <int ABL>
__device__ __forceinline__ void attn_block(const BlockRef& cur, char* lds) {
    int tid_ = threadIdx.x; asm volatile("" : "+v"(tid_));
    const int tid = tid_, wid = __builtin_amdgcn_readfirstlane(tid >> 6), lane = tid & 63, r32 = lane & 31, hi = lane >> 5;
    const int NT = (cur.P0 + QB - 1) / KVBLK + 1;
    const int qlo = cur.P0 + wid * QBLK;
    char* V_lds = lds; char* K_lds = lds + 3 * SHM_V;
    float* ws = (float*)(lds + 3 * SHM_V + 3 * SHM_K) + wid * 64; float* li_l = ws, * al_l = ws + 32;
    float m_reg = -1e30f, l_reg = 0; f32x16 o[4] = {};
    const int kp = kpiece(tid), vp0 = vpiece(tid, 0), vp1 = vpiece(tid, 1), kw0 = koff(kp & 63, kp >> 6);
    const int vbase = (int)(uintptr_t)V_lds, vb0 = vbase + v_rd_base(lane);
    const bf16_t* Kh = cur.K; const bf16_t* Vh = cur.V;
    bf16x8 qr[12], sv0, sv1, sk0, sk1, sk2, pa0, pa1, pa2, pa3; f32x16 p0, p1;
#pragma unroll
    for (int d0 = 0; d0 < 12; ++d0) qr[d0] = ld8(cur.Q + (size_t)wid * QBLK * DQ + (2 * d0 + hi) * 256 + r32 * 8);
    sv0 = ld8(Vh + vp0 * 8); sv1 = ld8(Vh + vp1 * 8); sk0 = ld8(Kh + kp * 8); sk1 = ld8(Kh + (kp + 512) * 8); sk2 = ld8(Kh + (kp + 1024) * 8);
    VMW(); *(bf16x8*)(V_lds + v_st(vp0 & 63, (vp0 >> 6) * 8)) = sv0; *(bf16x8*)(V_lds + v_st(vp1 & 63, (vp1 >> 6) * 8)) = sv1;
    *(bf16x8*)(K_lds + kw0) = sk0; *(bf16x8*)(K_lds + kw0 + 8192) = sk1; *(bf16x8*)(K_lds + kw0 + 16384) = sk2;
    { const size_t k0 = KVBLK; sv0 = ld8(Vh + k0 * DVV + vp0 * 8); sv1 = ld8(Vh + k0 * DVV + vp1 * 8);
      sk0 = ld8(Kh + k0 * DQ + kp * 8); sk1 = ld8(Kh + k0 * DQ + (kp + 512) * 8); sk2 = ld8(Kh + k0 * DQ + (kp + 1024) * 8); }
    __syncthreads();
    if (wid >= 4) __syncthreads();
    int kcur = 0, vprev = 2, snext = 1;
#define ROT() do { vprev = kcur; kcur = snext; snext = snext == 2 ? 0 : snext + 1; } while (0)
#define STEP(M, t) do { attn_step<M, ABL>((t), NT, Kh, Vh, K_lds, V_lds, kcur, vprev, snext, o, p0, p1, pa0, pa1, pa2, pa3, sv0, sv1, sk0, sk1, sk2, qr, m_reg, l_reg, al_l, tid, r32, hi, qlo, vbase); ROT(); } while (0)
#pragma unroll 1
    for (int t = 0; t < NT; ++t) STEP(true, t);
#undef STEP
#undef ROT
    pv_tile<0>(o, vb0 + vprev * SHM_V, pa0, pa1, pa2, pa3);
    if (hi == 0) li_l[r32] = l_reg; asm volatile("s_waitcnt lgkmcnt(0)" ::: "memory");
    float rli[16];
#pragma unroll
    for (int r = 0; r < 16; ++r) rli[r] = __builtin_amdgcn_rcpf(li_l[crow(r, hi)]);
    bf16_t* Ow = cur.O + (size_t)(wid * QBLK) * OPITCH;
#pragma unroll
    for (int r = 0; r < 16; ++r) { const int orow = crow(r, hi);
#pragma unroll
        for (int d0 = 0; d0 < 4; ++d0) { const float v = o[d0][r] * rli[r]; const float vn = __shfl_xor(v, 1);
            if ((r32 & 1) == 0) *(unsigned*)(Ow + (size_t)orow * OPITCH + d0 * 32 + r32) = cvtpk(v, vn); } }
    if (wid < 4) __syncthreads();
    __syncthreads();
}
#undef VMW
#undef SBAR
__device__ __forceinline__ BlockRef make_ref(int L, int pass, const bf16_t* Q, const bf16_t* K, const bf16_t* V, bf16_t* O) {
    const int bh = L >> 4, x = L & 15, qb = pass ? 31 - x : x, b = bh >> 2, h = bh & 3;
    BlockRef r; r.Q = Q + ((size_t)bh * 8192 + (size_t)qb * QB) * DQ; r.K = K + (size_t)bh * 8192 * DQ; r.V = V + (size_t)bh * 8192 * DVV;
    r.O = O + ((size_t)b * 8192 + (size_t)qb * QB) * OPITCH + h * DVV; r.P0 = qb * QB; return r;
}
template <int ABL>
__device__ __forceinline__ void attn_phase(char* lds, const bf16_t* Q, const bf16_t* K, const bf16_t* V, bf16_t* O, int G, int bid) {
    for (int L = bid; L < 256; L += G)
#pragma unroll 1
        for (int pass = 0; pass < 2; ++pass) { const BlockRef cur = make_ref(L, pass, Q, K, V, O); attn_block<ABL>(cur, lds); }
}
}
namespace prj {
__device__ __forceinline__ int crow(int r, int hi) { return (r & 3) + 8 * (r >> 2) + 4 * hi; }
__device__ __forceinline__ float swap_add(float v) { auto rr = __builtin_amdgcn_permlane32_swap(__float_as_uint(v), __float_as_uint(v), false, false); return __uint_as_float(rr[0]) + __uint_as_float(rr[1]); }
__device__ __forceinline__ float sumsq8(bf16x8 v) { float s = 0.f;
#pragma unroll
    for (int j = 0; j < 8; ++j) { const float f = bf2f((bf16_t)v[j]); s += f * f; } return s; }
__device__ __forceinline__ bf16x8 ldg8(const bf16_t* p) { return *reinterpret_cast<const bf16x8*>(p); }
__device__ __forceinline__ const bf16_t* projt(const unsigned char* ws, int t, int col) { return (const bf16_t*)(ws + WSX_B) + ((size_t)((t >> 5) * 192 + (col >> 3)) * 32 + (t & 31)) * 8 + (col & 7); }
__device__ __forceinline__ v2u pack4(float a, float b, float c, float d) { return (v2u){cvtpk(a, b), cvtpk(c, d)}; }

__device__ __forceinline__ void stage_weights(const unsigned char* src, LAS unsigned char* wl, int nkb, int wave, int lane) {
    __syncthreads();
    for (int i = wave; i < nkb; i += NWAVES) __builtin_amdgcn_global_load_lds((const unsigned*)(src + (size_t)i * 1024 + lane * 16), (LAS unsigned*)(wl + i * 1024), 16, 0, 0);
    asm volatile("s_waitcnt vmcnt(0)" ::: "memory");
    __syncthreads();
}
__device__ __forceinline__ void stage_weights2(const unsigned char* src0, const unsigned char* src1, LAS unsigned char* wl, int wave, int lane) {
    __syncthreads();
    for (int i = wave; i < 32; i += NWAVES) { __builtin_amdgcn_global_load_lds((const unsigned*)(src0 + (size_t)i * 1024 + lane * 16), (LAS unsigned*)(wl + i * 1024), 16, 0, 0);
                                              __builtin_amdgcn_global_load_lds((const unsigned*)(src1 + (size_t)i * 1024 + lane * 16), (LAS unsigned*)(wl + (32 + i) * 1024), 16, 0, 0); }
    asm volatile("s_waitcnt vmcnt(0)" ::: "memory");
    __syncthreads();
}
__device__ __forceinline__ void unit_q(const Inputs& I, unsigned char* ws, LAS unsigned char* wl, int wave, int grp, int lane) {
    const int r32 = lane & 31, hi = lane >> 5, t = grp * 32 + r32, b = t >> 13, s = t & 8191;
    const bf16_t* pr = projt(ws, t, C_QLAT + 8 * hi);
    float ssq = 0.f;
#pragma unroll
    for (int ks = 0; ks < 16; ++ks) ssq += sumsq8(ldg8(pr + 512 * ks));
    const float msq = swap_add(ssq) * (1.f / 256.f) + EPS;
    const LAS bf16x8* WQF = (const LAS bf16x8*)wl + lane;
    const float* cs = (const float*)(ws + WSX_CS) + (size_t)t * 64;
#pragma unroll 1
    for (int h = 0; h < 4; ++h) {
        stage_weights(ws + WSX_WQF + (size_t)h * 96 * 1024, wl, 96, wave, lane);
        f32x16 acc[6];
#pragma unroll
        for (int nb = 0; nb < 6; ++nb) acc[nb] = f32x16{};
#pragma unroll
        for (int k0 = 0; k0 < 16; k0 += 4) { bf16x8 bq[4];
#pragma unroll
            for (int i = 0; i < 4; ++i) bq[i] = ldg8(pr + 512 * (k0 + i));
#pragma unroll
            for (int i = 0; i < 4; ++i)
#pragma unroll
                for (int nb = 0; nb < 6; ++nb) acc[nb] = __builtin_amdgcn_mfma_f32_32x32x16_bf16(WQF[(nb * 16 + k0 + i) * 64], bq[i], acc[nb], 0, 0, 0);
            asm volatile("" ::: "memory"); }
        float ss = 0.f;
#pragma unroll
        for (int nb = 0; nb < 6; ++nb)
#pragma unroll
            for (int r = 0; r < 16; ++r) ss += acc[nb][r] * acc[nb][r];
        const float rs = rsqrtf(swap_add(ss) * (1.f / 192.f) + EPS * msq);
        bf16_t* qp = (bf16_t*)(ws + WSX_Q) + ((size_t)((b * 4 + h) * 256 + (s >> 5)) * 24) * 256 + r32 * 8 + 4 * hi;
#pragma unroll
        for (int nb = 0; nb < 4; ++nb)
#pragma unroll
            for (int q = 0; q < 4; ++q) { const int n = 32 * nb + 8 * q + 4 * hi; const f32x4 g = *(const f32x4*)(I.q_norm + n);
                *(v2u*)(qp + (4 * nb + q) * 256) = pack4(acc[nb][4 * q] * rs * g[0], acc[nb][4 * q + 1] * rs * g[1], acc[nb][4 * q + 2] * rs * g[2], acc[nb][4 * q + 3] * rs * g[3]); asm volatile("" ::: "memory"); }
#pragma unroll
        for (int q = 0; q < 4; ++q) { const int j = 8 * q + 4 * hi; const f32x4 g1 = *(const f32x4*)(I.q_norm + 128 + j), g2 = *(const f32x4*)(I.q_norm + 160 + j);
            const f32x4 c = *(const f32x4*)(cs + j), sn = *(const f32x4*)(cs + 32 + j);
            float o1[4], o2[4];
#pragma unroll
            for (int i = 0; i < 4; ++i) { const float x1 = acc[4][4 * q + i] * rs * g1[i], x2 = acc[5][4 * q + i] * rs * g2[i]; o1[i] = x1 * c[i] - x2 * sn[i]; o2[i] = x2 * c[i] + x1 * sn[i]; }
            *(v2u*)(qp + (16 + q) * 256) = pack4(o1[0], o1[1], o1[2], o1[3]); *(v2u*)(qp + (20 + q) * 256) = pack4(o2[0], o2[1], o2[2], o2[3]); }
    }
}
__device__ __forceinline__ void unit_kv(const Inputs& I, unsigned char* ws, LAS unsigned char* wl, int wave, int grp, int lane) {
    const int r32 = lane & 31, hi = lane >> 5, t = grp * 32 + r32, b = t >> 13, s = t & 8191;
    bf16x8 bk[8]; float ssq = 0.f;
#pragma unroll
    for (int ks = 0; ks < 8; ++ks) { bk[ks] = ldg8(projt(ws, t, C_KVLAT + 8 * hi) + 512 * ks); ssq += sumsq8(bk[ks]); }
    const float rstd = rsqrtf(swap_add(ssq) * (1.f / 128.f) + EPS);
    float kr1[16], kr2[16]; float ssr = 0.f;
#pragma unroll
    for (int q = 0; q < 4; ++q) { const int j = 8 * q + 4 * hi; const v2u a = *(const v2u*)projt(ws, t, C_KROPE + j), c = *(const v2u*)projt(ws, t, C_KROPE + 32 + j);
        kr1[4 * q] = __uint_as_float(a.x << 16); kr1[4 * q + 1] = __uint_as_float(a.x & 0xffff0000u); kr1[4 * q + 2] = __uint_as_float(a.y << 16); kr1[4 * q + 3] = __uint_as_float(a.y & 0xffff0000u);
        kr2[4 * q] = __uint_as_float(c.x << 16); kr2[4 * q + 1] = __uint_as_float(c.x & 0xffff0000u); kr2[4 * q + 2] = __uint_as_float(c.y << 16); kr2[4 * q + 3] = __uint_as_float(c.y & 0xffff0000u); }
#pragma unroll
    for (int r = 0; r < 16; ++r) ssr += kr1[r] * kr1[r] + kr2[r] * kr2[r];
    const LAS bf16x8* WKVF = (const LAS bf16x8*)wl + lane;
    const float* cs = (const float*)(ws + WSX_CS) + (size_t)t * 64;
#pragma unroll 1
    for (int h = 0; h < 4; ++h) {
        stage_weights(ws + WSX_WKVF + (size_t)h * 64 * 1024, wl, 64, wave, lane);
        bf16_t* kp = (bf16_t*)(ws + WSX_K) + ((size_t)((b * 4 + h) * 128 + (s >> 6)) * 24) * 512 + (s & 63) * 8 + 4 * hi;
        bf16_t* vp = (bf16_t*)(ws + WSX_V) + ((size_t)((b * 4 + h) * 128 + (s >> 6)) * 16) * 512 + (s & 63) * 8 + 4 * hi;
        f32x16 acc[4];
#pragma unroll
        for (int nb = 0; nb < 4; nb += 2) { acc[nb] = f32x16{}; acc[nb + 1] = f32x16{}; bf16x8 wf[16];
#pragma unroll
            for (int i = 0; i < 16; ++i) wf[i] = WKVF[(nb * 8 + i) * 64];
#pragma unroll
            for (int i = 0; i < 8; ++i) acc[nb] = __builtin_amdgcn_mfma_f32_32x32x16_bf16(wf[i], bk[i], acc[nb], 0, 0, 0);
#pragma unroll
            for (int i = 0; i < 8; ++i) acc[nb + 1] = __builtin_amdgcn_mfma_f32_32x32x16_bf16(wf[8 + i], bk[i], acc[nb + 1], 0, 0, 0);
            }
        float ss = 0.f;
#pragma unroll
        for (int nb = 0; nb < 4; ++nb)
#pragma unroll
            for (int r = 0; r < 16; ++r) ss += acc[nb][r] * acc[nb][r];
        const float rs = rsqrtf(swap_add(ss * rstd * rstd + ssr) * (1.f / 192.f) + EPS), rk = rs * rstd;
#pragma unroll
        for (int nb = 0; nb < 4; ++nb)
#pragma unroll
            for (int q = 0; q < 4; ++q) { const int n = 32 * nb + 8 * q + 4 * hi; const f32x4 g = *(const f32x4*)(I.k_norm + n);
                *(v2u*)(kp + (4 * nb + q) * 512) = pack4(acc[nb][4 * q] * rk * g[0], acc[nb][4 * q + 1] * rk * g[1], acc[nb][4 * q + 2] * rk * g[2], acc[nb][4 * q + 3] * rk * g[3]); }
#pragma unroll
        for (int q = 0; q < 4; ++q) { const int j = 8 * q + 4 * hi; const f32x4 g1 = *(const f32x4*)(I.k_norm + 128 + j), g2 = *(const f32x4*)(I.k_norm + 160 + j);
            const f32x4 c = *(const f32x4*)(cs + j), sn = *(const f32x4*)(cs + 32 + j);
            float o1[4], o2[4];
#pragma unroll
            for (int i = 0; i < 4; ++i) { const float x1 = kr1[4 * q + i] * rs * g1[i], x2 = kr2[4 * q + i] * rs * g2[i]; o1[i] = x1 * c[i] - x2 * sn[i]; o2[i] = x2 * c[i] + x1 * sn[i]; }
            *(v2u*)(kp + (16 + q) * 512) = pack4(o1[0], o1[1], o1[2], o1[3]); *(v2u*)(kp + (20 + q) * 512) = pack4(o2[0], o2[1], o2[2], o2[3]); }
        asm volatile("" ::: "memory");
#pragma unroll
        for (int nb = 0; nb < 4; nb += 2) { acc[nb] = f32x16{}; acc[nb + 1] = f32x16{}; bf16x8 wf[16];
#pragma unroll
            for (int i = 0; i < 16; ++i) wf[i] = WKVF[((4 + nb) * 8 + i) * 64];
#pragma unroll
            for (int i = 0; i < 8; ++i) acc[nb] = __builtin_amdgcn_mfma_f32_32x32x16_bf16(wf[i], bk[i], acc[nb], 0, 0, 0);
#pragma unroll
            for (int i = 0; i < 8; ++i) acc[nb + 1] = __builtin_amdgcn_mfma_f32_32x32x16_bf16(wf[8 + i], bk[i], acc[nb + 1], 0, 0, 0);
            }
#pragma unroll
        for (int nb = 0; nb < 4; ++nb)
#pragma unroll
            for (int q = 0; q < 4; ++q) { const int n = 32 * nb + 8 * q + 4 * hi;
                *(v2u*)(vp + (4 * nb + q) * 512) = pack4(acc[nb][4 * q] * rstd, acc[nb][4 * q + 1] * rstd, acc[nb][4 * q + 2] * rstd, acc[nb][4 * q + 3] * rstd); }
        asm volatile("" ::: "memory");
    }
}
#define LRU_SCAN_STEP(CTRL) asm volatile("s_nop 1\n\t" \
    "v_fmac_f32_dpp %0, %0, %16 " CTRL "\n\tv_fmac_f32_dpp %1, %1, %17 " CTRL "\n\tv_fmac_f32_dpp %2, %2, %18 " CTRL "\n\tv_fmac_f32_dpp %3, %3, %19 " CTRL "\n\t" \
    "v_fmac_f32_dpp %4, %4, %20 " CTRL "\n\tv_fmac_f32_dpp %5, %5, %21 " CTRL "\n\tv_fmac_f32_dpp %6, %6, %22 " CTRL "\n\tv_fmac_f32_dpp %7, %7, %23 " CTRL "\n\t" \
    "v_fmac_f32_dpp %8, %8, %24 " CTRL "\n\tv_fmac_f32_dpp %9, %9, %25 " CTRL "\n\tv_fmac_f32_dpp %10, %10, %26 " CTRL "\n\tv_fmac_f32_dpp %11, %11, %27 " CTRL "\n\t" \
    "v_fmac_f32_dpp %12, %12, %28 " CTRL "\n\tv_fmac_f32_dpp %13, %13, %29 " CTRL "\n\tv_fmac_f32_dpp %14, %14, %30 " CTRL "\n\tv_fmac_f32_dpp %15, %15, %31 " CTRL "\n\t" \
    "v_mul_f32_dpp %16, %16, %16 " CTRL "\n\tv_mul_f32_dpp %17, %17, %17 " CTRL "\n\tv_mul_f32_dpp %18, %18, %18 " CTRL "\n\tv_mul_f32_dpp %19, %19, %19 " CTRL "\n\t" \
    "v_mul_f32_dpp %20, %20, %20 " CTRL "\n\tv_mul_f32_dpp %21, %21, %21 " CTRL "\n\tv_mul_f32_dpp %22, %22, %22 " CTRL "\n\tv_mul_f32_dpp %23, %23, %23 " CTRL "\n\t" \
    "v_mul_f32_dpp %24, %24, %24 " CTRL "\n\tv_mul_f32_dpp %25, %25, %25 " CTRL "\n\tv_mul_f32_dpp %26, %26, %26 " CTRL "\n\tv_mul_f32_dpp %27, %27, %27 " CTRL "\n\t" \
    "v_mul_f32_dpp %28, %28, %28 " CTRL "\n\tv_mul_f32_dpp %29, %29, %29 " CTRL "\n\tv_mul_f32_dpp %30, %30, %30 " CTRL "\n\tv_mul_f32_dpp %31, %31, %31 " CTRL "\n\ts_nop 1" \
    : "+v"(bv[0]), "+v"(bv[1]), "+v"(bv[2]), "+v"(bv[3]), "+v"(bv[4]), "+v"(bv[5]), "+v"(bv[6]), "+v"(bv[7]), "+v"(bv[8]), "+v"(bv[9]), "+v"(bv[10]), "+v"(bv[11]), "+v"(bv[12]), "+v"(bv[13]), "+v"(bv[14]), "+v"(bv[15]), \
      "+v"(av[0]), "+v"(av[1]), "+v"(av[2]), "+v"(av[3]), "+v"(av[4]), "+v"(av[5]), "+v"(av[6]), "+v"(av[7]), "+v"(av[8]), "+v"(av[9]), "+v"(av[10]), "+v"(av[11]), "+v"(av[12]), "+v"(av[13]), "+v"(av[14]), "+v"(av[15]))
constexpr int PRJ_TAB = 96 * 1024;
__device__ __forceinline__ void lru_tables(Frame& F, const Inputs& I) {
    LAS float* tb = (LAS float*)(F.lds + PRJ_TAB);
    for (int i = ((int)threadIdx.x); i < 2048; i += 512) tb[i] = I.conv_w[i];
    { const int c = ((int)threadIdx.x); tb[2048 + c] = I.conv_b[c]; tb[2560 + c] = -1.4426950408889634f * I.lru_ba[c]; tb[3072 + c] = -1.4426950408889634f * I.lru_bx[c];
      tb[3584 + c] = -8.f * 1.4426950408889634f * ((const float*)(F.ws + WSX_SP))[c]; }
    __syncthreads();
}
__device__ __forceinline__ void unit_lru(const Inputs& I, unsigned char* ws, LAS unsigned char* wl, int wave, int grp, int hp, int lane) {
    const int r32 = lane & 31, hi = lane >> 5, t = grp * 32 + r32, s = t & 8191;
    const bool reset = I.positions[t] == 0;
    const LAS float* tbl = (const LAS float*)(wl + PRJ_TAB);
    int xt[4]; float xz[4];
#pragma unroll
    for (int j = 0; j < 4; ++j) { const bool ok = s - 3 + j >= 0; xt[j] = ok ? t - 3 + j : t; xz[j] = ok ? 1.f : 0.f; }
    bf16_t* HL = (bf16_t*)(ws + WSX_D) + (size_t)t * 512; bf16_t* PC = HL + (size_t)NTOK * 512;
    float* SUMA = (float*)(ws + WSX_SUMA) + (size_t)grp * 512; float* SUMB = (float*)(ws + WSX_SUMB) + (size_t)grp * 512;
#pragma unroll 1
    for (int h = 2 * hp; h < 2 * hp + 2; ++h) {
        stage_weights2(ws + WSX_WAF + (size_t)h * 32 * 1024, ws + WSX_WXF + (size_t)h * 32 * 1024, wl, wave, lane);
        bf16x8 xf[8];
#pragma unroll
        for (int k2 = 0; k2 < 8; k2 += 2) { v2u xx[2][2][4];
#pragma unroll
            for (int kk = 0; kk < 2; ++kk)
#pragma unroll
                for (int j4 = 0; j4 < 2; ++j4)
#pragma unroll
                    for (int j = 0; j < 4; ++j) xx[kk][j4][j] = *(const v2u*)projt(ws, xt[j], C_XLRU + 128 * h + 32 * ((k2 + kk) >> 1) + 16 * ((k2 + kk) & 1) + 8 * j4 + 4 * hi);
#pragma unroll
            for (int kk = 0; kk < 2; ++kk) { unsigned w[4];
#pragma unroll
                for (int j4 = 0; j4 < 2; ++j4) { const int C = 128 * h + 32 * ((k2 + kk) >> 1) + 16 * ((k2 + kk) & 1) + 8 * j4 + 4 * hi;
                    f32x4 v = *(const LAS f32x4*)(tbl + 2048 + C);
#pragma unroll
                    for (int j = 0; j < 4; ++j) { const v2u x = xx[kk][j4][j]; const f32x4 cw = *(const LAS f32x4*)(tbl + j * 512 + C) * xz[j];
                        v[0] += cw[0] * __uint_as_float(x.x << 16); v[1] += cw[1] * __uint_as_float(x.x & 0xffff0000u); v[2] += cw[2] * __uint_as_float(x.y << 16); v[3] += cw[3] * __uint_as_float(x.y & 0xffff0000u); }
                    w[2 * j4] = cvtpk(v[0], v[1]); w[2 * j4 + 1] = cvtpk(v[2], v[3]); }
                v4u ww = {w[0], w[1], w[2], w[3]}; xf[k2 + kk] = *reinterpret_cast<bf16x8*>(&ww); }
            asm volatile("" ::: "memory"); }
        const LAS bf16x8* WAF = (const LAS bf16x8*)wl + lane; const LAS bf16x8* WXF = (const LAS bf16x8*)(wl + 32 * 1024) + lane;
#pragma unroll
        for (int nb = 0; nb < 4; ++nb) {
            f32x16 aa = f32x16{}, bb = f32x16{};
            { bf16x8 wf[16];
#pragma unroll
              for (int i = 0; i < 8; ++i) { wf[i] = WAF[(nb * 8 + i) * 64]; wf[8 + i] = WXF[(nb * 8 + i) * 64]; }
#pragma unroll
              for (int i = 0; i < 8; ++i) aa = __builtin_amdgcn_mfma_f32_32x32x16_bf16(wf[i], xf[i], aa, 0, 0, 0);
#pragma unroll
              for (int i = 0; i < 8; ++i) bb = __builtin_amdgcn_mfma_f32_32x32x16_bf16(wf[8 + i], xf[i], bb, 0, 0, 0);
              }
            float av[16], bv[16];
#pragma unroll
            for (int q = 0; q < 4; ++q) { const int C = 128 * h + 32 * nb + 8 * q + 4 * hi;
                const f32x4 ba = *(const LAS f32x4*)(tbl + 2560 + C), bx = *(const LAS f32x4*)(tbl + 3072 + C), sp = *(const LAS f32x4*)(tbl + 3584 + C);
#pragma unroll
                for (int i = 0; i < 4; ++i) { const int r = 4 * q + i;
                    const float rg = __builtin_amdgcn_rcpf(1.f + __builtin_amdgcn_exp2f(fmaf(aa[r], -1.4426950408889634f, ba[i])));
                    const float ig = __builtin_amdgcn_rcpf(1.f + __builtin_amdgcn_exp2f(fmaf(bb[r], -1.4426950408889634f, bx[i])));
                    float a = __builtin_amdgcn_exp2f(rg * sp[i]), mult = __builtin_amdgcn_sqrtf(fmaxf(fmaf(-a, a, 1.f), 0.f));
                    if (reset) { a = 0.f; mult = 1.f; }
                    const float xc = bf2f((bf16_t)xf[2 * nb + (r >> 3)][4 * ((r >> 2) & 1) + (r & 3)]);
                    av[r] = a; bv[r] = mult * ig * xc; } }
            LRU_SCAN_STEP("row_shr:1 row_mask:0xf bank_mask:0xf"); LRU_SCAN_STEP("row_shr:2 row_mask:0xf bank_mask:0xf"); LRU_SCAN_STEP("row_shr:4 row_mask:0xf bank_mask:0xf");
            LRU_SCAN_STEP("row_shr:8 row_mask:0xf bank_mask:0xf"); LRU_SCAN_STEP("row_bcast:15 row_mask:0xa bank_mask:0xf");
#pragma unroll
            for (int q = 0; q < 4; ++q) { const int C = 128 * h + 32 * nb + 8 * q + 4 * hi;
                *(v2u*)(HL + C) = pack4(bv[4 * q], bv[4 * q + 1], bv[4 * q + 2], bv[4 * q + 3]);
                *(v2u*)(PC + C) = pack4(av[4 * q], av[4 * q + 1], av[4 * q + 2], av[4 * q + 3]);
                if (r32 == 31) { *(f32x4*)(SUMA + C) = (f32x4){av[4 * q], av[4 * q + 1], av[4 * q + 2], av[4 * q + 3]};
                                 *(f32x4*)(SUMB + C) = (f32x4){bv[4 * q], bv[4 * q + 1], bv[4 * q + 2], bv[4 * q + 3]}; } }
            asm volatile("" ::: "memory");
        }
    }
}
__device__ __forceinline__ void phase_proj(Frame& F, const Inputs& I, int kmask) {
    LAS unsigned char* wl = F.lds;
    lru_tables(F, I);
    const int b = F.vcu, G = F.G;
    if (kmask & 2) for (int u = b; u < 256; u += G) unit_lru(I, F.ws, wl, F.wave, (u >> 1) * 8 + F.wave, u & 1, ((int)(threadIdx.x & 63)));
    asm volatile("" ::: "memory");
    if (kmask & 1) for (int u = b; u < 128; u += G) unit_q(I, F.ws, wl, F.wave, u * 8 + F.wave, ((int)(threadIdx.x & 63)));
    asm volatile("" ::: "memory");
    if (kmask & 4) for (int u = (G == 256 ? b - 128 : b); u < 128; u += G) if (u >= 0) unit_kv(I, F.ws, wl, F.wave, u * 8 + F.wave, ((int)(threadIdx.x & 63)));
    __syncthreads();
}
__device__ __forceinline__ float gelu_t(float v) { const float u = 0.7978845608028654f * (v + 0.044715f * v * v * v); return v / (1.f + __expf(-2.f * u)); }
__device__ __forceinline__ void unpack8(v4u w, float* f) {
    f[0] = __uint_as_float(w.x << 16); f[1] = __uint_as_float(w.x & 0xffff0000u); f[2] = __uint_as_float(w.y << 16); f[3] = __uint_as_float(w.y & 0xffff0000u);
    f[4] = __uint_as_float(w.z << 16); f[5] = __uint_as_float(w.z & 0xffff0000u); f[6] = __uint_as_float(w.w << 16); f[7] = __uint_as_float(w.w & 0xffff0000u); }
__device__ __forceinline__ void phase_mix(Frame& F, const Inputs& I) {
    LAS float* carry = (LAS float*)F.lds;
    const float* SUMA = (const float*)(F.ws + WSX_SUMA); const float* SUMB = (const float*)(F.ws + WSX_SUMB);
    const bf16_t* HL = (const bf16_t*)(F.ws + WSX_D); const bf16_t* PC = HL + (size_t)NTOK * 512;
    const bf16_t* PROJ = (const bf16_t*)(F.ws + WSX_B); bf16_t* MIXED = (bf16_t*)(F.ws + WSX_E); const bf16_t* AO = (const bf16_t*)(F.ws + WSX_AO);
    const int nper = 1024 / F.G;
    const int c0 = F.vcu * nper, bfirst = (c0 >> 8) << 8;
    {
        float h = 0.f; const int c = ((int)threadIdx.x);
        int k = bfirst;
        for (; k + 16 <= c0; k += 16) { float a[16], bq[16];
#pragma unroll
            for (int i = 0; i < 16; ++i) { a[i] = SUMA[(size_t)(k + i) * 512 + c]; bq[i] = SUMB[(size_t)(k + i) * 512 + c]; }
#pragma unroll
            for (int i = 0; i < 16; ++i) h = a[i] * h + bq[i]; }
        for (; k < c0; k += 4) { float a[4], bq[4];
#pragma unroll
            for (int i = 0; i < 4; ++i) { a[i] = SUMA[(size_t)(k + i) * 512 + c]; bq[i] = SUMB[(size_t)(k + i) * 512 + c]; }
#pragma unroll
            for (int i = 0; i < 4; ++i) h = a[i] * h + bq[i]; }
        carry[c] = h; }
    __syncthreads();
    const int C = 8 * ((int)(threadIdx.x & 63));
    const f32x4 g0 = *(const f32x4*)(I.lru_out_norm + C), g1 = *(const f32x4*)(I.lru_out_norm + C + 4), q0 = *(const f32x4*)(I.attn_out_norm + C), q1 = *(const f32x4*)(I.attn_out_norm + C + 4);
    for (int k = c0; k < c0 + nper; ++k) {
        const int tb = k * 32 + F.wave * 4;
        v4u hl4[4], pc4[4], gg4[4], at4[4];
#pragma unroll
        for (int rr = 0; rr < 4; ++rr) { const size_t t = tb + rr; hl4[rr] = *(const v4u*)(HL + t * 512 + C); pc4[rr] = *(const v4u*)(PC + t * 512 + C);
            gg4[rr] = *(const v4u*)projt(F.ws, (int)t, C_GLRU + C); at4[rr] = *(const v4u*)(AO + t * 512 + C); }
        float cy[8]; *(f32x4*)cy = *(const LAS f32x4*)(carry + C); *(f32x4*)(cy + 4) = *(const LAS f32x4*)(carry + C + 4);
        float hl[8];
#pragma unroll
        for (int rr = 0; rr < 4; ++rr) { const size_t t = tb + rr;
            float a[8], p[8], g[8], v[8];
            unpack8(hl4[rr], a); unpack8(pc4[rr], p); unpack8(gg4[rr], g);
            float ss = 0.f;
#pragma unroll
            for (int j = 0; j < 8; ++j) { hl[j] = a[j] + p[j] * cy[j]; v[j] = hl[j] * gelu_t(g[j]); ss += v[j] * v[j]; }
            float rs = rsqrtf(wave_sum_f(ss) * (1.f / 512.f) + EPS);
            *(v4u*)(MIXED + t * 1024 + 512 + C) = (v4u){cvtpk(v[0] * rs * g0[0], v[1] * rs * g0[1]), cvtpk(v[2] * rs * g0[2], v[3] * rs * g0[3]), cvtpk(v[4] * rs * g1[0], v[5] * rs * g1[1]), cvtpk(v[6] * rs * g1[2], v[7] * rs * g1[3])};
            unpack8(at4[rr], a); ss = 0.f;
#pragma unroll
            for (int j = 0; j < 8; ++j) ss += a[j] * a[j];
            rs = rsqrtf(wave_sum_f(ss) * (1.f / 512.f) + EPS);
            *(v4u*)(MIXED + t * 1024 + C) = (v4u){cvtpk(a[0] * rs * q0[0], a[1] * rs * q0[1]), cvtpk(a[2] * rs * q0[2], a[3] * rs * q0[3]), cvtpk(a[4] * rs * q1[0], a[5] * rs * q1[1]), cvtpk(a[6] * rs * q1[2], a[7] * rs * q1[3])};
        }
        __syncthreads();
        if (F.wave == 7) {
#pragma unroll
            for (int j = 0; j < 8; ++j) carry[8 * ((int)(threadIdx.x & 63)) + j] = hl[j]; }
        __syncthreads();
    }
}
}
namespace moe {
constexpr size_t WSX_RSTD = WSX_ROUTE + 800 * 1024;
constexpr size_t WSX_BB = WSX_ROUTE + 960 * 1024;
constexpr size_t WSX_WRFB = 70 * MiB;
constexpr size_t WSX_RBIAS = 70 * MiB + 512 * 1024;
constexpr int TP_OFF = LDSCTL_OFF + 512;
__device__ __forceinline__ int route_expert_of_n(int n) { const int a = (n >> 4) & 1, b = (n >> 3) & 1, h = (n >> 2) & 1, c = n & 3; return 8 * (2 * a + h) + 4 * b + c; }
__device__ __forceinline__ void router_fold(Frame& F, const Inputs& I) {
    const float* mod = (const float*)(F.ws + WS_MOD);
    const int gt = blockIdx.x * 512 + ((int)threadIdx.x), NGT = F.G * 512;
    v4u* WRFB = (v4u*)(F.ws + WSX_WRFB);
    for (int g = gt; g < 4 * 2 * 64 * 64; g += NGT) {
        const int lane = g & 63, ks = (g >> 6) & 63, nb = (g >> 12) & 1, b = g >> 13, hi = lane >> 5, n = lane & 31; float v[8];
#pragma unroll
        for (int j = 0; j < 8; ++j) { const int k = 16 * ks + 8 * hi + j; const float gg = I.norm2_g[k] * (1.f + mod[b * MODW + 4096 + k]);
            const float w = nb == 0 ? I.w_re[k * 32 + route_expert_of_n(n)] : (n < 4 ? I.w_rg[k * 4 + n] : 0.f); v[j] = w * gg; }
        WRFB[g] = (v4u){pk2(v[0], v[1]), pk2(v[2], v[3]), pk2(v[4], v[5]), pk2(v[6], v[7])};
    }
    {
        const int gw = blockIdx.x * NWAVES + F.wave;
        if (gw < 4 * 64) { const int b = gw >> 6, n = gw & 63; float s = 0.f;
            if (n < 36) { const int e = n < 32 ? route_expert_of_n(n) : n - 32; const float* W = n < 32 ? I.w_re + e : I.w_rg + e; const int ld = n < 32 ? 32 : 4;
                for (int k = ((int)(threadIdx.x & 63)); k < 1024; k += 64) s += mod[b * MODW + 3072 + k] * W[k * ld];
                s = wave_sum_f(s) + (n < 32 ? I.b_re[e] : I.b_rg[e]); }
            if (((int)(threadIdx.x & 63)) == 0) ((float*)(F.ws + WSX_RBIAS))[gw] = s; } }
}
__device__ __forceinline__ float swap_other(float v) { auto rr = __builtin_amdgcn_permlane32_swap(__float_as_uint(v), __float_as_uint(v), false, false); return (threadIdx.x & 32) ? __uint_as_float(rr[0]) : __uint_as_float(rr[1]); }
__device__ __forceinline__ void phase_route(Frame& F) {
    LAS int* lcnt = (LAS int*)(F.lds);
    if (((int)threadIdx.x) < 32) lcnt[((int)threadIdx.x)] = 0;
    __syncthreads();
    const bf16_t* x1 = (const bf16_t*)(F.ws + WSX_X1);
    int2* rexp = (int2*)(F.ws + WSX_ROUTE); float2* rw = (float2*)(F.ws + WSX_ROUTE + 256 * 1024); int2* rpos = (int2*)(F.ws + WSX_ROUTE + 512 * 1024);
    float* RSTD = (float*)(F.ws + WSX_RSTD);
    const int lane = ((int)(threadIdx.x & 63)), r32 = lane & 31, hi = lane >> 5;
    for (int grp = F.wave * F.G + blockIdx.x; grp < 1024; grp += F.G * NWAVES) {
        const int t = grp * 32 + r32, b = t >> 13;
        const bf16_t* xr = x1 + (size_t)t * DM + 8 * hi;
        const bf16x8* WF = (const bf16x8*)(F.ws + WSX_WRFB) + (size_t)b * 2 * 64 * 64 + lane;
        f32x16 a0 = f32x16{}, a1 = f32x16{}; float ss = 0.f;
#pragma unroll 8
        for (int ks = 0; ks < 64; ++ks) { const bf16x8 xb = *(const bf16x8*)(xr + 16 * ks);
#pragma unroll
            for (int j = 0; j < 8; ++j) { const float f = bf2f((bf16_t)xb[j]); ss += f * f; }
            a0 = __builtin_amdgcn_mfma_f32_32x32x16_bf16(WF[ks * 64], xb, a0, 0, 0, 0);
            a1 = __builtin_amdgcn_mfma_f32_32x32x16_bf16(WF[(64 + ks) * 64], xb, a1, 0, 0, 0); }
        { auto rr = __builtin_amdgcn_permlane32_swap(__float_as_uint(ss), __float_as_uint(ss), false, false); ss = __uint_as_float(rr[0]) + __uint_as_float(rr[1]); }
        const float rstd = rsqrtf(ss * (1.f / DM) + EPS);
        const float* rb = (const float*)(F.ws + WSX_RBIAS) + b * 64;
        float gl0 = a1[0] * rstd + rb[32], gl1 = a1[1] * rstd + rb[33], gl2 = a1[2] * rstd + rb[34], gl3 = a1[3] * rstd + rb[35];
        int gi = 0; float gm = gl0; if (gl1 > gm) { gm = gl1; gi = 1; } if (gl2 > gm) { gm = gl2; gi = 2; } if (gl3 > gm) { gm = gl3; gi = 3; }
        float gp = 1.f / (__expf(gl0 - gm) + __expf(gl1 - gm) + __expf(gl2 - gm) + __expf(gl3 - gm));
        { const float og = swap_other(__int_as_float(gi)), op = swap_other(gp); if (hi) { gi = __float_as_int(og); gp = op; } }
        const bool owner = (gi & 1) == hi; const int hsel = gi >> 1;
        float m0 = -3e38f, m1 = -3e38f; int e0 = 0, e1 = 0;
#pragma unroll
        for (int i = 0; i < 8; ++i) { const int n = 16 * hsel + 8 * (i >> 2) + 4 * hi + (i & 3);
            const float el = (hsel ? a0[8 + i] : a0[i]) * rstd + rb[n];
            if (el > m0) { m1 = m0; e1 = e0; m0 = el; e0 = i; } else if (el > m1) { m1 = el; e1 = i; } }
        if (owner) {
            const float p1 = __expf(m1 - m0); const int E0 = gi * 8 + e0, E1 = gi * 8 + e1;
            rexp[t] = make_int2(E0, E1); rw[t] = make_float2(gp / (1.f + p1), gp * p1 / (1.f + p1));
            const int k0 = __hip_atomic_fetch_add(lcnt + E0, 1, __ATOMIC_RELAXED, __HIP_MEMORY_SCOPE_WORKGROUP), k1 = __hip_atomic_fetch_add(lcnt + E1, 1, __ATOMIC_RELAXED, __HIP_MEMORY_SCOPE_WORKGROUP);
            rpos[t] = make_int2((int)(blockIdx.x << 16) | k0, (int)(blockIdx.x << 16) | k1);
            RSTD[t] = rstd; }
    }
    __syncthreads();
    if (((int)threadIdx.x) < 32) { const int n = lcnt[((int)threadIdx.x)]; int base = 0;
        if (n > 0) base = (int)__hip_atomic_fetch_add((unsigned*)(F.ctl + CW_CNT + 64 * ((int)threadIdx.x)), (unsigned)n, __ATOMIC_RELAXED, __HIP_MEMORY_SCOPE_AGENT);
        ((int*)(F.ws + WSX_BB))[blockIdx.x * 32 + ((int)threadIdx.x)] = base; }
    __syncthreads();
}
__device__ __forceinline__ void moe_tables(Frame& F) {
    LAS int* tp = (LAS int*)(F.lds + TP_OFF);
    if (((int)threadIdx.x) == 0) { int acc = 0; for (int e = 0; e < 32; ++e) { tp[e] = acc; const int c = (int)__hip_atomic_load((unsigned*)(F.ctl + CW_CNT + 64 * e), __ATOMIC_RELAXED, __HIP_MEMORY_SCOPE_AGENT); acc += (c + 255) >> 8; } tp[32] = acc; }
    __syncthreads();
}
__device__ __forceinline__ void phase_sort(Frame& F, const Inputs& I) {
    LAS float* Gs = (LAS float*)F.lds; LAS float* Ss = Gs + 4096;
    const float* mod = (const float*)(F.ws + WS_MOD);
    for (int i = ((int)threadIdx.x); i < 4096; i += 512) { const int b = i >> 10, k = i & 1023; Gs[i] = I.norm2_g[k] * (1.f + mod[b * MODW + 4096 + k]); Ss[i] = mod[b * MODW + 3072 + k]; }
    moe_tables(F);
    const LAS int* tp = (const LAS int*)(F.lds + TP_OFF);
    const int2* rexp = (const int2*)(F.ws + WSX_ROUTE); const int2* rpos = (const int2*)(F.ws + WSX_ROUTE + 512 * 1024); int2* rposF = (int2*)(F.ws + WSX_RPOSF);
    const float* RSTD = (const float*)(F.ws + WSX_RSTD); const int* BB = (const int*)(F.ws + WSX_BB);
    bf16_t* XS = (bf16_t*)(F.ws + WSX_XS);
    const int gw = F.vcu * NWAVES + F.wave, NGW = F.G * NWAVES;
    for (int m0 = gw; m0 < NTOK; m0 += 4 * NGW) {
        v4u xv[4][2]; int2 ee[4], pp[4]; float rstd[4]; int pos0[4], pos1[4];
        const int ln = ((int)(threadIdx.x & 63));
#pragma unroll
        for (int u = 0; u < 4; ++u) { const int m = m0 + u * NGW; ee[u] = rexp[m]; pp[u] = rpos[m]; rstd[u] = RSTD[m];
            const GAS v4u* xr = (const GAS v4u*)((const bf16_t*)(F.ws + WSX_X1) + (size_t)m * DM) + ln;
            xv[u][0] = xr[0]; xv[u][1] = xr[64]; }
#pragma unroll
        for (int u = 0; u < 4; ++u) { pos0[u] = tp[ee[u].x] * 256 + BB[(pp[u].x >> 16) * 32 + ee[u].x] + (pp[u].x & 0xffff); pos1[u] = tp[ee[u].y] * 256 + BB[(pp[u].y >> 16) * 32 + ee[u].y] + (pp[u].y & 0xffff); }
#pragma unroll
        for (int u = 0; u < 4; ++u) { const int m = m0 + u * NGW, b = m >> 13;
            GAS v4u* o0 = (GAS v4u*)(XS + (size_t)pos0[u] * DM) + ln; GAS v4u* o1 = (GAS v4u*)(XS + (size_t)pos1[u] * DM) + ln;
#pragma unroll
            for (int j = 0; j < 2; ++j) { float f[8]; prj::unpack8(xv[u][j], f); const int k0 = 512 * j + 8 * ln;
                const f32x4 g0 = *(const LAS f32x4*)(Gs + b * 1024 + k0), g1 = *(const LAS f32x4*)(Gs + b * 1024 + k0 + 4), s0 = *(const LAS f32x4*)(Ss + b * 1024 + k0), s1 = *(const LAS f32x4*)(Ss + b * 1024 + k0 + 4);
                const float r = rstd[u];
                const v4u w = {cvtpk(f[0] * r * g0[0] + s0[0], f[1] * r * g0[1] + s0[1]), cvtpk(f[2] * r * g0[2] + s0[2], f[3] * r * g0[3] + s0[3]),
                               cvtpk(f[4] * r * g1[0] + s1[0], f[5] * r * g1[1] + s1[1]), cvtpk(f[6] * r * g1[2] + s1[2], f[7] * r * g1[3] + s1[3])};
                o0[64 * j] = w; o1[64 * j] = w; }
            if (ln == 0) rposF[m] = make_int2(pos0[u], pos1[u]); }
    }
    __syncthreads();
}
__device__ __forceinline__ void phase_combine(Frame& F) {
    const float* mod = (const float*)(F.ws + WS_MOD);
    const float2* rw = (const float2*)(F.ws + WSX_ROUTE + 256 * 1024); const int2* rpos = (const int2*)(F.ws + WSX_RPOSF);
    const bf16_t* YS = (const bf16_t*)(F.ws + WSX_XS);
    const int gw = F.vcu * NWAVES + F.wave, NGW = F.G * NWAVES;
    for (int m0 = gw; m0 < NTOK; m0 += 2 * NGW) {
        int2 pp[2]; float2 ww[2]; v2u xv[2][4]; v2u ya[2][4], yb[2][4];
        const int ln = ((int)(threadIdx.x & 63));
#pragma unroll
        for (int u = 0; u < 2; ++u) { const int m = m0 + u * NGW; pp[u] = rpos[m]; ww[u] = rw[m];
            const GAS v2u* xr = (const GAS v2u*)((const bf16_t*)(F.ws + WSX_X1) + (size_t)m * DM) + ln;
#pragma unroll
            for (int j = 0; j < 4; ++j) xv[u][j] = xr[64 * j]; }
#pragma unroll
        for (int u = 0; u < 2; ++u) { const GAS v2u* y0 = (const GAS v2u*)(YS + (size_t)pp[u].x * DM) + ln; const GAS v2u* y1 = (const GAS v2u*)(YS + (size_t)pp[u].y * DM) + ln;
#pragma unroll
            for (int j = 0; j < 4; ++j) { ya[u][j] = y0[64 * j]; yb[u][j] = y1[64 * j]; } }
#pragma unroll
        for (int u = 0; u < 2; ++u) { const int m = m0 + u * NGW, b = m >> 13; GAS f32x4* xr = (GAS f32x4*)(F.out + (size_t)m * DM) + ln; const float* g2 = mod + b * MODW + 5120 + 4 * ln;
#pragma unroll
            for (int j = 0; j < 4; ++j) { const v2u a = ya[u][j], c = yb[u][j], xx = xv[u][j]; const f32x4 g = *(const f32x4*)(g2 + 256 * j); const float w0 = ww[u].x, w1 = ww[u].y;
                f32x4 y; y[0] = w0 * __uint_as_float(a.x << 16) + w1 * __uint_as_float(c.x << 16); y[1] = w0 * __uint_as_float(a.x & 0xffff0000u) + w1 * __uint_as_float(c.x & 0xffff0000u);
                y[2] = w0 * __uint_as_float(a.y << 16) + w1 * __uint_as_float(c.y << 16); y[3] = w0 * __uint_as_float(a.y & 0xffff0000u) + w1 * __uint_as_float(c.y & 0xffff0000u);
                const f32x4 xf = {__uint_as_float(xx.x << 16), __uint_as_float(xx.x & 0xffff0000u), __uint_as_float(xx.y << 16), __uint_as_float(xx.y & 0xffff0000u)};
                xr[64 * j] = xf + g * y; } }
    }
}
}
__device__ __forceinline__ Inputs load_inputs(const Args& args) {
    Inputs I; const void* const* p = args.in;
    I.x = (const float*)p[0]; I.c = (const float*)p[1]; I.positions = (const int*)p[2]; I.w_ada = (const float*)p[3]; I.b_ada = (const float*)p[4]; I.norm1_g = (const float*)p[5];
    I.w_in = (const float*)p[6]; I.q_a_norm = (const float*)p[7]; I.w_q_b = (const float*)p[8]; I.kv_a_norm = (const float*)p[9]; I.w_kv_b = (const float*)p[10]; I.q_norm = (const float*)p[11];
    I.k_norm = (const float*)p[12]; I.conv_w = (const float*)p[13]; I.conv_b = (const float*)p[14]; I.lru_wa = (const float*)p[15]; I.lru_ba = (const float*)p[16]; I.lru_wx = (const float*)p[17];
    I.lru_bx = (const float*)p[18]; I.lru_lambda = (const float*)p[19]; I.attn_out_norm = (const float*)p[20]; I.lru_out_norm = (const float*)p[21]; I.w_out = (const float*)p[22];
    I.norm2_g = (const float*)p[23]; I.w_rg = (const float*)p[24]; I.b_rg = (const float*)p[25]; I.w_re = (const float*)p[26]; I.b_re = (const float*)p[27]; I.w_gate = (const float*)p[28];
    I.w_up = (const float*)p[29]; I.w_down = (const float*)p[30]; return I;
}
__global__ void __launch_bounds__(NWAVES * 64, 2) mega_fwd(Args args) {
    extern __shared__ __attribute__((aligned(16))) unsigned char lds[];
    Frame F;
    F.lds = (LAS unsigned char*)lds; F.MISC = (volatile LAS unsigned*)(F.lds + MISC_OFF);
    F.wave = __builtin_amdgcn_readfirstlane(threadIdx.x >> 6);
    F.G = gridDim.x; { const int bx = blockIdx.x; F.vcu = (F.G % 8 == 0) ? (bx % 8) * (F.G / 8) + bx / 8 : bx; }
    F.ws = args.ws; F.out = args.out; F.ctl = (gu32*)(args.ws + WS_CTL);
    for (int u = ((int)threadIdx.x); u < (LDS_BYTES - LDSCTL_OFF) / 4; u += NWAVES * 64) ((LAS unsigned*)(F.lds + LDSCTL_OFF))[u] = 0u;
    __syncthreads();
    XcdBarrier bar = xcd_barrier_post((unsigned*)(F.ctl + CW_BAR) + args.li * XCD_BAR_WORDS, F.MISC + 8);
    const int lo = args.ph_lo, hi = args.ph_hi;
constexpr int REPS[12] = {1,1,1,1,1,1,1,1,1,1,1,1};
#define IN(k) (lo <= (k) && (k) < hi)
#define SEAM(k) do { if (IN(k) && IN((k) + 1)) xcd_barrier(bar); } while (0)
    if (IN(0)) for (int rep_ = 0; rep_ < REPS[0]; ++rep_) { const Inputs I = load_inputs(args); (void)I; phase_prologue(F, I); } SEAM(0);
    if (IN(1)) for (int rep_ = 0; rep_ < REPS[1]; ++rep_) { const Inputs I = load_inputs(args); (void)I; moe::router_fold(F, I); phase_xn(F, I); } SEAM(1);
    if (IN(2)) for (int rep_ = 0; rep_ < REPS[2]; ++rep_) { const Inputs I = load_inputs(args); (void)I;
        pg8::Gemm g{(const bf16_t*)(F.ws + WSX_A), (const bf16_t*)(F.ws + WSX_WIN), NTOK, PROJP, DM}; pg8::StaticOrder S; S.init(NTOK, PROJP, F.G, (int)blockIdx.x);
        pg8::EpiProjT E{(bf16_t*)(F.ws + WSX_B)};
        pg8::gemm_phase<pg8::EpiProjT, pg8::StaticOrder, true, true>(F.lds, g, S, E);
    } SEAM(2);
    if (IN(3)) for (int rep_ = 0; rep_ < REPS[3]; ++rep_) { const Inputs I = load_inputs(args); (void)I; prj::phase_proj(F, I, args.pad); } SEAM(3);
    if (IN(4)) for (int rep_ = 0; rep_ < REPS[4]; ++rep_) { const Inputs I = load_inputs(args); (void)I;
#ifndef ATT_ABL
#define ATT_ABL 0
#endif
        if (ATT_ABL == 0 || args.pad == 7) att::attn_phase<0>((char*)lds, (const bf16_t*)(F.ws + WSX_Q), (const bf16_t*)(F.ws + WSX_K), (const bf16_t*)(F.ws + WSX_V), (bf16_t*)(F.ws + WSX_AO), F.G, F.vcu);
        else att::attn_phase<ATT_ABL>((char*)lds, (const bf16_t*)(F.ws + WSX_Q), (const bf16_t*)(F.ws + WSX_K), (const bf16_t*)(F.ws + WSX_V), (bf16_t*)(F.ws + WSX_AO), F.G, F.vcu);
    } SEAM(4);
    if (IN(5)) for (int rep_ = 0; rep_ < REPS[5]; ++rep_) { const Inputs I = load_inputs(args); (void)I; prj::phase_mix(F, I); } SEAM(5);
    if (IN(6)) for (int rep_ = 0; rep_ < REPS[6]; ++rep_) { const Inputs I = load_inputs(args); (void)I;
        pg8::Gemm g{(const bf16_t*)(F.ws + WSX_E), (const bf16_t*)(F.ws + WSX_WOUT), NTOK, DM, DM}; pg8::StaticOrder S; S.init(NTOK, DM, F.G, (int)blockIdx.x);
        pg8::EpiResid E{I.x, (const float*)(F.ws + WS_MOD), (bf16_t*)(F.ws + WSX_X1)};
        pg8::gemm_phase<pg8::EpiResid, pg8::StaticOrder, true, true>(F.lds, g, S, E);
    } SEAM(6);
    if (IN(7)) for (int rep_ = 0; rep_ < REPS[7]; ++rep_) { const Inputs I = load_inputs(args); (void)I; moe::phase_route(F); } SEAM(7);
    if (IN(8)) for (int rep_ = 0; rep_ < REPS[8]; ++rep_) { const Inputs I = load_inputs(args); (void)I; moe::phase_sort(F, I); } SEAM(8);
    if (IN(9)) for (int rep_ = 0; rep_ < REPS[9]; ++rep_) { const Inputs I = load_inputs(args); (void)I;
        if (!IN(8)) moe::moe_tables(F);
        pg8::Gemm g{(const bf16_t*)(F.ws + WSX_XS), (const bf16_t*)(F.ws + WSX_W1T), MAXROWS, 0, DM};
        pg8::GroupedOrder S{(const LAS int*)(F.lds + moe::TP_OFF), 2, F.G, (int)blockIdx.x};
        pg8::EpiSiluMul E{(bf16_t*)(F.ws + WSX_HID)};
        pg8::gemm_phase<pg8::EpiSiluMul, pg8::GroupedOrder, true, true>(F.lds, g, S, E);
    } SEAM(9);
    if (IN(10)) for (int rep_ = 0; rep_ < REPS[10]; ++rep_) { const Inputs I = load_inputs(args); (void)I;
        if (!IN(8)) moe::moe_tables(F);
        int kk2 = DFF; asm volatile("" : "+s"(kk2));
        pg8::Gemm g{(const bf16_t*)(F.ws + WSX_HID), (const bf16_t*)(F.ws + WSX_W2T), MAXROWS, 0, kk2};
        pg8::GroupedOrder S{(const LAS int*)(F.lds + moe::TP_OFF), 4, F.G, (int)blockIdx.x};
        pg8::EpiYs E{(bf16_t*)(F.ws + WSX_XS)};
        pg8::gemm_phase<pg8::EpiYs, pg8::GroupedOrder, true, true>(F.lds, g, S, E);
    } SEAM(10);
    if (IN(11)) for (int rep_ = 0; rep_ < REPS[11]; ++rep_) { const Inputs I = load_inputs(args); (void)I; moe::phase_combine(F); }
#undef IN
#undef SEAM
}
static int g_grid = 0;
static bool mega_setup() {
    if (g_grid) return g_grid > 0;
    int dev = 0, cus = 0, per_cu = 0;
    if (hipGetDevice(&dev) != hipSuccess || hipDeviceGetAttribute(&cus, hipDeviceAttributeMultiprocessorCount, dev) != hipSuccess) { g_grid = -1; return false; }
    if (hipFuncSetAttribute((const void*)mega_fwd, hipFuncAttributeMaxDynamicSharedMemorySize, LDS_BYTES) != hipSuccess) { fprintf(stderr, "hipFuncSetAttribute failed\n"); g_grid = -1; return false; }
    if (hipOccupancyMaxActiveBlocksPerMultiprocessor(&per_cu, (const void*)mega_fwd, NWAVES * 64, LDS_BYTES) != hipSuccess || per_cu < 1) { fprintf(stderr, "occupancy query: %d\n", per_cu); (void)hipGetLastError(); g_grid = -1; return false; }
    g_grid = cus;
    return true;
}
static void mega_launch(void* const* d_in, void* d_out, void* d_ws, hipStream_t stream, int lo, int hi, int li, int knob = 7) {
    Args a{}; for (int i = 0; i < 31; ++i) a.in[i] = d_in[i];
    a.out = (float*)d_out; a.ws = (unsigned char*)d_ws; a.ph_lo = lo; a.ph_hi = hi; a.li = li; a.pad = knob;
    hipLaunchKernelGGL(mega_fwd, dim3(g_grid), dim3(NWAVES * 64), LDS_BYTES, stream, a);
}
extern "C" void kernel_launch(void* const* d_in, const int* in_sizes, int n_in, void* d_out, int out_size, void* d_ws, size_t ws_size, hipStream_t stream) {
    if (n_in != 31 || ws_size < WSX_END || out_size != NTOK * DM) { fprintf(stderr, "kernel_launch: unexpected shapes n_in=%d ws=%zu out=%d\n", n_in, ws_size, out_size); return; }
    if (!mega_setup()) return;
    const Inputs I = get_inputs(d_in);
    char* ws = (char*)d_ws; float* out = (float*)d_out;
    float* mod = (float*)(ws + WS_MOD);
    int2* rexp = (int2*)(ws + WSX_ROUTE); float2* rw = (float2*)(ws + WSX_ROUTE + 256 * 1024);
    bf16_t* XN = (bf16_t*)(ws + WSX_A); bf16_t* H2 = (bf16_t*)(ws + WSX_A);
    bf16_t* PROJ = (bf16_t*)(ws + WSX_B);
    bf16_t* MIXED = (bf16_t*)(ws + WSX_E);
    (void)XN; (void)mod;
    hipMemsetAsync(ws + WS_CTL, 0, 1 * MiB, stream);
    mega_launch(d_in, d_out, d_ws, stream, 0, 12, 0);
}
```

```cpp
#include <hip/hip_runtime.h>
#include <cstdio>
#include <cstdint>
#include <cmath>
constexpr int NB = 4, SEQ = 8192, DM = 1024, NTOK = NB * SEQ;
constexpr int NH = 4, DQK = 192, DNOPE = 128, DROPE = 64, DV = 128;
constexpr int QLR = 256, KVLR = 128, LRUW = 512, LRUH = 4, LRUB = 128;
constexpr int NPROJ = 1472, PROJP = 1536;
constexpr int C_QLAT = 0, C_KVLAT = 256, C_KROPE = 384, C_XLRU = 448, C_GLRU = 960;
constexpr int NEXP = 32, NGRP = 4, EPG = 8, DFF = 256;
constexpr float EPS = 1e-6f;
constexpr int MODW = 6 * DM;

typedef unsigned short bf16_t;
__device__ __forceinline__ float bf2f(bf16_t v) { return __uint_as_float(((unsigned)v) << 16); }
__device__ __forceinline__ bf16_t f2bf(float f) { unsigned u = __float_as_uint(f); return (bf16_t)((u + 0x7fffu + ((u >> 16) & 1u)) >> 16); }

constexpr size_t MiB = 1u << 20;
constexpr size_t WS_CTL = 0;
constexpr size_t WS_MOD = 1 * MiB;
constexpr size_t WS_ROUTE = 2 * MiB;
constexpr size_t WS_A = 64 * MiB;
constexpr size_t WS_B = 128 * MiB;
constexpr size_t WS_C = 224 * MiB;
constexpr size_t WS_D = 352 * MiB;
constexpr size_t WS_E = 416 * MiB;
constexpr size_t WS_END = 480 * MiB;
constexpr size_t WS_Q = WS_C, WS_K = WS_C + 48 * MiB, WS_V = WS_C + 96 * MiB;

__device__ __forceinline__ float silu_f(float v) { return v / (1.f + __expf(-v)); }
__device__ __forceinline__ float sigmoid_f(float v) { return 1.f / (1.f + __expf(-v)); }
__device__ __forceinline__ float gelu_tanh(float v) { const float u = 0.7978845608028654f * (v + 0.044715f * v * v * v); return v / (1.f + __expf(-2.f * u)); }

__device__ __forceinline__ float block_sum_256(float v, float* red) {
    for (int o = 32; o > 0; o >>= 1) v += __shfl_xor(v, o);
    __syncthreads();
    if ((threadIdx.x & 63) == 0) red[threadIdx.x >> 6] = v;
    __syncthreads();
    return red[0] + red[1] + red[2] + red[3];
}
__device__ __forceinline__ float wave_sum(float v) { for (int o = 32; o > 0; o >>= 1) v += __shfl_xor(v, o); return v; }

__device__ __forceinline__ void rope_cs(int pos, int i, float& c, float& s) {
    const double inv = exp(-0.28782313662425575 * (double)i);
    double a = (double)pos * inv;
    const double k = rint(a * 0.15915494309189535);
    a = fma(-k, 6.283185307179586, a); a = fma(-k, 2.4492935982947064e-16, a);
    const float r = (float)a;
    c = __cosf(r); s = __sinf(r);
}

__global__ void nv_mod(const float* __restrict__ c, const float* __restrict__ w_ada, const float* __restrict__ b_ada, float* __restrict__ mod) {
    const int n = blockIdx.x * 256 + threadIdx.x, b = blockIdx.y;
    float acc = b_ada[n];
    for (int k = 0; k < DM; ++k) acc += silu_f(c[b * DM + k]) * w_ada[(size_t)k * MODW + n];
    mod[b * MODW + n] = acc;
}
__global__ void nv_norm_mod(const float* __restrict__ x, const float* __restrict__ g, const float* __restrict__ mod, int which, bf16_t* __restrict__ out) {
    const int t = blockIdx.x * 4 + (threadIdx.x >> 6), lane = threadIdx.x & 63, b = t / SEQ;
    const float* xr = x + (size_t)t * DM;
    float v[16]; float ss = 0.f;
#pragma unroll
    for (int j = 0; j < 16; ++j) { v[j] = xr[lane + 64 * j]; ss += v[j] * v[j]; }
    ss = wave_sum(ss);
    const float rstd = rsqrtf(ss / DM + EPS);
    const float* sh = mod + b * MODW + (which ? 3 * DM : 0); const float* sc = sh + DM;
#pragma unroll
    for (int j = 0; j < 16; ++j) { const int k = lane + 64 * j; out[(size_t)t * DM + k] = f2bf(v[j] * rstd * g[k] * (1.f + sc[k]) + sh[k]); }
}

template <class Epi> __global__ void __launch_bounds__(256) nv_gemm(const bf16_t* __restrict__ A, int lda, const float* __restrict__ W, int ldw, int K, Epi epi) {
    __shared__ float As[16][65]; __shared__ float Bs[16][64];
    const int tid = threadIdx.x, tx = tid & 15, ty = tid >> 4, m0 = blockIdx.y * 64, n0 = blockIdx.x * 64;
    float acc[4][4];
#pragma unroll
    for (int i = 0; i < 4; ++i)
#pragma unroll
        for (int j = 0; j < 4; ++j) acc[i][j] = 0.f;
    for (int k0 = 0; k0 < K; k0 += 16) {
        { const int r = tid >> 2, kk = (tid & 3) * 4; const bf16_t* ap = A + (size_t)(m0 + r) * lda + k0 + kk;
#pragma unroll
          for (int j = 0; j < 4; ++j) As[kk + j][r] = bf2f(ap[j]); }
        { const int kk = tid >> 4, c = (tid & 15) * 4; const float* wp = W + (size_t)(k0 + kk) * ldw + n0 + c;
#pragma unroll
          for (int j = 0; j < 4; ++j) Bs[kk][c + j] = wp[j]; }
        __syncthreads();
#pragma unroll
        for (int kk = 0; kk < 16; ++kk) { float a[4], b[4];
#pragma unroll
            for (int i = 0; i < 4; ++i) a[i] = As[kk][ty * 4 + i];
#pragma unroll
            for (int j = 0; j < 4; ++j) b[j] = Bs[kk][tx * 4 + j];
#pragma unroll
            for (int i = 0; i < 4; ++i)
#pragma unroll
                for (int j = 0; j < 4; ++j) acc[i][j] += a[i] * b[j]; }
        __syncthreads();
    }
#pragma unroll
    for (int i = 0; i < 4; ++i)
#pragma unroll
        for (int j = 0; j < 4; ++j) epi(m0 + ty * 4 + i, n0 + tx * 4 + j, acc[i][j]);
}
struct EpiStoreBf16 { bf16_t* C; int ldc; int pad; __device__ void operator()(int r, int c, float v) const { C[(size_t)r * ldc + c] = f2bf(v); } };
struct EpiOutProj { const float* x; const float* mod; float* out; __device__ void operator()(int r, int c, float v) const { const int b = r / SEQ; out[(size_t)r * DM + c] = x[(size_t)r * DM + c] + mod[b * MODW + 2 * DM + c] * v; } };

__global__ void __launch_bounds__(256) nv_qkv(const bf16_t* __restrict__ proj, const int* __restrict__ positions, const float* __restrict__ q_a_norm, const float* __restrict__ w_q_b,
                                               const float* __restrict__ kv_a_norm, const float* __restrict__ w_kv_b, const float* __restrict__ q_norm, const float* __restrict__ k_norm,
                                               bf16_t* __restrict__ Q, bf16_t* __restrict__ Kb, bf16_t* __restrict__ Vb) {
    __shared__ float qn[QLR], kvn[KVLR], kr[DROPE], qo[NH * DQK], kvo[NH * 256], red[4], cs[64];
    const int t = blockIdx.x, tid = threadIdx.x, b = t / SEQ, s = t % SEQ;
    const bf16_t* pr = proj + (size_t)t * PROJP;
    const float ql = bf2f(pr[C_QLAT + tid]);
    const float sq = block_sum_256(ql * ql, red);
    qn[tid] = ql * rsqrtf(sq / QLR + EPS) * q_a_norm[tid];
    const float kl = tid < KVLR ? bf2f(pr[C_KVLAT + tid]) : 0.f;
    const float skv = block_sum_256(kl * kl, red);
    if (tid < KVLR) kvn[tid] = kl * rsqrtf(skv / KVLR + EPS) * kv_a_norm[tid];
    if (tid < DROPE) kr[tid] = bf2f(pr[C_KROPE + tid]);
    if (tid < 32) { float c, sn; rope_cs(positions[t], tid, c, sn); cs[tid] = c; cs[32 + tid] = sn; }
    __syncthreads();
    for (int j = 0; j < 3; ++j) { const int col = tid + 256 * j; float a = 0.f; for (int k = 0; k < QLR; ++k) a += qn[k] * w_q_b[(size_t)k * (NH * DQK) + col]; qo[col] = a; }
    for (int j = 0; j < 4; ++j) { const int col = tid + 256 * j; float a = 0.f; for (int k = 0; k < KVLR; ++k) a += kvn[k] * w_kv_b[(size_t)k * (NH * 256) + col]; kvo[col] = a; }
    __syncthreads();
    const int h = tid >> 6, lane = tid & 63;
    {
        float v0 = qo[h * DQK + lane], v1 = qo[h * DQK + 64 + lane], v2 = qo[h * DQK + 128 + lane];
        const float rs = rsqrtf(wave_sum(v0 * v0 + v1 * v1 + v2 * v2) / DQK + EPS);
        v0 *= rs * q_norm[lane]; v1 *= rs * q_norm[64 + lane]; v2 *= rs * q_norm[128 + lane];
        const float oth = __shfl_xor(v2, 32); const int i = lane & 31; const float c = cs[i], sn = cs[32 + i];
        const float r2 = lane < 32 ? v2 * c - oth * sn : v2 * c + oth * sn;
        bf16_t* qp = Q + ((size_t)(b * NH + h) * SEQ + s) * DQK;
        qp[lane] = f2bf(v0); qp[64 + lane] = f2bf(v1); qp[128 + lane] = f2bf(r2);
    }
    {
        float v0 = kvo[h * 256 + lane], v1 = kvo[h * 256 + 64 + lane], v2 = kr[lane];
        const float rs = rsqrtf(wave_sum(v0 * v0 + v1 * v1 + v2 * v2) / DQK + EPS);
        v0 *= rs * k_norm[lane]; v1 *= rs * k_norm[64 + lane]; v2 *= rs * k_norm[128 + lane];
        const float oth = __shfl_xor(v2, 32); const int i = lane & 31; const float c = cs[i], sn = cs[32 + i];
        const float r2 = lane < 32 ? v2 * c - oth * sn : v2 * c + oth * sn;
        bf16_t* kp = Kb + ((size_t)(b * NH + h) * SEQ + s) * DQK;
        kp[lane] = f2bf(v0); kp[64 + lane] = f2bf(v1); kp[128 + lane] = f2bf(r2);
        bf16_t* vp = Vb + ((size_t)(b * NH + h) * SEQ + s) * DV;
        vp[lane] = f2bf(kvo[h * 256 + 128 + lane]); vp[64 + lane] = f2bf(kvo[h * 256 + 192 + lane]);
    }
}

__global__ void __launch_bounds__(256) nv_attn(const bf16_t* __restrict__ Q, const bf16_t* __restrict__ Kb, const bf16_t* __restrict__ Vb, bf16_t* __restrict__ mixed) {
    __shared__ float Ks[64][DQK + 4]; __shared__ float Vs[64][DV + 4];
    const int bh = blockIdx.y, qb = gridDim.x - 1 - blockIdx.x, tid = threadIdx.x, row = tid >> 2, part = tid & 3;
    const int qi = qb * 64 + row;
    float q[48], o[32]; float m = -1e30f, l = 0.f;
    { const bf16_t* qp = Q + ((size_t)bh * SEQ + qi) * DQK + part * 48;
#pragma unroll
      for (int d = 0; d < 48; ++d) q[d] = bf2f(qp[d]); }
#pragma unroll
    for (int d = 0; d < 32; ++d) o[d] = 0.f;
    const float scl = 0.07216878364870322f;
    for (int kt = 0; kt <= qb; ++kt) {
        __syncthreads();
        for (int e = tid; e < 64 * DQK; e += 256) { const int r = e / DQK, c = e % DQK; Ks[r][c] = bf2f(Kb[((size_t)bh * SEQ + kt * 64 + r) * DQK + c]); }
        for (int e = tid; e < 64 * DV; e += 256) { const int r = e / DV, c = e % DV; Vs[r][c] = bf2f(Vb[((size_t)bh * SEQ + kt * 64 + r) * DV + c]); }
        __syncthreads();
        for (int j = 0; j < 64; ++j) {
            float sdot = 0.f;
#pragma unroll
            for (int d = 0; d < 48; ++d) sdot += q[d] * Ks[j][part * 48 + d];
            sdot += __shfl_xor(sdot, 1); sdot += __shfl_xor(sdot, 2);
            sdot *= scl;
            if (kt * 64 + j <= qi) {
                const float mn = fmaxf(m, sdot), al = __expf(m - mn), p = __expf(sdot - mn);
                l = l * al + p; m = mn;
#pragma unroll
                for (int d = 0; d < 32; ++d) o[d] = o[d] * al + p * Vs[j][part * 32 + d];
            }
        }
    }
    const int b = bh / NH, h = bh % NH;
    bf16_t* op = mixed + ((size_t)(b * SEQ + qi)) * DM + h * DV + part * 32;
    const float il = 1.f / l;
#pragma unroll
    for (int d = 0; d < 32; ++d) op[d] = f2bf(o[d] * il);
}

__global__ void __launch_bounds__(512) nv_lru_gates(const bf16_t* __restrict__ proj, const int* __restrict__ positions, const float* __restrict__ conv_w, const float* __restrict__ conv_b,
                                                     const float* __restrict__ wa, const float* __restrict__ ba, const float* __restrict__ wx, const float* __restrict__ bx,
                                                     const float* __restrict__ lam, float* __restrict__ A32, float* __restrict__ B32) {
    __shared__ float xc[LRUW];
    const int t = blockIdx.x, c = threadIdx.x, s = t % SEQ;
    float v = conv_b[c];
    for (int j = 0; j < 4; ++j) { const int ss = s - 3 + j; if (ss >= 0) v += conv_w[j * LRUW + c] * bf2f(proj[(size_t)(t - 3 + j) * PROJP + C_XLRU + c]); }
    xc[c] = v;
    __syncthreads();
    const int h = c >> 7, jj = c & 127;
    float ra = ba[c], ri = bx[c];
    for (int i = 0; i < LRUB; ++i) { const float xv = xc[h * LRUB + i]; ra += xv * wa[(size_t)(h * LRUB + i) * LRUB + jj]; ri += xv * wx[(size_t)(h * LRUB + i) * LRUB + jj]; }
    const float r = sigmoid_f(ra), ig = sigmoid_f(ri);
    const float sp = log1pf(__expf(-lam[c]));
    const float log_a = -8.f * r * sp;
    float a = __expf(log_a), mult = sqrtf(fmaxf(1.f - __expf(2.f * log_a), 0.f));
    if (positions[t] == 0) { a = 0.f; mult = 1.f; }
    A32[(size_t)t * LRUW + c] = a; B32[(size_t)t * LRUW + c] = mult * (ig * v);
}
__global__ void nv_lru_scan(float* __restrict__ A32, const float* __restrict__ B32) {
    const int idx = blockIdx.x * blockDim.x + threadIdx.x, b = idx / LRUW, c = idx % LRUW;
    float h = 0.f;
    for (int s0 = 0; s0 < SEQ; s0 += 8) {
        float a[8], bb[8];
#pragma unroll
        for (int j = 0; j < 8; ++j) { const size_t o = ((size_t)(b * SEQ + s0 + j)) * LRUW + c; a[j] = A32[o]; bb[j] = B32[o]; }
#pragma unroll
        for (int j = 0; j < 8; ++j) { h = a[j] * h + bb[j]; A32[((size_t)(b * SEQ + s0 + j)) * LRUW + c] = h; }
    }
}
__global__ void nv_mixnorm(bf16_t* __restrict__ mixed, const float* __restrict__ H32, const bf16_t* __restrict__ proj, const float* __restrict__ g_attn, const float* __restrict__ g_lru) {
    const int t = blockIdx.x * 4 + (threadIdx.x >> 6), lane = threadIdx.x & 63;
    bf16_t* mr = mixed + (size_t)t * DM;
    float v[8], ss = 0.f;
#pragma unroll
    for (int j = 0; j < 8; ++j) { v[j] = bf2f(mr[lane + 64 * j]); ss += v[j] * v[j]; }
    float rs = rsqrtf(wave_sum(ss) / 512.f + EPS);
#pragma unroll
    for (int j = 0; j < 8; ++j) mr[lane + 64 * j] = f2bf(v[j] * rs * g_attn[lane + 64 * j]);
    ss = 0.f;
#pragma unroll
    for (int j = 0; j < 8; ++j) { const int c = lane + 64 * j; v[j] = H32[(size_t)t * LRUW + c] * gelu_tanh(bf2f(proj[(size_t)t * PROJP + C_GLRU + c])); ss += v[j] * v[j]; }
    rs = rsqrtf(wave_sum(ss) / 512.f + EPS);
#pragma unroll
    for (int j = 0; j < 8; ++j) mr[512 + lane + 64 * j] = f2bf(v[j] * rs * g_lru[lane + 64 * j]);
}
__global__ void nv_route(const float* __restrict__ x1, const float* __restrict__ g2, const float* __restrict__ mod, const float* __restrict__ w_rg, const float* __restrict__ b_rg,
                         const float* __restrict__ w_re, const float* __restrict__ b_re, bf16_t* __restrict__ H2, int2* __restrict__ rexp, float2* __restrict__ rw) {
    const int t = blockIdx.x * 4 + (threadIdx.x >> 6), lane = threadIdx.x & 63, b = t / SEQ;
    const float* xr = x1 + (size_t)t * DM;
    float v[16]; float ss = 0.f;
#pragma unroll
    for (int j = 0; j < 16; ++j) { v[j] = xr[lane + 64 * j]; ss += v[j] * v[j]; }
    const float rstd = rsqrtf(wave_sum(ss) / DM + EPS);
    const float* sh = mod + b * MODW + 3 * DM; const float* sc = sh + DM;
#pragma unroll
    for (int j = 0; j < 16; ++j) { const int k = lane + 64 * j; v[j] = v[j] * rstd * g2[k] * (1.f + sc[k]) + sh[k]; H2[(size_t)t * DM + k] = f2bf(v[j]); }
    float gl[NGRP];
#pragma unroll
    for (int g = 0; g < NGRP; ++g) { float a = 0.f;
#pragma unroll
        for (int j = 0; j < 16; ++j) a += v[j] * w_rg[(size_t)(lane + 64 * j) * NGRP + g];
        gl[g] = wave_sum(a) + b_rg[g]; }
    int gi = 0; float gm = gl[0];
#pragma unroll
    for (int g = 1; g < NGRP; ++g) if (gl[g] > gm) { gm = gl[g]; gi = g; }
    float gs = 0.f;
#pragma unroll
    for (int g = 0; g < NGRP; ++g) gs += __expf(gl[g] - gm);
    const float gp = 1.f / gs;
    float m0 = -1e30f, m1 = -1e30f; int e0 = 0, e1 = 0;
    for (int e = 0; e < EPG; ++e) { float a = 0.f;
#pragma unroll
        for (int j = 0; j < 16; ++j) a += v[j] * w_re[(size_t)(lane + 64 * j) * NEXP + gi * EPG + e];
        const float el = wave_sum(a) + b_re[gi * EPG + e];
        if (el > m0) { m1 = m0; e1 = e0; m0 = el; e0 = e; } else if (el > m1) { m1 = el; e1 = e; } }
    const float p1 = __expf(m1 - m0);
    const float w0 = gp / (1.f + p1), w1 = gp * p1 / (1.f + p1);
    if (lane == 0) { rexp[t] = make_int2(gi * EPG + e0, gi * EPG + e1); rw[t] = make_float2(w0, w1); }
}
__global__ void __launch_bounds__(256) nv_moe(const bf16_t* __restrict__ H2, const int2* __restrict__ rexp, const float2* __restrict__ rw, const float* __restrict__ w_gate,
                                               const float* __restrict__ w_up, const float* __restrict__ w_down, const float* __restrict__ mod, float* __restrict__ out) {
    __shared__ float hs[DM], hid[DFF];
    const int t = blockIdx.x, tid = threadIdx.x, b = t / SEQ;
    for (int j = 0; j < 4; ++j) hs[tid + 256 * j] = bf2f(H2[(size_t)t * DM + tid + 256 * j]);
    float y[4] = {0.f, 0.f, 0.f, 0.f};
    const int2 ee = rexp[t]; const float2 ww = rw[t];
    for (int k = 0; k < 2; ++k) {
        const int e = k ? ee.y : ee.x; const float w = k ? ww.y : ww.x;
        __syncthreads();
        const float* wg = w_gate + (size_t)e * DM * DFF; const float* wu = w_up + (size_t)e * DM * DFF;
        float g = 0.f, u = 0.f;
        for (int i = 0; i < DM; ++i) { const float hv = hs[i]; g += hv * wg[(size_t)i * DFF + tid]; u += hv * wu[(size_t)i * DFF + tid]; }
        hid[tid] = silu_f(g) * u;
        __syncthreads();
        const float* wd = w_down + (size_t)e * DFF * DM;
#pragma unroll
        for (int j = 0; j < 4; ++j) { float a = 0.f; for (int f = 0; f < DFF; ++f) a += hid[f] * wd[(size_t)f * DM + tid + 256 * j]; y[j] += w * a; }
    }
#pragma unroll
    for (int j = 0; j < 4; ++j) { const int c = tid + 256 * j; out[(size_t)t * DM + c] += mod[b * MODW + 5 * DM + c] * y[j]; }
}
struct Inputs {
    const float *x, *c; const int* positions;
    const float *w_ada, *b_ada, *norm1_g, *w_in, *q_a_norm, *w_q_b, *kv_a_norm, *w_kv_b, *q_norm, *k_norm, *conv_w, *conv_b, *lru_wa, *lru_ba, *lru_wx, *lru_bx, *lru_lambda,
                *attn_out_norm, *lru_out_norm, *w_out, *norm2_g, *w_rg, *b_rg, *w_re, *b_re, *w_gate, *w_up, *w_down;
};
static Inputs get_inputs(void* const* d_in) {
    Inputs I;
    I.x = (const float*)d_in[0]; I.c = (const float*)d_in[1]; I.positions = (const int*)d_in[2];
    I.w_ada = (const float*)d_in[3]; I.b_ada = (const float*)d_in[4]; I.norm1_g = (const float*)d_in[5];
    I.w_in = (const float*)d_in[6]; I.q_a_norm = (const float*)d_in[7]; I.w_q_b = (const float*)d_in[8];
    I.kv_a_norm = (const float*)d_in[9]; I.w_kv_b = (const float*)d_in[10]; I.q_norm = (const float*)d_in[11];
    I.k_norm = (const float*)d_in[12]; I.conv_w = (const float*)d_in[13]; I.conv_b = (const float*)d_in[14];
    I.lru_wa = (const float*)d_in[15]; I.lru_ba = (const float*)d_in[16]; I.lru_wx = (const float*)d_in[17];
    I.lru_bx = (const float*)d_in[18]; I.lru_lambda = (const float*)d_in[19]; I.attn_out_norm = (const float*)d_in[20];
    I.lru_out_norm = (const float*)d_in[21]; I.w_out = (const float*)d_in[22]; I.norm2_g = (const float*)d_in[23];
    I.w_rg = (const float*)d_in[24]; I.b_rg = (const float*)d_in[25]; I.w_re = (const float*)d_in[26];
    I.b_re = (const float*)d_in[27]; I.w_gate = (const float*)d_in[28]; I.w_up = (const float*)d_in[29];
    I.w_down = (const float*)d_in[30];
    return I;
}
#define GAS __attribute__((address_space(1)))
#define LAS __attribute__((address_space(3)))
typedef unsigned v4u __attribute__((ext_vector_type(4)));
typedef unsigned v2u __attribute__((ext_vector_type(2)));
typedef float f32x4 __attribute__((ext_vector_type(4)));
typedef float f32x16 __attribute__((ext_vector_type(16)));
typedef short bf16x8 __attribute__((ext_vector_type(8)));
typedef short s16x4 __attribute__((ext_vector_type(4)));
typedef GAS unsigned gu32;
#define RLX_AGENT __ATOMIC_RELAXED, __HIP_MEMORY_SCOPE_AGENT
#define LDS_WAIT() asm volatile("s_waitcnt lgkmcnt(0)" ::: "memory")
#define VM_WAIT() asm volatile("s_waitcnt vmcnt(0)" ::: "memory")
__device__ __forceinline__ unsigned pk2(float lo, float hi) { return (unsigned)f2bf(lo) | ((unsigned)f2bf(hi) << 16); }
__device__ __forceinline__ unsigned cvtpk(float lo, float hi) { unsigned r; asm volatile("v_cvt_pk_bf16_f32 %0, %1, %2" : "=v"(r) : "v"(lo), "v"(hi)); return r; }

constexpr size_t WSX_SUMA = 3 * MiB, WSX_SUMB = 5 * MiB;
constexpr size_t WSX_CS = 7 * MiB;
constexpr size_t WSX_WQF = 15 * MiB;
constexpr size_t WSX_WKVF = WSX_WQF + 384 * 1024;
constexpr size_t WSX_WAF = WSX_WKVF + 256 * 1024;
constexpr size_t WSX_WXF = WSX_WAF + 128 * 1024;
constexpr size_t WSX_WRF = WSX_WXF + 128 * 1024;
constexpr size_t WSX_SP = 2 * MiB + 768 * 1024;
constexpr size_t WSX_WIN = 16 * MiB;
constexpr size_t WSX_WOUT = 19 * MiB;
constexpr size_t WSX_W1T = 22 * MiB;
constexpr size_t WSX_W2T = 54 * MiB;
constexpr size_t WSX_A = 72 * MiB;
constexpr size_t WSX_B = 136 * MiB;
constexpr size_t WSX_C = 232 * MiB;
constexpr size_t WSX_D = 360 * MiB;
constexpr size_t WSX_E = 424 * MiB;
constexpr size_t WSX_END = 488 * MiB;
constexpr size_t WSX_Q = WSX_C, WSX_K = WSX_C + 48 * MiB, WSX_V = WSX_C + 96 * MiB;
constexpr size_t WSX_XS = 216 * MiB;
constexpr size_t WSX_HID = WSX_D;
constexpr size_t WSX_ROUTE = 2 * MiB;
constexpr int MAXROWS = 2 * NTOK + NEXP * 255;
constexpr size_t WSX_X1 = 72 * MiB;
constexpr size_t WSX_AO = WSX_A;
constexpr size_t WSX_RPOSF = 71 * MiB;
constexpr int CW_BAR = 4096;
constexpr int CW_CNT = 65536;

constexpr int RING_BYTES = 131072, LDSCTL_OFF = RING_BYTES, MISC_OFF = LDSCTL_OFF + 320, LDS_BYTES = 147456;
constexpr int NWAVES = 8;
namespace pg8 {
#define PG8_LAS __attribute__((address_space(3)))
typedef unsigned short bf16_t;
typedef short bf16x8 __attribute__((ext_vector_type(8)));
typedef float f32x4 __attribute__((ext_vector_type(4)));
typedef unsigned u32x4 __attribute__((ext_vector_type(4)));
constexpr int BM = 256, BK = 64, HALF = 128, HTB = HALF * BK * 2  , STAGE_BYTES = 8 * HTB, NXCD = 8, WGM = 8;

__host__ __device__ __forceinline__ int lds_byte(int r, int c) { const int st = (r >> 4) * 2 + (c >> 5), rr = r & 15, cc = c & 31, ob = rr * 64 + cc * 2; return st * 1024 + (ob ^ (((ob >> 9) & 1) << 5)); }
__host__ __device__ __forceinline__ void stage_rc(int b, int& R, int& C) { const int st = b / 1024, sb = b % 1024, swz = sb ^ (((sb >> 9) & 1) << 5); R = (st >> 1) * 16 + swz / 64; C = (st & 1) * 32 + (swz % 64) / 2; }
__host__ __device__ __forceinline__ int perm32(int rho) { const int n = rho >> 4, i = rho & 15; return 8 * (i >> 2) + 4 * n + (i & 3); }

struct Unit { int pm, pn; };
struct Gemm { const bf16_t* A; const bf16_t* Bt; int M, N, K; };

struct StaticOrder {
    int nM, nN, nwg, G, c;
    __host__ __device__ void init(int M, int N, int G_, int c_) { nM = M / BM; nN = N / BM; nwg = nM * nN; G = G_; c = c_; }
    __host__ __device__ bool next(int i, Unit& u) const {
        const long L = (long)i * G + c; if (L >= nwg) return false;
        int wgid = (int)L; { const int q = nwg / NXCD, r = nwg % NXCD, xcd = wgid % NXCD, off = wgid / NXCD; wgid = (xcd < r ? xcd * (q + 1) : r * (q + 1) + (xcd - r) * q) + off; }
        const int nig = WGM * nN, gid = wgid / nig, fm = gid * WGM, gsz = (nM - fm) < WGM ? (nM - fm) : WGM;
        u.pm = fm + ((wgid % nig) % gsz); u.pn = (wgid % nig) / gsz; return true;
    }
    __device__ __forceinline__ void a_ready(const Unit&) const {}
    __device__ __forceinline__ void done(const Unit&) const {}
};

__device__ __forceinline__ unsigned cvt_pk_bf16(float lo, float hi) { unsigned r; asm volatile("v_cvt_pk_bf16_f32 %0, %1, %2" : "=v"(r) : "v"(lo), "v"(hi)); return r; }
typedef float f32x2 __attribute__((ext_vector_type(2)));
__device__ __forceinline__ f32x2 gelu_pk(f32x2 v) {
    const f32x2 av = __builtin_elementwise_abs(v), d = av * 0.2316418882f + 1.0f;
    f32x2 t; t.x = __builtin_amdgcn_rcpf(d.x); t.y = __builtin_amdgcn_rcpf(d.y);
    f32x2 q = t * 0.5307027145f + (-0.7265760135f); q = q * t + 0.7107068705f; q = q * t + (-0.142248368f); q = q * t + 0.127414796f; q = q * t;
    const f32x2 s = (v * v) * (-0.72134752044f);
    f32x2 e; e.x = __builtin_amdgcn_exp2f(s.x); e.y = __builtin_amdgcn_exp2f(s.y);
    const f32x2 m = v * (q * e), r = v - m;
    f32x2 o; o.x = v.x < 0.f ? m.x : r.x; o.y = v.y < 0.f ? m.y : r.y; return o;
}

template <int ACT  > struct EpiBf16 {
    static constexpr bool PERM = true, AFTER_DRAIN = false; static_assert(ACT == 0 || ACT == 1, "EpiBf16: ACT is 0 (none) or 1 (gelu_pk)");
    bf16_t* O; int ldc; const float* bias; int split_cols; size_t split_stride; float scale0;
    __device__ __forceinline__ void operator()(const f32x4 (&acc)[2][2][4][2], const Unit& u, int wr, int wc, int fr, int fq) const {
        const int row0 = u.pm * BM + wr * 64 + fr; int colt = u.pn * BM; bf16_t* base = O;
        float sc = 1.f; if (split_cols) { const int t = colt / split_cols; base += (size_t)t * split_stride; colt -= t * split_cols; if (t == 0) sc = scale0; }
        const int col0 = colt + wc * 32 + 8 * fq, bcol0 = u.pn * BM + wc * 32 + 8 * fq;
        f32x4 bv[2][2];
#pragma unroll
        for (int bj = 0; bj < 2; ++bj)
#pragma unroll
            for (int n = 0; n < 2; ++n) bv[bj][n] = bias ? *(const f32x4*)(bias + bcol0 + bj * HALF + 4 * n) : (f32x4){0.f, 0.f, 0.f, 0.f};
#pragma unroll
        for (int ai = 0; ai < 2; ++ai)
#pragma unroll
            for (int m = 0; m < 4; ++m) { bf16_t* rowp = base + (size_t)(row0 + ai * HALF + m * 16) * ldc + col0;
#pragma unroll
                for (int bj = 0; bj < 2; ++bj) { f32x4 v0 = acc[ai][bj][m][0] + bv[bj][0], v1 = acc[ai][bj][m][1] + bv[bj][1];
                    if (ACT == 1) { f32x2 a = gelu_pk((f32x2){v0[0], v0[1]}), b = gelu_pk((f32x2){v0[2], v0[3]}), c = gelu_pk((f32x2){v1[0], v1[1]}), d = gelu_pk((f32x2){v1[2], v1[3]});
                        v0 = (f32x4){a.x, a.y, b.x, b.y}; v1 = (f32x4){c.x, c.y, d.x, d.y}; }
                    v0 = v0 * sc; v1 = v1 * sc; u32x4 w; w.x = cvt_pk_bf16(v0[0], v0[1]); w.y = cvt_pk_bf16(v0[2], v0[3]); w.z = cvt_pk_bf16(v1[0], v1[1]); w.w = cvt_pk_bf16(v1[2], v1[3]);
                    *(u32x4*)(rowp + bj * HALF) = w; } }
    }
};
struct EpiResid {
    static constexpr bool PERM = true, AFTER_DRAIN = false;
    const float* x; const float* mod; bf16_t* out;
    __device__ __forceinline__ void operator()(const f32x4 (&acc)[2][2][4][2], const Unit& u, int wr, int wc, int fr, int fq) const {
        const int col0 = u.pn * BM + wc * 32 + 8 * fq, b = (u.pm * BM) / 8192;
        f32x4 gv[2][2];
#pragma unroll
        for (int bj = 0; bj < 2; ++bj)
#pragma unroll
            for (int n = 0; n < 2; ++n) gv[bj][n] = *(const f32x4*)(mod + b * 6144 + 2048 + col0 + bj * HALF + n * 4);
#pragma unroll
        for (int ai = 0; ai < 2; ++ai)
#pragma unroll
            for (int m = 0; m < 4; ++m) { const size_t off = (size_t)(u.pm * BM + ai * HALF + wr * 64 + m * 16 + fr) * 1024 + col0;
#pragma unroll
                for (int bj = 0; bj < 2; ++bj) { const f32x4 x0 = *(const f32x4*)(x + off + bj * HALF), x1 = *(const f32x4*)(x + off + bj * HALF + 4);
                    const f32x4 v0 = x0 + gv[bj][0] * acc[ai][bj][m][0], v1 = x1 + gv[bj][1] * acc[ai][bj][m][1];
                    u32x4 w; w.x = cvt_pk_bf16(v0[0], v0[1]); w.y = cvt_pk_bf16(v0[2], v0[3]); w.z = cvt_pk_bf16(v1[0], v1[1]); w.w = cvt_pk_bf16(v1[2], v1[3]);
                    *(u32x4*)(out + off + bj * HALF) = w; } }
    }
};
__device__ __forceinline__ float silu_e(float v) { return v * __builtin_amdgcn_rcpf(1.f + __builtin_amdgcn_exp2f(-1.4426950408889634f * v)); }
struct EpiSiluMul {
    static constexpr bool PERM = true, AFTER_DRAIN = false;
    bf16_t* H;
    __device__ __forceinline__ void operator()(const f32x4 (&acc)[2][2][4][2], const Unit& u, int wr, int wc, int fr, int fq) const {
        const int half = u.pn & 1, col0 = half * 128 + wc * 32 + 8 * fq;
#pragma unroll
        for (int ai = 0; ai < 2; ++ai)
#pragma unroll
            for (int m = 0; m < 4; ++m) { const size_t row = (size_t)(u.pm * BM + ai * HALF + wr * 64 + m * 16 + fr);
                const f32x4 g0 = acc[ai][0][m][0], g1 = acc[ai][0][m][1], u0 = acc[ai][1][m][0], u1 = acc[ai][1][m][1];
                u32x4 w; w.x = cvt_pk_bf16(silu_e(g0[0]) * u0[0], silu_e(g0[1]) * u0[1]); w.y = cvt_pk_bf16(silu_e(g0[2]) * u0[2], silu_e(g0[3]) * u0[3]);
                w.z = cvt_pk_bf16(silu_e(g1[0]) * u1[0], silu_e(g1[1]) * u1[1]); w.w = cvt_pk_bf16(silu_e(g1[2]) * u1[2], silu_e(g1[3]) * u1[3]);
                *(u32x4*)(H + row * 256 + col0) = w; }
    }
};
struct EpiProjT {
    static constexpr bool PERM = true, AFTER_DRAIN = false;
    bf16_t* P;
    __device__ __forceinline__ void operator()(const f32x4 (&acc)[2][2][4][2], const Unit& u, int wr, int wc, int fr, int fq) const {
#pragma unroll
        for (int ai = 0; ai < 2; ++ai)
#pragma unroll
            for (int m = 0; m < 4; ++m) { const int row = u.pm * BM + ai * HALF + wr * 64 + m * 16 + fr;
#pragma unroll
                for (int bj = 0; bj < 2; ++bj) { const int c = (u.pn * BM + bj * HALF + wc * 32 + 8 * fq) >> 3; const f32x4 v0 = acc[ai][bj][m][0], v1 = acc[ai][bj][m][1];
                    u32x4 w; w.x = cvt_pk_bf16(v0[0], v0[1]); w.y = cvt_pk_bf16(v0[2], v0[3]); w.z = cvt_pk_bf16(v1[0], v1[1]); w.w = cvt_pk_bf16(v1[2], v1[3]);
                    *(u32x4*)(P + ((size_t)((row >> 5) * 192 + c) * 32 + (row & 31)) * 8) = w; } }
    }
};
struct EpiYs {
    static constexpr bool PERM = true, AFTER_DRAIN = false;
    bf16_t* Y;
    __device__ __forceinline__ void operator()(const f32x4 (&acc)[2][2][4][2], const Unit& u, int wr, int wc, int fr, int fq) const {
        const int col0 = (u.pn & 3) * BM + wc * 32 + 8 * fq;
#pragma unroll
        for (int ai = 0; ai < 2; ++ai)
#pragma unroll
            for (int m = 0; m < 4; ++m) { bf16_t* rowp = Y + (size_t)(u.pm * BM + ai * HALF + wr * 64 + m * 16 + fr) * 1024 + col0;
#pragma unroll
                for (int bj = 0; bj < 2; ++bj) { const f32x4 v0 = acc[ai][bj][m][0], v1 = acc[ai][bj][m][1];
                    u32x4 w; w.x = cvt_pk_bf16(v0[0], v0[1]); w.y = cvt_pk_bf16(v0[2], v0[3]); w.z = cvt_pk_bf16(v1[0], v1[1]); w.w = cvt_pk_bf16(v1[2], v1[3]);
                    *(u32x4*)(rowp + bj * HALF) = w; } }
    }
};
struct GroupedOrder {
    const __attribute__((address_space(3))) int* tp; int ncol, G, c;
    __device__ __forceinline__ bool next(int i, Unit& u) const {
        const int L = i * G + c, total = tp[32] * ncol; if (L >= total) return false;
        const int rt = L / ncol, ct = L - rt * ncol; int e = 0;
#pragma unroll 1
        for (int j = 1; j < 32; ++j) e += (tp[j] <= rt) ? 1 : 0;
        u.pm = rt; u.pn = e * ncol + ct; return true;
    }
    __device__ __forceinline__ void a_ready(const Unit&) const {}
    __device__ __forceinline__ void done(const Unit&) const {}
};
template <class Epi, class Sched, bool ALIGN_EPI = false, bool SP2 = false>
__device__ __forceinline__ void gemm_phase(PG8_LAS unsigned char* lds, const Gemm g, const Sched& S, const Epi& E) {
    const int tid = threadIdx.x, wid = __builtin_amdgcn_readfirstlane(tid >> 6), lane = tid & 63, wr = wid >> 2, wc = wid & 3, fr = lane & 15, fq = lane >> 4;
    const int K = g.K, nt = K / BK;
    unsigned voffA[2], voffB[2];
#pragma unroll
    for (int i = 0; i < 2; ++i) { int R, C; stage_rc(tid * 16 + i * 8192, R, C); const int Rb = Epi::PERM ? ((R & ~31) + perm32(R & 31)) : R;
        voffA[i] = (unsigned)(R * K + C) * 2u; voffB[i] = (unsigned)(Rb * K + C) * 2u; }
    const size_t kstep = (size_t)(BK * 2);
    const size_t hstep = (size_t)HALF * K * 2;
    const size_t tstep = 2 * hstep;
    const unsigned ldsw = (unsigned)wid * 1024u;
    const int aoff = lds_byte(wr * 64 + fr, fq * 8), boff = lds_byte(wc * 32 + fr, fq * 8);
#define PG8_SA(b, h) (((b) * 2 + (h)) * HTB)
#define PG8_SB(b, h) ((4 + (b) * 2 + (h)) * HTB)
#define PG8_STAGE(bufoff, gbase, voff) do { _Pragma("unroll") for (int _i = 0; _i < 2; ++_i) \
        __builtin_amdgcn_global_load_lds((const unsigned*)((const char*)(gbase) + (voff)[_i]), (PG8_LAS unsigned*)(lds + (bufoff) + ldsw + _i * 8192), 16, 0, 0); } while (0)
#define PG8_LDA(dst, b, h) do { _Pragma("unroll") for (int m = 0; m < 4; ++m) _Pragma("unroll") for (int k = 0; k < 2; ++k) dst[m][k] = *(const PG8_LAS bf16x8*)(lds + PG8_SA(b, h) + aoff + m * 2048 + k * 1024); } while (0)
#define PG8_LDB(dst, b, h) do { _Pragma("unroll") for (int n = 0; n < 2; ++n) _Pragma("unroll") for (int k = 0; k < 2; ++k) dst[n][k] = *(const PG8_LAS bf16x8*)(lds + PG8_SB(b, h) + boff + n * 2048 + k * 1024); } while (0)
#define PG8_MMA(ai, bj, At, Bt) do { __builtin_amdgcn_s_setprio(1); _Pragma("unroll") for (int m = 0; m < 4; ++m) _Pragma("unroll") for (int n = 0; n < 2; ++n) _Pragma("unroll") for (int k = 0; k < 2; ++k) \
        acc[ai][bj][m][n] = __builtin_amdgcn_mfma_f32_16x16x32_bf16(Bt[n][k], At[m][k], acc[ai][bj][m][n], 0, 0, 0); __builtin_amdgcn_s_setprio(0); } while (0)
#define PG8_WAIT_V(n) asm volatile("s_waitcnt vmcnt(" #n ")" ::: "memory")
#define PG8_WAIT_L(n) asm volatile("s_waitcnt lgkmcnt(" #n ")" ::: "memory")
#define PG8_BAR __builtin_amdgcn_s_barrier()
#define PG8_SCHED __builtin_amdgcn_sched_barrier(0)
    Unit cur, nxt; int ui = 0;
    if (!S.next(0, cur)) return;
    f32x4 acc[2][2][4][2];
#pragma unroll
    for (int a = 0; a < 2; ++a)
#pragma unroll
        for (int b = 0; b < 2; ++b)
#pragma unroll
            for (int m = 0; m < 4; ++m)
#pragma unroll
                for (int n = 0; n < 2; ++n) acc[a][b][m][n] = (f32x4){0.f, 0.f, 0.f, 0.f};
    bf16x8 At[4][2], B0[2][2], B1[2][2];
    const char* cA = (const char*)g.A + (size_t)cur.pm * tstep; const char* cB = (const char*)g.Bt + (size_t)cur.pn * tstep;
    S.a_ready(cur);
    if constexpr (SP2) {
        PG8_STAGE(PG8_SB(0, 0), cB, voffB); PG8_STAGE(PG8_SB(0, 1), cB + hstep, voffB); PG8_STAGE(PG8_SA(0, 0), cA, voffA); PG8_STAGE(PG8_SA(0, 1), cA + hstep, voffA);
        if (wr == 1) PG8_BAR;
        PG8_WAIT_V(2); PG8_BAR;
        PG8_STAGE(PG8_SB(1, 0), cB + kstep, voffB); PG8_STAGE(PG8_SA(1, 0), cA + kstep, voffA); PG8_STAGE(PG8_SB(1, 1), cB + hstep + kstep, voffB);
        PG8_WAIT_V(6); PG8_BAR;
    } else {
        PG8_STAGE(PG8_SB(0, 0), cB, voffB); PG8_STAGE(PG8_SA(0, 0), cA, voffA); PG8_STAGE(PG8_SB(0, 1), cB + hstep, voffB); PG8_STAGE(PG8_SA(0, 1), cA + hstep, voffA);
        if (wr == 1) PG8_BAR;
        PG8_WAIT_V(4); PG8_BAR;
        PG8_STAGE(PG8_SB(1, 0), cB + kstep, voffB); PG8_STAGE(PG8_SA(1, 0), cA + kstep, voffA); PG8_STAGE(PG8_SB(1, 1), cB + hstep + kstep, voffB);
        PG8_WAIT_V(6); PG8_BAR;
    }
    for (;;) {
        const bool has_next = S.next(ui + 1, nxt);
        const char* nA = has_next ? (const char*)g.A + (size_t)nxt.pm * tstep : cA; const char* nB = has_next ? (const char*)g.Bt + (size_t)nxt.pn * tstep : cB;
        for (int t = 0; t < nt; t += 2) {
            const bool last = (t == nt - 2);
            const char* a1 = cA + (size_t)(t + 1) * kstep;
            const char* a2 = last ? nA : cA + (size_t)(t + 2) * kstep; const char* b2 = last ? nB : cB + (size_t)(t + 2) * kstep;
            const char* a3 = a2 + kstep; const char* b3 = b2 + kstep;
            if (last && has_next) S.a_ready(nxt);
            if constexpr (SP2) {
            PG8_LDB(B0, 0, 0); PG8_LDB(B1, 0, 1); PG8_SCHED; PG8_LDA(At, 0, 0); PG8_STAGE(PG8_SA(1, 1), a1 + hstep, voffA);
            PG8_WAIT_V(8); PG8_WAIT_L(0); PG8_BAR; PG8_MMA(0, 0, At, B0); PG8_MMA(0, 1, At, B1); PG8_BAR; PG8_SCHED;
            PG8_LDA(At, 0, 1); PG8_STAGE(PG8_SB(0, 0), b2, voffB); PG8_STAGE(PG8_SB(0, 1), b2 + hstep, voffB); PG8_STAGE(PG8_SA(0, 0), a2, voffA);
            PG8_WAIT_V(8); PG8_WAIT_L(0); PG8_BAR; PG8_MMA(1, 0, At, B0); PG8_MMA(1, 1, At, B1); PG8_BAR; PG8_SCHED;
            PG8_LDB(B0, 1, 0); PG8_LDB(B1, 1, 1); PG8_SCHED; PG8_LDA(At, 1, 0); PG8_STAGE(PG8_SA(0, 1), a2 + hstep, voffA);
            PG8_WAIT_V(8); PG8_WAIT_L(0); PG8_BAR; PG8_MMA(0, 0, At, B0); PG8_MMA(0, 1, At, B1); PG8_BAR; PG8_SCHED;
            PG8_LDA(At, 1, 1); PG8_STAGE(PG8_SB(1, 0), b3, voffB); PG8_STAGE(PG8_SB(1, 1), b3 + hstep, voffB); PG8_STAGE(PG8_SA(1, 0), a3, voffA);
            PG8_WAIT_V(8); PG8_WAIT_L(0); PG8_BAR; PG8_MMA(1, 0, At, B0); PG8_MMA(1, 1, At, B1); PG8_BAR; PG8_SCHED;
            } else {
            PG8_LDB(B0, 0, 0); PG8_SCHED; PG8_LDA(At, 0, 0); PG8_STAGE(PG8_SA(1, 1), a1 + hstep, voffA);
            PG8_WAIT_L(8); PG8_BAR; PG8_WAIT_L(0); PG8_MMA(0, 0, At, B0); PG8_BAR; PG8_SCHED;
            PG8_LDB(B1, 0, 1); PG8_STAGE(PG8_SB(0, 0), b2, voffB);
            PG8_BAR; PG8_WAIT_L(0); PG8_MMA(0, 1, At, B1); PG8_BAR;
            PG8_LDA(At, 0, 1); PG8_STAGE(PG8_SA(0, 0), a2, voffA);
            PG8_BAR; PG8_WAIT_L(0); PG8_MMA(1, 0, At, B0); PG8_BAR; PG8_SCHED;
            PG8_STAGE(PG8_SB(0, 1), b2 + hstep, voffB);
            PG8_WAIT_V(6); PG8_BAR; PG8_MMA(1, 1, At, B1); PG8_BAR;
            PG8_LDB(B0, 1, 0); PG8_SCHED; PG8_LDA(At, 1, 0); PG8_STAGE(PG8_SA(0, 1), a2 + hstep, voffA);
            PG8_WAIT_L(8); PG8_BAR; PG8_WAIT_L(0); PG8_MMA(0, 0, At, B0); PG8_BAR; PG8_SCHED;
            PG8_LDB(B1, 1, 1); PG8_STAGE(PG8_SB(1, 0), b3, voffB);
            PG8_BAR; PG8_WAIT_L(0); PG8_MMA(0, 1, At, B1); PG8_BAR;
            PG8_LDA(At, 1, 1); PG8_STAGE(PG8_SA(1, 0), a3, voffA);
            PG8_BAR; PG8_WAIT_L(0); PG8_MMA(1, 0, At, B0); PG8_BAR; PG8_SCHED;
            PG8_STAGE(PG8_SB(1, 1), b3 + hstep, voffB);
            PG8_WAIT_V(6); PG8_BAR; PG8_MMA(1, 1, At, B1); PG8_BAR;
            }
        }
        if constexpr (ALIGN_EPI) { if (wr == 0) PG8_BAR; }
        if constexpr (!Epi::AFTER_DRAIN) { E(acc, cur, wr, wc, fr, fq); S.done(cur); }
        if (!has_next) break;
#pragma unroll
        for (int a = 0; a < 2; ++a)
#pragma unroll
            for (int b = 0; b < 2; ++b)
#pragma unroll
                for (int m = 0; m < 4; ++m)
#pragma unroll
                    for (int n = 0; n < 2; ++n) acc[a][b][m][n] = (f32x4){0.f, 0.f, 0.f, 0.f};
        cur = nxt; cA = nA; cB = nB; ++ui;
        if constexpr (ALIGN_EPI) { if (wr == 1) PG8_BAR; }
    }
    PG8_WAIT_V(0);
    if constexpr (!ALIGN_EPI) { if (wr == 0) PG8_BAR; }
    PG8_BAR;
    if constexpr (Epi::AFTER_DRAIN) { E.fused(acc, cur, wr, wc, fr, fq, lds, wid, lane); S.done(cur); }
#undef PG8_SA
#undef PG8_SB
#undef PG8_STAGE
#undef PG8_LDA
#undef PG8_LDB
#undef PG8_MMA
#undef PG8_WAIT_V
#undef PG8_WAIT_L
#undef PG8_BAR
#undef PG8_SCHED
}
}
#define XB_TMO      128
#define XB_XCNT(j)  (256  + 64 * (j))
#define XB_XSUB(j)  (1280 + 64 * (j))
#define XB_XGEN(j)  (2304 + 64 * (j))
#define XB_TOP      3328
#define XB_TOPGEN   3392
#define XCD_BAR_WORDS 3456
#define XB_SPIN_CAP (1u << 18)

__device__ __forceinline__ unsigned xb_ld(unsigned* p)              { return __hip_atomic_load(p, __ATOMIC_RELAXED, __HIP_MEMORY_SCOPE_AGENT); }
__device__ __forceinline__ unsigned xb_add(unsigned* p, unsigned v) { return __hip_atomic_fetch_add(p, v, __ATOMIC_RELAXED, __HIP_MEMORY_SCOPE_AGENT); }
__device__ __forceinline__ unsigned xb_xcc_id() { return (unsigned)__builtin_amdgcn_s_getreg((3 << 11) | 20) & 0xFu; }
#define XB_SPIN(cond, bar) do { unsigned _sp = 0; while (cond) { __builtin_amdgcn_s_sleep(1); \
    if ((++_sp & 255u) == 0u) { if (xb_ld(&(bar)[XB_TMO])) break; if (_sp > XB_SPIN_CAP) { atomicAdd(&(bar)[XB_TMO], 1u); break; } } } } while (0)

struct XcdBarrier {
    unsigned* bar; unsigned x;
    volatile LAS unsigned* st;
};

__device__ __forceinline__ XcdBarrier xcd_barrier_post(unsigned* bar, volatile LAS unsigned* st) {
    XcdBarrier b; b.bar = bar; b.x = xb_xcc_id(); b.st = st;
    if (threadIdx.x == 0) (void)xb_add(&bar[XB_XCNT(b.x)], 1u);
    return b;
}
__device__ __forceinline__ void xcd_barrier_complete(unsigned* bar, unsigned x, unsigned& nloc, unsigned& nx) {
    const unsigned G = gridDim.x * gridDim.y * gridDim.z;
    unsigned sum, cnt, mine, sp = 0u;
    for (;;) {
        sum = 0u; cnt = 0u; mine = 0u;
#pragma unroll
        for (unsigned j = 0; j < 16; ++j) { const unsigned c = xb_ld(&bar[XB_XCNT(j)]); sum += c; cnt += (c > 0u) ? 1u : 0u; mine = (j == x) ? c : mine; }
        if (sum == G) break;
        __builtin_amdgcn_s_sleep(1);
        if ((++sp & 255u) == 0u) { if (xb_ld(&bar[XB_TMO])) break; if (sp > XB_SPIN_CAP) { atomicAdd(&bar[XB_TMO], 1u); break; } }
    }
    nloc = mine > 0u ? mine : 1u; nx = cnt > 0u ? cnt : 1u;
}

__device__ __forceinline__ void xcd_barrier(const XcdBarrier& b) {
    asm volatile("s_waitcnt vmcnt(0)" ::: "memory");
    __syncthreads();
    if (threadIdx.x == 0) {
        unsigned* bar = b.bar;
        __builtin_amdgcn_s_waitcnt(0);
        unsigned nloc = b.st[0], nx = b.st[1];
        if (nloc == 0u) { xcd_barrier_complete(bar, b.x, nloc, nx); b.st[0] = nloc; b.st[1] = nx; }
        const unsigned old = xb_add(&bar[XB_XSUB(b.x)], 1u);
        const unsigned gen = old / nloc;
        if (old + 1u == (gen + 1u) * nloc) {
            __builtin_amdgcn_fence(__ATOMIC_RELEASE, "agent");
            asm volatile("s_waitcnt vmcnt(0)" ::: "memory");
            const unsigned og = xb_add(&bar[XB_TOP], 1u);
            const unsigned tg = og / nx;
            if (og + 1u == (tg + 1u) * nx) xb_add(&bar[XB_TOPGEN], 1u);
            else XB_SPIN(xb_ld(&bar[XB_TOPGEN]) == tg, bar);
            __builtin_amdgcn_fence(__ATOMIC_ACQUIRE, "agent");
            xb_add(&bar[XB_XGEN(b.x)], 1u);
            asm volatile("s_waitcnt vmcnt(0)" ::: "memory");
        } else {
            XB_SPIN(xb_ld(&bar[XB_XGEN(b.x)]) == gen, bar);
            __builtin_amdgcn_fence(__ATOMIC_ACQUIRE, "agent");
            asm volatile("s_waitcnt vmcnt(0)" ::: "memory");
        }
    }
    __syncthreads();
}
struct Args { const void* in[31]; float* out; unsigned char* ws; int ph_lo, ph_hi, li, pad; };
struct Frame {
    LAS unsigned char* lds; volatile LAS unsigned* MISC; gu32* ctl;
    int tid, lane, wave, vcu, G;
    unsigned char* ws; float* out;
};
__device__ __forceinline__ float wave_sum_f(float v) {
#pragma unroll
    for (int o = 1; o < 64; o <<= 1) v += __shfl_xor(v, o);
    return v;
}
__device__ __forceinline__ void p0_transpose_item(const float* W, int K, int N, bf16_t* WT, int row_off, LAS float* scr, int kb, int nb, int lane) {
    const int k0 = 64 * kb, n0 = 32 * nb;
#pragma unroll 8
    for (int i = 0; i < 32; ++i) { const int kk = 2 * i + (lane >> 5); scr[kk * 33 + (lane & 31)] = W[(size_t)(k0 + kk) * N + n0 + (lane & 31)]; }
    LDS_WAIT(); asm volatile("" ::: "memory");
    const int c = lane & 7;
#pragma unroll
    for (int j = 0; j < 4; ++j) { const int n = (lane >> 3) + 8 * j; const LAS float* s = scr + (8 * c) * 33 + n;
        v4u o; o.x = pk2(s[0 * 33], s[1 * 33]); o.y = pk2(s[2 * 33], s[3 * 33]); o.z = pk2(s[4 * 33], s[5 * 33]); o.w = pk2(s[6 * 33], s[7 * 33]);
        *(GAS v4u*)(WT + (size_t)(row_off + n0 + n) * K + k0 + 8 * c) = o; }
    LDS_WAIT(); asm volatile("" ::: "memory");
}
__device__ __forceinline__ int lru_chan(int ks, int hi, int j) { return 32 * (ks >> 1) + 16 * (ks & 1) + 8 * (j >> 2) + 4 * hi + (j & 3); }
__device__ __forceinline__ void phase_prologue(Frame& F, const Inputs& I) {
    if (blockIdx.x < 192) {
        LAS float* sl = (LAS float*)F.lds; LAS float* red = sl + 4096;
        for (int i = ((int)threadIdx.x); i < 4096; i += 512) { const float v = I.c[i]; sl[i] = v / (1.f + __expf(-v)); }
        __syncthreads();
        const int col0 = blockIdx.x * 32, kg = ((int)threadIdx.x) >> 5, col = ((int)threadIdx.x) & 31;
        float a0 = 0.f, a1 = 0.f, a2 = 0.f, a3 = 0.f;
#pragma unroll 8
        for (int i = 0; i < 64; ++i) { const int k = kg + 16 * i; const float w = I.w_ada[(size_t)k * MODW + col0 + col];
            a0 += sl[k] * w; a1 += sl[1024 + k] * w; a2 += sl[2048 + k] * w; a3 += sl[3072 + k] * w; }
        red[(kg * 4 + 0) * 32 + col] = a0; red[(kg * 4 + 1) * 32 + col] = a1; red[(kg * 4 + 2) * 32 + col] = a2; red[(kg * 4 + 3) * 32 + col] = a3;
        __syncthreads();
        if (((int)threadIdx.x) < 128) { const int b = ((int)threadIdx.x) >> 5, c = ((int)threadIdx.x) & 31; float s = I.b_ada[col0 + c];
            for (int g = 0; g < 16; ++g) s += red[(g * 4 + b) * 32 + c];
            ((float*)(F.ws + WS_MOD))[b * MODW + col0 + c] = s; }
        __syncthreads();
    }
    {
        LAS float* scr = (LAS float*)(F.lds + F.wave * 16384);
        const int gw = F.vcu * NWAVES + F.wave, NGW = F.G * NWAVES;
        bf16_t* WIN = (bf16_t*)(F.ws + WSX_WIN); bf16_t* WOUT = (bf16_t*)(F.ws + WSX_WOUT); bf16_t* W1T = (bf16_t*)(F.ws + WSX_W1T); bf16_t* W2T = (bf16_t*)(F.ws + WSX_W2T);
        constexpr int I_IN = 16 * 46, I_OUT = 16 * 32, I_G = 32 * 16 * 8, I_D = 32 * 4 * 32, NIT = I_IN + I_OUT + 2 * I_G + I_D;
        for (int it = gw; it < NIT; it += NGW) {
            int r = it;
            if (r < I_IN) { p0_transpose_item(I.w_in, 1024, NPROJ, WIN, 0, scr, r / 46, r % 46, ((int)(threadIdx.x & 63))); continue; } r -= I_IN;
            if (r < I_OUT) { p0_transpose_item(I.w_out, 1024, 1024, WOUT, 0, scr, r / 32, r % 32, ((int)(threadIdx.x & 63))); continue; } r -= I_OUT;
            if (r < 2 * I_G) { const int up = r >= I_G ? 1 : 0; if (up) r -= I_G; const int e = r >> 7, kb = (r >> 3) & 15, nb = r & 7, n0 = 32 * nb;
                p0_transpose_item((up ? I.w_up : I.w_gate) + (size_t)e * 1024 * 256, 1024, 256, W1T, e * 512 + (n0 >> 7) * 256 + (n0 & 127) - n0 + up * 128, scr, kb, nb, ((int)(threadIdx.x & 63))); continue; } r -= 2 * I_G;
            { const int e = r >> 7, kb = (r >> 5) & 3, nb = r & 31; p0_transpose_item(I.w_down + (size_t)e * 256 * 1024, 256, 1024, W2T, e * 1024, scr, kb, nb, ((int)(threadIdx.x & 63))); }
        }
    }
    {
        const int gt = blockIdx.x * 512 + ((int)threadIdx.x), NGT = F.G * 512;
        v4u* WQF = (v4u*)(F.ws + WSX_WQF); v4u* WKVF = (v4u*)(F.ws + WSX_WKVF); v4u* WAF = (v4u*)(F.ws + WSX_WAF); v4u* WXF = (v4u*)(F.ws + WSX_WXF); v4u* WRF = (v4u*)(F.ws + WSX_WRF);
        constexpr int NQ = 4 * 6 * 16 * 64, NKV = 4 * 8 * 8 * 64, NA = 4 * 4 * 8 * 64, NR = 2 * 64 * 64, NZ = 64 * 1024 / 8, NTOT = NQ + NKV + 2 * NA + NR + NZ;
        for (int g = gt; g < NTOT; g += NGT) {
            int r = g; float v[8];
            if (r < NQ) { const int lane = r & 63, ks = (r >> 6) & 15, hn = r >> 10, h = hn / 6, nb = hn % 6, hi = lane >> 5, r32 = lane & 31;
#pragma unroll
                for (int j = 0; j < 8; ++j) { const int k = 16 * ks + 8 * hi + j; v[j] = I.w_q_b[(size_t)k * 768 + h * 192 + 32 * nb + r32] * I.q_a_norm[k]; }
                WQF[r] = (v4u){pk2(v[0], v[1]), pk2(v[2], v[3]), pk2(v[4], v[5]), pk2(v[6], v[7])}; continue; } r -= NQ;
            if (r < NKV) { const int lane = r & 63, ks = (r >> 6) & 7, hn = r >> 9, h = hn >> 3, nb = hn & 7, hi = lane >> 5, r32 = lane & 31;
#pragma unroll
                for (int j = 0; j < 8; ++j) { const int k = 16 * ks + 8 * hi + j; v[j] = I.w_kv_b[(size_t)k * 1024 + h * 256 + 32 * nb + r32] * I.kv_a_norm[k]; }
                WKVF[r] = (v4u){pk2(v[0], v[1]), pk2(v[2], v[3]), pk2(v[4], v[5]), pk2(v[6], v[7])}; continue; } r -= NKV;
            if (r < 2 * NA) { const int x = r >= NA ? 1 : 0; if (x) r -= NA; const int lane = r & 63, ks = (r >> 6) & 7, hn = r >> 9, h = hn >> 2, nb = hn & 3, hi = lane >> 5, r32 = lane & 31;
                const float* W = x ? I.lru_wx : I.lru_wa;
#pragma unroll
                for (int j = 0; j < 8; ++j) v[j] = W[(size_t)(h * 128 + lru_chan(ks, hi, j)) * 128 + 32 * nb + r32];
                (x ? WXF : WAF)[r] = (v4u){pk2(v[0], v[1]), pk2(v[2], v[3]), pk2(v[4], v[5]), pk2(v[6], v[7])}; continue; } r -= 2 * NA;
            if (r < NR) { const int lane = r & 63, ks = (r >> 6) & 63, nb = r >> 12, hi = lane >> 5, n = 32 * nb + (lane & 31);
#pragma unroll
                for (int j = 0; j < 8; ++j) { const int k = 16 * ks + 8 * hi + j; v[j] = n < 4 ? I.w_rg[k * 4 + n] : (n < 36 ? I.w_re[k * 32 + n - 4] : 0.f); }
                WRF[r] = (v4u){pk2(v[0], v[1]), pk2(v[2], v[3]), pk2(v[4], v[5]), pk2(v[6], v[7])}; continue; } r -= NR;
            ((v4u*)(F.ws + WSX_WIN + (size_t)NPROJ * 1024 * 2))[r] = (v4u){0u, 0u, 0u, 0u};
        }
        if (gt < 512) ((float*)(F.ws + WSX_SP))[gt] = log1pf(__expf(-I.lru_lambda[gt]));
        float* CS = (float*)(F.ws + WSX_CS);
        for (int g = gt; g < NTOK * 32; g += NGT) { const int t = g >> 5, i = g & 31; float c, s; rope_cs(I.positions[t], i, c, s); CS[t * 64 + i] = c; CS[t * 64 + 32 + i] = s; }
    }
}
__device__ __forceinline__ void phase_xn(Frame& F, const Inputs& I) {
    LAS float* Gs = (LAS float*)F.lds; LAS float* Ss = Gs + 4096;
    const float* mod = (const float*)(F.ws + WS_MOD);
#pragma unroll
    for (int i = ((int)threadIdx.x); i < 4096; i += 512) { const int b = i >> 10, k = i & 1023; Gs[i] = I.norm1_g[k] * (1.f + mod[b * MODW + 1024 + k]); Ss[i] = mod[b * MODW + k]; }
    __syncthreads();
    bf16_t* XN = (bf16_t*)(F.ws + WSX_A);
    const int gw = F.vcu * NWAVES + F.wave, NGW = F.G * NWAVES;
    for (int m0 = gw; m0 < NTOK; m0 += 2 * NGW) {
        f32x4 v[2][4];
#pragma unroll
        for (int u = 0; u < 2; ++u) { const GAS f32x4* xr = (const GAS f32x4*)(I.x + (size_t)(m0 + u * NGW) * DM) + ((int)(threadIdx.x & 63));
#pragma unroll
            for (int j = 0; j < 4; ++j) v[u][j] = xr[64 * j]; }
#pragma unroll
        for (int u = 0; u < 2; ++u) { const int m = m0 + u * NGW, b = m >> 13; float s = 0.f;
#pragma unroll
            for (int j = 0; j < 4; ++j) s += (v[u][j].x * v[u][j].x + v[u][j].y * v[u][j].y) + (v[u][j].z * v[u][j].z + v[u][j].w * v[u][j].w);
            const float rstd = rsqrtf(wave_sum_f(s) * (1.f / DM) + EPS);
            GAS v2u* o8 = (GAS v2u*)(XN + (size_t)m * DM) + ((int)(threadIdx.x & 63));
#pragma unroll
            for (int j = 0; j < 4; ++j) { const f32x4 g = *(const LAS f32x4*)(Gs + b * 1024 + 256 * j + 4 * ((int)(threadIdx.x & 63))), sh = *(const LAS f32x4*)(Ss + b * 1024 + 256 * j + 4 * ((int)(threadIdx.x & 63)));
                const f32x4 o = v[u][j] * rstd * g + sh; o8[64 * j] = (v2u){pk2(o.x, o.y), pk2(o.z, o.w)}; } }
    }
    __syncthreads();
}
namespace att {
constexpr int NW = 8, QBLK = 32, KVBLK = 64, QB = NW * QBLK;
constexpr int DQ = 192, DVV = 128, OPITCH = 512;
constexpr int SHM_V = KVBLK * DVV * 2, SHM_K = KVBLK * DQ * 2;
constexpr int ATT_LDS = 3 * SHM_V + 3 * SHM_K + NW * 64 * 4;
constexpr float SCALE = 0.07216878364870322f;
constexpr float THR = 8.f;
#define SBAR() __builtin_amdgcn_sched_barrier(0)
__device__ __forceinline__ int koff(int row, int chunk) { return (chunk >> 3) * 8192 + row * 128 + ((((chunk & 7) ^ ((row >> 1) & 7))) << 4); }
__device__ __forceinline__ int v_st(int k, int c) { const int kk = (k & ~0xC) | ((k & 4) << 1) | ((k & 8) >> 1); return ((kk >> 3) * 4 + (c >> 5)) * 512 + ((kk & 7) * 32 + (c & 31)) * 2; }
__device__ __forceinline__ int v_rd_base(int lane) { return ((lane & 3) << 3) | (((lane >> 2) & 3) << 6) | (((lane >> 4) & 1) << 5) | (((lane >> 5) & 1) << 8); }
constexpr int v_rd_off(int d0, int ks, int half) { return d0 * 512 + ks * 4096 + half * 2048; }
__device__ __forceinline__ int crow(int r, int hi) { return (r & 3) + 8 * (r >> 2) + 4 * hi; }
__device__ __forceinline__ bf16x8 ld8(const bf16_t* p) { return *reinterpret_cast<const bf16x8*>(p); }
__device__ __forceinline__ void mask_tile(f32x16& p0, f32x16& p1, int dq) {
    const float NEG = -__builtin_inff();
#pragma unroll
    for (int r = 0; r < 16; ++r) { const int c = (r & 3) + 8 * (r >> 2); if (dq - c < 0) p0[r] = NEG; if (dq - c - 32 < 0) p1[r] = NEG; }
}
__device__ __forceinline__ void partialSM(f32x16& p0, f32x16& p1, float& m_reg, float& mn, float& alpha) {
    float pmax = p0[0];
#pragma unroll
    for (int r = 1; r < 16; ++r) pmax = fmaxf(pmax, p0[r]);
#pragma unroll
    for (int r = 0; r < 16; ++r) pmax = fmaxf(pmax, p1[r]);
    { auto rr = __builtin_amdgcn_permlane32_swap(__float_as_uint(pmax), __float_as_uint(pmax), false, false); pmax = fmaxf(__uint_as_float(rr[0]), __uint_as_float(rr[1])); }
    constexpr float C2 = 1.4426950408889634f * SCALE;
    if (__builtin_expect(__all((pmax - m_reg) * SCALE <= THR), 1)) { mn = m_reg; alpha = 1.f; }
    else { mn = fmaxf(m_reg, pmax); alpha = __builtin_amdgcn_exp2f((m_reg - mn) * C2); m_reg = mn; }
    const float mnL = -mn * C2;
#pragma unroll
    for (int r = 0; r < 16; ++r) p0[r] = fmaf(p0[r], C2, mnL);
#pragma unroll
    for (int r = 0; r < 16; ++r) p1[r] = fmaf(p1[r], C2, mnL);
#pragma unroll
    for (int r = 0; r < 16; ++r) p0[r] = __builtin_amdgcn_exp2f(p0[r]);
}
__device__ __forceinline__ void finishSM(f32x16& p0, f32x16& p1, float alpha, float& l_reg, bf16x8& pa0, bf16x8& pa1, bf16x8& pa2, bf16x8& pa3) {
#pragma unroll
    for (int r = 0; r < 16; ++r) p1[r] = __builtin_amdgcn_exp2f(p1[r]);
    float ps = 0;
#pragma unroll
    for (int r = 0; r < 16; ++r) ps += p0[r];
#pragma unroll
    for (int r = 0; r < 16; ++r) ps += p1[r];
    { auto rr = __builtin_amdgcn_permlane32_swap(__float_as_uint(ps), __float_as_uint(ps), false, false); ps = __uint_as_float(rr[0]) + __uint_as_float(rr[1]); }
    l_reg = l_reg * alpha + ps;
#define PK4(P, B_, OUT) do { unsigned a0 = cvtpk(P[B_+0], P[B_+1]), a1 = cvtpk(P[B_+2], P[B_+3]); unsigned b0 = cvtpk(P[B_+4], P[B_+5]), b1 = cvtpk(P[B_+6], P[B_+7]); \
        auto r0 = __builtin_amdgcn_permlane32_swap(a0, b0, false, false); auto r1 = __builtin_amdgcn_permlane32_swap(a1, b1, false, false); \
        v4u w = {r0[0], r1[0], r0[1], r1[1]}; OUT = *reinterpret_cast<bf16x8*>(&w); } while (0)
    PK4(p0, 0, pa0); PK4(p0, 8, pa1); PK4(p1, 0, pa2); PK4(p1, 8, pa3);
#undef PK4
}
template <int KB>
__device__ __forceinline__ void qkt(f32x16& p0, f32x16& p1, const char* K_lds, int r32, int hi, const bf16x8* qr) {
    p0 = f32x16{}; p1 = f32x16{};
    const char* kb[4];
#pragma unroll
    for (int dd = 0; dd < 4; ++dd) kb[dd] = K_lds + KB * SHM_K + koff(r32, 2 * dd + hi);
    bf16x8 kf[2][2];
#define KLD(d) do { const char* a_ = kb[(d) & 3] + ((d) >> 2) * 8192; kf[(d) & 1][0] = *reinterpret_cast<const bf16x8*>(a_); kf[(d) & 1][1] = *reinterpret_cast<const bf16x8*>(a_ + 32 * 128); } while (0)
    KLD(0);
#pragma unroll
    for (int d0 = 0; d0 < 12; ++d0) { if (d0 + 1 < 12) KLD(d0 + 1);
        p0 = __builtin_amdgcn_mfma_f32_32x32x16_bf16(kf[d0 & 1][0], qr[d0], p0, 0, 0, 0);
        p1 = __builtin_amdgcn_mfma_f32_32x32x16_bf16(kf[d0 & 1][1], qr[d0], p1, 0, 0, 0); }
#undef KLD
    __builtin_amdgcn_sched_group_barrier(0x100, 2, 0);
#pragma unroll
    for (int d0 = 0; d0 < 11; ++d0) { __builtin_amdgcn_sched_group_barrier(0x100, 2, 0); __builtin_amdgcn_sched_group_barrier(0x8, 2, 0); }
    __builtin_amdgcn_sched_group_barrier(0x8, 2, 0);
}
template <int VB>
__device__ __forceinline__ void pv_tile(f32x16* o, int vb0, bf16x8 pa0, bf16x8 pa1, bf16x8 pa2, bf16x8 pa3) {
    s16x4 lo[2][4], hv[2][4];
#define TRRD(dst, off) asm volatile("ds_read_b64_tr_b16 %0, %1 offset:%2" : "=&v"(dst) : "v"(vb0), "i"(off) : "memory")
#define VLD(d) do { TRRD(lo[(d) & 1][0], VB * SHM_V + v_rd_off((d), 0, 0)); TRRD(hv[(d) & 1][0], VB * SHM_V + v_rd_off((d), 0, 1)); TRRD(lo[(d) & 1][1], VB * SHM_V + v_rd_off((d), 1, 0)); TRRD(hv[(d) & 1][1], VB * SHM_V + v_rd_off((d), 1, 1)); \
        TRRD(lo[(d) & 1][2], VB * SHM_V + v_rd_off((d), 2, 0)); TRRD(hv[(d) & 1][2], VB * SHM_V + v_rd_off((d), 2, 1)); TRRD(lo[(d) & 1][3], VB * SHM_V + v_rd_off((d), 3, 0)); TRRD(hv[(d) & 1][3], VB * SHM_V + v_rd_off((d), 3, 1)); } while (0)
#define VF(d, k) (bf16x8){lo[(d) & 1][k][0], lo[(d) & 1][k][1], lo[(d) & 1][k][2], lo[(d) & 1][k][3], hv[(d) & 1][k][0], hv[(d) & 1][k][1], hv[(d) & 1][k][2], hv[(d) & 1][k][3]}
#define PVM(d) do { o[d] = __builtin_amdgcn_mfma_f32_32x32x16_bf16(pa0, VF(d, 0), o[d], 0, 0, 0); o[d] = __builtin_amdgcn_mfma_f32_32x32x16_bf16(pa1, VF(d, 1), o[d], 0, 0, 0); \
        o[d] = __builtin_amdgcn_mfma_f32_32x32x16_bf16(pa2, VF(d, 2), o[d], 0, 0, 0); o[d] = __builtin_amdgcn_mfma_f32_32x32x16_bf16(pa3, VF(d, 3), o[d], 0, 0, 0); } while (0)
    asm volatile("s_waitcnt lgkmcnt(0)" ::: "memory");
    VLD(0); VLD(1); asm volatile("s_waitcnt lgkmcnt(8)" ::: "memory"); SBAR(); PVM(0); SBAR();
    VLD(2); asm volatile("s_waitcnt lgkmcnt(8)" ::: "memory"); SBAR(); PVM(1); SBAR();
    VLD(3); asm volatile("s_waitcnt lgkmcnt(8)" ::: "memory"); SBAR(); PVM(2); SBAR();
    asm volatile("s_waitcnt lgkmcnt(0)" ::: "memory"); SBAR(); PVM(3);
#undef PVM
#undef VF
#undef VLD
#undef TRRD
}
template <bool DOPV>
__device__ __forceinline__ void pv_sm(f32x16* o, int vb0, bf16x8 pa0, bf16x8 pa1, bf16x8 pa2, bf16x8 pa3, f32x16& p0, f32x16& p1, bf16x8& pn0, bf16x8& pn1, bf16x8& pn2, bf16x8& pn3,
                                      float& m_reg, float& l_reg, float& al_out) {
    s16x4 lo[2][4], hv[2][4];
#define TRRD(dst, off) asm volatile("ds_read_b64_tr_b16 %0, %1 offset:%2" : "=&v"(dst) : "v"(vb0), "i"(off) : "memory")
#define VLD(d) do { if (DOPV) { TRRD(lo[(d) & 1][0], v_rd_off((d), 0, 0)); TRRD(hv[(d) & 1][0], v_rd_off((d), 0, 1)); TRRD(lo[(d) & 1][1], v_rd_off((d), 1, 0)); TRRD(hv[(d) & 1][1], v_rd_off((d), 1, 1)); \
        TRRD(lo[(d) & 1][2], v_rd_off((d), 2, 0)); TRRD(hv[(d) & 1][2], v_rd_off((d), 2, 1)); TRRD(lo[(d) & 1][3], v_rd_off((d), 3, 0)); TRRD(hv[(d) & 1][3], v_rd_off((d), 3, 1)); } } while (0)
#define VF(d, k) (bf16x8){lo[(d) & 1][k][0], lo[(d) & 1][k][1], lo[(d) & 1][k][2], lo[(d) & 1][k][3], hv[(d) & 1][k][0], hv[(d) & 1][k][1], hv[(d) & 1][k][2], hv[(d) & 1][k][3]}
#define MM(d, k, PA) do { if (DOPV) o[d] = __builtin_amdgcn_mfma_f32_32x32x16_bf16(PA, VF(d, k), o[d], 0, 0, 0); SBAR(); } while (0)
#define LW(N) do { if (DOPV) asm volatile("s_waitcnt lgkmcnt(" #N ")" ::: "memory"); SBAR(); } while (0)
#define MX3(a, b, c) __builtin_fmaxf(__builtin_fmaxf((a), (b)), (c))
    constexpr float C2 = 1.4426950408889634f * SCALE;
    float mx, mn, mnL, al;
    LW(0); VLD(0); VLD(1); LW(8);
    MM(0, 0, pa0); mx = MX3(p0[0], p0[1], p0[2]); mx = MX3(mx, p0[3], p0[4]); mx = MX3(mx, p0[5], p0[6]); mx = MX3(mx, p0[7], p0[8]); SBAR();
    MM(0, 1, pa1); mx = MX3(mx, p0[9], p0[10]); mx = MX3(mx, p0[11], p0[12]); mx = MX3(mx, p0[13], p0[14]); mx = MX3(mx, p0[15], p1[0]); SBAR();
    MM(0, 2, pa2); mx = MX3(mx, p1[1], p1[2]); mx = MX3(mx, p1[3], p1[4]); mx = MX3(mx, p1[5], p1[6]); mx = MX3(mx, p1[7], p1[8]); SBAR();
    MM(0, 3, pa3); mx = MX3(mx, p1[9], p1[10]); mx = MX3(mx, p1[11], p1[12]); mx = MX3(mx, p1[13], p1[14]); mx = __builtin_fmaxf(mx, p1[15]); SBAR();
    VLD(2); LW(8);
    MM(1, 0, pa0); { auto rr = __builtin_amdgcn_permlane32_swap(__float_as_uint(mx), __float_as_uint(mx), false, false); mx = __builtin_fmaxf(__uint_as_float(rr[0]), __uint_as_float(rr[1])); }
        { const bool keep = __all((mx - m_reg) * SCALE <= THR); mn = keep ? m_reg : __builtin_fmaxf(m_reg, mx); al = __builtin_amdgcn_exp2f((m_reg - mn) * C2); m_reg = mn; mnL = -mn * C2; } SBAR();
#define FM4(P, B) do { P[B] = fmaf(P[B], C2, mnL); P[B + 1] = fmaf(P[B + 1], C2, mnL); P[B + 2] = fmaf(P[B + 2], C2, mnL); P[B + 3] = fmaf(P[B + 3], C2, mnL); } while (0)
#define EX2(P, B) do { P[B] = __builtin_amdgcn_exp2f(P[B]); P[B + 1] = __builtin_amdgcn_exp2f(P[B + 1]); } while (0)
    MM(1, 1, pa1); FM4(p0, 0); FM4(p0, 4); SBAR();
    MM(1, 2, pa2); FM4(p0, 8); FM4(p0, 12); SBAR();
    MM(1, 3, pa3); FM4(p1, 0); FM4(p1, 4); SBAR();
    VLD(3); LW(8);
    MM(2, 0, pa0); FM4(p1, 8); FM4(p1, 12); SBAR();
    MM(2, 1, pa1); EX2(p0, 0); EX2(p0, 2); SBAR();
    MM(2, 2, pa2); EX2(p0, 4); EX2(p0, 6); SBAR();
    MM(2, 3, pa3); EX2(p0, 8); EX2(p0, 10); SBAR();
    LW(0);
    MM(3, 0, pa0); EX2(p0, 12); EX2(p0, 14); SBAR();
    MM(3, 1, pa1); EX2(p1, 0); EX2(p1, 2); SBAR();
    MM(3, 2, pa2); EX2(p1, 4); EX2(p1, 6); SBAR();
    MM(3, 3, pa3); EX2(p1, 8); EX2(p1, 10); SBAR();
    EX2(p1, 12); EX2(p1, 14);
    float ps = 0;
#pragma unroll
    for (int r = 0; r < 16; ++r) ps += p0[r];
#pragma unroll
    for (int r = 0; r < 16; ++r) ps += p1[r];
    { auto rr = __builtin_amdgcn_permlane32_swap(__float_as_uint(ps), __float_as_uint(ps), false, false); ps = __uint_as_float(rr[0]) + __uint_as_float(rr[1]); }
    l_reg = l_reg * al + ps; al_out = al;
#define PK4(P, B_, OUT) do { unsigned a0 = cvtpk(P[B_+0], P[B_+1]), a1 = cvtpk(P[B_+2], P[B_+3]); unsigned b0 = cvtpk(P[B_+4], P[B_+5]), b1 = cvtpk(P[B_+6], P[B_+7]); \
        auto r0 = __builtin_amdgcn_permlane32_swap(a0, b0, false, false); auto r1 = __builtin_amdgcn_permlane32_swap(a1, b1, false, false); \
        v4u w = {r0[0], r1[0], r0[1], r1[1]}; OUT = *reinterpret_cast<bf16x8*>(&w); } while (0)
    PK4(p0, 0, pn0); PK4(p0, 8, pn1); PK4(p1, 0, pn2); PK4(p1, 8, pn3);
#undef PK4
#undef EX2
#undef FM4
#undef MX3
#undef LW
#undef MM
#undef VF
#undef VLD
#undef TRRD
}
__device__ __forceinline__ int kperm(int l) { return ((l & 7) << 1) | ((l >> 3) & 1) | (l & 48); }
__device__ __forceinline__ int kpiece(int tid) { return (tid >> 6) * 64 + kperm(tid & 63); }
__device__ __forceinline__ int vpiece(int tid, int i) { const int l = tid & 63, w = tid >> 6; return (4 * (w & 3) + (l & 3)) * 64 + (l >> 2) + 16 * ((w >> 2) + 2 * i); }
struct BlockRef { const bf16_t* Q; const bf16_t* K; const bf16_t* V; bf16_t* O; int P0; };
#define VMW() asm volatile("s_waitcnt vmcnt(0)" ::: "memory")
__device__ __forceinline__ void dma16(const void* gsrc, char* ldst) { __builtin_amdgcn_global_load_lds((const unsigned*)gsrc, (__attribute__((address_space(3))) unsigned*)(uintptr_t)ldst, 16, 0, 0); }
#define WAITBAR(N) asm volatile("s_waitcnt vmcnt(" #N ") lgkmcnt(0)\n\ts_barrier" ::: "memory")
template <int ABL>
__device__ __forceinline__ void attn_block(const BlockRef& cur, char* lds) {
    int tid_ = threadIdx.x; asm volatile("" : "+v"(tid_));
    const int tid = tid_, wid = __builtin_amdgcn_readfirstlane(tid >> 6), lane = tid & 63, r32 = lane & 31, hi = lane >> 5;
    const int NT = (cur.P0 + QB - 1) / KVBLK + 1;
    const int qlo = cur.P0 + wid * QBLK;
    char* V_lds = lds; char* K_lds = lds + 3 * SHM_V;
    float* ws = (float*)(lds + 3 * SHM_V + 3 * SHM_K) + wid * 64; float* li_l = ws, * al_l = ws + 32;
    float m_reg = -1e30f, l_reg = 0; f32x16 o[4] = {};
    const int krow = 8 * wid + (lane >> 3), ksx = (lane & 7) ^ ((krow >> 1) & 7), ksrc = (ksx * 64 + krow) * 8;
    int vsrc[2];
#pragma unroll
    for (int i = 0; i < 2; ++i) { const int st = 2 * (wid + 8 * i) + (lane >> 5), kk = (st >> 2) * 8 + ((lane & 31) >> 2), c = (st & 3) * 32 + (lane & 3) * 8;
        const int k = (kk & ~0xC) | ((kk & 4) << 1) | ((kk & 8) >> 1); vsrc[i] = ((c >> 3) * 64 + k) * 8; }
    const int vbase = (int)(uintptr_t)V_lds;
    const bf16_t* Kh = cur.K; const bf16_t* Vh = cur.V;
#define DMA_K(t, slot) do { const bf16_t* kt_ = Kh + (size_t)(t) * KVBLK * DQ + ksrc; char* kd_ = K_lds + (slot) * SHM_K + wid * 1024; \
        dma16(kt_, kd_); dma16(kt_ + 4096, kd_ + 8192); dma16(kt_ + 8192, kd_ + 16384); } while (0)
#define DMA_V(t, slot) do { const bf16_t* vt_ = Vh + (size_t)(t) * KVBLK * DVV; char* vd_ = V_lds + (slot) * SHM_V + wid * 1024; dma16(vt_ + vsrc[0], vd_); dma16(vt_ + vsrc[1], vd_ + 8192); } while (0)
    bf16x8 qr[12], pa0, pa1, pa2, pa3; f32x16 p0, p1;
#pragma unroll
    for (int d0 = 0; d0 < 12; ++d0) qr[d0] = ld8(cur.Q + (size_t)wid * QBLK * DQ + (2 * d0 + hi) * 256 + r32 * 8);
    DMA_K(0, 0); DMA_K(1, 1); DMA_V(0, 0);
    WAITBAR(0);
    int s0 = 0, s1 = 1, s2 = 2;
    {
        float mn, al; DMA_K(2, s2); DMA_V(1, s1);
        SBAR(); qkt<0>(p0, p1, K_lds + s0 * SHM_K, r32, hi, qr); SBAR();
        if (KVBLK - 1 > qlo) { asm volatile("" ::: "memory"); mask_tile(p0, p1, qlo + r32 - 4 * hi); }
        partialSM(p0, p1, m_reg, mn, al); finishSM(p0, p1, al, l_reg, pa0, pa1, pa2, pa3);
        WAITBAR(5); { const int tmp = s0; s0 = s1; s1 = s2; s2 = tmp; } }
#pragma unroll 1
    for (int t = 1; t < NT; ++t) {
        float al;
        if (t + 2 < NT) DMA_K(t + 2, s2);
        if (t + 1 < NT) DMA_V(t + 1, s1);
        SBAR(); qkt<0>(p0, p1, K_lds + s0 * SHM_K, r32, hi, qr); SBAR();
        { const int kb_ = t * KVBLK; if (kb_ + KVBLK - 1 > qlo) { asm volatile("" ::: "memory"); mask_tile(p0, p1, qlo + r32 - 4 * hi - kb_); } }
        { int ll = tid; asm volatile("" : "+v"(ll)); const int vb0 = vbase + v_rd_base(ll & 63) + s2 * SHM_V; bf16x8 pn0, pn1, pn2, pn3;
          pv_sm<true>(o, vb0, pa0, pa1, pa2, pa3, p0, p1, pn0, pn1, pn2, pn3, m_reg, l_reg, al);
          pa0 = pn0; pa1 = pn1; pa2 = pn2; pa3 = pn3; }
        if (__any(al < 1.f)) { asm volatile("" ::: "memory"); if (hi == 0) al_l[r32] = al; asm volatile("s_waitcnt lgkmcnt(0)" ::: "memory");
#pragma unroll
            for (int d_ = 0; d_ < 4; ++d_)
#pragma unroll
                for (int r = 0; r < 16; ++r) o[d_][r] *= al_l[crow(r, hi)]; }
        if (t + 2 < NT) WAITBAR(5); else WAITBAR(0);
        { const int tmp = s0; s0 = s1; s1 = s2; s2 = tmp; }
    }
#undef DMA_K
#undef DMA_V
    { int ll = tid; asm volatile("" : "+v"(ll)); pv_tile<0>(o, vbase + v_rd_base(ll & 63) + s2 * SHM_V, pa0, pa1, pa2, pa3); }
    if (hi == 0) li_l[r32] = l_reg; asm volatile("s_waitcnt lgkmcnt(0)" ::: "memory");
    float rli[16];
#pragma unroll
    for (int r = 0; r < 16; ++r) rli[r] = __builtin_amdgcn_rcpf(li_l[crow(r, hi)]);
    bf16_t* Ow = cur.O + (size_t)(wid * QBLK) * OPITCH;
#pragma unroll
    for (int r = 0; r < 16; ++r) { const int orow = crow(r, hi);
#pragma unroll
        for (int d0 = 0; d0 < 4; ++d0) { const float v = o[d0][r] * rli[r]; const float vn = __shfl_xor(v, 1);
            if ((r32 & 1) == 0) *(unsigned*)(Ow + (size_t)orow * OPITCH + d0 * 32 + r32) = cvtpk(v, vn); } }
    WAITBAR(0);
}
#undef WAITBAR
#undef VMW
#undef SBAR
__device__ __forceinline__ BlockRef make_ref(int L, int pass, const bf16_t* Q, const bf16_t* K, const bf16_t* V, bf16_t* O) {
    const int bh = L >> 4, x = L & 15, qb = pass ? 31 - x : x, b = bh >> 2, h = bh & 3;
    BlockRef r; r.Q = Q + ((size_t)bh * 8192 + (size_t)qb * QB) * DQ; r.K = K + (size_t)bh * 8192 * DQ; r.V = V + (size_t)bh * 8192 * DVV;
    r.O = O + ((size_t)b * 8192 + (size_t)qb * QB) * OPITCH + h * DVV; r.P0 = qb * QB; return r;
}
template <int ABL>
__device__ __forceinline__ void attn_phase(char* lds, const bf16_t* Q, const bf16_t* K, const bf16_t* V, bf16_t* O, int G, int bid) {
    for (int L = bid; L < 256; L += G)
#pragma unroll 1
        for (int pass = 0; pass < 2; ++pass) { const BlockRef cur = make_ref(L, pass, Q, K, V, O); attn_block<ABL>(cur, lds); }
}
}
namespace prj {
__device__ __forceinline__ int crow(int r, int hi) { return (r & 3) + 8 * (r >> 2) + 4 * hi; }
__device__ __forceinline__ float swap_add(float v) { auto rr = __builtin_amdgcn_permlane32_swap(__float_as_uint(v), __float_as_uint(v), false, false); return __uint_as_float(rr[0]) + __uint_as_float(rr[1]); }
__device__ __forceinline__ float sumsq8(bf16x8 v) { float s = 0.f;
#pragma unroll
    for (int j = 0; j < 8; ++j) { const float f = bf2f((bf16_t)v[j]); s += f * f; } return s; }
__device__ __forceinline__ bf16x8 ldg8(const bf16_t* p) { return *reinterpret_cast<const bf16x8*>(p); }
__device__ __forceinline__ const bf16_t* projt(const unsigned char* ws, int t, int col) { return (const bf16_t*)(ws + WSX_B) + ((size_t)((t >> 5) * 192 + (col >> 3)) * 32 + (t & 31)) * 8 + (col & 7); }
__device__ __forceinline__ v2u pack4(float a, float b, float c, float d) { return (v2u){cvtpk(a, b), cvtpk(c, d)}; }

__device__ __forceinline__ void stage_weights(const unsigned char* src, LAS unsigned char* wl, int nkb, int wave, int lane) {
    __syncthreads();
    for (int i = wave; i < nkb; i += NWAVES) __builtin_amdgcn_global_load_lds((const unsigned*)(src + (size_t)i * 1024 + lane * 16), (LAS unsigned*)(wl + i * 1024), 16, 0, 0);
    asm volatile("s_waitcnt vmcnt(0)" ::: "memory");
    __syncthreads();
}
__device__ __forceinline__ void stage_weights2(const unsigned char* src0, const unsigned char* src1, LAS unsigned char* wl, int wave, int lane) {
    __syncthreads();
    for (int i = wave; i < 32; i += NWAVES) { __builtin_amdgcn_global_load_lds((const unsigned*)(src0 + (size_t)i * 1024 + lane * 16), (LAS unsigned*)(wl + i * 1024), 16, 0, 0);
                                              __builtin_amdgcn_global_load_lds((const unsigned*)(src1 + (size_t)i * 1024 + lane * 16), (LAS unsigned*)(wl + (32 + i) * 1024), 16, 0, 0); }
    asm volatile("s_waitcnt vmcnt(0)" ::: "memory");
    __syncthreads();
}
__device__ __forceinline__ void unit_q(const Inputs& I, unsigned char* ws, LAS unsigned char* wl, int wave, int grp, int lane) {
    const int r32 = lane & 31, hi = lane >> 5, t = grp * 32 + r32, b = t >> 13, s = t & 8191;
    const bf16_t* pr = projt(ws, t, C_QLAT + 8 * hi);
    float ssq = 0.f; bf16x8 bq[16];
#pragma unroll
    for (int ks = 0; ks < 16; ++ks) { bq[ks] = ldg8(pr + 512 * ks); ssq += sumsq8(bq[ks]); }
    const float msq = swap_add(ssq) * (1.f / 256.f) + EPS;
    const LAS bf16x8* WQF = (const LAS bf16x8*)wl + lane;
    const float* cs = (const float*)(ws + WSX_CS) + (size_t)t * 64;
#pragma unroll 1
    for (int h = 0; h < 4; ++h) {
        stage_weights(ws + WSX_WQF + (size_t)h * 96 * 1024, wl, 96, wave, lane);
        f32x16 acc[6];
#pragma unroll
        for (int nb = 0; nb < 6; ++nb) acc[nb] = f32x16{};
#pragma unroll
        for (int k0 = 0; k0 < 16; k0 += 2) { bf16x8 wf[12];
#pragma unroll
            for (int i = 0; i < 2; ++i)
#pragma unroll
                for (int nb = 0; nb < 6; ++nb) wf[i * 6 + nb] = WQF[(nb * 16 + k0 + i) * 64];
#pragma unroll
            for (int i = 0; i < 2; ++i)
#pragma unroll
                for (int nb = 0; nb < 6; ++nb) acc[nb] = __builtin_amdgcn_mfma_f32_32x32x16_bf16(wf[i * 6 + nb], bq[k0 + i], acc[nb], 0, 0, 0);
            asm volatile("" ::: "memory"); }
        float ss = 0.f;
#pragma unroll
        for (int nb = 0; nb < 6; ++nb)
#pragma unroll
            for (int r = 0; r < 16; ++r) ss += acc[nb][r] * acc[nb][r];
        const float rs = rsqrtf(swap_add(ss) * (1.f / 192.f) + EPS * msq);
        bf16_t* qp = (bf16_t*)(ws + WSX_Q) + ((size_t)((b * 4 + h) * 256 + (s >> 5)) * 24) * 256 + r32 * 8 + 4 * hi;
#pragma unroll
        for (int nb = 0; nb < 4; ++nb)
#pragma unroll
            for (int q = 0; q < 4; ++q) { const int n = 32 * nb + 8 * q + 4 * hi; const f32x4 g = *(const f32x4*)(I.q_norm + n);
                *(v2u*)(qp + (4 * nb + q) * 256) = pack4(acc[nb][4 * q] * rs * g[0], acc[nb][4 * q + 1] * rs * g[1], acc[nb][4 * q + 2] * rs * g[2], acc[nb][4 * q + 3] * rs * g[3]); asm volatile("" ::: "memory"); }
#pragma unroll
        for (int q = 0; q < 4; ++q) { const int j = 8 * q + 4 * hi; const f32x4 g1 = *(const f32x4*)(I.q_norm + 128 + j), g2 = *(const f32x4*)(I.q_norm + 160 + j);
            const f32x4 c = *(const f32x4*)(cs + j), sn = *(const f32x4*)(cs + 32 + j);
            float o1[4], o2[4];
#pragma unroll
            for (int i = 0; i < 4; ++i) { const float x1 = acc[4][4 * q + i] * rs * g1[i], x2 = acc[5][4 * q + i] * rs * g2[i]; o1[i] = x1 * c[i] - x2 * sn[i]; o2[i] = x2 * c[i] + x1 * sn[i]; }
            *(v2u*)(qp + (16 + q) * 256) = pack4(o1[0], o1[1], o1[2], o1[3]); *(v2u*)(qp + (20 + q) * 256) = pack4(o2[0], o2[1], o2[2], o2[3]); }
    }
}
__device__ __forceinline__ void unit_kv(const Inputs& I, unsigned char* ws, LAS unsigned char* wl, int wave, int grp, int lane) {
    const int r32 = lane & 31, hi = lane >> 5, t = grp * 32 + r32, b = t >> 13, s = t & 8191;
    bf16x8 bk[8]; float ssq = 0.f;
#pragma unroll
    for (int ks = 0; ks < 8; ++ks) { bk[ks] = ldg8(projt(ws, t, C_KVLAT + 8 * hi) + 512 * ks); ssq += sumsq8(bk[ks]); }
    const float rstd = rsqrtf(swap_add(ssq) * (1.f / 128.f) + EPS);
    float kr1[16], kr2[16]; float ssr = 0.f;
#pragma unroll
    for (int q = 0; q < 4; ++q) { const int j = 8 * q + 4 * hi; const v2u a = *(const v2u*)projt(ws, t, C_KROPE + j), c = *(const v2u*)projt(ws, t, C_KROPE + 32 + j);
        kr1[4 * q] = __uint_as_float(a.x << 16); kr1[4 * q + 1] = __uint_as_float(a.x & 0xffff0000u); kr1[4 * q + 2] = __uint_as_float(a.y << 16); kr1[4 * q + 3] = __uint_as_float(a.y & 0xffff0000u);
        kr2[4 * q] = __uint_as_float(c.x << 16); kr2[4 * q + 1] = __uint_as_float(c.x & 0xffff0000u); kr2[4 * q + 2] = __uint_as_float(c.y << 16); kr2[4 * q + 3] = __uint_as_float(c.y & 0xffff0000u); }
#pragma unroll
    for (int r = 0; r < 16; ++r) ssr += kr1[r] * kr1[r] + kr2[r] * kr2[r];
    const LAS bf16x8* WKVF = (const LAS bf16x8*)wl + lane;
    const float* cs = (const float*)(ws + WSX_CS) + (size_t)t * 64;
#pragma unroll 1
    for (int h = 0; h < 4; ++h) {
        stage_weights(ws + WSX_WKVF + (size_t)h * 64 * 1024, wl, 64, wave, lane);
        bf16_t* kp = (bf16_t*)(ws + WSX_K) + ((size_t)((b * 4 + h) * 128 + (s >> 6)) * 24) * 512 + (s & 63) * 8 + 4 * hi;
        bf16_t* vp = (bf16_t*)(ws + WSX_V) + ((size_t)((b * 4 + h) * 128 + (s >> 6)) * 16) * 512 + (s & 63) * 8 + 4 * hi;
        f32x16 acc[4];
#pragma unroll
        for (int nb = 0; nb < 4; nb += 2) { acc[nb] = f32x16{}; acc[nb + 1] = f32x16{}; bf16x8 wf[16];
#pragma unroll
            for (int i = 0; i < 16; ++i) wf[i] = WKVF[(nb * 8 + i) * 64];
#pragma unroll
            for (int i = 0; i < 8; ++i) acc[nb] = __builtin_amdgcn_mfma_f32_32x32x16_bf16(wf[i], bk[i], acc[nb], 0, 0, 0);
#pragma unroll
            for (int i = 0; i < 8; ++i) acc[nb + 1] = __builtin_amdgcn_mfma_f32_32x32x16_bf16(wf[8 + i], bk[i], acc[nb + 1], 0, 0, 0);
            }
        float ss = 0.f;
#pragma unroll
        for (int nb = 0; nb < 4; ++nb)
#pragma unroll
            for (int r = 0; r < 16; ++r) ss += acc[nb][r] * acc[nb][r];
        const float rs = rsqrtf(swap_add(ss * rstd * rstd + ssr) * (1.f / 192.f) + EPS), rk = rs * rstd;
#pragma unroll
        for (int nb = 0; nb < 4; ++nb)
#pragma unroll
            for (int q = 0; q < 4; ++q) { const int n = 32 * nb + 8 * q + 4 * hi; const f32x4 g = *(const f32x4*)(I.k_norm + n);
                *(v2u*)(kp + (4 * nb + q) * 512) = pack4(acc[nb][4 * q] * rk * g[0], acc[nb][4 * q + 1] * rk * g[1], acc[nb][4 * q + 2] * rk * g[2], acc[nb][4 * q + 3] * rk * g[3]); }
#pragma unroll
        for (int q = 0; q < 4; ++q) { const int j = 8 * q + 4 * hi; const f32x4 g1 = *(const f32x4*)(I.k_norm + 128 + j), g2 = *(const f32x4*)(I.k_norm + 160 + j);
            const f32x4 c = *(const f32x4*)(cs + j), sn = *(const f32x4*)(cs + 32 + j);
            float o1[4], o2[4];
#pragma unroll
            for (int i = 0; i < 4; ++i) { const float x1 = kr1[4 * q + i] * rs * g1[i], x2 = kr2[4 * q + i] * rs * g2[i]; o1[i] = x1 * c[i] - x2 * sn[i]; o2[i] = x2 * c[i] + x1 * sn[i]; }
            *(v2u*)(kp + (16 + q) * 512) = pack4(o1[0], o1[1], o1[2], o1[3]); *(v2u*)(kp + (20 + q) * 512) = pack4(o2[0], o2[1], o2[2], o2[3]); }
        asm volatile("" ::: "memory");
#pragma unroll
        for (int nb = 0; nb < 4; nb += 2) { acc[nb] = f32x16{}; acc[nb + 1] = f32x16{}; bf16x8 wf[16];
#pragma unroll
            for (int i = 0; i < 16; ++i) wf[i] = WKVF[((4 + nb) * 8 + i) * 64];
#pragma unroll
            for (int i = 0; i < 8; ++i) acc[nb] = __builtin_amdgcn_mfma_f32_32x32x16_bf16(wf[i], bk[i], acc[nb], 0, 0, 0);
#pragma unroll
            for (int i = 0; i < 8; ++i) acc[nb + 1] = __builtin_amdgcn_mfma_f32_32x32x16_bf16(wf[8 + i], bk[i], acc[nb + 1], 0, 0, 0);
            }
#pragma unroll
        for (int nb = 0; nb < 4; ++nb)
#pragma unroll
            for (int q = 0; q < 4; ++q) { const int n = 32 * nb + 8 * q + 4 * hi;
                *(v2u*)(vp + (4 * nb + q) * 512) = pack4(acc[nb][4 * q] * rstd, acc[nb][4 * q + 1] * rstd, acc[nb][4 * q + 2] * rstd, acc[nb][4 * q + 3] * rstd); }
        asm volatile("" ::: "memory");
    }
}
#define LRU_SCAN_STEP(CTRL) asm volatile("s_nop 1\n\t" \
    "v_fmac_f32_dpp %0, %0, %16 " CTRL "\n\tv_fmac_f32_dpp %1, %1, %17 " CTRL "\n\tv_fmac_f32_dpp %2, %2, %18 " CTRL "\n\tv_fmac_f32_dpp %3, %3, %19 " CTRL "\n\t" \
    "v_fmac_f32_dpp %4, %4, %20 " CTRL "\n\tv_fmac_f32_dpp %5, %5, %21 " CTRL "\n\tv_fmac_f32_dpp %6, %6, %22 " CTRL "\n\tv_fmac_f32_dpp %7, %7, %23 " CTRL "\n\t" \
    "v_fmac_f32_dpp %8, %8, %24 " CTRL "\n\tv_fmac_f32_dpp %9, %9, %25 " CTRL "\n\tv_fmac_f32_dpp %10, %10, %26 " CTRL "\n\tv_fmac_f32_dpp %11, %11, %27 " CTRL "\n\t" \
    "v_fmac_f32_dpp %12, %12, %28 " CTRL "\n\tv_fmac_f32_dpp %13, %13, %29 " CTRL "\n\tv_fmac_f32_dpp %14, %14, %30 " CTRL "\n\tv_fmac_f32_dpp %15, %15, %31 " CTRL "\n\t" \
    "v_mul_f32_dpp %16, %16, %16 " CTRL "\n\tv_mul_f32_dpp %17, %17, %17 " CTRL "\n\tv_mul_f32_dpp %18, %18, %18 " CTRL "\n\tv_mul_f32_dpp %19, %19, %19 " CTRL "\n\t" \
    "v_mul_f32_dpp %20, %20, %20 " CTRL "\n\tv_mul_f32_dpp %21, %21, %21 " CTRL "\n\tv_mul_f32_dpp %22, %22, %22 " CTRL "\n\tv_mul_f32_dpp %23, %23, %23 " CTRL "\n\t" \
    "v_mul_f32_dpp %24, %24, %24 " CTRL "\n\tv_mul_f32_dpp %25, %25, %25 " CTRL "\n\tv_mul_f32_dpp %26, %26, %26 " CTRL "\n\tv_mul_f32_dpp %27, %27, %27 " CTRL "\n\t" \
    "v_mul_f32_dpp %28, %28, %28 " CTRL "\n\tv_mul_f32_dpp %29, %29, %29 " CTRL "\n\tv_mul_f32_dpp %30, %30, %30 " CTRL "\n\tv_mul_f32_dpp %31, %31, %31 " CTRL "\n\ts_nop 1" \
    : "+v"(bv[0]), "+v"(bv[1]), "+v"(bv[2]), "+v"(bv[3]), "+v"(bv[4]), "+v"(bv[5]), "+v"(bv[6]), "+v"(bv[7]), "+v"(bv[8]), "+v"(bv[9]), "+v"(bv[10]), "+v"(bv[11]), "+v"(bv[12]), "+v"(bv[13]), "+v"(bv[14]), "+v"(bv[15]), \
      "+v"(av[0]), "+v"(av[1]), "+v"(av[2]), "+v"(av[3]), "+v"(av[4]), "+v"(av[5]), "+v"(av[6]), "+v"(av[7]), "+v"(av[8]), "+v"(av[9]), "+v"(av[10]), "+v"(av[11]), "+v"(av[12]), "+v"(av[13]), "+v"(av[14]), "+v"(av[15]))
constexpr int PRJ_TAB = 96 * 1024;
__device__ __forceinline__ void lru_tables(Frame& F, const Inputs& I) {
    LAS float* tb = (LAS float*)(F.lds + PRJ_TAB);
    for (int i = ((int)threadIdx.x); i < 2048; i += 512) tb[i] = I.conv_w[i];
    { const int c = ((int)threadIdx.x); tb[2048 + c] = I.conv_b[c]; tb[2560 + c] = -1.4426950408889634f * I.lru_ba[c]; tb[3072 + c] = -1.4426950408889634f * I.lru_bx[c];
      tb[3584 + c] = -8.f * 1.4426950408889634f * ((const float*)(F.ws + WSX_SP))[c]; }
    __syncthreads();
}
__device__ __forceinline__ void unit_lru(const Inputs& I, unsigned char* ws, LAS unsigned char* wl, int wave, int grp, int hp, int lane) {
    const int r32 = lane & 31, hi = lane >> 5, t = grp * 32 + r32, s = t & 8191;
    const bool reset = I.positions[t] == 0;
    const LAS float* tbl = (const LAS float*)(wl + PRJ_TAB);
    int xt[4]; float xz[4];
#pragma unroll
    for (int j = 0; j < 4; ++j) { const bool ok = s - 3 + j >= 0; xt[j] = ok ? t - 3 + j : t; xz[j] = ok ? 1.f : 0.f; }
    bf16_t* HL = (bf16_t*)(ws + WSX_D) + (size_t)t * 512; bf16_t* PC = HL + (size_t)NTOK * 512;
    float* SUMA = (float*)(ws + WSX_SUMA) + (size_t)grp * 512; float* SUMB = (float*)(ws + WSX_SUMB) + (size_t)grp * 512;
#pragma unroll 1
    for (int h = 2 * hp; h < 2 * hp + 2; ++h) {
        stage_weights2(ws + WSX_WAF + (size_t)h * 32 * 1024, ws + WSX_WXF + (size_t)h * 32 * 1024, wl, wave, lane);
        bf16x8 xf[8];
#pragma unroll
        for (int k2 = 0; k2 < 8; k2 += 2) { v2u xx[2][2][4];
#pragma unroll
            for (int kk = 0; kk < 2; ++kk)
#pragma unroll
                for (int j4 = 0; j4 < 2; ++j4)
#pragma unroll
                    for (int j = 0; j < 4; ++j) xx[kk][j4][j] = *(const v2u*)projt(ws, xt[j], C_XLRU + 128 * h + 32 * ((k2 + kk) >> 1) + 16 * ((k2 + kk) & 1) + 8 * j4 + 4 * hi);
#pragma unroll
            for (int kk = 0; kk < 2; ++kk) { unsigned w[4];
#pragma unroll
                for (int j4 = 0; j4 < 2; ++j4) { const int C = 128 * h + 32 * ((k2 + kk) >> 1) + 16 * ((k2 + kk) & 1) + 8 * j4 + 4 * hi;
                    f32x4 v = *(const LAS f32x4*)(tbl + 2048 + C);
#pragma unroll
                    for (int j = 0; j < 4; ++j) { const v2u x = xx[kk][j4][j]; const f32x4 cw = *(const LAS f32x4*)(tbl + j * 512 + C) * xz[j];
                        v[0] += cw[0] * __uint_as_float(x.x << 16); v[1] += cw[1] * __uint_as_float(x.x & 0xffff0000u); v[2] += cw[2] * __uint_as_float(x.y << 16); v[3] += cw[3] * __uint_as_float(x.y & 0xffff0000u); }
                    w[2 * j4] = cvtpk(v[0], v[1]); w[2 * j4 + 1] = cvtpk(v[2], v[3]); }
                v4u ww = {w[0], w[1], w[2], w[3]}; xf[k2 + kk] = *reinterpret_cast<bf16x8*>(&ww); }
            asm volatile("" ::: "memory"); }
        const LAS bf16x8* WAF = (const LAS bf16x8*)wl + lane; const LAS bf16x8* WXF = (const LAS bf16x8*)(wl + 32 * 1024) + lane;
#pragma unroll
        for (int nb = 0; nb < 4; ++nb) {
            f32x16 aa = f32x16{}, bb = f32x16{};
            { bf16x8 wf[16];
#pragma unroll
              for (int i = 0; i < 8; ++i) { wf[i] = WAF[(nb * 8 + i) * 64]; wf[8 + i] = WXF[(nb * 8 + i) * 64]; }
#pragma unroll
              for (int i = 0; i < 8; ++i) aa = __builtin_amdgcn_mfma_f32_32x32x16_bf16(wf[i], xf[i], aa, 0, 0, 0);
#pragma unroll
              for (int i = 0; i < 8; ++i) bb = __builtin_amdgcn_mfma_f32_32x32x16_bf16(wf[8 + i], xf[i], bb, 0, 0, 0);
              }
            float av[16], bv[16];
#pragma unroll
            for (int q = 0; q < 4; ++q) { const int C = 128 * h + 32 * nb + 8 * q + 4 * hi;
                const f32x4 ba = *(const LAS f32x4*)(tbl + 2560 + C), bx = *(const LAS f32x4*)(tbl + 3072 + C), sp = *(const LAS f32x4*)(tbl + 3584 + C);
#pragma unroll
                for (int i = 0; i < 4; ++i) { const int r = 4 * q + i;
                    const float rg = __builtin_amdgcn_rcpf(1.f + __builtin_amdgcn_exp2f(fmaf(aa[r], -1.4426950408889634f, ba[i])));
                    const float ig = __builtin_amdgcn_rcpf(1.f + __builtin_amdgcn_exp2f(fmaf(bb[r], -1.4426950408889634f, bx[i])));
                    float a = __builtin_amdgcn_exp2f(rg * sp[i]), mult = __builtin_amdgcn_sqrtf(fmaxf(fmaf(-a, a, 1.f), 0.f));
                    if (reset) { a = 0.f; mult = 1.f; }
                    const float xc = bf2f((bf16_t)xf[2 * nb + (r >> 3)][4 * ((r >> 2) & 1) + (r & 3)]);
                    av[r] = a; bv[r] = mult * ig * xc; } }
            LRU_SCAN_STEP("row_shr:1 row_mask:0xf bank_mask:0xf"); LRU_SCAN_STEP("row_shr:2 row_mask:0xf bank_mask:0xf"); LRU_SCAN_STEP("row_shr:4 row_mask:0xf bank_mask:0xf");
            LRU_SCAN_STEP("row_shr:8 row_mask:0xf bank_mask:0xf"); LRU_SCAN_STEP("row_bcast:15 row_mask:0xa bank_mask:0xf");
#pragma unroll
            for (int q = 0; q < 4; ++q) { const int C = 128 * h + 32 * nb + 8 * q + 4 * hi;
                *(v2u*)(HL + C) = pack4(bv[4 * q], bv[4 * q + 1], bv[4 * q + 2], bv[4 * q + 3]);
                *(v2u*)(PC + C) = pack4(av[4 * q], av[4 * q + 1], av[4 * q + 2], av[4 * q + 3]);
                if (r32 == 31) { *(f32x4*)(SUMA + C) = (f32x4){av[4 * q], av[4 * q + 1], av[4 * q + 2], av[4 * q + 3]};
                                 *(f32x4*)(SUMB + C) = (f32x4){bv[4 * q], bv[4 * q + 1], bv[4 * q + 2], bv[4 * q + 3]}; } }
            asm volatile("" ::: "memory");
        }
    }
}
__device__ __forceinline__ void phase_proj(Frame& F, const Inputs& I, int kmask) {
    LAS unsigned char* wl = F.lds;
    lru_tables(F, I);
    const int b = F.vcu, G = F.G;
    if (kmask & 2) for (int u = b; u < 256; u += G) unit_lru(I, F.ws, wl, F.wave, (u >> 1) * 8 + F.wave, u & 1, ((int)(threadIdx.x & 63)));
    asm volatile("" ::: "memory");
    if (kmask & 1) for (int u = b; u < 128; u += G) unit_q(I, F.ws, wl, F.wave, u * 8 + F.wave, ((int)(threadIdx.x & 63)));
    asm volatile("" ::: "memory");
    if (kmask & 4) for (int u = (G == 256 ? b - 128 : b); u < 128; u += G) if (u >= 0) unit_kv(I, F.ws, wl, F.wave, u * 8 + F.wave, ((int)(threadIdx.x & 63)));
    __syncthreads();
}
__device__ __forceinline__ float gelu_t(float v) { const float u = 0.7978845608028654f * (v + 0.044715f * v * v * v); return v / (1.f + __expf(-2.f * u)); }
__device__ __forceinline__ void unpack8(v4u w, float* f) {
    f[0] = __uint_as_float(w.x << 16); f[1] = __uint_as_float(w.x & 0xffff0000u); f[2] = __uint_as_float(w.y << 16); f[3] = __uint_as_float(w.y & 0xffff0000u);
    f[4] = __uint_as_float(w.z << 16); f[5] = __uint_as_float(w.z & 0xffff0000u); f[6] = __uint_as_float(w.w << 16); f[7] = __uint_as_float(w.w & 0xffff0000u); }
__device__ __forceinline__ void phase_mix(Frame& F, const Inputs& I) {
    LAS float* carry = (LAS float*)F.lds;
    const float* SUMA = (const float*)(F.ws + WSX_SUMA); const float* SUMB = (const float*)(F.ws + WSX_SUMB);
    const bf16_t* HL = (const bf16_t*)(F.ws + WSX_D); const bf16_t* PC = HL + (size_t)NTOK * 512;
    const bf16_t* PROJ = (const bf16_t*)(F.ws + WSX_B); bf16_t* MIXED = (bf16_t*)(F.ws + WSX_E); const bf16_t* AO = (const bf16_t*)(F.ws + WSX_AO);
    const int nper = 1024 / F.G;
    const int c0 = F.vcu * nper, bfirst = (c0 >> 8) << 8;
    {
        float h = 0.f; const int c = ((int)threadIdx.x);
        int k = bfirst;
        for (; k + 16 <= c0; k += 16) { float a[16], bq[16];
#pragma unroll
            for (int i = 0; i < 16; ++i) { a[i] = SUMA[(size_t)(k + i) * 512 + c]; bq[i] = SUMB[(size_t)(k + i) * 512 + c]; }
#pragma unroll
            for (int i = 0; i < 16; ++i) h = a[i] * h + bq[i]; }
        for (; k < c0; k += 4) { float a[4], bq[4];
#pragma unroll
            for (int i = 0; i < 4; ++i) { a[i] = SUMA[(size_t)(k + i) * 512 + c]; bq[i] = SUMB[(size_t)(k + i) * 512 + c]; }
#pragma unroll
            for (int i = 0; i < 4; ++i) h = a[i] * h + bq[i]; }
        carry[c] = h; }
    __syncthreads();
    const int C = 8 * ((int)(threadIdx.x & 63));
    const f32x4 g0 = *(const f32x4*)(I.lru_out_norm + C), g1 = *(const f32x4*)(I.lru_out_norm + C + 4), q0 = *(const f32x4*)(I.attn_out_norm + C), q1 = *(const f32x4*)(I.attn_out_norm + C + 4);
    for (int k = c0; k < c0 + nper; ++k) {
        const int tb = k * 32 + F.wave * 4;
        v4u hl4[4], pc4[4], gg4[4], at4[4];
#pragma unroll
        for (int rr = 0; rr < 4; ++rr) { const size_t t = tb + rr; hl4[rr] = *(const v4u*)(HL + t * 512 + C); pc4[rr] = *(const v4u*)(PC + t * 512 + C);
            gg4[rr] = *(const v4u*)projt(F.ws, (int)t, C_GLRU + C); at4[rr] = *(const v4u*)(AO + t * 512 + C); }
        float cy[8]; *(f32x4*)cy = *(const LAS f32x4*)(carry + C); *(f32x4*)(cy + 4) = *(const LAS f32x4*)(carry + C + 4);
        float hl[8];
#pragma unroll
        for (int rr = 0; rr < 4; ++rr) { const size_t t = tb + rr;
            float a[8], p[8], g[8], v[8];
            unpack8(hl4[rr], a); unpack8(pc4[rr], p); unpack8(gg4[rr], g);
            float ss = 0.f;
#pragma unroll
            for (int j = 0; j < 8; ++j) { hl[j] = a[j] + p[j] * cy[j]; v[j] = hl[j] * gelu_t(g[j]); ss += v[j] * v[j]; }
            float rs = rsqrtf(wave_sum_f(ss) * (1.f / 512.f) + EPS);
            *(v4u*)(MIXED + t * 1024 + 512 + C) = (v4u){cvtpk(v[0] * rs * g0[0], v[1] * rs * g0[1]), cvtpk(v[2] * rs * g0[2], v[3] * rs * g0[3]), cvtpk(v[4] * rs * g1[0], v[5] * rs * g1[1]), cvtpk(v[6] * rs * g1[2], v[7] * rs * g1[3])};
            unpack8(at4[rr], a); ss = 0.f;
#pragma unroll
            for (int j = 0; j < 8; ++j) ss += a[j] * a[j];
            rs = rsqrtf(wave_sum_f(ss) * (1.f / 512.f) + EPS);
            *(v4u*)(MIXED + t * 1024 + C) = (v4u){cvtpk(a[0] * rs * q0[0], a[1] * rs * q0[1]), cvtpk(a[2] * rs * q0[2], a[3] * rs * q0[3]), cvtpk(a[4] * rs * q1[0], a[5] * rs * q1[1]), cvtpk(a[6] * rs * q1[2], a[7] * rs * q1[3])};
        }
        __syncthreads();
        if (F.wave == 7) {
#pragma unroll
            for (int j = 0; j < 8; ++j) carry[8 * ((int)(threadIdx.x & 63)) + j] = hl[j]; }
        __syncthreads();
    }
}
}
namespace moe {
constexpr size_t WSX_RSTD = WSX_ROUTE + 800 * 1024;
constexpr size_t WSX_BB = WSX_ROUTE + 960 * 1024;
constexpr size_t WSX_WRFB = 70 * MiB;
constexpr size_t WSX_RBIAS = 70 * MiB + 512 * 1024;
constexpr int TP_OFF = LDSCTL_OFF + 512;
__device__ __forceinline__ int route_expert_of_n(int n) { const int a = (n >> 4) & 1, b = (n >> 3) & 1, h = (n >> 2) & 1, c = n & 3; return 8 * (2 * a + h) + 4 * b + c; }
__device__ __forceinline__ void router_fold(Frame& F, const Inputs& I) {
    const float* mod = (const float*)(F.ws + WS_MOD);
    const int gt = blockIdx.x * 512 + ((int)threadIdx.x), NGT = F.G * 512;
    v4u* WRFB = (v4u*)(F.ws + WSX_WRFB);
    for (int g = gt; g < 4 * 2 * 64 * 64; g += NGT) {
        const int lane = g & 63, ks = (g >> 6) & 63, nb = (g >> 12) & 1, b = g >> 13, hi = lane >> 5, n = lane & 31; float v[8];
#pragma unroll
        for (int j = 0; j < 8; ++j) { const int k = 16 * ks + 8 * hi + j; const float gg = I.norm2_g[k] * (1.f + mod[b * MODW + 4096 + k]);
            const float w = nb == 0 ? I.w_re[k * 32 + route_expert_of_n(n)] : (n < 4 ? I.w_rg[k * 4 + n] : 0.f); v[j] = w * gg; }
        WRFB[g] = (v4u){pk2(v[0], v[1]), pk2(v[2], v[3]), pk2(v[4], v[5]), pk2(v[6], v[7])};
    }
    {
        const int gw = blockIdx.x * NWAVES + F.wave;
        if (gw < 4 * 64) { const int b = gw >> 6, n = gw & 63; float s = 0.f;
            if (n < 36) { const int e = n < 32 ? route_expert_of_n(n) : n - 32; const float* W = n < 32 ? I.w_re + e : I.w_rg + e; const int ld = n < 32 ? 32 : 4;
                for (int k = ((int)(threadIdx.x & 63)); k < 1024; k += 64) s += mod[b * MODW + 3072 + k] * W[k * ld];
                s = wave_sum_f(s) + (n < 32 ? I.b_re[e] : I.b_rg[e]); }
            if (((int)(threadIdx.x & 63)) == 0) ((float*)(F.ws + WSX_RBIAS))[gw] = s; } }
}
__device__ __forceinline__ float swap_other(float v) { auto rr = __builtin_amdgcn_permlane32_swap(__float_as_uint(v), __float_as_uint(v), false, false); return (threadIdx.x & 32) ? __uint_as_float(rr[0]) : __uint_as_float(rr[1]); }
__device__ __forceinline__ void phase_route(Frame& F) {
    LAS int* lcnt = (LAS int*)(F.lds);
    if (((int)threadIdx.x) < 32) lcnt[((int)threadIdx.x)] = 0;
    __syncthreads();
    const bf16_t* x1 = (const bf16_t*)(F.ws + WSX_X1);
    int2* rexp = (int2*)(F.ws + WSX_ROUTE); float2* rw = (float2*)(F.ws + WSX_ROUTE + 256 * 1024); int2* rpos = (int2*)(F.ws + WSX_ROUTE + 512 * 1024);
    float* RSTD = (float*)(F.ws + WSX_RSTD);
    const int lane = ((int)(threadIdx.x & 63)), r32 = lane & 31, hi = lane >> 5;
    for (int grp = F.wave * F.G + blockIdx.x; grp < 1024; grp += F.G * NWAVES) {
        const int t = grp * 32 + r32, b = t >> 13;
        const bf16_t* xr = x1 + (size_t)t * DM + 8 * hi;
        const bf16x8* WF = (const bf16x8*)(F.ws + WSX_WRFB) + (size_t)b * 2 * 64 * 64 + lane;
        f32x16 a0 = f32x16{}, a1 = f32x16{}; float ss = 0.f;
#pragma unroll 8
        for (int ks = 0; ks < 64; ++ks) { const bf16x8 xb = *(const bf16x8*)(xr + 16 * ks);
#pragma unroll
            for (int j = 0; j < 8; ++j) { const float f = bf2f((bf16_t)xb[j]); ss += f * f; }
            a0 = __builtin_amdgcn_mfma_f32_32x32x16_bf16(WF[ks * 64], xb, a0, 0, 0, 0);
            a1 = __builtin_amdgcn_mfma_f32_32x32x16_bf16(WF[(64 + ks) * 64], xb, a1, 0, 0, 0); }
        { auto rr = __builtin_amdgcn_permlane32_swap(__float_as_uint(ss), __float_as_uint(ss), false, false); ss = __uint_as_float(rr[0]) + __uint_as_float(rr[1]); }
        const float rstd = rsqrtf(ss * (1.f / DM) + EPS);
        const float* rb = (const float*)(F.ws + WSX_RBIAS) + b * 64;
        float gl0 = a1[0] * rstd + rb[32], gl1 = a1[1] * rstd + rb[33], gl2 = a1[2] * rstd + rb[34], gl3 = a1[3] * rstd + rb[35];
        int gi = 0; float gm = gl0; if (gl1 > gm) { gm = gl1; gi = 1; } if (gl2 > gm) { gm = gl2; gi = 2; } if (gl3 > gm) { gm = gl3; gi = 3; }
        float gp = 1.f / (__expf(gl0 - gm) + __expf(gl1 - gm) + __expf(gl2 - gm) + __expf(gl3 - gm));
        { const float og = swap_other(__int_as_float(gi)), op = swap_other(gp); if (hi) { gi = __float_as_int(og); gp = op; } }
        const bool owner = (gi & 1) == hi; const int hsel = gi >> 1;
        float m0 = -3e38f, m1 = -3e38f; int e0 = 0, e1 = 0;
#pragma unroll
        for (int i = 0; i < 8; ++i) { const int n = 16 * hsel + 8 * (i >> 2) + 4 * hi + (i & 3);
            const float el = (hsel ? a0[8 + i] : a0[i]) * rstd + rb[n];
            if (el > m0) { m1 = m0; e1 = e0; m0 = el; e0 = i; } else if (el > m1) { m1 = el; e1 = i; } }
        if (owner) {
            const float p1 = __expf(m1 - m0); const int E0 = gi * 8 + e0, E1 = gi * 8 + e1;
            rexp[t] = make_int2(E0, E1); rw[t] = make_float2(gp / (1.f + p1), gp * p1 / (1.f + p1));
            const int k0 = __hip_atomic_fetch_add(lcnt + E0, 1, __ATOMIC_RELAXED, __HIP_MEMORY_SCOPE_WORKGROUP), k1 = __hip_atomic_fetch_add(lcnt + E1, 1, __ATOMIC_RELAXED, __HIP_MEMORY_SCOPE_WORKGROUP);
            rpos[t] = make_int2((int)(blockIdx.x << 16) | k0, (int)(blockIdx.x << 16) | k1);
            RSTD[t] = rstd; }
    }
    __syncthreads();
    if (((int)threadIdx.x) < 32) { const int n = lcnt[((int)threadIdx.x)]; int base = 0;
        if (n > 0) base = (int)__hip_atomic_fetch_add((unsigned*)(F.ctl + CW_CNT + 64 * ((int)threadIdx.x)), (unsigned)n, __ATOMIC_RELAXED, __HIP_MEMORY_SCOPE_AGENT);
        ((int*)(F.ws + WSX_BB))[blockIdx.x * 32 + ((int)threadIdx.x)] = base; }
    __syncthreads();
}
__device__ __forceinline__ void moe_tables(Frame& F) {
    LAS int* tp = (LAS int*)(F.lds + TP_OFF);
    if (((int)threadIdx.x) < 32) tp[64 + ((int)threadIdx.x)] = (int)__hip_atomic_load((unsigned*)(F.ctl + CW_CNT + 64 * ((int)threadIdx.x)), __ATOMIC_RELAXED, __HIP_MEMORY_SCOPE_AGENT);
    __syncthreads();
    if (((int)threadIdx.x) == 0) { int acc = 0; for (int e = 0; e < 32; ++e) { tp[e] = acc; acc += (tp[64 + e] + 255) >> 8; } tp[32] = acc; }
    __syncthreads();
}
__device__ __forceinline__ void phase_sort(Frame& F, const Inputs& I) {
    LAS float* Gs = (LAS float*)F.lds; LAS float* Ss = Gs + 4096;
    const float* mod = (const float*)(F.ws + WS_MOD);
#pragma unroll
    for (int i = ((int)threadIdx.x); i < 4096; i += 512) { const int b = i >> 10, k = i & 1023; Gs[i] = I.norm2_g[k] * (1.f + mod[b * MODW + 4096 + k]); Ss[i] = mod[b * MODW + 3072 + k]; }
    moe_tables(F);
    const LAS int* tp = (const LAS int*)(F.lds + TP_OFF);
    const int2* rexp = (const int2*)(F.ws + WSX_ROUTE); const int2* rpos = (const int2*)(F.ws + WSX_ROUTE + 512 * 1024); int2* rposF = (int2*)(F.ws + WSX_RPOSF);
    const float* RSTD = (const float*)(F.ws + WSX_RSTD); const int* BB = (const int*)(F.ws + WSX_BB);
    bf16_t* XS = (bf16_t*)(F.ws + WSX_XS);
    const int gw = F.vcu * NWAVES + F.wave, NGW = F.G * NWAVES;
    for (int m0 = gw; m0 < NTOK; m0 += 4 * NGW) {
        v4u xv[4][2]; int2 ee[4], pp[4]; float rstd[4]; int pos0[4], pos1[4];
        const int ln = ((int)(threadIdx.x & 63));
#pragma unroll
        for (int u = 0; u < 4; ++u) { const int m = m0 + u * NGW; ee[u] = rexp[m]; pp[u] = rpos[m]; rstd[u] = RSTD[m];
            const GAS v4u* xr = (const GAS v4u*)((const bf16_t*)(F.ws + WSX_X1) + (size_t)m * DM) + ln;
            xv[u][0] = xr[0]; xv[u][1] = xr[64]; }
#pragma unroll
        for (int u = 0; u < 4; ++u) { pos0[u] = tp[ee[u].x] * 256 + BB[(pp[u].x >> 16) * 32 + ee[u].x] + (pp[u].x & 0xffff); pos1[u] = tp[ee[u].y] * 256 + BB[(pp[u].y >> 16) * 32 + ee[u].y] + (pp[u].y & 0xffff); }
#pragma unroll
        for (int u = 0; u < 4; ++u) { const int m = m0 + u * NGW, b = m >> 13;
            GAS v4u* o0 = (GAS v4u*)(XS + (size_t)pos0[u] * DM) + ln; GAS v4u* o1 = (GAS v4u*)(XS + (size_t)pos1[u] * DM) + ln;
#pragma unroll
            for (int j = 0; j < 2; ++j) { float f[8]; prj::unpack8(xv[u][j], f); const int k0 = 512 * j + 8 * ln;
                const f32x4 g0 = *(const LAS f32x4*)(Gs + b * 1024 + k0), g1 = *(const LAS f32x4*)(Gs + b * 1024 + k0 + 4), s0 = *(const LAS f32x4*)(Ss + b * 1024 + k0), s1 = *(const LAS f32x4*)(Ss + b * 1024 + k0 + 4);
                const float r = rstd[u];
                const v4u w = {cvtpk(f[0] * r * g0[0] + s0[0], f[1] * r * g0[1] + s0[1]), cvtpk(f[2] * r * g0[2] + s0[2], f[3] * r * g0[3] + s0[3]),
                               cvtpk(f[4] * r * g1[0] + s1[0], f[5] * r * g1[1] + s1[1]), cvtpk(f[6] * r * g1[2] + s1[2], f[7] * r * g1[3] + s1[3])};
                o0[64 * j] = w; o1[64 * j] = w; }
            if (ln == 0) rposF[m] = make_int2(pos0[u], pos1[u]); }
    }
    __syncthreads();
}
__device__ __forceinline__ void phase_combine(Frame& F) {
    const float* mod = (const float*)(F.ws + WS_MOD);
    const float2* rw = (const float2*)(F.ws + WSX_ROUTE + 256 * 1024); const int2* rpos = (const int2*)(F.ws + WSX_RPOSF);
    const bf16_t* YS = (const bf16_t*)(F.ws + WSX_XS);
    const int gw = F.vcu * NWAVES + F.wave, NGW = F.G * NWAVES;
    for (int m0 = gw; m0 < NTOK; m0 += 4 * NGW) {
        int2 pp[4]; float2 ww[4]; v2u xv[4][4]; v2u ya[4][4], yb[4][4];
        const int ln = ((int)(threadIdx.x & 63));
#pragma unroll
        for (int u = 0; u < 4; ++u) { const int m = m0 + u * NGW; pp[u] = rpos[m]; ww[u] = rw[m];
            const GAS v2u* xr = (const GAS v2u*)((const bf16_t*)(F.ws + WSX_X1) + (size_t)m * DM) + ln;
#pragma unroll
            for (int j = 0; j < 4; ++j) xv[u][j] = xr[64 * j]; }
#pragma unroll
        for (int u = 0; u < 4; ++u) { const GAS v2u* y0 = (const GAS v2u*)(YS + (size_t)pp[u].x * DM) + ln; const GAS v2u* y1 = (const GAS v2u*)(YS + (size_t)pp[u].y * DM) + ln;
#pragma unroll
            for (int j = 0; j < 4; ++j) { ya[u][j] = y0[64 * j]; yb[u][j] = y1[64 * j]; } }
#pragma unroll
        for (int u = 0; u < 4; ++u) { const int m = m0 + u * NGW, b = m >> 13; GAS f32x4* xr = (GAS f32x4*)(F.out + (size_t)m * DM) + ln; const float* g2 = mod + b * MODW + 5120 + 4 * ln;
#pragma unroll
            for (int j = 0; j < 4; ++j) { const v2u a = ya[u][j], c = yb[u][j], xx = xv[u][j]; const f32x4 g = *(const f32x4*)(g2 + 256 * j); const float w0 = ww[u].x, w1 = ww[u].y;
                f32x4 y; y[0] = w0 * __uint_as_float(a.x << 16) + w1 * __uint_as_float(c.x << 16); y[1] = w0 * __uint_as_float(a.x & 0xffff0000u) + w1 * __uint_as_float(c.x & 0xffff0000u);
                y[2] = w0 * __uint_as_float(a.y << 16) + w1 * __uint_as_float(c.y << 16); y[3] = w0 * __uint_as_float(a.y & 0xffff0000u) + w1 * __uint_as_float(c.y & 0xffff0000u);
                const f32x4 xf = {__uint_as_float(xx.x << 16), __uint_as_float(xx.x & 0xffff0000u), __uint_as_float(xx.y << 16), __uint_as_float(xx.y & 0xffff0000u)};
                xr[64 * j] = xf + g * y; } }
    }
}
}
#ifndef SEAM_TWICE
#define SEAM_TWICE 0
#endif
__device__ __forceinline__ Inputs load_inputs(const Args& args) {
    Inputs I; const void* const* p = args.in;
    I.x = (const float*)p[0]; I.c = (const float*)p[1]; I.positions = (const int*)p[2]; I.w_ada = (const float*)p[3]; I.b_ada = (const float*)p[4]; I.norm1_g = (const float*)p[5];
    I.w_in = (const float*)p[6]; I.q_a_norm = (const float*)p[7]; I.w_q_b = (const float*)p[8]; I.kv_a_norm = (const float*)p[9]; I.w_kv_b = (const float*)p[10]; I.q_norm = (const float*)p[11];
    I.k_norm = (const float*)p[12]; I.conv_w = (const float*)p[13]; I.conv_b = (const float*)p[14]; I.lru_wa = (const float*)p[15]; I.lru_ba = (const float*)p[16]; I.lru_wx = (const float*)p[17];
    I.lru_bx = (const float*)p[18]; I.lru_lambda = (const float*)p[19]; I.attn_out_norm = (const float*)p[20]; I.lru_out_norm = (const float*)p[21]; I.w_out = (const float*)p[22];
    I.norm2_g = (const float*)p[23]; I.w_rg = (const float*)p[24]; I.b_rg = (const float*)p[25]; I.w_re = (const float*)p[26]; I.b_re = (const float*)p[27]; I.w_gate = (const float*)p[28];
    I.w_up = (const float*)p[29]; I.w_down = (const float*)p[30]; return I;
}
__global__ void __launch_bounds__(NWAVES * 64, 2) mega_fwd(Args args) {
    extern __shared__ __attribute__((aligned(16))) unsigned char lds[];
    Frame F;
    F.lds = (LAS unsigned char*)lds; F.MISC = (volatile LAS unsigned*)(F.lds + MISC_OFF);
    F.wave = __builtin_amdgcn_readfirstlane(threadIdx.x >> 6);
    F.G = gridDim.x; { const int bx = blockIdx.x; F.vcu = (F.G % 8 == 0) ? (bx % 8) * (F.G / 8) + bx / 8 : bx; }
    F.ws = args.ws; F.out = args.out; F.ctl = (gu32*)(args.ws + WS_CTL);
    for (int u = ((int)threadIdx.x); u < (LDS_BYTES - LDSCTL_OFF) / 4; u += NWAVES * 64) ((LAS unsigned*)(F.lds + LDSCTL_OFF))[u] = 0u;
    __syncthreads();
    XcdBarrier bar = xcd_barrier_post((unsigned*)(F.ctl + CW_BAR) + args.li * XCD_BAR_WORDS, F.MISC + 8);
    const int lo = args.ph_lo, hi = args.ph_hi;
constexpr int REPS[12] = {1,1,1,1,1,1,1,1,1,1,1,1};
#define IN(k) (lo <= (k) && (k) < hi)
#define SEAM(k) do { if (IN(k) && IN((k) + 1)) { xcd_barrier(bar); if (SEAM_TWICE) xcd_barrier(bar); } } while (0)
    if (IN(0)) for (int rep_ = 0; rep_ < REPS[0]; ++rep_) { const Inputs I = load_inputs(args); (void)I; phase_prologue(F, I); } SEAM(0);
    if (IN(1)) for (int rep_ = 0; rep_ < REPS[1]; ++rep_) { const Inputs I = load_inputs(args); (void)I; moe::router_fold(F, I); phase_xn(F, I); } SEAM(1);
    if (IN(2)) for (int rep_ = 0; rep_ < REPS[2]; ++rep_) { const Inputs I = load_inputs(args); (void)I;
        pg8::Gemm g{(const bf16_t*)(F.ws + WSX_A), (const bf16_t*)(F.ws + WSX_WIN), NTOK, PROJP, DM}; pg8::StaticOrder S; S.init(NTOK, PROJP, F.G, (int)blockIdx.x);
        pg8::EpiProjT E{(bf16_t*)(F.ws + WSX_B)};
        pg8::gemm_phase<pg8::EpiProjT, pg8::StaticOrder, true, true>(F.lds, g, S, E);
    } SEAM(2);
    if (IN(3)) for (int rep_ = 0; rep_ < REPS[3]; ++rep_) { const Inputs I = load_inputs(args); (void)I; prj::phase_proj(F, I, args.pad); } SEAM(3);
    if (IN(4)) for (int rep_ = 0; rep_ < REPS[4]; ++rep_) { const Inputs I = load_inputs(args); (void)I;
#ifndef ATT_ABL
#define ATT_ABL 0
#endif
        if (ATT_ABL == 0 || args.pad == 7) att::attn_phase<0>((char*)lds, (const bf16_t*)(F.ws + WSX_Q), (const bf16_t*)(F.ws + WSX_K), (const bf16_t*)(F.ws + WSX_V), (bf16_t*)(F.ws + WSX_AO), F.G, F.vcu);
        else att::attn_phase<ATT_ABL>((char*)lds, (const bf16_t*)(F.ws + WSX_Q), (const bf16_t*)(F.ws + WSX_K), (const bf16_t*)(F.ws + WSX_V), (bf16_t*)(F.ws + WSX_AO), F.G, F.vcu);
    } SEAM(4);
    if (IN(5)) for (int rep_ = 0; rep_ < REPS[5]; ++rep_) { const Inputs I = load_inputs(args); (void)I; prj::phase_mix(F, I); } SEAM(5);
    if (IN(6)) for (int rep_ = 0; rep_ < REPS[6]; ++rep_) { const Inputs I = load_inputs(args); (void)I;
        pg8::Gemm g{(const bf16_t*)(F.ws + WSX_E), (const bf16_t*)(F.ws + WSX_WOUT), NTOK, DM, DM}; pg8::StaticOrder S; S.init(NTOK, DM, F.G, (int)blockIdx.x);
        pg8::EpiResid E{I.x, (const float*)(F.ws + WS_MOD), (bf16_t*)(F.ws + WSX_X1)};
        pg8::gemm_phase<pg8::EpiResid, pg8::StaticOrder, true, true>(F.lds, g, S, E);
    } SEAM(6);
    if (IN(7)) for (int rep_ = 0; rep_ < REPS[7]; ++rep_) { const Inputs I = load_inputs(args); (void)I; moe::phase_route(F); } SEAM(7);
    if (IN(8)) for (int rep_ = 0; rep_ < REPS[8]; ++rep_) { const Inputs I = load_inputs(args); (void)I; moe::phase_sort(F, I); } SEAM(8);
    if (IN(9)) for (int rep_ = 0; rep_ < REPS[9]; ++rep_) { const Inputs I = load_inputs(args); (void)I;
        if (!IN(8)) moe::moe_tables(F);
        pg8::Gemm g{(const bf16_t*)(F.ws + WSX_XS), (const bf16_t*)(F.ws + WSX_W1T), MAXROWS, 0, DM};
        pg8::GroupedOrder S{(const LAS int*)(F.lds + moe::TP_OFF), 2, F.G, (int)blockIdx.x};
        pg8::EpiSiluMul E{(bf16_t*)(F.ws + WSX_HID)};
        pg8::gemm_phase<pg8::EpiSiluMul, pg8::GroupedOrder, true, true>(F.lds, g, S, E);
    } SEAM(9);
    if (IN(10)) for (int rep_ = 0; rep_ < REPS[10]; ++rep_) { const Inputs I = load_inputs(args); (void)I;
        if (!IN(8)) moe::moe_tables(F);
        int kk2 = DFF; asm volatile("" : "+s"(kk2));
        pg8::Gemm g{(const bf16_t*)(F.ws + WSX_HID), (const bf16_t*)(F.ws + WSX_W2T), MAXROWS, 0, kk2};
        pg8::GroupedOrder S{(const LAS int*)(F.lds + moe::TP_OFF), 4, F.G, (int)blockIdx.x};
        pg8::EpiYs E{(bf16_t*)(F.ws + WSX_XS)};
        pg8::gemm_phase<pg8::EpiYs, pg8::GroupedOrder, true, true>(F.lds, g, S, E);
    } SEAM(10);
    if (IN(11)) for (int rep_ = 0; rep_ < REPS[11]; ++rep_) { const Inputs I = load_inputs(args); (void)I; moe::phase_combine(F); }
#undef IN
#undef SEAM
}
static int g_grid = 0;
static bool mega_setup() {
    if (g_grid) return g_grid > 0;
    int dev = 0, cus = 0, per_cu = 0;
    if (hipGetDevice(&dev) != hipSuccess || hipDeviceGetAttribute(&cus, hipDeviceAttributeMultiprocessorCount, dev) != hipSuccess) { g_grid = -1; return false; }
    if (hipFuncSetAttribute((const void*)mega_fwd, hipFuncAttributeMaxDynamicSharedMemorySize, LDS_BYTES) != hipSuccess) { fprintf(stderr, "hipFuncSetAttribute failed\n"); g_grid = -1; return false; }
    if (hipOccupancyMaxActiveBlocksPerMultiprocessor(&per_cu, (const void*)mega_fwd, NWAVES * 64, LDS_BYTES) != hipSuccess || per_cu < 1) { fprintf(stderr, "occupancy query: %d\n", per_cu); (void)hipGetLastError(); g_grid = -1; return false; }
    g_grid = cus;
    return true;
}
static void mega_launch(void* const* d_in, void* d_out, void* d_ws, hipStream_t stream, int lo, int hi, int li, int knob = 7) {
    Args a{}; for (int i = 0; i < 31; ++i) a.in[i] = d_in[i];
    a.out = (float*)d_out; a.ws = (unsigned char*)d_ws; a.ph_lo = lo; a.ph_hi = hi; a.li = li; a.pad = knob;
    hipLaunchKernelGGL(mega_fwd, dim3(g_grid), dim3(NWAVES * 64), LDS_BYTES, stream, a);
}
extern "C" void kernel_launch(void* const* d_in, const int* in_sizes, int n_in, void* d_out, int out_size, void* d_ws, size_t ws_size, hipStream_t stream) {
    if (n_in != 31 || ws_size < WSX_END || out_size != NTOK * DM) { fprintf(stderr, "kernel_launch: unexpected shapes n_in=%d ws=%zu out=%d\n", n_in, ws_size, out_size); return; }
    if (!mega_setup()) return;
    const Inputs I = get_inputs(d_in);
    char* ws = (char*)d_ws; float* out = (float*)d_out;
    float* mod = (float*)(ws + WS_MOD);
    int2* rexp = (int2*)(ws + WSX_ROUTE); float2* rw = (float2*)(ws + WSX_ROUTE + 256 * 1024);
    bf16_t* XN = (bf16_t*)(ws + WSX_A); bf16_t* H2 = (bf16_t*)(ws + WSX_A);
    bf16_t* PROJ = (bf16_t*)(ws + WSX_B);
    bf16_t* MIXED = (bf16_t*)(ws + WSX_E);
    (void)XN; (void)mod;
    hipMemsetAsync(ws + WS_CTL, 0, 1 * MiB, stream);
    mega_launch(d_in, d_out, d_ws, stream, 0, 12, 0);
}
```

```cpp
#include <hip/hip_runtime.h>
#include <cstdio>
#include <cstdint>
#include <cmath>
constexpr int NB = 4, SEQ = 8192, DM = 1024, NTOK = NB * SEQ;
constexpr int NH = 4, DQK = 192, DNOPE = 128, DROPE = 64, DV = 128;
constexpr int QLR = 256, KVLR = 128, LRUW = 512, LRUH = 4, LRUB = 128;
constexpr int NPROJ = 1472, PROJP = 1536;
constexpr int C_QLAT = 0, C_KVLAT = 256, C_KROPE = 384, C_XLRU = 448, C_GLRU = 960;
constexpr int NEXP = 32, NGRP = 4, EPG = 8, DFF = 256;
constexpr float EPS = 1e-6f;
constexpr int MODW = 6 * DM;

typedef unsigned short bf16_t;
__device__ __forceinline__ float bf2f(bf16_t v) { return __uint_as_float(((unsigned)v) << 16); }
__device__ __forceinline__ bf16_t f2bf(float f) { unsigned u = __float_as_uint(f); return (bf16_t)((u + 0x7fffu + ((u >> 16) & 1u)) >> 16); }

constexpr size_t MiB = 1u << 20;
constexpr size_t WS_CTL = 0;
constexpr size_t WS_MOD = 1 * MiB;
constexpr size_t WS_ROUTE = 2 * MiB;
constexpr size_t WS_A = 64 * MiB;
constexpr size_t WS_B = 128 * MiB;
constexpr size_t WS_C = 224 * MiB;
constexpr size_t WS_D = 352 * MiB;
constexpr size_t WS_E = 416 * MiB;
constexpr size_t WS_END = 480 * MiB;
constexpr size_t WS_Q = WS_C, WS_K = WS_C + 48 * MiB, WS_V = WS_C + 96 * MiB;

__device__ __forceinline__ float silu_f(float v) { return v / (1.f + __expf(-v)); }
__device__ __forceinline__ float sigmoid_f(float v) { return 1.f / (1.f + __expf(-v)); }
__device__ __forceinline__ float gelu_tanh(float v) { const float u = 0.7978845608028654f * (v + 0.044715f * v * v * v); return v / (1.f + __expf(-2.f * u)); }

__device__ __forceinline__ float block_sum_256(float v, float* red) {
    for (int o = 32; o > 0; o >>= 1) v += __shfl_xor(v, o);
    __syncthreads();
    if ((threadIdx.x & 63) == 0) red[threadIdx.x >> 6] = v;
    __syncthreads();
    return red[0] + red[1] + red[2] + red[3];
}
__device__ __forceinline__ float wave_sum(float v) { for (int o = 32; o > 0; o >>= 1) v += __shfl_xor(v, o); return v; }

__device__ __forceinline__ void rope_cs(int pos, int i, float& c, float& s) {
    const double inv = exp(-0.28782313662425575 * (double)i);
    double a = (double)pos * inv;
    const double k = rint(a * 0.15915494309189535);
    a = fma(-k, 6.283185307179586, a); a = fma(-k, 2.4492935982947064e-16, a);
    const float r = (float)a;
    c = __cosf(r); s = __sinf(r);
}

__global__ void nv_mod(const float* __restrict__ c, const float* __restrict__ w_ada, const float* __restrict__ b_ada, float* __restrict__ mod) {
    const int n = blockIdx.x * 256 + threadIdx.x, b = blockIdx.y;
    float acc = b_ada[n];
    for (int k = 0; k < DM; ++k) acc += silu_f(c[b * DM + k]) * w_ada[(size_t)k * MODW + n];
    mod[b * MODW + n] = acc;
}
__global__ void nv_norm_mod(const float* __restrict__ x, const float* __restrict__ g, const float* __restrict__ mod, int which, bf16_t* __restrict__ out) {
    const int t = blockIdx.x * 4 + (threadIdx.x >> 6), lane = threadIdx.x & 63, b = t / SEQ;
    const float* xr = x + (size_t)t * DM;
    float v[16]; float ss = 0.f;
#pragma unroll
    for (int j = 0; j < 16; ++j) { v[j] = xr[lane + 64 * j]; ss += v[j] * v[j]; }
    ss = wave_sum(ss);
    const float rstd = rsqrtf(ss / DM + EPS);
    const float* sh = mod + b * MODW + (which ? 3 * DM : 0); const float* sc = sh + DM;
#pragma unroll
    for (int j = 0; j < 16; ++j) { const int k = lane + 64 * j; out[(size_t)t * DM + k] = f2bf(v[j] * rstd * g[k] * (1.f + sc[k]) + sh[k]); }
}

template <class Epi> __global__ void __launch_bounds__(256) nv_gemm(const bf16_t* __restrict__ A, int lda, const float* __restrict__ W, int ldw, int K, Epi epi) {
    __shared__ float As[16][65]; __shared__ float Bs[16][64];
    const int tid = threadIdx.x, tx = tid & 15, ty = tid >> 4, m0 = blockIdx.y * 64, n0 = blockIdx.x * 64;
    float acc[4][4];
#pragma unroll
    for (int i = 0; i < 4; ++i)
#pragma unroll
        for (int j = 0; j < 4; ++j) acc[i][j] = 0.f;
    for (int k0 = 0; k0 < K; k0 += 16) {
        { const int r = tid >> 2, kk = (tid & 3) * 4; const bf16_t* ap = A + (size_t)(m0 + r) * lda + k0 + kk;
#pragma unroll
          for (int j = 0; j < 4; ++j) As[kk + j][r] = bf2f(ap[j]); }
        { const int kk = tid >> 4, c = (tid & 15) * 4; const float* wp = W + (size_t)(k0 + kk) * ldw + n0 + c;
#pragma unroll
          for (int j = 0; j < 4; ++j) Bs[kk][c + j] = wp[j]; }
        __syncthreads();
#pragma unroll
        for (int kk = 0; kk < 16; ++kk) { float a[4], b[4];
#pragma unroll
            for (int i = 0; i < 4; ++i) a[i] = As[kk][ty * 4 + i];
#pragma unroll
            for (int j = 0; j < 4; ++j) b[j] = Bs[kk][tx * 4 + j];
#pragma unroll
            for (int i = 0; i < 4; ++i)
#pragma unroll
                for (int j = 0; j < 4; ++j) acc[i][j] += a[i] * b[j]; }
        __syncthreads();
    }
#pragma unroll
    for (int i = 0; i < 4; ++i)
#pragma unroll
        for (int j = 0; j < 4; ++j) epi(m0 + ty * 4 + i, n0 + tx * 4 + j, acc[i][j]);
}
struct EpiStoreBf16 { bf16_t* C; int ldc; int pad; __device__ void operator()(int r, int c, float v) const { C[(size_t)r * ldc + c] = f2bf(v); } };
struct EpiOutProj { const float* x; const float* mod; float* out; __device__ void operator()(int r, int c, float v) const { const int b = r / SEQ; out[(size_t)r * DM + c] = x[(size_t)r * DM + c] + mod[b * MODW + 2 * DM + c] * v; } };

__global__ void __launch_bounds__(256) nv_qkv(const bf16_t* __restrict__ proj, const int* __restrict__ positions, const float* __restrict__ q_a_norm, const float* __restrict__ w_q_b,
                                               const float* __restrict__ kv_a_norm, const float* __restrict__ w_kv_b, const float* __restrict__ q_norm, const float* __restrict__ k_norm,
                                               bf16_t* __restrict__ Q, bf16_t* __restrict__ Kb, bf16_t* __restrict__ Vb) {
    __shared__ float qn[QLR], kvn[KVLR], kr[DROPE], qo[NH * DQK], kvo[NH * 256], red[4], cs[64];
    const int t = blockIdx.x, tid = threadIdx.x, b = t / SEQ, s = t % SEQ;
    const bf16_t* pr = proj + (size_t)t * PROJP;
    const float ql = bf2f(pr[C_QLAT + tid]);
    const float sq = block_sum_256(ql * ql, red);
    qn[tid] = ql * rsqrtf(sq / QLR + EPS) * q_a_norm[tid];
    const float kl = tid < KVLR ? bf2f(pr[C_KVLAT + tid]) : 0.f;
    const float skv = block_sum_256(kl * kl, red);
    if (tid < KVLR) kvn[tid] = kl * rsqrtf(skv / KVLR + EPS) * kv_a_norm[tid];
    if (tid < DROPE) kr[tid] = bf2f(pr[C_KROPE + tid]);
    if (tid < 32) { float c, sn; rope_cs(positions[t], tid, c, sn); cs[tid] = c; cs[32 + tid] = sn; }
    __syncthreads();
    for (int j = 0; j < 3; ++j) { const int col = tid + 256 * j; float a = 0.f; for (int k = 0; k < QLR; ++k) a += qn[k] * w_q_b[(size_t)k * (NH * DQK) + col]; qo[col] = a; }
    for (int j = 0; j < 4; ++j) { const int col = tid + 256 * j; float a = 0.f; for (int k = 0; k < KVLR; ++k) a += kvn[k] * w_kv_b[(size_t)k * (NH * 256) + col]; kvo[col] = a; }
    __syncthreads();
    const int h = tid >> 6, lane = tid & 63;
    {
        float v0 = qo[h * DQK + lane], v1 = qo[h * DQK + 64 + lane], v2 = qo[h * DQK + 128 + lane];
        const float rs = rsqrtf(wave_sum(v0 * v0 + v1 * v1 + v2 * v2) / DQK + EPS);
        v0 *= rs * q_norm[lane]; v1 *= rs * q_norm[64 + lane]; v2 *= rs * q_norm[128 + lane];
        const float oth = __shfl_xor(v2, 32); const int i = lane & 31; const float c = cs[i], sn = cs[32 + i];
        const float r2 = lane < 32 ? v2 * c - oth * sn : v2 * c + oth * sn;
        bf16_t* qp = Q + ((size_t)(b * NH + h) * SEQ + s) * DQK;
        qp[lane] = f2bf(v0); qp[64 + lane] = f2bf(v1); qp[128 + lane] = f2bf(r2);
    }
    {
        float v0 = kvo[h * 256 + lane], v1 = kvo[h * 256 + 64 + lane], v2 = kr[lane];
        const float rs = rsqrtf(wave_sum(v0 * v0 + v1 * v1 + v2 * v2) / DQK + EPS);
        v0 *= rs * k_norm[lane]; v1 *= rs * k_norm[64 + lane]; v2 *= rs * k_norm[128 + lane];
        const float oth = __shfl_xor(v2, 32); const int i = lane & 31; const float c = cs[i], sn = cs[32 + i];
        const float r2 = lane < 32 ? v2 * c - oth * sn : v2 * c + oth * sn;
        bf16_t* kp = Kb + ((size_t)(b * NH + h) * SEQ + s) * DQK;
        kp[lane] = f2bf(v0); kp[64 + lane] = f2bf(v1); kp[128 + lane] = f2bf(r2);
        bf16_t* vp = Vb + ((size_t)(b * NH + h) * SEQ + s) * DV;
        vp[lane] = f2bf(kvo[h * 256 + 128 + lane]); vp[64 + lane] = f2bf(kvo[h * 256 + 192 + lane]);
    }
}

__global__ void __launch_bounds__(256) nv_attn(const bf16_t* __restrict__ Q, const bf16_t* __restrict__ Kb, const bf16_t* __restrict__ Vb, bf16_t* __restrict__ mixed) {
    __shared__ float Ks[64][DQK + 4]; __shared__ float Vs[64][DV + 4];
    const int bh = blockIdx.y, qb = gridDim.x - 1 - blockIdx.x, tid = threadIdx.x, row = tid >> 2, part = tid & 3;
    const int qi = qb * 64 + row;
    float q[48], o[32]; float m = -1e30f, l = 0.f;
    { const bf16_t* qp = Q + ((size_t)bh * SEQ + qi) * DQK + part * 48;
#pragma unroll
      for (int d = 0; d < 48; ++d) q[d] = bf2f(qp[d]); }
#pragma unroll
    for (int d = 0; d < 32; ++d) o[d] = 0.f;
    const float scl = 0.07216878364870322f;
    for (int kt = 0; kt <= qb; ++kt) {
        __syncthreads();
        for (int e = tid; e < 64 * DQK; e += 256) { const int r = e / DQK, c = e % DQK; Ks[r][c] = bf2f(Kb[((size_t)bh * SEQ + kt * 64 + r) * DQK + c]); }
        for (int e = tid; e < 64 * DV; e += 256) { const int r = e / DV, c = e % DV; Vs[r][c] = bf2f(Vb[((size_t)bh * SEQ + kt * 64 + r) * DV + c]); }
        __syncthreads();
        for (int j = 0; j < 64; ++j) {
            float sdot = 0.f;
#pragma unroll
            for (int d = 0; d < 48; ++d) sdot += q[d] * Ks[j][part * 48 + d];
            sdot += __shfl_xor(sdot, 1); sdot += __shfl_xor(sdot, 2);
            sdot *= scl;
            if (kt * 64 + j <= qi) {
                const float mn = fmaxf(m, sdot), al = __expf(m - mn), p = __expf(sdot - mn);
                l = l * al + p; m = mn;
#pragma unroll
                for (int d = 0; d < 32; ++d) o[d] = o[d] * al + p * Vs[j][part * 32 + d];
            }
        }
    }
    const int b = bh / NH, h = bh % NH;
    bf16_t* op = mixed + ((size_t)(b * SEQ + qi)) * DM + h * DV + part * 32;
    const float il = 1.f / l;
#pragma unroll
    for (int d = 0; d < 32; ++d) op[d] = f2bf(o[d] * il);
}

__global__ void __launch_bounds__(512) nv_lru_gates(const bf16_t* __restrict__ proj, const int* __restrict__ positions, const float* __restrict__ conv_w, const float* __restrict__ conv_b,
                                                     const float* __restrict__ wa, const float* __restrict__ ba, const float* __restrict__ wx, const float* __restrict__ bx,
                                                     const float* __restrict__ lam, float* __restrict__ A32, float* __restrict__ B32) {
    __shared__ float xc[LRUW];
    const int t = blockIdx.x, c = threadIdx.x, s = t % SEQ;
    float v = conv_b[c];
    for (int j = 0; j < 4; ++j) { const int ss = s - 3 + j; if (ss >= 0) v += conv_w[j * LRUW + c] * bf2f(proj[(size_t)(t - 3 + j) * PROJP + C_XLRU + c]); }
    xc[c] = v;
    __syncthreads();
    const int h = c >> 7, jj = c & 127;
    float ra = ba[c], ri = bx[c];
    for (int i = 0; i < LRUB; ++i) { const float xv = xc[h * LRUB + i]; ra += xv * wa[(size_t)(h * LRUB + i) * LRUB + jj]; ri += xv * wx[(size_t)(h * LRUB + i) * LRUB + jj]; }
    const float r = sigmoid_f(ra), ig = sigmoid_f(ri);
    const float sp = log1pf(__expf(-lam[c]));
    const float log_a = -8.f * r * sp;
    float a = __expf(log_a), mult = sqrtf(fmaxf(1.f - __expf(2.f * log_a), 0.f));
    if (positions[t] == 0) { a = 0.f; mult = 1.f; }
    A32[(size_t)t * LRUW + c] = a; B32[(size_t)t * LRUW + c] = mult * (ig * v);
}
__global__ void nv_lru_scan(float* __restrict__ A32, const float* __restrict__ B32) {
    const int idx = blockIdx.x * blockDim.x + threadIdx.x, b = idx / LRUW, c = idx % LRUW;
    float h = 0.f;
    for (int s0 = 0; s0 < SEQ; s0 += 8) {
        float a[8], bb[8];
#pragma unroll
        for (int j = 0; j < 8; ++j) { const size_t o = ((size_t)(b * SEQ + s0 + j)) * LRUW + c; a[j] = A32[o]; bb[j] = B32[o]; }
#pragma unroll
        for (int j = 0; j < 8; ++j) { h = a[j] * h + bb[j]; A32[((size_t)(b * SEQ + s0 + j)) * LRUW + c] = h; }
    }
}
__global__ void nv_mixnorm(bf16_t* __restrict__ mixed, const float* __restrict__ H32, const bf16_t* __restrict__ proj, const float* __restrict__ g_attn, const float* __restrict__ g_lru) {
    const int t = blockIdx.x * 4 + (threadIdx.x >> 6), lane = threadIdx.x & 63;
    bf16_t* mr = mixed + (size_t)t * DM;
    float v[8], ss = 0.f;
#pragma unroll
    for (int j = 0; j < 8; ++j) { v[j] = bf2f(mr[lane + 64 * j]); ss += v[j] * v[j]; }
    float rs = rsqrtf(wave_sum(ss) / 512.f + EPS);
#pragma unroll
    for (int j = 0; j < 8; ++j) mr[lane + 64 * j] = f2bf(v[j] * rs * g_attn[lane + 64 * j]);
    ss = 0.f;
#pragma unroll
    for (int j = 0; j < 8; ++j) { const int c = lane + 64 * j; v[j] = H32[(size_t)t * LRUW + c] * gelu_tanh(bf2f(proj[(size_t)t * PROJP + C_GLRU + c])); ss += v[j] * v[j]; }
    rs = rsqrtf(wave_sum(ss) / 512.f + EPS);
#pragma unroll
    for (int j = 0; j < 8; ++j) mr[512 + lane + 64 * j] = f2bf(v[j] * rs * g_lru[lane + 64 * j]);
}
__global__ void nv_route(const float* __restrict__ x1, const float* __restrict__ g2, const float* __restrict__ mod, const float* __restrict__ w_rg, const float* __restrict__ b_rg,
                         const float* __restrict__ w_re, const float* __restrict__ b_re, bf16_t* __restrict__ H2, int2* __restrict__ rexp, float2* __restrict__ rw) {
    const int t = blockIdx.x * 4 + (threadIdx.x >> 6), lane = threadIdx.x & 63, b = t / SEQ;
    const float* xr = x1 + (size_t)t * DM;
    float v[16]; float ss = 0.f;
#pragma unroll
    for (int j = 0; j < 16; ++j) { v[j] = xr[lane + 64 * j]; ss += v[j] * v[j]; }
    const float rstd = rsqrtf(wave_sum(ss) / DM + EPS);
    const float* sh = mod + b * MODW + 3 * DM; const float* sc = sh + DM;
#pragma unroll
    for (int j = 0; j < 16; ++j) { const int k = lane + 64 * j; v[j] = v[j] * rstd * g2[k] * (1.f + sc[k]) + sh[k]; H2[(size_t)t * DM + k] = f2bf(v[j]); }
    float gl[NGRP];
#pragma unroll
    for (int g = 0; g < NGRP; ++g) { float a = 0.f;
#pragma unroll
        for (int j = 0; j < 16; ++j) a += v[j] * w_rg[(size_t)(lane + 64 * j) * NGRP + g];
        gl[g] = wave_sum(a) + b_rg[g]; }
    int gi = 0; float gm = gl[0];
#pragma unroll
    for (int g = 1; g < NGRP; ++g) if (gl[g] > gm) { gm = gl[g]; gi = g; }
    float gs = 0.f;
#pragma unroll
    for (int g = 0; g < NGRP; ++g) gs += __expf(gl[g] - gm);
    const float gp = 1.f / gs;
    float m0 = -1e30f, m1 = -1e30f; int e0 = 0, e1 = 0;
    for (int e = 0; e < EPG; ++e) { float a = 0.f;
#pragma unroll
        for (int j = 0; j < 16; ++j) a += v[j] * w_re[(size_t)(lane + 64 * j) * NEXP + gi * EPG + e];
        const float el = wave_sum(a) + b_re[gi * EPG + e];
        if (el > m0) { m1 = m0; e1 = e0; m0 = el; e0 = e; } else if (el > m1) { m1 = el; e1 = e; } }
    const float p1 = __expf(m1 - m0);
    const float w0 = gp / (1.f + p1), w1 = gp * p1 / (1.f + p1);
    if (lane == 0) { rexp[t] = make_int2(gi * EPG + e0, gi * EPG + e1); rw[t] = make_float2(w0, w1); }
}
__global__ void __launch_bounds__(256) nv_moe(const bf16_t* __restrict__ H2, const int2* __restrict__ rexp, const float2* __restrict__ rw, const float* __restrict__ w_gate,
                                               const float* __restrict__ w_up, const float* __restrict__ w_down, const float* __restrict__ mod, float* __restrict__ out) {
    __shared__ float hs[DM], hid[DFF];
    const int t = blockIdx.x, tid = threadIdx.x, b = t / SEQ;
    for (int j = 0; j < 4; ++j) hs[tid + 256 * j] = bf2f(H2[(size_t)t * DM + tid + 256 * j]);
    float y[4] = {0.f, 0.f, 0.f, 0.f};
    const int2 ee = rexp[t]; const float2 ww = rw[t];
    for (int k = 0; k < 2; ++k) {
        const int e = k ? ee.y : ee.x; const float w = k ? ww.y : ww.x;
        __syncthreads();
        const float* wg = w_gate + (size_t)e * DM * DFF; const float* wu = w_up + (size_t)e * DM * DFF;
        float g = 0.f, u = 0.f;
        for (int i = 0; i < DM; ++i) { const float hv = hs[i]; g += hv * wg[(size_t)i * DFF + tid]; u += hv * wu[(size_t)i * DFF + tid]; }
        hid[tid] = silu_f(g) * u;
        __syncthreads();
        const float* wd = w_down + (size_t)e * DFF * DM;
#pragma unroll
        for (int j = 0; j < 4; ++j) { float a = 0.f; for (int f = 0; f < DFF; ++f) a += hid[f] * wd[(size_t)f * DM + tid + 256 * j]; y[j] += w * a; }
    }
#pragma unroll
    for (int j = 0; j < 4; ++j) { const int c = tid + 256 * j; out[(size_t)t * DM + c] += mod[b * MODW + 5 * DM + c] * y[j]; }
}
struct Inputs {
    const float *x, *c; const int* positions;
    const float *w_ada, *b_ada, *norm1_g, *w_in, *q_a_norm, *w_q_b, *kv_a_norm, *w_kv_b, *q_norm, *k_norm, *conv_w, *conv_b, *lru_wa, *lru_ba, *lru_wx, *lru_bx, *lru_lambda,
                *attn_out_norm, *lru_out_norm, *w_out, *norm2_g, *w_rg, *b_rg, *w_re, *b_re, *w_gate, *w_up, *w_down;
};
static Inputs get_inputs(void* const* d_in) {
    Inputs I;
    I.x = (const float*)d_in[0]; I.c = (const float*)d_in[1]; I.positions = (const int*)d_in[2];
    I.w_ada = (const float*)d_in[3]; I.b_ada = (const float*)d_in[4]; I.norm1_g = (const float*)d_in[5];
    I.w_in = (const float*)d_in[6]; I.q_a_norm = (const float*)d_in[7]; I.w_q_b = (const float*)d_in[8];
    I.kv_a_norm = (const float*)d_in[9]; I.w_kv_b = (const float*)d_in[10]; I.q_norm = (const float*)d_in[11];
    I.k_norm = (const float*)d_in[12]; I.conv_w = (const float*)d_in[13]; I.conv_b = (const float*)d_in[14];
    I.lru_wa = (const float*)d_in[15]; I.lru_ba = (const float*)d_in[16]; I.lru_wx = (const float*)d_in[17];
    I.lru_bx = (const float*)d_in[18]; I.lru_lambda = (const float*)d_in[19]; I.attn_out_norm = (const float*)d_in[20];
    I.lru_out_norm = (const float*)d_in[21]; I.w_out = (const float*)d_in[22]; I.norm2_g = (const float*)d_in[23];
    I.w_rg = (const float*)d_in[24]; I.b_rg = (const float*)d_in[25]; I.w_re = (const float*)d_in[26];
    I.b_re = (const float*)d_in[27]; I.w_gate = (const float*)d_in[28]; I.w_up = (const float*)d_in[29];
    I.w_down = (const float*)d_in[30];
    return I;
}
#define GAS __attribute__((address_space(1)))
#define LAS __attribute__((address_space(3)))
typedef unsigned v4u __attribute__((ext_vector_type(4)));
typedef unsigned v2u __attribute__((ext_vector_type(2)));
typedef float f32x4 __attribute__((ext_vector_type(4)));
typedef float f32x16 __attribute__((ext_vector_type(16)));
typedef short bf16x8 __attribute__((ext_vector_type(8)));
typedef short s16x4 __attribute__((ext_vector_type(4)));
typedef GAS unsigned gu32;
#define RLX_AGENT __ATOMIC_RELAXED, __HIP_MEMORY_SCOPE_AGENT
#define LDS_WAIT() asm volatile("s_waitcnt lgkmcnt(0)" ::: "memory")
#define VM_WAIT() asm volatile("s_waitcnt vmcnt(0)" ::: "memory")
__device__ __forceinline__ unsigned pk2(float lo, float hi) { return (unsigned)f2bf(lo) | ((unsigned)f2bf(hi) << 16); }
__device__ __forceinline__ unsigned cvtpk(float lo, float hi) { unsigned r; asm volatile("v_cvt_pk_bf16_f32 %0, %1, %2" : "=v"(r) : "v"(lo), "v"(hi)); return r; }

constexpr size_t WSX_SUMA = 3 * MiB, WSX_SUMB = 5 * MiB;
constexpr size_t WSX_CS = 7 * MiB;
constexpr size_t WSX_WQF = 15 * MiB;
constexpr size_t WSX_WKVF = WSX_WQF + 384 * 1024;
constexpr size_t WSX_WAF = WSX_WKVF + 256 * 1024;
constexpr size_t WSX_WXF = WSX_WAF + 128 * 1024;
constexpr size_t WSX_WRF = WSX_WXF + 128 * 1024;
constexpr size_t WSX_SP = 2 * MiB + 768 * 1024;
constexpr size_t WSX_WIN = 16 * MiB;
constexpr size_t WSX_WOUT = 19 * MiB;
constexpr size_t WSX_W1T = 22 * MiB;
constexpr size_t WSX_W2T = 54 * MiB;
constexpr size_t WSX_A = 72 * MiB;
constexpr size_t WSX_B = 136 * MiB;
constexpr size_t WSX_C = 232 * MiB;
constexpr size_t WSX_D = 360 * MiB;
constexpr size_t WSX_E = 424 * MiB;
constexpr size_t WSX_END = 488 * MiB;
constexpr size_t WSX_Q = WSX_C, WSX_K = WSX_C + 48 * MiB, WSX_V = WSX_C + 96 * MiB;
constexpr size_t WSX_XS = 216 * MiB;
constexpr size_t WSX_HID = WSX_D;
constexpr size_t WSX_ROUTE = 2 * MiB;
constexpr int MAXROWS = 2 * NTOK + NEXP * 255;
constexpr size_t WSX_X1 = 72 * MiB;
constexpr size_t WSX_AO = WSX_A;
constexpr size_t WSX_RPOSF = 71 * MiB;
constexpr int CW_BAR = 4096;
constexpr int CW_CNT = 65536;

constexpr int RING_BYTES = 131072, LDSCTL_OFF = RING_BYTES, MISC_OFF = LDSCTL_OFF + 320, LDS_BYTES = 147456;
constexpr int NWAVES = 8;
namespace pg8 {
#define PG8_LAS __attribute__((address_space(3)))
typedef unsigned short bf16_t;
typedef short bf16x8 __attribute__((ext_vector_type(8)));
typedef float f32x4 __attribute__((ext_vector_type(4)));
typedef unsigned u32x4 __attribute__((ext_vector_type(4)));
constexpr int BM = 256, BK = 64, HALF = 128, HTB = HALF * BK * 2  , STAGE_BYTES = 8 * HTB, NXCD = 8, WGM = 8;

__host__ __device__ __forceinline__ int lds_byte(int r, int c) { const int st = (r >> 4) * 2 + (c >> 5), rr = r & 15, cc = c & 31, ob = rr * 64 + cc * 2; return st * 1024 + (ob ^ (((ob >> 9) & 1) << 5)); }
__host__ __device__ __forceinline__ void stage_rc(int b, int& R, int& C) { const int st = b / 1024, sb = b % 1024, swz = sb ^ (((sb >> 9) & 1) << 5); R = (st >> 1) * 16 + swz / 64; C = (st & 1) * 32 + (swz % 64) / 2; }
__host__ __device__ __forceinline__ int perm32(int rho) { const int n = rho >> 4, i = rho & 15; return 8 * (i >> 2) + 4 * n + (i & 3); }

struct Unit { int pm, pn; };
struct Gemm { const bf16_t* A; const bf16_t* Bt; int M, N, K; };

struct StaticOrder {
    int nM, nN, nwg, G, c;
    __host__ __device__ void init(int M, int N, int G_, int c_) { nM = M / BM; nN = N / BM; nwg = nM * nN; G = G_; c = c_; }
    __host__ __device__ bool next(int i, Unit& u) const {
        const long L = (long)i * G + c; if (L >= nwg) return false;
        int wgid = (int)L; { const int q = nwg / NXCD, r = nwg % NXCD, xcd = wgid % NXCD, off = wgid / NXCD; wgid = (xcd < r ? xcd * (q + 1) : r * (q + 1) + (xcd - r) * q) + off; }
        const int nig = WGM * nN, gid = wgid / nig, fm = gid * WGM, gsz = (nM - fm) < WGM ? (nM - fm) : WGM;
        u.pm = fm + ((wgid % nig) % gsz); u.pn = (wgid % nig) / gsz; return true;
    }
    __device__ __forceinline__ void a_ready(const Unit&) const {}
    __device__ __forceinline__ void done(const Unit&) const {}
};

__device__ __forceinline__ unsigned cvt_pk_bf16(float lo, float hi) { unsigned r; asm volatile("v_cvt_pk_bf16_f32 %0, %1, %2" : "=v"(r) : "v"(lo), "v"(hi)); return r; }
typedef float f32x2 __attribute__((ext_vector_type(2)));
__device__ __forceinline__ f32x2 gelu_pk(f32x2 v) {
    const f32x2 av = __builtin_elementwise_abs(v), d = av * 0.2316418882f + 1.0f;
    f32x2 t; t.x = __builtin_amdgcn_rcpf(d.x); t.y = __builtin_amdgcn_rcpf(d.y);
    f32x2 q = t * 0.5307027145f + (-0.7265760135f); q = q * t + 0.7107068705f; q = q * t + (-0.142248368f); q = q * t + 0.127414796f; q = q * t;
    const f32x2 s = (v * v) * (-0.72134752044f);
    f32x2 e; e.x = __builtin_amdgcn_exp2f(s.x); e.y = __builtin_amdgcn_exp2f(s.y);
    const f32x2 m = v * (q * e), r = v - m;
    f32x2 o; o.x = v.x < 0.f ? m.x : r.x; o.y = v.y < 0.f ? m.y : r.y; return o;
}

template <int ACT  > struct EpiBf16 {
    static constexpr bool PERM = true, AFTER_DRAIN = false; static_assert(ACT == 0 || ACT == 1, "EpiBf16: ACT is 0 (none) or 1 (gelu_pk)");
    bf16_t* O; int ldc; const float* bias; int split_cols; size_t split_stride; float scale0;
    __device__ __forceinline__ void operator()(const f32x4 (&acc)[2][2][4][2], const Unit& u, int wr, int wc, int fr, int fq) const {
        const int row0 = u.pm * BM + wr * 64 + fr; int colt = u.pn * BM; bf16_t* base = O;
        float sc = 1.f; if (split_cols) { const int t = colt / split_cols; base += (size_t)t * split_stride; colt -= t * split_cols; if (t == 0) sc = scale0; }
        const int col0 = colt + wc * 32 + 8 * fq, bcol0 = u.pn * BM + wc * 32 + 8 * fq;
        f32x4 bv[2][2];
#pragma unroll
        for (int bj = 0; bj < 2; ++bj)
#pragma unroll
            for (int n = 0; n < 2; ++n) bv[bj][n] = bias ? *(const f32x4*)(bias + bcol0 + bj * HALF + 4 * n) : (f32x4){0.f, 0.f, 0.f, 0.f};
#pragma unroll
        for (int ai = 0; ai < 2; ++ai)
#pragma unroll
            for (int m = 0; m < 4; ++m) { bf16_t* rowp = base + (size_t)(row0 + ai * HALF + m * 16) * ldc + col0;
#pragma unroll
                for (int bj = 0; bj < 2; ++bj) { f32x4 v0 = acc[ai][bj][m][0] + bv[bj][0], v1 = acc[ai][bj][m][1] + bv[bj][1];
                    if (ACT == 1) { f32x2 a = gelu_pk((f32x2){v0[0], v0[1]}), b = gelu_pk((f32x2){v0[2], v0[3]}), c = gelu_pk((f32x2){v1[0], v1[1]}), d = gelu_pk((f32x2){v1[2], v1[3]});
                        v0 = (f32x4){a.x, a.y, b.x, b.y}; v1 = (f32x4){c.x, c.y, d.x, d.y}; }
                    v0 = v0 * sc; v1 = v1 * sc; u32x4 w; w.x = cvt_pk_bf16(v0[0], v0[1]); w.y = cvt_pk_bf16(v0[2], v0[3]); w.z = cvt_pk_bf16(v1[0], v1[1]); w.w = cvt_pk_bf16(v1[2], v1[3]);
                    *(u32x4*)(rowp + bj * HALF) = w; } }
    }
};
struct EpiResid {
    static constexpr bool PERM = true, AFTER_DRAIN = false;
    const float* x; const float* mod; bf16_t* out;
    __device__ __forceinline__ void operator()(const f32x4 (&acc)[2][2][4][2], const Unit& u, int wr, int wc, int fr, int fq) const {
        const int col0 = u.pn * BM + wc * 32 + 8 * fq, b = (u.pm * BM) / 8192;
        f32x4 gv[2][2];
#pragma unroll
        for (int bj = 0; bj < 2; ++bj)
#pragma unroll
            for (int n = 0; n < 2; ++n) gv[bj][n] = *(const f32x4*)(mod + b * 6144 + 2048 + col0 + bj * HALF + n * 4);
#pragma unroll
        for (int ai = 0; ai < 2; ++ai)
#pragma unroll
            for (int m = 0; m < 4; ++m) { const size_t off = (size_t)(u.pm * BM + ai * HALF + wr * 64 + m * 16 + fr) * 1024 + col0;
#pragma unroll
                for (int bj = 0; bj < 2; ++bj) { const f32x4 x0 = *(const f32x4*)(x + off + bj * HALF), x1 = *(const f32x4*)(x + off + bj * HALF + 4);
                    const f32x4 v0 = x0 + gv[bj][0] * acc[ai][bj][m][0], v1 = x1 + gv[bj][1] * acc[ai][bj][m][1];
                    u32x4 w; w.x = cvt_pk_bf16(v0[0], v0[1]); w.y = cvt_pk_bf16(v0[2], v0[3]); w.z = cvt_pk_bf16(v1[0], v1[1]); w.w = cvt_pk_bf16(v1[2], v1[3]);
                    *(u32x4*)(out + off + bj * HALF) = w; } }
    }
};
__device__ __forceinline__ float silu_e(float v) { return v * __builtin_amdgcn_rcpf(1.f + __builtin_amdgcn_exp2f(-1.4426950408889634f * v)); }
struct EpiSiluMul {
    static constexpr bool PERM = true, AFTER_DRAIN = false;
    bf16_t* H;
    __device__ __forceinline__ void operator()(const f32x4 (&acc)[2][2][4][2], const Unit& u, int wr, int wc, int fr, int fq) const {
        const int half = u.pn & 1, col0 = half * 128 + wc * 32 + 8 * fq;
#pragma unroll
        for (int ai = 0; ai < 2; ++ai)
#pragma unroll
            for (int m = 0; m < 4; ++m) { const size_t row = (size_t)(u.pm * BM + ai * HALF + wr * 64 + m * 16 + fr);
                const f32x4 g0 = acc[ai][0][m][0], g1 = acc[ai][0][m][1], u0 = acc[ai][1][m][0], u1 = acc[ai][1][m][1];
                u32x4 w; w.x = cvt_pk_bf16(silu_e(g0[0]) * u0[0], silu_e(g0[1]) * u0[1]); w.y = cvt_pk_bf16(silu_e(g0[2]) * u0[2], silu_e(g0[3]) * u0[3]);
                w.z = cvt_pk_bf16(silu_e(g1[0]) * u1[0], silu_e(g1[1]) * u1[1]); w.w = cvt_pk_bf16(silu_e(g1[2]) * u1[2], silu_e(g1[3]) * u1[3]);
                *(u32x4*)(H + row * 256 + col0) = w; }
    }
};
struct EpiProjT {
    static constexpr bool PERM = true, AFTER_DRAIN = false;
    bf16_t* P;
    __device__ __forceinline__ void operator()(const f32x4 (&acc)[2][2][4][2], const Unit& u, int wr, int wc, int fr, int fq) const {
#pragma unroll
        for (int ai = 0; ai < 2; ++ai)
#pragma unroll
            for (int m = 0; m < 4; ++m) { const int row = u.pm * BM + ai * HALF + wr * 64 + m * 16 + fr;
#pragma unroll
                for (int bj = 0; bj < 2; ++bj) { const int c = (u.pn * BM + bj * HALF + wc * 32 + 8 * fq) >> 3; const f32x4 v0 = acc[ai][bj][m][0], v1 = acc[ai][bj][m][1];
                    u32x4 w; w.x = cvt_pk_bf16(v0[0], v0[1]); w.y = cvt_pk_bf16(v0[2], v0[3]); w.z = cvt_pk_bf16(v1[0], v1[1]); w.w = cvt_pk_bf16(v1[2], v1[3]);
                    *(u32x4*)(P + ((size_t)((row >> 5) * 192 + c) * 32 + (row & 31)) * 8) = w; } }
    }
};
struct EpiYs {
    static constexpr bool PERM = true, AFTER_DRAIN = false;
    bf16_t* Y;
    __device__ __forceinline__ void operator()(const f32x4 (&acc)[2][2][4][2], const Unit& u, int wr, int wc, int fr, int fq) const {
        const int col0 = (u.pn & 3) * BM + wc * 32 + 8 * fq;
#pragma unroll
        for (int ai = 0; ai < 2; ++ai)
#pragma unroll
            for (int m = 0; m < 4; ++m) { bf16_t* rowp = Y + (size_t)(u.pm * BM + ai * HALF + wr * 64 + m * 16 + fr) * 1024 + col0;
#pragma unroll
                for (int bj = 0; bj < 2; ++bj) { const f32x4 v0 = acc[ai][bj][m][0], v1 = acc[ai][bj][m][1];
                    u32x4 w; w.x = cvt_pk_bf16(v0[0], v0[1]); w.y = cvt_pk_bf16(v0[2], v0[3]); w.z = cvt_pk_bf16(v1[0], v1[1]); w.w = cvt_pk_bf16(v1[2], v1[3]);
                    *(u32x4*)(rowp + bj * HALF) = w; } }
    }
};
struct GroupedOrder {
    const __attribute__((address_space(3))) int* tp; int ncol, G, c;
    __device__ __forceinline__ bool next(int i, Unit& u) const {
        const int L = i * G + c, total = tp[32] * ncol; if (L >= total) return false;
        const int rt = L / ncol, ct = L - rt * ncol; int e = 0;
#pragma unroll 1
        for (int j = 1; j < 32; ++j) e += (tp[j] <= rt) ? 1 : 0;
        u.pm = rt; u.pn = e * ncol + ct; return true;
    }
    __device__ __forceinline__ void a_ready(const Unit&) const {}
    __device__ __forceinline__ void done(const Unit&) const {}
};
template <class Epi, class Sched, bool ALIGN_EPI = false, bool SP2 = false>
__device__ __forceinline__ void gemm_phase(PG8_LAS unsigned char* lds, const Gemm g, const Sched& S, const Epi& E) {
    const int tid = threadIdx.x, wid = __builtin_amdgcn_readfirstlane(tid >> 6), lane = tid & 63, wr = wid >> 2, wc = wid & 3, fr = lane & 15, fq = lane >> 4;
    const int K = g.K, nt = K / BK;
    unsigned voffA[2], voffB[2];
#pragma unroll
    for (int i = 0; i < 2; ++i) { int R, C; stage_rc(tid * 16 + i * 8192, R, C); const int Rb = Epi::PERM ? ((R & ~31) + perm32(R & 31)) : R;
        voffA[i] = (unsigned)(R * K + C) * 2u; voffB[i] = (unsigned)(Rb * K + C) * 2u; }
    const size_t kstep = (size_t)(BK * 2);
    const size_t hstep = (size_t)HALF * K * 2;
    const size_t tstep = 2 * hstep;
    const unsigned ldsw = (unsigned)wid * 1024u;
    const int aoff = lds_byte(wr * 64 + fr, fq * 8), boff = lds_byte(wc * 32 + fr, fq * 8);
#define PG8_SA(b, h) (((b) * 2 + (h)) * HTB)
#define PG8_SB(b, h) ((4 + (b) * 2 + (h)) * HTB)
#define PG8_STAGE(bufoff, gbase, voff) do { _Pragma("unroll") for (int _i = 0; _i < 2; ++_i) \
        __builtin_amdgcn_global_load_lds((const unsigned*)((const char*)(gbase) + (voff)[_i]), (PG8_LAS unsigned*)(lds + (bufoff) + ldsw + _i * 8192), 16, 0, 0); } while (0)
#define PG8_LDA(dst, b, h) do { _Pragma("unroll") for (int m = 0; m < 4; ++m) _Pragma("unroll") for (int k = 0; k < 2; ++k) dst[m][k] = *(const PG8_LAS bf16x8*)(lds + PG8_SA(b, h) + aoff + m * 2048 + k * 1024); } while (0)
#define PG8_LDB(dst, b, h) do { _Pragma("unroll") for (int n = 0; n < 2; ++n) _Pragma("unroll") for (int k = 0; k < 2; ++k) dst[n][k] = *(const PG8_LAS bf16x8*)(lds + PG8_SB(b, h) + boff + n * 2048 + k * 1024); } while (0)
#define PG8_MMA(ai, bj, At, Bt) do { __builtin_amdgcn_s_setprio(1); _Pragma("unroll") for (int m = 0; m < 4; ++m) _Pragma("unroll") for (int n = 0; n < 2; ++n) _Pragma("unroll") for (int k = 0; k < 2; ++k) \
        acc[ai][bj][m][n] = __builtin_amdgcn_mfma_f32_16x16x32_bf16(Bt[n][k], At[m][k], acc[ai][bj][m][n], 0, 0, 0); __builtin_amdgcn_s_setprio(0); } while (0)
#define PG8_WAIT_V(n) asm volatile("s_waitcnt vmcnt(" #n ")" ::: "memory")
#define PG8_WAIT_L(n) asm volatile("s_waitcnt lgkmcnt(" #n ")" ::: "memory")
#define PG8_BAR __builtin_amdgcn_s_barrier()
#define PG8_SCHED __builtin_amdgcn_sched_barrier(0)
    Unit cur, nxt; int ui = 0;
    if (!S.next(0, cur)) return;
    f32x4 acc[2][2][4][2];
#pragma unroll
    for (int a = 0; a < 2; ++a)
#pragma unroll
        for (int b = 0; b < 2; ++b)
#pragma unroll
            for (int m = 0; m < 4; ++m)
#pragma unroll
                for (int n = 0; n < 2; ++n) acc[a][b][m][n] = (f32x4){0.f, 0.f, 0.f, 0.f};
    bf16x8 At[4][2], B0[2][2], B1[2][2];
    const char* cA = (const char*)g.A + (size_t)cur.pm * tstep; const char* cB = (const char*)g.Bt + (size_t)cur.pn * tstep;
    S.a_ready(cur);
    if constexpr (SP2) {
        PG8_STAGE(PG8_SB(0, 0), cB, voffB); PG8_STAGE(PG8_SB(0, 1), cB + hstep, voffB); PG8_STAGE(PG8_SA(0, 0), cA, voffA); PG8_STAGE(PG8_SA(0, 1), cA + hstep, voffA);
        if (wr == 1) PG8_BAR;
        PG8_WAIT_V(2); PG8_BAR;
        PG8_STAGE(PG8_SB(1, 0), cB + kstep, voffB); PG8_STAGE(PG8_SA(1, 0), cA + kstep, voffA); PG8_STAGE(PG8_SB(1, 1), cB + hstep + kstep, voffB);
        PG8_WAIT_V(6); PG8_BAR;
    } else {
        PG8_STAGE(PG8_SB(0, 0), cB, voffB); PG8_STAGE(PG8_SA(0, 0), cA, voffA); PG8_STAGE(PG8_SB(0, 1), cB + hstep, voffB); PG8_STAGE(PG8_SA(0, 1), cA + hstep, voffA);
        if (wr == 1) PG8_BAR;
        PG8_WAIT_V(4); PG8_BAR;
        PG8_STAGE(PG8_SB(1, 0), cB + kstep, voffB); PG8_STAGE(PG8_SA(1, 0), cA + kstep, voffA); PG8_STAGE(PG8_SB(1, 1), cB + hstep + kstep, voffB);
        PG8_WAIT_V(6); PG8_BAR;
    }
    for (;;) {
        const bool has_next = S.next(ui + 1, nxt);
        const char* nA = has_next ? (const char*)g.A + (size_t)nxt.pm * tstep : cA; const char* nB = has_next ? (const char*)g.Bt + (size_t)nxt.pn * tstep : cB;
        for (int t = 0; t < nt; t += 2) {
            const bool last = (t == nt - 2);
            const char* a1 = cA + (size_t)(t + 1) * kstep;
            const char* a2 = last ? nA : cA + (size_t)(t + 2) * kstep; const char* b2 = last ? nB : cB + (size_t)(t + 2) * kstep;
            const char* a3 = a2 + kstep; const char* b3 = b2 + kstep;
            if (last && has_next) S.a_ready(nxt);
            if constexpr (SP2) {
            PG8_LDB(B0, 0, 0); PG8_LDB(B1, 0, 1); PG8_SCHED; PG8_LDA(At, 0, 0); PG8_STAGE(PG8_SA(1, 1), a1 + hstep, voffA);
            PG8_WAIT_V(8); PG8_WAIT_L(0); PG8_BAR; PG8_MMA(0, 0, At, B0); PG8_MMA(0, 1, At, B1); PG8_BAR; PG8_SCHED;
            PG8_LDA(At, 0, 1); PG8_STAGE(PG8_SB(0, 0), b2, voffB); PG8_STAGE(PG8_SB(0, 1), b2 + hstep, voffB); PG8_STAGE(PG8_SA(0, 0), a2, voffA);
            PG8_WAIT_V(8); PG8_WAIT_L(0); PG8_BAR; PG8_MMA(1, 0, At, B0); PG8_MMA(1, 1, At, B1); PG8_BAR; PG8_SCHED;
            PG8_LDB(B0, 1, 0); PG8_LDB(B1, 1, 1); PG8_SCHED; PG8_LDA(At, 1, 0); PG8_STAGE(PG8_SA(0, 1), a2 + hstep, voffA);
            PG8_WAIT_V(8); PG8_WAIT_L(0); PG8_BAR; PG8_MMA(0, 0, At, B0); PG8_MMA(0, 1, At, B1); PG8_BAR; PG8_SCHED;
            PG8_LDA(At, 1, 1); PG8_STAGE(PG8_SB(1, 0), b3, voffB); PG8_STAGE(PG8_SB(1, 1), b3 + hstep, voffB); PG8_STAGE(PG8_SA(1, 0), a3, voffA);
            PG8_WAIT_V(8); PG8_WAIT_L(0); PG8_BAR; PG8_MMA(1, 0, At, B0); PG8_MMA(1, 1, At, B1); PG8_BAR; PG8_SCHED;
            } else {
            PG8_LDB(B0, 0, 0); PG8_SCHED; PG8_LDA(At, 0, 0); PG8_STAGE(PG8_SA(1, 1), a1 + hstep, voffA);
            PG8_WAIT_L(8); PG8_BAR; PG8_WAIT_L(0); PG8_MMA(0, 0, At, B0); PG8_BAR; PG8_SCHED;
            PG8_LDB(B1, 0, 1); PG8_STAGE(PG8_SB(0, 0), b2, voffB);
            PG8_BAR; PG8_WAIT_L(0); PG8_MMA(0, 1, At, B1); PG8_BAR;
            PG8_LDA(At, 0, 1); PG8_STAGE(PG8_SA(0, 0), a2, voffA);
            PG8_BAR; PG8_WAIT_L(0); PG8_MMA(1, 0, At, B0); PG8_BAR; PG8_SCHED;
            PG8_STAGE(PG8_SB(0, 1), b2 + hstep, voffB);
            PG8_WAIT_V(6); PG8_BAR; PG8_MMA(1, 1, At, B1); PG8_BAR;
            PG8_LDB(B0, 1, 0); PG8_SCHED; PG8_LDA(At, 1, 0); PG8_STAGE(PG8_SA(0, 1), a2 + hstep, voffA);
            PG8_WAIT_L(8); PG8_BAR; PG8_WAIT_L(0); PG8_MMA(0, 0, At, B0); PG8_BAR; PG8_SCHED;
            PG8_LDB(B1, 1, 1); PG8_STAGE(PG8_SB(1, 0), b3, voffB);
            PG8_BAR; PG8_WAIT_L(0); PG8_MMA(0, 1, At, B1); PG8_BAR;
            PG8_LDA(At, 1, 1); PG8_STAGE(PG8_SA(1, 0), a3, voffA);
            PG8_BAR; PG8_WAIT_L(0); PG8_MMA(1, 0, At, B0); PG8_BAR; PG8_SCHED;
            PG8_STAGE(PG8_SB(1, 1), b3 + hstep, voffB);
            PG8_WAIT_V(6); PG8_BAR; PG8_MMA(1, 1, At, B1); PG8_BAR;
            }
        }
        if constexpr (ALIGN_EPI) { if (wr == 0) PG8_BAR; }
        if constexpr (!Epi::AFTER_DRAIN) { E(acc, cur, wr, wc, fr, fq); S.done(cur); }
        if (!has_next) break;
#pragma unroll
        for (int a = 0; a < 2; ++a)
#pragma unroll
            for (int b = 0; b < 2; ++b)
#pragma unroll
                for (int m = 0; m < 4; ++m)
#pragma unroll
                    for (int n = 0; n < 2; ++n) acc[a][b][m][n] = (f32x4){0.f, 0.f, 0.f, 0.f};
        cur = nxt; cA = nA; cB = nB; ++ui;
        if constexpr (ALIGN_EPI) { if (wr == 1) PG8_BAR; }
    }
    PG8_WAIT_V(0);
    if constexpr (!ALIGN_EPI) { if (wr == 0) PG8_BAR; }
    PG8_BAR;
    if constexpr (Epi::AFTER_DRAIN) { E.fused(acc, cur, wr, wc, fr, fq, lds, wid, lane); S.done(cur); }
#undef PG8_SA
#undef PG8_SB
#undef PG8_STAGE
#undef PG8_LDA
#undef PG8_LDB
#undef PG8_MMA
#undef PG8_WAIT_V
#undef PG8_WAIT_L
#undef PG8_BAR
#undef PG8_SCHED
}
}
#define XB_TMO      128
#define XB_XCNT(j)  (256  + 64 * (j))
#define XB_XSUB(j)  (1280 + 64 * (j))
#define XB_XGEN(j)  (2304 + 64 * (j))
#define XB_TOP      3328
#define XB_TOPGEN   3392
#define XCD_BAR_WORDS 3456
#define XB_SPIN_CAP (1u << 18)

__device__ __forceinline__ unsigned xb_ld(unsigned* p)              { return __hip_atomic_load(p, __ATOMIC_RELAXED, __HIP_MEMORY_SCOPE_AGENT); }
__device__ __forceinline__ unsigned xb_add(unsigned* p, unsigned v) { return __hip_atomic_fetch_add(p, v, __ATOMIC_RELAXED, __HIP_MEMORY_SCOPE_AGENT); }
__device__ __forceinline__ unsigned xb_xcc_id() { return (unsigned)__builtin_amdgcn_s_getreg((3 << 11) | 20) & 0xFu; }
#define XB_SPIN(cond, bar) do { unsigned _sp = 0; while (cond) { __builtin_amdgcn_s_sleep(1); \
    if ((++_sp & 255u) == 0u) { if (xb_ld(&(bar)[XB_TMO])) break; if (_sp > XB_SPIN_CAP) { atomicAdd(&(bar)[XB_TMO], 1u); break; } } } } while (0)

struct XcdBarrier {
    unsigned* bar; unsigned x;
    volatile LAS unsigned* st;
};

__device__ __forceinline__ XcdBarrier xcd_barrier_post(unsigned* bar, volatile LAS unsigned* st) {
    XcdBarrier b; b.bar = bar; b.x = xb_xcc_id(); b.st = st;
    if (threadIdx.x == 0) (void)xb_add(&bar[XB_XCNT(b.x)], 1u);
    return b;
}
__device__ __forceinline__ void xcd_barrier_complete(unsigned* bar, unsigned x, unsigned& nloc, unsigned& nx) {
    const unsigned G = gridDim.x * gridDim.y * gridDim.z;
    unsigned sum, cnt, mine, sp = 0u;
    for (;;) {
        sum = 0u; cnt = 0u; mine = 0u;
#pragma unroll
        for (unsigned j = 0; j < 16; ++j) { const unsigned c = xb_ld(&bar[XB_XCNT(j)]); sum += c; cnt += (c > 0u) ? 1u : 0u; mine = (j == x) ? c : mine; }
        if (sum == G) break;
        __builtin_amdgcn_s_sleep(1);
        if ((++sp & 255u) == 0u) { if (xb_ld(&bar[XB_TMO])) break; if (sp > XB_SPIN_CAP) { atomicAdd(&bar[XB_TMO], 1u); break; } }
    }
    nloc = mine > 0u ? mine : 1u; nx = cnt > 0u ? cnt : 1u;
}

__device__ __forceinline__ void xcd_barrier(const XcdBarrier& b) {
    asm volatile("s_waitcnt vmcnt(0)" ::: "memory");
    __syncthreads();
    if (threadIdx.x == 0) {
        unsigned* bar = b.bar;
        __builtin_amdgcn_s_waitcnt(0);
        unsigned nloc = b.st[0], nx = b.st[1];
        if (nloc == 0u) { xcd_barrier_complete(bar, b.x, nloc, nx); b.st[0] = nloc; b.st[1] = nx; }
        const unsigned old = xb_add(&bar[XB_XSUB(b.x)], 1u);
        const unsigned gen = old / nloc;
        if (old + 1u == (gen + 1u) * nloc) {
            __builtin_amdgcn_fence(__ATOMIC_RELEASE, "agent");
            asm volatile("s_waitcnt vmcnt(0)" ::: "memory");
            const unsigned og = xb_add(&bar[XB_TOP], 1u);
            const unsigned tg = og / nx;
            if (og + 1u == (tg + 1u) * nx) xb_add(&bar[XB_TOPGEN], 1u);
            else XB_SPIN(xb_ld(&bar[XB_TOPGEN]) == tg, bar);
            __builtin_amdgcn_fence(__ATOMIC_ACQUIRE, "agent");
            xb_add(&bar[XB_XGEN(b.x)], 1u);
            asm volatile("s_waitcnt vmcnt(0)" ::: "memory");
        } else {
            XB_SPIN(xb_ld(&bar[XB_XGEN(b.x)]) == gen, bar);
            __builtin_amdgcn_fence(__ATOMIC_ACQUIRE, "agent");
            asm volatile("s_waitcnt vmcnt(0)" ::: "memory");
        }
    }
    __syncthreads();
}
struct Args { const void* in[31]; float* out; unsigned char* ws; int ph_lo, ph_hi, li, pad; };
struct Frame {
    LAS unsigned char* lds; volatile LAS unsigned* MISC; gu32* ctl;
    int tid, lane, wave, vcu, G;
    unsigned char* ws; float* out;
};
__device__ __forceinline__ float wave_sum_f(float v) {
#pragma unroll
    for (int o = 1; o < 64; o <<= 1) v += __shfl_xor(v, o);
    return v;
}
__device__ __forceinline__ void p0_transpose_item(const float* W, int K, int N, bf16_t* WT, int row_off, LAS float* scr, int kb, int nb, int lane) {
    const int k0 = 64 * kb, n0 = 32 * nb;
#pragma unroll 8
    for (int i = 0; i < 32; ++i) { const int kk = 2 * i + (lane >> 5); scr[kk * 33 + (lane & 31)] = W[(size_t)(k0 + kk) * N + n0 + (lane & 31)]; }
    LDS_WAIT(); asm volatile("" ::: "memory");
    const int c = lane & 7;
#pragma unroll
    for (int j = 0; j < 4; ++j) { const int n = (lane >> 3) + 8 * j; const LAS float* s = scr + (8 * c) * 33 + n;
        v4u o; o.x = pk2(s[0 * 33], s[1 * 33]); o.y = pk2(s[2 * 33], s[3 * 33]); o.z = pk2(s[4 * 33], s[5 * 33]); o.w = pk2(s[6 * 33], s[7 * 33]);
        *(GAS v4u*)(WT + (size_t)(row_off + n0 + n) * K + k0 + 8 * c) = o; }
    LDS_WAIT(); asm volatile("" ::: "memory");
}
__device__ __forceinline__ int lru_chan(int ks, int hi, int j) { return 32 * (ks >> 1) + 16 * (ks & 1) + 8 * (j >> 2) + 4 * hi + (j & 3); }
__device__ __forceinline__ void phase_prologue(Frame& F, const Inputs& I) {
    if (blockIdx.x < 192) {
        LAS float* sl = (LAS float*)F.lds; LAS float* red = sl + 4096;
        for (int i = ((int)threadIdx.x); i < 4096; i += 512) { const float v = I.c[i]; sl[i] = v / (1.f + __expf(-v)); }
        __syncthreads();
        const int col0 = blockIdx.x * 32, kg = ((int)threadIdx.x) >> 5, col = ((int)threadIdx.x) & 31;
        float a0 = 0.f, a1 = 0.f, a2 = 0.f, a3 = 0.f;
#pragma unroll 8
        for (int i = 0; i < 64; ++i) { const int k = kg + 16 * i; const float w = I.w_ada[(size_t)k * MODW + col0 + col];
            a0 += sl[k] * w; a1 += sl[1024 + k] * w; a2 += sl[2048 + k] * w; a3 += sl[3072 + k] * w; }
        red[(kg * 4 + 0) * 32 + col] = a0; red[(kg * 4 + 1) * 32 + col] = a1; red[(kg * 4 + 2) * 32 + col] = a2; red[(kg * 4 + 3) * 32 + col] = a3;
        __syncthreads();
        if (((int)threadIdx.x) < 128) { const int b = ((int)threadIdx.x) >> 5, c = ((int)threadIdx.x) & 31; float s = I.b_ada[col0 + c];
            for (int g = 0; g < 16; ++g) s += red[(g * 4 + b) * 32 + c];
            ((float*)(F.ws + WS_MOD))[b * MODW + col0 + c] = s; }
        __syncthreads();
    }
    {
        LAS float* scr = (LAS float*)(F.lds + F.wave * 16384);
        const int gw = F.vcu * NWAVES + F.wave, NGW = F.G * NWAVES;
        bf16_t* WIN = (bf16_t*)(F.ws + WSX_WIN); bf16_t* WOUT = (bf16_t*)(F.ws + WSX_WOUT); bf16_t* W1T = (bf16_t*)(F.ws + WSX_W1T); bf16_t* W2T = (bf16_t*)(F.ws + WSX_W2T);
        constexpr int I_IN = 16 * 46, I_OUT = 16 * 32, I_G = 32 * 16 * 8, I_D = 32 * 4 * 32, NIT = I_IN + I_OUT + 2 * I_G + I_D;
        for (int it = gw; it < NIT; it += NGW) {
            int r = it;
            if (r < I_IN) { p0_transpose_item(I.w_in, 1024, NPROJ, WIN, 0, scr, r / 46, r % 46, ((int)(threadIdx.x & 63))); continue; } r -= I_IN;
            if (r < I_OUT) { p0_transpose_item(I.w_out, 1024, 1024, WOUT, 0, scr, r / 32, r % 32, ((int)(threadIdx.x & 63))); continue; } r -= I_OUT;
            if (r < 2 * I_G) { const int up = r >= I_G ? 1 : 0; if (up) r -= I_G; const int e = r >> 7, kb = (r >> 3) & 15, nb = r & 7, n0 = 32 * nb;
                p0_transpose_item((up ? I.w_up : I.w_gate) + (size_t)e * 1024 * 256, 1024, 256, W1T, e * 512 + (n0 >> 7) * 256 + (n0 & 127) - n0 + up * 128, scr, kb, nb, ((int)(threadIdx.x & 63))); continue; } r -= 2 * I_G;
            { const int e = r >> 7, kb = (r >> 5) & 3, nb = r & 31; p0_transpose_item(I.w_down + (size_t)e * 256 * 1024, 256, 1024, W2T, e * 1024, scr, kb, nb, ((int)(threadIdx.x & 63))); }
        }
    }
    {
        const int gt = blockIdx.x * 512 + ((int)threadIdx.x), NGT = F.G * 512;
        v4u* WQF = (v4u*)(F.ws + WSX_WQF); v4u* WKVF = (v4u*)(F.ws + WSX_WKVF); v4u* WAF = (v4u*)(F.ws + WSX_WAF); v4u* WXF = (v4u*)(F.ws + WSX_WXF); v4u* WRF = (v4u*)(F.ws + WSX_WRF);
        constexpr int NQ = 4 * 6 * 16 * 64, NKV = 4 * 8 * 8 * 64, NA = 4 * 4 * 8 * 64, NR = 2 * 64 * 64, NZ = 64 * 1024 / 8, NTOT = NQ + NKV + 2 * NA + NR + NZ;
        for (int g = gt; g < NTOT; g += NGT) {
            int r = g; float v[8];
            if (r < NQ) { const int lane = r & 63, ks = (r >> 6) & 15, hn = r >> 10, h = hn / 6, nb = hn % 6, hi = lane >> 5, r32 = lane & 31;
#pragma unroll
                for (int j = 0; j < 8; ++j) { const int k = 16 * ks + 8 * hi + j; v[j] = I.w_q_b[(size_t)k * 768 + h * 192 + 32 * nb + r32] * I.q_a_norm[k]; }
                WQF[r] = (v4u){pk2(v[0], v[1]), pk2(v[2], v[3]), pk2(v[4], v[5]), pk2(v[6], v[7])}; continue; } r -= NQ;
            if (r < NKV) { const int lane = r & 63, ks = (r >> 6) & 7, hn = r >> 9, h = hn >> 3, nb = hn & 7, hi = lane >> 5, r32 = lane & 31;
#pragma unroll
                for (int j = 0; j < 8; ++j) { const int k = 16 * ks + 8 * hi + j; v[j] = I.w_kv_b[(size_t)k * 1024 + h * 256 + 32 * nb + r32] * I.kv_a_norm[k]; }
                WKVF[r] = (v4u){pk2(v[0], v[1]), pk2(v[2], v[3]), pk2(v[4], v[5]), pk2(v[6], v[7])}; continue; } r -= NKV;
            if (r < 2 * NA) { const int x = r >= NA ? 1 : 0; if (x) r -= NA; const int lane = r & 63, ks = (r >> 6) & 7, hn = r >> 9, h = hn >> 2, nb = hn & 3, hi = lane >> 5, r32 = lane & 31;
                const float* W = x ? I.lru_wx : I.lru_wa;
#pragma unroll
                for (int j = 0; j < 8; ++j) v[j] = W[(size_t)(h * 128 + lru_chan(ks, hi, j)) * 128 + 32 * nb + r32];
                (x ? WXF : WAF)[r] = (v4u){pk2(v[0], v[1]), pk2(v[2], v[3]), pk2(v[4], v[5]), pk2(v[6], v[7])}; continue; } r -= 2 * NA;
            if (r < NR) { const int lane = r & 63, ks = (r >> 6) & 63, nb = r >> 12, hi = lane >> 5, n = 32 * nb + (lane & 31);
#pragma unroll
                for (int j = 0; j < 8; ++j) { const int k = 16 * ks + 8 * hi + j; v[j] = n < 4 ? I.w_rg[k * 4 + n] : (n < 36 ? I.w_re[k * 32 + n - 4] : 0.f); }
                WRF[r] = (v4u){pk2(v[0], v[1]), pk2(v[2], v[3]), pk2(v[4], v[5]), pk2(v[6], v[7])}; continue; } r -= NR;
            ((v4u*)(F.ws + WSX_WIN + (size_t)NPROJ * 1024 * 2))[r] = (v4u){0u, 0u, 0u, 0u};
        }
        if (gt < 512) ((float*)(F.ws + WSX_SP))[gt] = log1pf(__expf(-I.lru_lambda[gt]));
        float* CS = (float*)(F.ws + WSX_CS);
        for (int g = gt; g < NTOK * 32; g += NGT) { const int t = g >> 5, i = g & 31; float c, s; rope_cs(I.positions[t], i, c, s); CS[t * 64 + i] = c; CS[t * 64 + 32 + i] = s; }
    }
}
__device__ __forceinline__ void phase_xn(Frame& F, const Inputs& I) {
    LAS float* Gs = (LAS float*)F.lds; LAS float* Ss = Gs + 4096;
    const float* mod = (const float*)(F.ws + WS_MOD);
#pragma unroll
    for (int i = ((int)threadIdx.x); i < 4096; i += 512) { const int b = i >> 10, k = i & 1023; Gs[i] = I.norm1_g[k] * (1.f + mod[b * MODW + 1024 + k]); Ss[i] = mod[b * MODW + k]; }
    __syncthreads();
    bf16_t* XN = (bf16_t*)(F.ws + WSX_A);
    const int gw = F.vcu * NWAVES + F.wave, NGW = F.G * NWAVES;
    for (int m0 = gw; m0 < NTOK; m0 += 2 * NGW) {
        f32x4 v[2][4];
#pragma unroll
        for (int u = 0; u < 2; ++u) { const GAS f32x4* xr = (const GAS f32x4*)(I.x + (size_t)(m0 + u * NGW) * DM) + ((int)(threadIdx.x & 63));
#pragma unroll
            for (int j = 0; j < 4; ++j) v[u][j] = xr[64 * j]; }
#pragma unroll
        for (int u = 0; u < 2; ++u) { const int m = m0 + u * NGW, b = m >> 13; float s = 0.f;
#pragma unroll
            for (int j = 0; j < 4; ++j) s += (v[u][j].x * v[u][j].x + v[u][j].y * v[u][j].y) + (v[u][j].z * v[u][j].z + v[u][j].w * v[u][j].w);
            const float rstd = rsqrtf(wave_sum_f(s) * (1.f / DM) + EPS);
            GAS v2u* o8 = (GAS v2u*)(XN + (size_t)m * DM) + ((int)(threadIdx.x & 63));
#pragma unroll
            for (int j = 0; j < 4; ++j) { const f32x4 g = *(const LAS f32x4*)(Gs + b * 1024 + 256 * j + 4 * ((int)(threadIdx.x & 63))), sh = *(const LAS f32x4*)(Ss + b * 1024 + 256 * j + 4 * ((int)(threadIdx.x & 63)));
                const f32x4 o = v[u][j] * rstd * g + sh; o8[64 * j] = (v2u){pk2(o.x, o.y), pk2(o.z, o.w)}; } }
    }
    __syncthreads();
}
namespace att {
constexpr int NW = 8, QBLK = 32, KVBLK = 64, QB = NW * QBLK;
constexpr int DQ = 192, DVV = 128, OPITCH = 512;
constexpr int SHM_V = KVBLK * DVV * 2, SHM_K = KVBLK * DQ * 2;
constexpr int ATT_LDS = 3 * SHM_V + 3 * SHM_K + NW * 64 * 4;
constexpr float SCALE = 0.07216878364870322f;
constexpr float THR = 8.f;
#define SBAR() __builtin_amdgcn_sched_barrier(0)
__device__ __forceinline__ int koff(int row, int chunk) { return (chunk >> 3) * 8192 + row * 128 + ((((chunk & 7) ^ ((row >> 1) & 7))) << 4); }
__device__ __forceinline__ int v_st(int k, int c) { const int kk = (k & ~0xC) | ((k & 4) << 1) | ((k & 8) >> 1); return ((kk >> 3) * 4 + (c >> 5)) * 512 + ((kk & 7) * 32 + (c & 31)) * 2; }
__device__ __forceinline__ int v_rd_base(int lane) { return ((lane & 3) << 3) | (((lane >> 2) & 3) << 6) | (((lane >> 4) & 1) << 5) | (((lane >> 5) & 1) << 8); }
constexpr int v_rd_off(int d0, int ks, int half) { return d0 * 512 + ks * 4096 + half * 2048; }
__device__ __forceinline__ int crow(int r, int hi) { return (r & 3) + 8 * (r >> 2) + 4 * hi; }
__device__ __forceinline__ bf16x8 ld8(const bf16_t* p) { return *reinterpret_cast<const bf16x8*>(p); }
__device__ __forceinline__ void mask_tile(f32x16& p0, f32x16& p1, int dq) {
    const float NEG = -__builtin_inff();
#pragma unroll
    for (int r = 0; r < 16; ++r) { const int c = (r & 3) + 8 * (r >> 2); if (dq - c < 0) p0[r] = NEG; if (dq - c - 32 < 0) p1[r] = NEG; }
}
__device__ __forceinline__ void partialSM(f32x16& p0, f32x16& p1, float& m_reg, float& mn, float& alpha) {
    float pmax = p0[0];
#pragma unroll
    for (int r = 1; r < 16; ++r) pmax = fmaxf(pmax, p0[r]);
#pragma unroll
    for (int r = 0; r < 16; ++r) pmax = fmaxf(pmax, p1[r]);
    { auto rr = __builtin_amdgcn_permlane32_swap(__float_as_uint(pmax), __float_as_uint(pmax), false, false); pmax = fmaxf(__uint_as_float(rr[0]), __uint_as_float(rr[1])); }
    constexpr float C2 = 1.4426950408889634f * SCALE;
    if (__builtin_expect(__all((pmax - m_reg) * SCALE <= THR), 1)) { mn = m_reg; alpha = 1.f; }
    else { mn = fmaxf(m_reg, pmax); alpha = __builtin_amdgcn_exp2f((m_reg - mn) * C2); m_reg = mn; }
    const float mnL = -mn * C2;
#pragma unroll
    for (int r = 0; r < 16; ++r) p0[r] = fmaf(p0[r], C2, mnL);
#pragma unroll
    for (int r = 0; r < 16; ++r) p1[r] = fmaf(p1[r], C2, mnL);
#pragma unroll
    for (int r = 0; r < 16; ++r) p0[r] = __builtin_amdgcn_exp2f(p0[r]);
}
__device__ __forceinline__ void finishSM(f32x16& p0, f32x16& p1, float alpha, float& l_reg, bf16x8& pa0, bf16x8& pa1, bf16x8& pa2, bf16x8& pa3) {
#pragma unroll
    for (int r = 0; r < 16; ++r) p1[r] = __builtin_amdgcn_exp2f(p1[r]);
    float ps = 0;
#pragma unroll
    for (int r = 0; r < 16; ++r) ps += p0[r];
#pragma unroll
    for (int r = 0; r < 16; ++r) ps += p1[r];
    { auto rr = __builtin_amdgcn_permlane32_swap(__float_as_uint(ps), __float_as_uint(ps), false, false); ps = __uint_as_float(rr[0]) + __uint_as_float(rr[1]); }
    l_reg = l_reg * alpha + ps;
#define PK4(P, B_, OUT) do { unsigned a0 = cvtpk(P[B_+0], P[B_+1]), a1 = cvtpk(P[B_+2], P[B_+3]); unsigned b0 = cvtpk(P[B_+4], P[B_+5]), b1 = cvtpk(P[B_+6], P[B_+7]); \
        auto r0 = __builtin_amdgcn_permlane32_swap(a0, b0, false, false); auto r1 = __builtin_amdgcn_permlane32_swap(a1, b1, false, false); \
        v4u w = {r0[0], r1[0], r0[1], r1[1]}; OUT = *reinterpret_cast<bf16x8*>(&w); } while (0)
    PK4(p0, 0, pa0); PK4(p0, 8, pa1); PK4(p1, 0, pa2); PK4(p1, 8, pa3);
#undef PK4
}
template <int KB>
__device__ __forceinline__ void qkt(f32x16& p0, f32x16& p1, const char* K_lds, int r32, int hi, const bf16x8* qr) {
    p0 = f32x16{}; p1 = f32x16{};
    const char* kb[4];
#pragma unroll
    for (int dd = 0; dd < 4; ++dd) kb[dd] = K_lds + KB * SHM_K + koff(r32, 2 * dd + hi);
    bf16x8 kf[2][2];
#define KLD(d) do { const char* a_ = kb[(d) & 3] + ((d) >> 2) * 8192; kf[(d) & 1][0] = *reinterpret_cast<const bf16x8*>(a_); kf[(d) & 1][1] = *reinterpret_cast<const bf16x8*>(a_ + 32 * 128); } while (0)
    KLD(0);
#pragma unroll
    for (int d0 = 0; d0 < 12; ++d0) { if (d0 + 1 < 12) KLD(d0 + 1);
        p0 = __builtin_amdgcn_mfma_f32_32x32x16_bf16(kf[d0 & 1][0], qr[d0], p0, 0, 0, 0);
        p1 = __builtin_amdgcn_mfma_f32_32x32x16_bf16(kf[d0 & 1][1], qr[d0], p1, 0, 0, 0); }
#undef KLD
    __builtin_amdgcn_sched_group_barrier(0x100, 2, 0);
#pragma unroll
    for (int d0 = 0; d0 < 11; ++d0) { __builtin_amdgcn_sched_group_barrier(0x100, 2, 0); __builtin_amdgcn_sched_group_barrier(0x8, 2, 0); }
    __builtin_amdgcn_sched_group_barrier(0x8, 2, 0);
}
template <int VB>
__device__ __forceinline__ void pv_tile(f32x16* o, int vb0, bf16x8 pa0, bf16x8 pa1, bf16x8 pa2, bf16x8 pa3) {
    s16x4 lo[2][4], hv[2][4];
#define TRRD(dst, off) asm volatile("ds_read_b64_tr_b16 %0, %1 offset:%2" : "=&v"(dst) : "v"(vb0), "i"(off) : "memory")
#define VLD(d) do { TRRD(lo[(d) & 1][0], VB * SHM_V + v_rd_off((d), 0, 0)); TRRD(hv[(d) & 1][0], VB * SHM_V + v_rd_off((d), 0, 1)); TRRD(lo[(d) & 1][1], VB * SHM_V + v_rd_off((d), 1, 0)); TRRD(hv[(d) & 1][1], VB * SHM_V + v_rd_off((d), 1, 1)); \
        TRRD(lo[(d) & 1][2], VB * SHM_V + v_rd_off((d), 2, 0)); TRRD(hv[(d) & 1][2], VB * SHM_V + v_rd_off((d), 2, 1)); TRRD(lo[(d) & 1][3], VB * SHM_V + v_rd_off((d), 3, 0)); TRRD(hv[(d) & 1][3], VB * SHM_V + v_rd_off((d), 3, 1)); } while (0)
#define VF(d, k) (bf16x8){lo[(d) & 1][k][0], lo[(d) & 1][k][1], lo[(d) & 1][k][2], lo[(d) & 1][k][3], hv[(d) & 1][k][0], hv[(d) & 1][k][1], hv[(d) & 1][k][2], hv[(d) & 1][k][3]}
#define PVM(d) do { o[d] = __builtin_amdgcn_mfma_f32_32x32x16_bf16(pa0, VF(d, 0), o[d], 0, 0, 0); o[d] = __builtin_amdgcn_mfma_f32_32x32x16_bf16(pa1, VF(d, 1), o[d], 0, 0, 0); \
        o[d] = __builtin_amdgcn_mfma_f32_32x32x16_bf16(pa2, VF(d, 2), o[d], 0, 0, 0); o[d] = __builtin_amdgcn_mfma_f32_32x32x16_bf16(pa3, VF(d, 3), o[d], 0, 0, 0); } while (0)
    asm volatile("s_waitcnt lgkmcnt(0)" ::: "memory");
    VLD(0); VLD(1); asm volatile("s_waitcnt lgkmcnt(8)" ::: "memory"); SBAR(); PVM(0); SBAR();
    VLD(2); asm volatile("s_waitcnt lgkmcnt(8)" ::: "memory"); SBAR(); PVM(1); SBAR();
    VLD(3); asm volatile("s_waitcnt lgkmcnt(8)" ::: "memory"); SBAR(); PVM(2); SBAR();
    asm volatile("s_waitcnt lgkmcnt(0)" ::: "memory"); SBAR(); PVM(3);
#undef PVM
#undef VF
#undef VLD
#undef TRRD
}
template <bool DOPV>
__device__ __forceinline__ void pv_sm(f32x16* o, int vb0, bf16x8 pa0, bf16x8 pa1, bf16x8 pa2, bf16x8 pa3, f32x16& p0, f32x16& p1, float& m_reg, float& al_out) {
    s16x4 lo[2][4], hv[2][4];
#define TRRD(dst, off) asm volatile("ds_read_b64_tr_b16 %0, %1 offset:%2" : "=&v"(dst) : "v"(vb0), "i"(off) : "memory")
#define VLD(d) do { if (DOPV) { TRRD(lo[(d) & 1][0], v_rd_off((d), 0, 0)); TRRD(hv[(d) & 1][0], v_rd_off((d), 0, 1)); TRRD(lo[(d) & 1][1], v_rd_off((d), 1, 0)); TRRD(hv[(d) & 1][1], v_rd_off((d), 1, 1)); \
        TRRD(lo[(d) & 1][2], v_rd_off((d), 2, 0)); TRRD(hv[(d) & 1][2], v_rd_off((d), 2, 1)); TRRD(lo[(d) & 1][3], v_rd_off((d), 3, 0)); TRRD(hv[(d) & 1][3], v_rd_off((d), 3, 1)); } } while (0)
#define VF(d, k) (bf16x8){lo[(d) & 1][k][0], lo[(d) & 1][k][1], lo[(d) & 1][k][2], lo[(d) & 1][k][3], hv[(d) & 1][k][0], hv[(d) & 1][k][1], hv[(d) & 1][k][2], hv[(d) & 1][k][3]}
#define MM(d, k, PA) do { if (DOPV) o[d] = __builtin_amdgcn_mfma_f32_32x32x16_bf16(PA, VF(d, k), o[d], 0, 0, 0); SBAR(); } while (0)
#define LW(N) do { if (DOPV) asm volatile("s_waitcnt lgkmcnt(" #N ")" ::: "memory"); SBAR(); } while (0)
#define MX3(a, b, c) __builtin_fmaxf(__builtin_fmaxf((a), (b)), (c))
    constexpr float C2 = 1.4426950408889634f * SCALE;
    float mx, mn, mnL, al;
    LW(0); VLD(0); VLD(1); LW(8);
    MM(0, 0, pa0); mx = MX3(p0[0], p0[1], p0[2]); mx = MX3(mx, p0[3], p0[4]); mx = MX3(mx, p0[5], p0[6]); mx = MX3(mx, p0[7], p0[8]); SBAR();
    MM(0, 1, pa1); mx = MX3(mx, p0[9], p0[10]); mx = MX3(mx, p0[11], p0[12]); mx = MX3(mx, p0[13], p0[14]); mx = MX3(mx, p0[15], p1[0]); SBAR();
    MM(0, 2, pa2); mx = MX3(mx, p1[1], p1[2]); mx = MX3(mx, p1[3], p1[4]); mx = MX3(mx, p1[5], p1[6]); mx = MX3(mx, p1[7], p1[8]); SBAR();
    MM(0, 3, pa3); mx = MX3(mx, p1[9], p1[10]); mx = MX3(mx, p1[11], p1[12]); mx = MX3(mx, p1[13], p1[14]); mx = __builtin_fmaxf(mx, p1[15]); SBAR();
    VLD(2); LW(8);
    MM(1, 0, pa0); { auto rr = __builtin_amdgcn_permlane32_swap(__float_as_uint(mx), __float_as_uint(mx), false, false); mx = __builtin_fmaxf(__uint_as_float(rr[0]), __uint_as_float(rr[1])); }
        { const bool keep = __all((mx - m_reg) * SCALE <= THR); mn = keep ? m_reg : __builtin_fmaxf(m_reg, mx); al = __builtin_amdgcn_exp2f((m_reg - mn) * C2); m_reg = mn; mnL = -mn * C2; } SBAR();
#define FM4(P, B) do { P[B] = fmaf(P[B], C2, mnL); P[B + 1] = fmaf(P[B + 1], C2, mnL); P[B + 2] = fmaf(P[B + 2], C2, mnL); P[B + 3] = fmaf(P[B + 3], C2, mnL); } while (0)
#define EX2(P, B) do { P[B] = __builtin_amdgcn_exp2f(P[B]); P[B + 1] = __builtin_amdgcn_exp2f(P[B + 1]); } while (0)
    MM(1, 1, pa1); FM4(p0, 0); FM4(p0, 4); SBAR();
    MM(1, 2, pa2); FM4(p0, 8); FM4(p0, 12); SBAR();
    MM(1, 3, pa3); FM4(p1, 0); FM4(p1, 4); SBAR();
    VLD(3); LW(8);
    MM(2, 0, pa0); FM4(p1, 8); FM4(p1, 12); SBAR();
    MM(2, 1, pa1); EX2(p0, 0); EX2(p0, 2); SBAR();
    MM(2, 2, pa2); EX2(p0, 4); EX2(p0, 6); SBAR();
    MM(2, 3, pa3); EX2(p0, 8); EX2(p0, 10); SBAR();
    LW(0);
    MM(3, 0, pa0); EX2(p0, 12); EX2(p0, 14); SBAR();
    MM(3, 1, pa1); EX2(p1, 0); EX2(p1, 2); SBAR();
    MM(3, 2, pa2); EX2(p1, 4); EX2(p1, 6); SBAR();
    MM(3, 3, pa3); EX2(p1, 8); EX2(p1, 10); SBAR();
    al_out = al;
#undef EX2
#undef FM4
#undef MX3
#undef LW
#undef MM
#undef VF
#undef VLD
#undef TRRD
}
__device__ __forceinline__ void qkt_fin(f32x16& n0, f32x16& n1, const char* Kslot, int r32, int hi, const bf16x8* qr, f32x16& p0, f32x16& p1, bf16x8& pa0, bf16x8& pa1, bf16x8& pa2, bf16x8& pa3, float& l_reg, float al) {
    n0 = f32x16{}; n1 = f32x16{};
    const char* kb[4];
#pragma unroll
    for (int dd = 0; dd < 4; ++dd) kb[dd] = Kslot + koff(r32, 2 * dd + hi);
    bf16x8 kf[2][2];
#define KLD(d) do { const char* a_ = kb[(d) & 3] + ((d) >> 2) * 8192; kf[(d) & 1][0] = *reinterpret_cast<const bf16x8*>(a_); kf[(d) & 1][1] = *reinterpret_cast<const bf16x8*>(a_ + 32 * 128); } while (0)
#define QM(d) do { if ((d) + 1 < 12) KLD((d) + 1); n0 = __builtin_amdgcn_mfma_f32_32x32x16_bf16(kf[(d) & 1][0], qr[d], n0, 0, 0, 0); n1 = __builtin_amdgcn_mfma_f32_32x32x16_bf16(kf[(d) & 1][1], qr[d], n1, 0, 0, 0); SBAR(); } while (0)
#define PK4(P, B_, OUT) do { unsigned a0 = cvtpk(P[B_+0], P[B_+1]), a1 = cvtpk(P[B_+2], P[B_+3]); unsigned b0 = cvtpk(P[B_+4], P[B_+5]), b1 = cvtpk(P[B_+6], P[B_+7]); \
        auto r0 = __builtin_amdgcn_permlane32_swap(a0, b0, false, false); auto r1 = __builtin_amdgcn_permlane32_swap(a1, b1, false, false); \
        v4u w = {r0[0], r1[0], r0[1], r1[1]}; OUT = *reinterpret_cast<bf16x8*>(&w); } while (0)
    float ps;
    KLD(0); SBAR();
    QM(0); p1[12] = __builtin_amdgcn_exp2f(p1[12]); p1[13] = __builtin_amdgcn_exp2f(p1[13]); p1[14] = __builtin_amdgcn_exp2f(p1[14]); p1[15] = __builtin_amdgcn_exp2f(p1[15]); SBAR();
    QM(1); ps = (p0[0] + p0[1]) + (p0[2] + p0[3]); ps += (p0[4] + p0[5]) + (p0[6] + p0[7]); SBAR();
    QM(2); ps += (p0[8] + p0[9]) + (p0[10] + p0[11]); ps += (p0[12] + p0[13]) + (p0[14] + p0[15]); SBAR();
    QM(3); ps += (p1[0] + p1[1]) + (p1[2] + p1[3]); ps += (p1[4] + p1[5]) + (p1[6] + p1[7]); SBAR();
    QM(4); ps += (p1[8] + p1[9]) + (p1[10] + p1[11]); ps += (p1[12] + p1[13]) + (p1[14] + p1[15]); SBAR();
    QM(5); { auto rr = __builtin_amdgcn_permlane32_swap(__float_as_uint(ps), __float_as_uint(ps), false, false); ps = __uint_as_float(rr[0]) + __uint_as_float(rr[1]); } l_reg = l_reg * al + ps; SBAR();
    QM(6); PK4(p0, 0, pa0); SBAR();
    QM(7); PK4(p0, 8, pa1); SBAR();
    QM(8); PK4(p1, 0, pa2); SBAR();
    QM(9); PK4(p1, 8, pa3); SBAR();
    QM(10); QM(11);
#undef PK4
#undef QM
#undef KLD
}
__device__ __forceinline__ int kperm(int l) { return ((l & 7) << 1) | ((l >> 3) & 1) | (l & 48); }
__device__ __forceinline__ int kpiece(int tid) { return (tid >> 6) * 64 + kperm(tid & 63); }
__device__ __forceinline__ int vpiece(int tid, int i) { const int l = tid & 63, w = tid >> 6; return (4 * (w & 3) + (l & 3)) * 64 + (l >> 2) + 16 * ((w >> 2) + 2 * i); }
struct BlockRef { const bf16_t* Q; const bf16_t* K; const bf16_t* V; bf16_t* O; int P0; };
#define VMW() asm volatile("s_waitcnt vmcnt(0)" ::: "memory")
__device__ __forceinline__ void dma16(const void* gsrc, char* ldst) { __builtin_amdgcn_global_load_lds((const unsigned*)gsrc, (__attribute__((address_space(3))) unsigned*)(uintptr_t)ldst, 16, 0, 0); }
#define WAITBAR(N) asm volatile("s_waitcnt vmcnt(" #N ") lgkmcnt(0)\n\ts_barrier" ::: "memory")
template <int ABL>
__device__ __forceinline__ void attn_block(const BlockRef& cur, char* lds) {
    int tid_ = threadIdx.x; asm volatile("" : "+v"(tid_));
    const int tid = tid_, wid = __builtin_amdgcn_readfirstlane(tid >> 6), lane = tid & 63, r32 = lane & 31, hi = lane >> 5;
    const int NT = (cur.P0 + QB - 1) / KVBLK + 1;
    const int qlo = cur.P0 + wid * QBLK;
    char* V_lds = lds; char* K_lds = lds + 3 * SHM_V;
    float* ws = (float*)(lds + 3 * SHM_V + 3 * SHM_K) + wid * 64; float* li_l = ws, * al_l = ws + 32;
    float m_reg = -1e30f, l_reg = 0; f32x16 o[4] = {};
    const int krow = 8 * wid + (lane >> 3), ksx = (lane & 7) ^ ((krow >> 1) & 7), ksrc = (ksx * 64 + krow) * 8;
    int vsrc[2];
#pragma unroll
    for (int i = 0; i < 2; ++i) { const int st = 2 * (wid + 8 * i) + (lane >> 5), kk = (st >> 2) * 8 + ((lane & 31) >> 2), c = (st & 3) * 32 + (lane & 3) * 8;
        const int k = (kk & ~0xC) | ((kk & 4) << 1) | ((kk & 8) >> 1); vsrc[i] = ((c >> 3) * 64 + k) * 8; }
    const int vbase = (int)(uintptr_t)V_lds;
    const bf16_t* Kh = cur.K; const bf16_t* Vh = cur.V;
#define DMA_K(t, slot) do { const bf16_t* kt_ = Kh + (size_t)(t) * KVBLK * DQ + ksrc; char* kd_ = K_lds + (slot) * SHM_K + wid * 1024; \
        dma16(kt_, kd_); dma16(kt_ + 4096, kd_ + 8192); dma16(kt_ + 8192, kd_ + 16384); } while (0)
#define DMA_V(t, slot) do { const bf16_t* vt_ = Vh + (size_t)(t) * KVBLK * DVV; char* vd_ = V_lds + (slot) * SHM_V + wid * 1024; dma16(vt_ + vsrc[0], vd_); dma16(vt_ + vsrc[1], vd_ + 8192); } while (0)
    bf16x8 qr[12], pa0, pa1, pa2, pa3; f32x16 p0, p1;
#pragma unroll
    for (int d0 = 0; d0 < 12; ++d0) qr[d0] = ld8(cur.Q + (size_t)wid * QBLK * DQ + (2 * d0 + hi) * 256 + r32 * 8);
    DMA_K(0, 0); DMA_K(1, 1); DMA_V(0, 0);
    WAITBAR(0);
    int s0 = 0, s1 = 1, s2 = 2;
    f32x16 q0, q1; float alp = 1.f;
#define RESC(a) do { if (__any((a) < 1.f)) { asm volatile("" ::: "memory"); if (hi == 0) al_l[r32] = (a); asm volatile("s_waitcnt lgkmcnt(0)" ::: "memory"); \
        _Pragma("unroll") for (int d_ = 0; d_ < 4; ++d_) _Pragma("unroll") for (int r = 0; r < 16; ++r) o[d_][r] *= al_l[crow(r, hi)]; } } while (0)
#define ROT3() do { const int tmp = s0; s0 = s1; s1 = s2; s2 = tmp; } while (0)
    {
        DMA_K(2, s2); DMA_V(1, s1);
        SBAR(); qkt<0>(p0, p1, K_lds + s0 * SHM_K, r32, hi, qr); SBAR();
        if (KVBLK - 1 > qlo) { asm volatile("" ::: "memory"); mask_tile(p0, p1, qlo + r32 - 4 * hi); }
        pv_sm<false>(o, 0, pa0, pa1, pa2, pa3, p0, p1, m_reg, alp);
        WAITBAR(5); ROT3(); }
#define STEP(t, N0, N1, O0, O1) do { \
        if ((t) + 2 < NT) DMA_K((t) + 2, s2); \
        if ((t) + 1 < NT) DMA_V((t) + 1, s1); \
        SBAR(); qkt_fin(N0, N1, K_lds + s0 * SHM_K, r32, hi, qr, O0, O1, pa0, pa1, pa2, pa3, l_reg, alp); SBAR(); \
        { const int kb_ = (t) * KVBLK; if (kb_ + KVBLK - 1 > qlo) { asm volatile("" ::: "memory"); mask_tile(N0, N1, qlo + r32 - 4 * hi - kb_); } } \
        { int ll = tid; asm volatile("" : "+v"(ll)); pv_sm<true>(o, vbase + v_rd_base(ll & 63) + s2 * SHM_V, pa0, pa1, pa2, pa3, N0, N1, m_reg, alp); } \
        RESC(alp); \
        if ((t) + 2 < NT) WAITBAR(5); else WAITBAR(0); \
        ROT3(); } while (0)
#pragma unroll 1
    for (int t = 1; t + 1 < NT; t += 2) { STEP(t, q0, q1, p0, p1); STEP(t + 1, p0, p1, q0, q1); }
    STEP(NT - 1, q0, q1, p0, p1);
#undef STEP
    {
        q1[12] = __builtin_amdgcn_exp2f(q1[12]); q1[13] = __builtin_amdgcn_exp2f(q1[13]); q1[14] = __builtin_amdgcn_exp2f(q1[14]); q1[15] = __builtin_amdgcn_exp2f(q1[15]);
        float ps = 0;
#pragma unroll
        for (int r = 0; r < 16; ++r) ps += q0[r];
#pragma unroll
        for (int r = 0; r < 16; ++r) ps += q1[r];
        { auto rr = __builtin_amdgcn_permlane32_swap(__float_as_uint(ps), __float_as_uint(ps), false, false); ps = __uint_as_float(rr[0]) + __uint_as_float(rr[1]); }
        l_reg = l_reg * alp + ps;
#define PK4(P, B_, OUT) do { unsigned a0 = cvtpk(P[B_+0], P[B_+1]), a1 = cvtpk(P[B_+2], P[B_+3]); unsigned b0 = cvtpk(P[B_+4], P[B_+5]), b1 = cvtpk(P[B_+6], P[B_+7]); \
        auto r0 = __builtin_amdgcn_permlane32_swap(a0, b0, false, false); auto r1 = __builtin_amdgcn_permlane32_swap(a1, b1, false, false); \
        v4u w = {r0[0], r1[0], r0[1], r1[1]}; OUT = *reinterpret_cast<bf16x8*>(&w); } while (0)
        PK4(q0, 0, pa0); PK4(q0, 8, pa1); PK4(q1, 0, pa2); PK4(q1, 8, pa3);
#undef PK4
    }
#undef RESC
#undef ROT3
#undef DMA_K
#undef DMA_V
    { int ll = tid; asm volatile("" : "+v"(ll)); pv_tile<0>(o, vbase + v_rd_base(ll & 63) + s2 * SHM_V, pa0, pa1, pa2, pa3); }
    if (hi == 0) li_l[r32] = l_reg; asm volatile("s_waitcnt lgkmcnt(0)" ::: "memory");
    float rli[16];
#pragma unroll
    for (int r = 0; r < 16; ++r) rli[r] = __builtin_amdgcn_rcpf(li_l[crow(r, hi)]);
    bf16_t* Ow = cur.O + (size_t)(wid * QBLK) * OPITCH;
#pragma unroll
    for (int r = 0; r < 16; ++r) { const int orow = crow(r, hi);
#pragma unroll
        for (int d0 = 0; d0 < 4; ++d0) { const float v = o[d0][r] * rli[r]; const float vn = __shfl_xor(v, 1);
            if ((r32 & 1) == 0) *(unsigned*)(Ow + (size_t)orow * OPITCH + d0 * 32 + r32) = cvtpk(v, vn); } }
    WAITBAR(0);
}
#undef WAITBAR
#undef VMW
#undef SBAR
__device__ __forceinline__ BlockRef make_ref(int L, int pass, const bf16_t* Q, const bf16_t* K, const bf16_t* V, bf16_t* O) {
    const int bh = L >> 4, x = L & 15, qb = pass ? 31 - x : x, b = bh >> 2, h = bh & 3;
    BlockRef r; r.Q = Q + ((size_t)bh * 8192 + (size_t)qb * QB) * DQ; r.K = K + (size_t)bh * 8192 * DQ; r.V = V + (size_t)bh * 8192 * DVV;
    r.O = O + ((size_t)b * 8192 + (size_t)qb * QB) * OPITCH + h * DVV; r.P0 = qb * QB; return r;
}
template <int ABL>
__device__ __forceinline__ void attn_phase(char* lds, const bf16_t* Q, const bf16_t* K, const bf16_t* V, bf16_t* O, int G, int bid) {
    for (int L = bid; L < 256; L += G)
#pragma unroll 1
        for (int pass = 0; pass < 2; ++pass) { const BlockRef cur = make_ref(L, pass, Q, K, V, O); attn_block<ABL>(cur, lds); }
}
}
namespace prj {
__device__ __forceinline__ int crow(int r, int hi) { return (r & 3) + 8 * (r >> 2) + 4 * hi; }
__device__ __forceinline__ float swap_add(float v) { auto rr = __builtin_amdgcn_permlane32_swap(__float_as_uint(v), __float_as_uint(v), false, false); return __uint_as_float(rr[0]) + __uint_as_float(rr[1]); }
__device__ __forceinline__ float sumsq8(bf16x8 v) { float s = 0.f;
#pragma unroll
    for (int j = 0; j < 8; ++j) { const float f = bf2f((bf16_t)v[j]); s += f * f; } return s; }
__device__ __forceinline__ bf16x8 ldg8(const bf16_t* p) { return *reinterpret_cast<const bf16x8*>(p); }
__device__ __forceinline__ const bf16_t* projt(const unsigned char* ws, int t, int col) { return (const bf16_t*)(ws + WSX_B) + ((size_t)((t >> 5) * 192 + (col >> 3)) * 32 + (t & 31)) * 8 + (col & 7); }
__device__ __forceinline__ v2u pack4(float a, float b, float c, float d) { return (v2u){cvtpk(a, b), cvtpk(c, d)}; }

__device__ __forceinline__ void stage_weights(const unsigned char* src, LAS unsigned char* wl, int nkb, int wave, int lane) {
    __syncthreads();
    for (int i = wave; i < nkb; i += NWAVES) __builtin_amdgcn_global_load_lds((const unsigned*)(src + (size_t)i * 1024 + lane * 16), (LAS unsigned*)(wl + i * 1024), 16, 0, 0);
    asm volatile("s_waitcnt vmcnt(0)" ::: "memory");
    __syncthreads();
}
__device__ __forceinline__ void stage_weights2(const unsigned char* src0, const unsigned char* src1, LAS unsigned char* wl, int wave, int lane) {
    __syncthreads();
    for (int i = wave; i < 32; i += NWAVES) { __builtin_amdgcn_global_load_lds((const unsigned*)(src0 + (size_t)i * 1024 + lane * 16), (LAS unsigned*)(wl + i * 1024), 16, 0, 0);
                                              __builtin_amdgcn_global_load_lds((const unsigned*)(src1 + (size_t)i * 1024 + lane * 16), (LAS unsigned*)(wl + (32 + i) * 1024), 16, 0, 0); }
    asm volatile("s_waitcnt vmcnt(0)" ::: "memory");
    __syncthreads();
}
__device__ __forceinline__ void unit_q(const Inputs& I, unsigned char* ws, LAS unsigned char* wl, int wave, int grp, int lane) {
    const int r32 = lane & 31, hi = lane >> 5, t = grp * 32 + r32, b = t >> 13, s = t & 8191;
    const bf16_t* pr = projt(ws, t, C_QLAT + 8 * hi);
    float ssq = 0.f; bf16x8 bq[16];
#pragma unroll
    for (int ks = 0; ks < 16; ++ks) { bq[ks] = ldg8(pr + 512 * ks); ssq += sumsq8(bq[ks]); }
    const float msq = swap_add(ssq) * (1.f / 256.f) + EPS;
    const LAS bf16x8* WQF = (const LAS bf16x8*)wl + lane;
    const float* cs = (const float*)(ws + WSX_CS) + (size_t)t * 64;
#pragma unroll 1
    for (int h = 0; h < 4; ++h) {
        stage_weights(ws + WSX_WQF + (size_t)h * 96 * 1024, wl, 96, wave, lane);
        f32x16 acc[6];
#pragma unroll
        for (int nb = 0; nb < 6; ++nb) acc[nb] = f32x16{};
#pragma unroll
        for (int k0 = 0; k0 < 16; k0 += 2) { bf16x8 wf[12];
#pragma unroll
            for (int i = 0; i < 2; ++i)
#pragma unroll
                for (int nb = 0; nb < 6; ++nb) wf[i * 6 + nb] = WQF[(nb * 16 + k0 + i) * 64];
#pragma unroll
            for (int i = 0; i < 2; ++i)
#pragma unroll
                for (int nb = 0; nb < 6; ++nb) acc[nb] = __builtin_amdgcn_mfma_f32_32x32x16_bf16(wf[i * 6 + nb], bq[k0 + i], acc[nb], 0, 0, 0);
            asm volatile("" ::: "memory"); }
        float ss = 0.f;
#pragma unroll
        for (int nb = 0; nb < 6; ++nb)
#pragma unroll
            for (int r = 0; r < 16; ++r) ss += acc[nb][r] * acc[nb][r];
        const float rs = rsqrtf(swap_add(ss) * (1.f / 192.f) + EPS * msq);
        bf16_t* qp = (bf16_t*)(ws + WSX_Q) + ((size_t)((b * 4 + h) * 256 + (s >> 5)) * 24) * 256 + r32 * 8 + 4 * hi;
#pragma unroll
        for (int nb = 0; nb < 4; ++nb)
#pragma unroll
            for (int q = 0; q < 4; ++q) { const int n = 32 * nb + 8 * q + 4 * hi; const f32x4 g = *(const f32x4*)(I.q_norm + n);
                *(v2u*)(qp + (4 * nb + q) * 256) = pack4(acc[nb][4 * q] * rs * g[0], acc[nb][4 * q + 1] * rs * g[1], acc[nb][4 * q + 2] * rs * g[2], acc[nb][4 * q + 3] * rs * g[3]); asm volatile("" ::: "memory"); }
#pragma unroll
        for (int q = 0; q < 4; ++q) { const int j = 8 * q + 4 * hi; const f32x4 g1 = *(const f32x4*)(I.q_norm + 128 + j), g2 = *(const f32x4*)(I.q_norm + 160 + j);
            const f32x4 c = *(const f32x4*)(cs + j), sn = *(const f32x4*)(cs + 32 + j);
            float o1[4], o2[4];
#pragma unroll
            for (int i = 0; i < 4; ++i) { const float x1 = acc[4][4 * q + i] * rs * g1[i], x2 = acc[5][4 * q + i] * rs * g2[i]; o1[i] = x1 * c[i] - x2 * sn[i]; o2[i] = x2 * c[i] + x1 * sn[i]; }
            *(v2u*)(qp + (16 + q) * 256) = pack4(o1[0], o1[1], o1[2], o1[3]); *(v2u*)(qp + (20 + q) * 256) = pack4(o2[0], o2[1], o2[2], o2[3]); }
    }
}
__device__ __forceinline__ void unit_kv(const Inputs& I, unsigned char* ws, LAS unsigned char* wl, int wave, int grp, int lane) {
    const int r32 = lane & 31, hi = lane >> 5, t = grp * 32 + r32, b = t >> 13, s = t & 8191;
    bf16x8 bk[8]; float ssq = 0.f;
#pragma unroll
    for (int ks = 0; ks < 8; ++ks) { bk[ks] = ldg8(projt(ws, t, C_KVLAT + 8 * hi) + 512 * ks); ssq += sumsq8(bk[ks]); }
    const float rstd = rsqrtf(swap_add(ssq) * (1.f / 128.f) + EPS);
    float kr1[16], kr2[16]; float ssr = 0.f;
#pragma unroll
    for (int q = 0; q < 4; ++q) { const int j = 8 * q + 4 * hi; const v2u a = *(const v2u*)projt(ws, t, C_KROPE + j), c = *(const v2u*)projt(ws, t, C_KROPE + 32 + j);
        kr1[4 * q] = __uint_as_float(a.x << 16); kr1[4 * q + 1] = __uint_as_float(a.x & 0xffff0000u); kr1[4 * q + 2] = __uint_as_float(a.y << 16); kr1[4 * q + 3] = __uint_as_float(a.y & 0xffff0000u);
        kr2[4 * q] = __uint_as_float(c.x << 16); kr2[4 * q + 1] = __uint_as_float(c.x & 0xffff0000u); kr2[4 * q + 2] = __uint_as_float(c.y << 16); kr2[4 * q + 3] = __uint_as_float(c.y & 0xffff0000u); }
#pragma unroll
    for (int r = 0; r < 16; ++r) ssr += kr1[r] * kr1[r] + kr2[r] * kr2[r];
    const LAS bf16x8* WKVF = (const LAS bf16x8*)wl + lane;
    const float* cs = (const float*)(ws + WSX_CS) + (size_t)t * 64;
#pragma unroll 1
    for (int h = 0; h < 4; ++h) {
        stage_weights(ws + WSX_WKVF + (size_t)h * 64 * 1024, wl, 64, wave, lane);
        bf16_t* kp = (bf16_t*)(ws + WSX_K) + ((size_t)((b * 4 + h) * 128 + (s >> 6)) * 24) * 512 + (s & 63) * 8 + 4 * hi;
        bf16_t* vp = (bf16_t*)(ws + WSX_V) + ((size_t)((b * 4 + h) * 128 + (s >> 6)) * 16) * 512 + (s & 63) * 8 + 4 * hi;
        f32x16 acc[4];
#pragma unroll
        for (int nb = 0; nb < 4; nb += 2) { acc[nb] = f32x16{}; acc[nb + 1] = f32x16{}; bf16x8 wf[16];
#pragma unroll
            for (int i = 0; i < 16; ++i) wf[i] = WKVF[(nb * 8 + i) * 64];
#pragma unroll
            for (int i = 0; i < 8; ++i) acc[nb] = __builtin_amdgcn_mfma_f32_32x32x16_bf16(wf[i], bk[i], acc[nb], 0, 0, 0);
#pragma unroll
            for (int i = 0; i < 8; ++i) acc[nb + 1] = __builtin_amdgcn_mfma_f32_32x32x16_bf16(wf[8 + i], bk[i], acc[nb + 1], 0, 0, 0);
            }
        float ss = 0.f;
#pragma unroll
        for (int nb = 0; nb < 4; ++nb)
#pragma unroll
            for (int r = 0; r < 16; ++r) ss += acc[nb][r] * acc[nb][r];
        const float rs = rsqrtf(swap_add(ss * rstd * rstd + ssr) * (1.f / 192.f) + EPS), rk = rs * rstd;
#pragma unroll
        for (int nb = 0; nb < 4; ++nb)
#pragma unroll
            for (int q = 0; q < 4; ++q) { const int n = 32 * nb + 8 * q + 4 * hi; const f32x4 g = *(const f32x4*)(I.k_norm + n);
                *(v2u*)(kp + (4 * nb + q) * 512) = pack4(acc[nb][4 * q] * rk * g[0], acc[nb][4 * q + 1] * rk * g[1], acc[nb][4 * q + 2] * rk * g[2], acc[nb][4 * q + 3] * rk * g[3]); }
#pragma unroll
        for (int q = 0; q < 4; ++q) { const int j = 8 * q + 4 * hi; const f32x4 g1 = *(const f32x4*)(I.k_norm + 128 + j), g2 = *(const f32x4*)(I.k_norm + 160 + j);
            const f32x4 c = *(const f32x4*)(cs + j), sn = *(const f32x4*)(cs + 32 + j);
            float o1[4], o2[4];
#pragma unroll
            for (int i = 0; i < 4; ++i) { const float x1 = kr1[4 * q + i] * rs * g1[i], x2 = kr2[4 * q + i] * rs * g2[i]; o1[i] = x1 * c[i] - x2 * sn[i]; o2[i] = x2 * c[i] + x1 * sn[i]; }
            *(v2u*)(kp + (16 + q) * 512) = pack4(o1[0], o1[1], o1[2], o1[3]); *(v2u*)(kp + (20 + q) * 512) = pack4(o2[0], o2[1], o2[2], o2[3]); }
        asm volatile("" ::: "memory");
#pragma unroll
        for (int nb = 0; nb < 4; nb += 2) { acc[nb] = f32x16{}; acc[nb + 1] = f32x16{}; bf16x8 wf[16];
#pragma unroll
            for (int i = 0; i < 16; ++i) wf[i] = WKVF[((4 + nb) * 8 + i) * 64];
#pragma unroll
            for (int i = 0; i < 8; ++i) acc[nb] = __builtin_amdgcn_mfma_f32_32x32x16_bf16(wf[i], bk[i], acc[nb], 0, 0, 0);
#pragma unroll
            for (int i = 0; i < 8; ++i) acc[nb + 1] = __builtin_amdgcn_mfma_f32_32x32x16_bf16(wf[8 + i], bk[i], acc[nb + 1], 0, 0, 0);
            }
#pragma unroll
        for (int nb = 0; nb < 4; ++nb)
#pragma unroll
            for (int q = 0; q < 4; ++q) { const int n = 32 * nb + 8 * q + 4 * hi;
                *(v2u*)(vp + (4 * nb + q) * 512) = pack4(acc[nb][4 * q] * rstd, acc[nb][4 * q + 1] * rstd, acc[nb][4 * q + 2] * rstd, acc[nb][4 * q + 3] * rstd); }
        asm volatile("" ::: "memory");
    }
}
#define LRU_SCAN_STEP(CTRL) asm volatile("s_nop 1\n\t" \
    "v_fmac_f32_dpp %0, %0, %16 " CTRL "\n\tv_fmac_f32_dpp %1, %1, %17 " CTRL "\n\tv_fmac_f32_dpp %2, %2, %18 " CTRL "\n\tv_fmac_f32_dpp %3, %3, %19 " CTRL "\n\t" \
    "v_fmac_f32_dpp %4, %4, %20 " CTRL "\n\tv_fmac_f32_dpp %5, %5, %21 " CTRL "\n\tv_fmac_f32_dpp %6, %6, %22 " CTRL "\n\tv_fmac_f32_dpp %7, %7, %23 " CTRL "\n\t" \
    "v_fmac_f32_dpp %8, %8, %24 " CTRL "\n\tv_fmac_f32_dpp %9, %9, %25 " CTRL "\n\tv_fmac_f32_dpp %10, %10, %26 " CTRL "\n\tv_fmac_f32_dpp %11, %11, %27 " CTRL "\n\t" \
    "v_fmac_f32_dpp %12, %12, %28 " CTRL "\n\tv_fmac_f32_dpp %13, %13, %29 " CTRL "\n\tv_fmac_f32_dpp %14, %14, %30 " CTRL "\n\tv_fmac_f32_dpp %15, %15, %31 " CTRL "\n\t" \
    "v_mul_f32_dpp %16, %16, %16 " CTRL "\n\tv_mul_f32_dpp %17, %17, %17 " CTRL "\n\tv_mul_f32_dpp %18, %18, %18 " CTRL "\n\tv_mul_f32_dpp %19, %19, %19 " CTRL "\n\t" \
    "v_mul_f32_dpp %20, %20, %20 " CTRL "\n\tv_mul_f32_dpp %21, %21, %21 " CTRL "\n\tv_mul_f32_dpp %22, %22, %22 " CTRL "\n\tv_mul_f32_dpp %23, %23, %23 " CTRL "\n\t" \
    "v_mul_f32_dpp %24, %24, %24 " CTRL "\n\tv_mul_f32_dpp %25, %25, %25 " CTRL "\n\tv_mul_f32_dpp %26, %26, %26 " CTRL "\n\tv_mul_f32_dpp %27, %27, %27 " CTRL "\n\t" \
    "v_mul_f32_dpp %28, %28, %28 " CTRL "\n\tv_mul_f32_dpp %29, %29, %29 " CTRL "\n\tv_mul_f32_dpp %30, %30, %30 " CTRL "\n\tv_mul_f32_dpp %31, %31, %31 " CTRL "\n\ts_nop 1" \
    : "+v"(bv[0]), "+v"(bv[1]), "+v"(bv[2]), "+v"(bv[3]), "+v"(bv[4]), "+v"(bv[5]), "+v"(bv[6]), "+v"(bv[7]), "+v"(bv[8]), "+v"(bv[9]), "+v"(bv[10]), "+v"(bv[11]), "+v"(bv[12]), "+v"(bv[13]), "+v"(bv[14]), "+v"(bv[15]), \
      "+v"(av[0]), "+v"(av[1]), "+v"(av[2]), "+v"(av[3]), "+v"(av[4]), "+v"(av[5]), "+v"(av[6]), "+v"(av[7]), "+v"(av[8]), "+v"(av[9]), "+v"(av[10]), "+v"(av[11]), "+v"(av[12]), "+v"(av[13]), "+v"(av[14]), "+v"(av[15]))
constexpr int PRJ_TAB = 96 * 1024;
__device__ __forceinline__ void lru_tables(Frame& F, const Inputs& I) {
    LAS float* tb = (LAS float*)(F.lds + PRJ_TAB);
    for (int i = ((int)threadIdx.x); i < 2048; i += 512) tb[i] = I.conv_w[i];
    { const int c = ((int)threadIdx.x); tb[2048 + c] = I.conv_b[c]; tb[2560 + c] = -1.4426950408889634f * I.lru_ba[c]; tb[3072 + c] = -1.4426950408889634f * I.lru_bx[c];
      tb[3584 + c] = -8.f * 1.4426950408889634f * ((const float*)(F.ws + WSX_SP))[c]; }
    __syncthreads();
}
__device__ __forceinline__ void unit_lru(const Inputs& I, unsigned char* ws, LAS unsigned char* wl, int wave, int grp, int hp, int lane) {
    const int r32 = lane & 31, hi = lane >> 5, t = grp * 32 + r32, s = t & 8191;
    const bool reset = I.positions[t] == 0;
    const LAS float* tbl = (const LAS float*)(wl + PRJ_TAB);
    int xt[4]; float xz[4];
#pragma unroll
    for (int j = 0; j < 4; ++j) { const bool ok = s - 3 + j >= 0; xt[j] = ok ? t - 3 + j : t; xz[j] = ok ? 1.f : 0.f; }
    bf16_t* HL = (bf16_t*)(ws + WSX_D) + (size_t)t * 512; bf16_t* PC = HL + (size_t)NTOK * 512;
    float* SUMA = (float*)(ws + WSX_SUMA) + (size_t)grp * 512; float* SUMB = (float*)(ws + WSX_SUMB) + (size_t)grp * 512;
#pragma unroll 1
    for (int h = 2 * hp; h < 2 * hp + 2; ++h) {
        stage_weights2(ws + WSX_WAF + (size_t)h * 32 * 1024, ws + WSX_WXF + (size_t)h * 32 * 1024, wl, wave, lane);
        bf16x8 xf[8];
#pragma unroll
        for (int k2 = 0; k2 < 8; k2 += 2) { v2u xx[2][2][4];
#pragma unroll
            for (int kk = 0; kk < 2; ++kk)
#pragma unroll
                for (int j4 = 0; j4 < 2; ++j4)
#pragma unroll
                    for (int j = 0; j < 4; ++j) xx[kk][j4][j] = *(const v2u*)projt(ws, xt[j], C_XLRU + 128 * h + 32 * ((k2 + kk) >> 1) + 16 * ((k2 + kk) & 1) + 8 * j4 + 4 * hi);
#pragma unroll
            for (int kk = 0; kk < 2; ++kk) { unsigned w[4];
#pragma unroll
                for (int j4 = 0; j4 < 2; ++j4) { const int C = 128 * h + 32 * ((k2 + kk) >> 1) + 16 * ((k2 + kk) & 1) + 8 * j4 + 4 * hi;
                    f32x4 v = *(const LAS f32x4*)(tbl + 2048 + C);
#pragma unroll
                    for (int j = 0; j < 4; ++j) { const v2u x = xx[kk][j4][j]; const f32x4 cw = *(const LAS f32x4*)(tbl + j * 512 + C) * xz[j];
                        v[0] += cw[0] * __uint_as_float(x.x << 16); v[1] += cw[1] * __uint_as_float(x.x & 0xffff0000u); v[2] += cw[2] * __uint_as_float(x.y << 16); v[3] += cw[3] * __uint_as_float(x.y & 0xffff0000u); }
                    w[2 * j4] = cvtpk(v[0], v[1]); w[2 * j4 + 1] = cvtpk(v[2], v[3]); }
                v4u ww = {w[0], w[1], w[2], w[3]}; xf[k2 + kk] = *reinterpret_cast<bf16x8*>(&ww); }
            asm volatile("" ::: "memory"); }
        const LAS bf16x8* WAF = (const LAS bf16x8*)wl + lane; const LAS bf16x8* WXF = (const LAS bf16x8*)(wl + 32 * 1024) + lane;
#pragma unroll
        for (int nb = 0; nb < 4; ++nb) {
            f32x16 aa = f32x16{}, bb = f32x16{};
            { bf16x8 wf[16];
#pragma unroll
              for (int i = 0; i < 8; ++i) { wf[i] = WAF[(nb * 8 + i) * 64]; wf[8 + i] = WXF[(nb * 8 + i) * 64]; }
#pragma unroll
              for (int i = 0; i < 8; ++i) aa = __builtin_amdgcn_mfma_f32_32x32x16_bf16(wf[i], xf[i], aa, 0, 0, 0);
#pragma unroll
              for (int i = 0; i < 8; ++i) bb = __builtin_amdgcn_mfma_f32_32x32x16_bf16(wf[8 + i], xf[i], bb, 0, 0, 0);
              }
            float av[16], bv[16];
#pragma unroll
            for (int q = 0; q < 4; ++q) { const int C = 128 * h + 32 * nb + 8 * q + 4 * hi;
                const f32x4 ba = *(const LAS f32x4*)(tbl + 2560 + C), bx = *(const LAS f32x4*)(tbl + 3072 + C), sp = *(const LAS f32x4*)(tbl + 3584 + C);
#pragma unroll
                for (int i = 0; i < 4; ++i) { const int r = 4 * q + i;
                    const float rg = __builtin_amdgcn_rcpf(1.f + __builtin_amdgcn_exp2f(fmaf(aa[r], -1.4426950408889634f, ba[i])));
                    const float ig = __builtin_amdgcn_rcpf(1.f + __builtin_amdgcn_exp2f(fmaf(bb[r], -1.4426950408889634f, bx[i])));
                    float a = __builtin_amdgcn_exp2f(rg * sp[i]), mult = __builtin_amdgcn_sqrtf(fmaxf(fmaf(-a, a, 1.f), 0.f));
                    if (reset) { a = 0.f; mult = 1.f; }
                    const float xc = bf2f((bf16_t)xf[2 * nb + (r >> 3)][4 * ((r >> 2) & 1) + (r & 3)]);
                    av[r] = a; bv[r] = mult * ig * xc; } }
            LRU_SCAN_STEP("row_shr:1 row_mask:0xf bank_mask:0xf"); LRU_SCAN_STEP("row_shr:2 row_mask:0xf bank_mask:0xf"); LRU_SCAN_STEP("row_shr:4 row_mask:0xf bank_mask:0xf");
            LRU_SCAN_STEP("row_shr:8 row_mask:0xf bank_mask:0xf"); LRU_SCAN_STEP("row_bcast:15 row_mask:0xa bank_mask:0xf");
#pragma unroll
            for (int q = 0; q < 4; ++q) { const int C = 128 * h + 32 * nb + 8 * q + 4 * hi;
                *(v2u*)(HL + C) = pack4(bv[4 * q], bv[4 * q + 1], bv[4 * q + 2], bv[4 * q + 3]);
                *(v2u*)(PC + C) = pack4(av[4 * q], av[4 * q + 1], av[4 * q + 2], av[4 * q + 3]);
                if (r32 == 31) { *(f32x4*)(SUMA + C) = (f32x4){av[4 * q], av[4 * q + 1], av[4 * q + 2], av[4 * q + 3]};
                                 *(f32x4*)(SUMB + C) = (f32x4){bv[4 * q], bv[4 * q + 1], bv[4 * q + 2], bv[4 * q + 3]}; } }
            asm volatile("" ::: "memory");
        }
    }
}
__device__ __forceinline__ void phase_proj(Frame& F, const Inputs& I, int kmask) {
    LAS unsigned char* wl = F.lds;
    lru_tables(F, I);
    const int b = F.vcu, G = F.G;
    if (kmask & 2) for (int u = b; u < 256; u += G) unit_lru(I, F.ws, wl, F.wave, (u >> 1) * 8 + F.wave, u & 1, ((int)(threadIdx.x & 63)));
    asm volatile("" ::: "memory");
    if (kmask & 1) for (int u = b; u < 128; u += G) unit_q(I, F.ws, wl, F.wave, u * 8 + F.wave, ((int)(threadIdx.x & 63)));
    asm volatile("" ::: "memory");
    if (kmask & 4) for (int u = (G == 256 ? b - 128 : b); u < 128; u += G) if (u >= 0) unit_kv(I, F.ws, wl, F.wave, u * 8 + F.wave, ((int)(threadIdx.x & 63)));
    __syncthreads();
}
__device__ __forceinline__ float gelu_t(float v) { const float u = 0.7978845608028654f * (v + 0.044715f * v * v * v); return v / (1.f + __expf(-2.f * u)); }
__device__ __forceinline__ void unpack8(v4u w, float* f) {
    f[0] = __uint_as_float(w.x << 16); f[1] = __uint_as_float(w.x & 0xffff0000u); f[2] = __uint_as_float(w.y << 16); f[3] = __uint_as_float(w.y & 0xffff0000u);
    f[4] = __uint_as_float(w.z << 16); f[5] = __uint_as_float(w.z & 0xffff0000u); f[6] = __uint_as_float(w.w << 16); f[7] = __uint_as_float(w.w & 0xffff0000u); }
__device__ __forceinline__ void phase_mix(Frame& F, const Inputs& I) {
    LAS float* carry = (LAS float*)F.lds;
    const float* SUMA = (const float*)(F.ws + WSX_SUMA); const float* SUMB = (const float*)(F.ws + WSX_SUMB);
    const bf16_t* HL = (const bf16_t*)(F.ws + WSX_D); const bf16_t* PC = HL + (size_t)NTOK * 512;
    const bf16_t* PROJ = (const bf16_t*)(F.ws + WSX_B); bf16_t* MIXED = (bf16_t*)(F.ws + WSX_E); const bf16_t* AO = (const bf16_t*)(F.ws + WSX_AO);
    const int nper = 1024 / F.G;
    const int c0 = F.vcu * nper, bfirst = (c0 >> 8) << 8;
    {
        float h = 0.f; const int c = ((int)threadIdx.x);
        int k = bfirst;
        for (; k + 16 <= c0; k += 16) { float a[16], bq[16];
#pragma unroll
            for (int i = 0; i < 16; ++i) { a[i] = SUMA[(size_t)(k + i) * 512 + c]; bq[i] = SUMB[(size_t)(k + i) * 512 + c]; }
#pragma unroll
            for (int i = 0; i < 16; ++i) h = a[i] * h + bq[i]; }
        for (; k < c0; k += 4) { float a[4], bq[4];
#pragma unroll
            for (int i = 0; i < 4; ++i) { a[i] = SUMA[(size_t)(k + i) * 512 + c]; bq[i] = SUMB[(size_t)(k + i) * 512 + c]; }
#pragma unroll
            for (int i = 0; i < 4; ++i) h = a[i] * h + bq[i]; }
        carry[c] = h; }
    __syncthreads();
    const int C = 8 * ((int)(threadIdx.x & 63));
    const f32x4 g0 = *(const f32x4*)(I.lru_out_norm + C), g1 = *(const f32x4*)(I.lru_out_norm + C + 4), q0 = *(const f32x4*)(I.attn_out_norm + C), q1 = *(const f32x4*)(I.attn_out_norm + C + 4);
    for (int k = c0; k < c0 + nper; ++k) {
        const int tb = k * 32 + F.wave * 4;
        v4u hl4[4], pc4[4], gg4[4], at4[4];
#pragma unroll
        for (int rr = 0; rr < 4; ++rr) { const size_t t = tb + rr; hl4[rr] = *(const v4u*)(HL + t * 512 + C); pc4[rr] = *(const v4u*)(PC + t * 512 + C);
            gg4[rr] = *(const v4u*)projt(F.ws, (int)t, C_GLRU + C); at4[rr] = *(const v4u*)(AO + t * 512 + C); }
        float cy[8]; *(f32x4*)cy = *(const LAS f32x4*)(carry + C); *(f32x4*)(cy + 4) = *(const LAS f32x4*)(carry + C + 4);
        float hl[8];
#pragma unroll
        for (int rr = 0; rr < 4; ++rr) { const size_t t = tb + rr;
            float a[8], p[8], g[8], v[8];
            unpack8(hl4[rr], a); unpack8(pc4[rr], p); unpack8(gg4[rr], g);
            float ss = 0.f;
#pragma unroll
            for (int j = 0; j < 8; ++j) { hl[j] = a[j] + p[j] * cy[j]; v[j] = hl[j] * gelu_t(g[j]); ss += v[j] * v[j]; }
            float rs = rsqrtf(wave_sum_f(ss) * (1.f / 512.f) + EPS);
            *(v4u*)(MIXED + t * 1024 + 512 + C) = (v4u){cvtpk(v[0] * rs * g0[0], v[1] * rs * g0[1]), cvtpk(v[2] * rs * g0[2], v[3] * rs * g0[3]), cvtpk(v[4] * rs * g1[0], v[5] * rs * g1[1]), cvtpk(v[6] * rs * g1[2], v[7] * rs * g1[3])};
            unpack8(at4[rr], a); ss = 0.f;
#pragma unroll
            for (int j = 0; j < 8; ++j) ss += a[j] * a[j];
            rs = rsqrtf(wave_sum_f(ss) * (1.f / 512.f) + EPS);
            *(v4u*)(MIXED + t * 1024 + C) = (v4u){cvtpk(a[0] * rs * q0[0], a[1] * rs * q0[1]), cvtpk(a[2] * rs * q0[2], a[3] * rs * q0[3]), cvtpk(a[4] * rs * q1[0], a[5] * rs * q1[1]), cvtpk(a[6] * rs * q1[2], a[7] * rs * q1[3])};
        }
        __syncthreads();
        if (F.wave == 7) {
#pragma unroll
            for (int j = 0; j < 8; ++j) carry[8 * ((int)(threadIdx.x & 63)) + j] = hl[j]; }
        __syncthreads();
    }
}
}
namespace moe {
constexpr size_t WSX_RSTD = WSX_ROUTE + 800 * 1024;
constexpr size_t WSX_BB = WSX_ROUTE + 960 * 1024;
constexpr size_t WSX_WRFB = 70 * MiB;
constexpr size_t WSX_RBIAS = 70 * MiB + 512 * 1024;
constexpr int TP_OFF = LDSCTL_OFF + 512;
__device__ __forceinline__ int route_expert_of_n(int n) { const int a = (n >> 4) & 1, b = (n >> 3) & 1, h = (n >> 2) & 1, c = n & 3; return 8 * (2 * a + h) + 4 * b + c; }
__device__ __forceinline__ void router_fold(Frame& F, const Inputs& I) {
    const float* mod = (const float*)(F.ws + WS_MOD);
    const int gt = blockIdx.x * 512 + ((int)threadIdx.x), NGT = F.G * 512;
    v4u* WRFB = (v4u*)(F.ws + WSX_WRFB);
    for (int g = gt; g < 4 * 2 * 64 * 64; g += NGT) {
        const int lane = g & 63, ks = (g >> 6) & 63, nb = (g >> 12) & 1, b = g >> 13, hi = lane >> 5, n = lane & 31; float v[8];
#pragma unroll
        for (int j = 0; j < 8; ++j) { const int k = 16 * ks + 8 * hi + j; const float gg = I.norm2_g[k] * (1.f + mod[b * MODW + 4096 + k]);
            const float w = nb == 0 ? I.w_re[k * 32 + route_expert_of_n(n)] : (n < 4 ? I.w_rg[k * 4 + n] : 0.f); v[j] = w * gg; }
        WRFB[g] = (v4u){pk2(v[0], v[1]), pk2(v[2], v[3]), pk2(v[4], v[5]), pk2(v[6], v[7])};
    }
    {
        const int gw = blockIdx.x * NWAVES + F.wave;
        if (gw < 4 * 64) { const int b = gw >> 6, n = gw & 63; float s = 0.f;
            if (n < 36) { const int e = n < 32 ? route_expert_of_n(n) : n - 32; const float* W = n < 32 ? I.w_re + e : I.w_rg + e; const int ld = n < 32 ? 32 : 4;
                for (int k = ((int)(threadIdx.x & 63)); k < 1024; k += 64) s += mod[b * MODW + 3072 + k] * W[k * ld];
                s = wave_sum_f(s) + (n < 32 ? I.b_re[e] : I.b_rg[e]); }
            if (((int)(threadIdx.x & 63)) == 0) ((float*)(F.ws + WSX_RBIAS))[gw] = s; } }
}
__device__ __forceinline__ float swap_other(float v) { auto rr = __builtin_amdgcn_permlane32_swap(__float_as_uint(v), __float_as_uint(v), false, false); return (threadIdx.x & 32) ? __uint_as_float(rr[0]) : __uint_as_float(rr[1]); }
__device__ __forceinline__ void phase_route(Frame& F) {
    LAS int* lcnt = (LAS int*)(F.lds);
    if (((int)threadIdx.x) < 32) lcnt[((int)threadIdx.x)] = 0;
    __syncthreads();
    const bf16_t* x1 = (const bf16_t*)(F.ws + WSX_X1);
    int2* rexp = (int2*)(F.ws + WSX_ROUTE); float2* rw = (float2*)(F.ws + WSX_ROUTE + 256 * 1024); int2* rpos = (int2*)(F.ws + WSX_ROUTE + 512 * 1024);
    float* RSTD = (float*)(F.ws + WSX_RSTD);
    const int lane = ((int)(threadIdx.x & 63)), r32 = lane & 31, hi = lane >> 5;
    for (int grp = F.wave * F.G + blockIdx.x; grp < 1024; grp += F.G * NWAVES) {
        const int t = grp * 32 + r32, b = t >> 13;
        const bf16_t* xr = x1 + (size_t)t * DM + 8 * hi;
        const bf16x8* WF = (const bf16x8*)(F.ws + WSX_WRFB) + (size_t)b * 2 * 64 * 64 + lane;
        f32x16 a0 = f32x16{}, a1 = f32x16{}; float ss = 0.f;
#pragma unroll 8
        for (int ks = 0; ks < 64; ++ks) { const bf16x8 xb = *(const bf16x8*)(xr + 16 * ks);
#pragma unroll
            for (int j = 0; j < 8; ++j) { const float f = bf2f((bf16_t)xb[j]); ss += f * f; }
            a0 = __builtin_amdgcn_mfma_f32_32x32x16_bf16(WF[ks * 64], xb, a0, 0, 0, 0);
            a1 = __builtin_amdgcn_mfma_f32_32x32x16_bf16(WF[(64 + ks) * 64], xb, a1, 0, 0, 0); }
        { auto rr = __builtin_amdgcn_permlane32_swap(__float_as_uint(ss), __float_as_uint(ss), false, false); ss = __uint_as_float(rr[0]) + __uint_as_float(rr[1]); }
        const float rstd = rsqrtf(ss * (1.f / DM) + EPS);
        const float* rb = (const float*)(F.ws + WSX_RBIAS) + b * 64;
        float gl0 = a1[0] * rstd + rb[32], gl1 = a1[1] * rstd + rb[33], gl2 = a1[2] * rstd + rb[34], gl3 = a1[3] * rstd + rb[35];
        int gi = 0; float gm = gl0; if (gl1 > gm) { gm = gl1; gi = 1; } if (gl2 > gm) { gm = gl2; gi = 2; } if (gl3 > gm) { gm = gl3; gi = 3; }
        float gp = 1.f / (__expf(gl0 - gm) + __expf(gl1 - gm) + __expf(gl2 - gm) + __expf(gl3 - gm));
        { const float og = swap_other(__int_as_float(gi)), op = swap_other(gp); if (hi) { gi = __float_as_int(og); gp = op; } }
        const bool owner = (gi & 1) == hi; const int hsel = gi >> 1;
        float m0 = -3e38f, m1 = -3e38f; int e0 = 0, e1 = 0;
#pragma unroll
        for (int i = 0; i < 8; ++i) { const int n = 16 * hsel + 8 * (i >> 2) + 4 * hi + (i & 3);
            const float el = (hsel ? a0[8 + i] : a0[i]) * rstd + rb[n];
            if (el > m0) { m1 = m0; e1 = e0; m0 = el; e0 = i; } else if (el > m1) { m1 = el; e1 = i; } }
        if (owner) {
            const float p1 = __expf(m1 - m0); const int E0 = gi * 8 + e0, E1 = gi * 8 + e1;
            rexp[t] = make_int2(E0, E1); rw[t] = make_float2(gp / (1.f + p1), gp * p1 / (1.f + p1));
            const int k0 = __hip_atomic_fetch_add(lcnt + E0, 1, __ATOMIC_RELAXED, __HIP_MEMORY_SCOPE_WORKGROUP), k1 = __hip_atomic_fetch_add(lcnt + E1, 1, __ATOMIC_RELAXED, __HIP_MEMORY_SCOPE_WORKGROUP);
            rpos[t] = make_int2((int)(blockIdx.x << 16) | k0, (int)(blockIdx.x << 16) | k1);
            RSTD[t] = rstd; }
    }
    __syncthreads();
    if (((int)threadIdx.x) < 32) { const int n = lcnt[((int)threadIdx.x)]; int base = 0;
        if (n > 0) base = (int)__hip_atomic_fetch_add((unsigned*)(F.ctl + CW_CNT + 64 * ((int)threadIdx.x)), (unsigned)n, __ATOMIC_RELAXED, __HIP_MEMORY_SCOPE_AGENT);
        ((int*)(F.ws + WSX_BB))[blockIdx.x * 32 + ((int)threadIdx.x)] = base; }
    __syncthreads();
}
__device__ __forceinline__ void moe_tables(Frame& F) {
    LAS int* tp = (LAS int*)(F.lds + TP_OFF);
    if (((int)threadIdx.x) < 32) tp[64 + ((int)threadIdx.x)] = (int)__hip_atomic_load((unsigned*)(F.ctl + CW_CNT + 64 * ((int)threadIdx.x)), __ATOMIC_RELAXED, __HIP_MEMORY_SCOPE_AGENT);
    __syncthreads();
    if (((int)threadIdx.x) == 0) { int acc = 0; for (int e = 0; e < 32; ++e) { tp[e] = acc; acc += (tp[64 + e] + 255) >> 8; } tp[32] = acc; }
    __syncthreads();
}
__device__ __forceinline__ void phase_sort(Frame& F, const Inputs& I) {
    LAS float* Gs = (LAS float*)F.lds; LAS float* Ss = Gs + 4096;
    const float* mod = (const float*)(F.ws + WS_MOD);
#pragma unroll
    for (int i = ((int)threadIdx.x); i < 4096; i += 512) { const int b = i >> 10, k = i & 1023; Gs[i] = I.norm2_g[k] * (1.f + mod[b * MODW + 4096 + k]); Ss[i] = mod[b * MODW + 3072 + k]; }
    moe_tables(F);
    const LAS int* tp = (const LAS int*)(F.lds + TP_OFF);
    const int2* rexp = (const int2*)(F.ws + WSX_ROUTE); const int2* rpos = (const int2*)(F.ws + WSX_ROUTE + 512 * 1024); int2* rposF = (int2*)(F.ws + WSX_RPOSF);
    const float* RSTD = (const float*)(F.ws + WSX_RSTD); const int* BB = (const int*)(F.ws + WSX_BB);
    bf16_t* XS = (bf16_t*)(F.ws + WSX_XS);
    const int gw = F.vcu * NWAVES + F.wave, NGW = F.G * NWAVES;
    for (int m0 = gw; m0 < NTOK; m0 += 4 * NGW) {
        v4u xv[4][2]; int2 ee[4], pp[4]; float rstd[4]; int pos0[4], pos1[4];
        const int ln = ((int)(threadIdx.x & 63));
#pragma unroll
        for (int u = 0; u < 4; ++u) { const int m = m0 + u * NGW; ee[u] = rexp[m]; pp[u] = rpos[m]; rstd[u] = RSTD[m];
            const GAS v4u* xr = (const GAS v4u*)((const bf16_t*)(F.ws + WSX_X1) + (size_t)m * DM) + ln;
            xv[u][0] = xr[0]; xv[u][1] = xr[64]; }
#pragma unroll
        for (int u = 0; u < 4; ++u) { pos0[u] = tp[ee[u].x] * 256 + BB[(pp[u].x >> 16) * 32 + ee[u].x] + (pp[u].x & 0xffff); pos1[u] = tp[ee[u].y] * 256 + BB[(pp[u].y >> 16) * 32 + ee[u].y] + (pp[u].y & 0xffff); }
#pragma unroll
        for (int u = 0; u < 4; ++u) { const int m = m0 + u * NGW, b = m >> 13;
            GAS v4u* o0 = (GAS v4u*)(XS + (size_t)pos0[u] * DM) + ln; GAS v4u* o1 = (GAS v4u*)(XS + (size_t)pos1[u] * DM) + ln;
#pragma unroll
            for (int j = 0; j < 2; ++j) { float f[8]; prj::unpack8(xv[u][j], f); const int k0 = 512 * j + 8 * ln;
                const f32x4 g0 = *(const LAS f32x4*)(Gs + b * 1024 + k0), g1 = *(const LAS f32x4*)(Gs + b * 1024 + k0 + 4), s0 = *(const LAS f32x4*)(Ss + b * 1024 + k0), s1 = *(const LAS f32x4*)(Ss + b * 1024 + k0 + 4);
                const float r = rstd[u];
                const v4u w = {cvtpk(f[0] * r * g0[0] + s0[0], f[1] * r * g0[1] + s0[1]), cvtpk(f[2] * r * g0[2] + s0[2], f[3] * r * g0[3] + s0[3]),
                               cvtpk(f[4] * r * g1[0] + s1[0], f[5] * r * g1[1] + s1[1]), cvtpk(f[6] * r * g1[2] + s1[2], f[7] * r * g1[3] + s1[3])};
                o0[64 * j] = w; o1[64 * j] = w; }
            if (ln == 0) rposF[m] = make_int2(pos0[u], pos1[u]); }
    }
    __syncthreads();
}
__device__ __forceinline__ void phase_combine(Frame& F) {
    const float* mod = (const float*)(F.ws + WS_MOD);
    const float2* rw = (const float2*)(F.ws + WSX_ROUTE + 256 * 1024); const int2* rpos = (const int2*)(F.ws + WSX_RPOSF);
    const bf16_t* YS = (const bf16_t*)(F.ws + WSX_XS);
    const int gw = F.vcu * NWAVES + F.wave, NGW = F.G * NWAVES;
    for (int m0 = gw; m0 < NTOK; m0 += 4 * NGW) {
        int2 pp[4]; float2 ww[4]; v2u xv[4][4]; v2u ya[4][4], yb[4][4];
        const int ln = ((int)(threadIdx.x & 63));
#pragma unroll
        for (int u = 0; u < 4; ++u) { const int m = m0 + u * NGW; pp[u] = rpos[m]; ww[u] = rw[m];
            const GAS v2u* xr = (const GAS v2u*)((const bf16_t*)(F.ws + WSX_X1) + (size_t)m * DM) + ln;
#pragma unroll
            for (int j = 0; j < 4; ++j) xv[u][j] = xr[64 * j]; }
#pragma unroll
        for (int u = 0; u < 4; ++u) { const GAS v2u* y0 = (const GAS v2u*)(YS + (size_t)pp[u].x * DM) + ln; const GAS v2u* y1 = (const GAS v2u*)(YS + (size_t)pp[u].y * DM) + ln;
#pragma unroll
            for (int j = 0; j < 4; ++j) { ya[u][j] = y0[64 * j]; yb[u][j] = y1[64 * j]; } }
#pragma unroll
        for (int u = 0; u < 4; ++u) { const int m = m0 + u * NGW, b = m >> 13; GAS f32x4* xr = (GAS f32x4*)(F.out + (size_t)m * DM) + ln; const float* g2 = mod + b * MODW + 5120 + 4 * ln;
#pragma unroll
            for (int j = 0; j < 4; ++j) { const v2u a = ya[u][j], c = yb[u][j], xx = xv[u][j]; const f32x4 g = *(const f32x4*)(g2 + 256 * j); const float w0 = ww[u].x, w1 = ww[u].y;
                f32x4 y; y[0] = w0 * __uint_as_float(a.x << 16) + w1 * __uint_as_float(c.x << 16); y[1] = w0 * __uint_as_float(a.x & 0xffff0000u) + w1 * __uint_as_float(c.x & 0xffff0000u);
                y[2] = w0 * __uint_as_float(a.y << 16) + w1 * __uint_as_float(c.y << 16); y[3] = w0 * __uint_as_float(a.y & 0xffff0000u) + w1 * __uint_as_float(c.y & 0xffff0000u);
                const f32x4 xf = {__uint_as_float(xx.x << 16), __uint_as_float(xx.x & 0xffff0000u), __uint_as_float(xx.y << 16), __uint_as_float(xx.y & 0xffff0000u)};
                xr[64 * j] = xf + g * y; } }
    }
}
}
#ifndef SEAM_TWICE
#define SEAM_TWICE 0
#endif
__device__ __forceinline__ Inputs load_inputs(const Args& args) {
    Inputs I; const void* const* p = args.in;
    I.x = (const float*)p[0]; I.c = (const float*)p[1]; I.positions = (const int*)p[2]; I.w_ada = (const float*)p[3]; I.b_ada = (const float*)p[4]; I.norm1_g = (const float*)p[5];
    I.w_in = (const float*)p[6]; I.q_a_norm = (const float*)p[7]; I.w_q_b = (const float*)p[8]; I.kv_a_norm = (const float*)p[9]; I.w_kv_b = (const float*)p[10]; I.q_norm = (const float*)p[11];
    I.k_norm = (const float*)p[12]; I.conv_w = (const float*)p[13]; I.conv_b = (const float*)p[14]; I.lru_wa = (const float*)p[15]; I.lru_ba = (const float*)p[16]; I.lru_wx = (const float*)p[17];
    I.lru_bx = (const float*)p[18]; I.lru_lambda = (const float*)p[19]; I.attn_out_norm = (const float*)p[20]; I.lru_out_norm = (const float*)p[21]; I.w_out = (const float*)p[22];
    I.norm2_g = (const float*)p[23]; I.w_rg = (const float*)p[24]; I.b_rg = (const float*)p[25]; I.w_re = (const float*)p[26]; I.b_re = (const float*)p[27]; I.w_gate = (const float*)p[28];
    I.w_up = (const float*)p[29]; I.w_down = (const float*)p[30]; return I;
}
__global__ void __launch_bounds__(NWAVES * 64, 2) mega_fwd(Args args) {
    extern __shared__ __attribute__((aligned(16))) unsigned char lds[];
    Frame F;
    F.lds = (LAS unsigned char*)lds; F.MISC = (volatile LAS unsigned*)(F.lds + MISC_OFF);
    F.wave = __builtin_amdgcn_readfirstlane(threadIdx.x >> 6);
    F.G = gridDim.x; { const int bx = blockIdx.x; F.vcu = (F.G % 8 == 0) ? (bx % 8) * (F.G / 8) + bx / 8 : bx; }
    F.ws = args.ws; F.out = args.out; F.ctl = (gu32*)(args.ws + WS_CTL);
    for (int u = ((int)threadIdx.x); u < (LDS_BYTES - LDSCTL_OFF) / 4; u += NWAVES * 64) ((LAS unsigned*)(F.lds + LDSCTL_OFF))[u] = 0u;
    __syncthreads();
    XcdBarrier bar = xcd_barrier_post((unsigned*)(F.ctl + CW_BAR) + args.li * XCD_BAR_WORDS, F.MISC + 8);
    const int lo = args.ph_lo, hi = args.ph_hi;
constexpr int REPS[12] = {1,1,1,1,1,1,1,1,1,1,1,1};
#define IN(k) (lo <= (k) && (k) < hi)
#define SEAM(k) do { if (IN(k) && IN((k) + 1)) { xcd_barrier(bar); if (SEAM_TWICE) xcd_barrier(bar); } } while (0)
    if (IN(0)) for (int rep_ = 0; rep_ < REPS[0]; ++rep_) { const Inputs I = load_inputs(args); (void)I; phase_prologue(F, I); } SEAM(0);
    if (IN(1)) for (int rep_ = 0; rep_ < REPS[1]; ++rep_) { const Inputs I = load_inputs(args); (void)I; moe::router_fold(F, I); phase_xn(F, I); } SEAM(1);
    if (IN(2)) for (int rep_ = 0; rep_ < REPS[2]; ++rep_) { const Inputs I = load_inputs(args); (void)I;
        pg8::Gemm g{(const bf16_t*)(F.ws + WSX_A), (const bf16_t*)(F.ws + WSX_WIN), NTOK, PROJP, DM}; pg8::StaticOrder S; S.init(NTOK, PROJP, F.G, (int)blockIdx.x);
        pg8::EpiProjT E{(bf16_t*)(F.ws + WSX_B)};
        pg8::gemm_phase<pg8::EpiProjT, pg8::StaticOrder, true, true>(F.lds, g, S, E);
    } SEAM(2);
    if (IN(3)) for (int rep_ = 0; rep_ < REPS[3]; ++rep_) { const Inputs I = load_inputs(args); (void)I; prj::phase_proj(F, I, args.pad); } SEAM(3);
    if (IN(4)) for (int rep_ = 0; rep_ < REPS[4]; ++rep_) { const Inputs I = load_inputs(args); (void)I;
#ifndef ATT_ABL
#define ATT_ABL 0
#endif
        if (ATT_ABL == 0 || args.pad == 7) att::attn_phase<0>((char*)lds, (const bf16_t*)(F.ws + WSX_Q), (const bf16_t*)(F.ws + WSX_K), (const bf16_t*)(F.ws + WSX_V), (bf16_t*)(F.ws + WSX_AO), F.G, F.vcu);
        else att::attn_phase<ATT_ABL>((char*)lds, (const bf16_t*)(F.ws + WSX_Q), (const bf16_t*)(F.ws + WSX_K), (const bf16_t*)(F.ws + WSX_V), (bf16_t*)(F.ws + WSX_AO), F.G, F.vcu);
    } SEAM(4);
    if (IN(5)) for (int rep_ = 0; rep_ < REPS[5]; ++rep_) { const Inputs I = load_inputs(args); (void)I; prj::phase_mix(F, I); } SEAM(5);
    if (IN(6)) for (int rep_ = 0; rep_ < REPS[6]; ++rep_) { const Inputs I = load_inputs(args); (void)I;
        pg8::Gemm g{(const bf16_t*)(F.ws + WSX_E), (const bf16_t*)(F.ws + WSX_WOUT), NTOK, DM, DM}; pg8::StaticOrder S; S.init(NTOK, DM, F.G, (int)blockIdx.x);
        pg8::EpiResid E{I.x, (const float*)(F.ws + WS_MOD), (bf16_t*)(F.ws + WSX_X1)};
        pg8::gemm_phase<pg8::EpiResid, pg8::StaticOrder, true, true>(F.lds, g, S, E);
    } SEAM(6);
    if (IN(7)) for (int rep_ = 0; rep_ < REPS[7]; ++rep_) { const Inputs I = load_inputs(args); (void)I; moe::phase_route(F); } SEAM(7);
    if (IN(8)) for (int rep_ = 0; rep_ < REPS[8]; ++rep_) { const Inputs I = load_inputs(args); (void)I; moe::phase_sort(F, I); } SEAM(8);
    if (IN(9)) for (int rep_ = 0; rep_ < REPS[9]; ++rep_) { const Inputs I = load_inputs(args); (void)I;
        if (!IN(8)) moe::moe_tables(F);
        pg8::Gemm g{(const bf16_t*)(F.ws + WSX_XS), (const bf16_t*)(F.ws + WSX_W1T), MAXROWS, 0, DM};
        pg8::GroupedOrder S{(const LAS int*)(F.lds + moe::TP_OFF), 2, F.G, (int)blockIdx.x};
        pg8::EpiSiluMul E{(bf16_t*)(F.ws + WSX_HID)};
        pg8::gemm_phase<pg8::EpiSiluMul, pg8::GroupedOrder, true, true>(F.lds, g, S, E);
    } SEAM(9);
    if (IN(10)) for (int rep_ = 0; rep_ < REPS[10]; ++rep_) { const Inputs I = load_inputs(args); (void)I;
        if (!IN(8)) moe::moe_tables(F);
        int kk2 = DFF; asm volatile("" : "+s"(kk2));
        pg8::Gemm g{(const bf16_t*)(F.ws + WSX_HID), (const bf16_t*)(F.ws + WSX_W2T), MAXROWS, 0, kk2};
        pg8::GroupedOrder S{(const LAS int*)(F.lds + moe::TP_OFF), 4, F.G, (int)blockIdx.x};
        pg8::EpiYs E{(bf16_t*)(F.ws + WSX_XS)};
        pg8::gemm_phase<pg8::EpiYs, pg8::GroupedOrder, true, true>(F.lds, g, S, E);
    } SEAM(10);
    if (IN(11)) for (int rep_ = 0; rep_ < REPS[11]; ++rep_) { const Inputs I = load_inputs(args); (void)I; moe::phase_combine(F); }
#undef IN
#undef SEAM
}
static int g_grid = 0;
static bool mega_setup() {
    if (g_grid) return g_grid > 0;
    int dev = 0, cus = 0, per_cu = 0;
    if (hipGetDevice(&dev) != hipSuccess || hipDeviceGetAttribute(&cus, hipDeviceAttributeMultiprocessorCount, dev) != hipSuccess) { g_grid = -1; return false; }
    if (hipFuncSetAttribute((const void*)mega_fwd, hipFuncAttributeMaxDynamicSharedMemorySize, LDS_BYTES) != hipSuccess) { fprintf(stderr, "hipFuncSetAttribute failed\n"); g_grid = -1; return false; }
    if (hipOccupancyMaxActiveBlocksPerMultiprocessor(&per_cu, (const void*)mega_fwd, NWAVES * 64, LDS_BYTES) != hipSuccess || per_cu < 1) { fprintf(stderr, "occupancy query: %d\n", per_cu); (void)hipGetLastError(); g_grid = -1; return false; }
    g_grid = cus;
    return true;
}
static void mega_launch(void* const* d_in, void* d_out, void* d_ws, hipStream_t stream, int lo, int hi, int li, int knob = 7) {
    Args a{}; for (int i = 0; i < 31; ++i) a.in[i] = d_in[i];
    a.out = (float*)d_out; a.ws = (unsigned char*)d_ws; a.ph_lo = lo; a.ph_hi = hi; a.li = li; a.pad = knob;
    hipLaunchKernelGGL(mega_fwd, dim3(g_grid), dim3(NWAVES * 64), LDS_BYTES, stream, a);
}
extern "C" void kernel_launch(void* const* d_in, const int* in_sizes, int n_in, void* d_out, int out_size, void* d_ws, size_t ws_size, hipStream_t stream) {
    if (n_in != 31 || ws_size < WSX_END || out_size != NTOK * DM) { fprintf(stderr, "kernel_launch: unexpected shapes n_in=%d ws=%zu out=%d\n", n_in, ws_size, out_size); return; }
    if (!mega_setup()) return;
    const Inputs I = get_inputs(d_in);
    char* ws = (char*)d_ws; float* out = (float*)d_out;
    float* mod = (float*)(ws + WS_MOD);
    int2* rexp = (int2*)(ws + WSX_ROUTE); float2* rw = (float2*)(ws + WSX_ROUTE + 256 * 1024);
    bf16_t* XN = (bf16_t*)(ws + WSX_A); bf16_t* H2 = (bf16_t*)(ws + WSX_A);
    bf16_t* PROJ = (bf16_t*)(ws + WSX_B);
    bf16_t* MIXED = (bf16_t*)(ws + WSX_E);
    (void)XN; (void)mod;
    hipMemsetAsync(ws + WS_CTL, 0, 1 * MiB, stream);
    mega_launch(d_in, d_out, d_ws, stream, 0, 12, 0);
}
```

```cpp
#include <hip/hip_runtime.h>
#include <cstdio>
#include <cstdint>
#include <cmath>
constexpr int NB = 4, SEQ = 8192, DM = 1024, NTOK = NB * SEQ;
constexpr int NH = 4, DQK = 192, DNOPE = 128, DROPE = 64, DV = 128;
constexpr int QLR = 256, KVLR = 128, LRUW = 512, LRUH = 4, LRUB = 128;
constexpr int NPROJ = 1472, PROJP = 1536;
constexpr int C_QLAT = 0, C_KVLAT = 256, C_KROPE = 384, C_XLRU = 448, C_GLRU = 960;
constexpr int NEXP = 32, NGRP = 4, EPG = 8, DFF = 256;
constexpr float EPS = 1e-6f;
constexpr int MODW = 6 * DM;

typedef unsigned short bf16_t;
__device__ __forceinline__ float bf2f(bf16_t v) { return __uint_as_float(((unsigned)v) << 16); }
__device__ __forceinline__ bf16_t f2bf(float f) { unsigned u = __float_as_uint(f); return (bf16_t)((u + 0x7fffu + ((u >> 16) & 1u)) >> 16); }

constexpr size_t MiB = 1u << 20;
constexpr size_t WS_CTL = 0;
constexpr size_t WS_MOD = 1 * MiB;
constexpr size_t WS_ROUTE = 2 * MiB;
constexpr size_t WS_A = 64 * MiB;
constexpr size_t WS_B = 128 * MiB;
constexpr size_t WS_C = 224 * MiB;
constexpr size_t WS_D = 352 * MiB;
constexpr size_t WS_E = 416 * MiB;
constexpr size_t WS_END = 480 * MiB;
constexpr size_t WS_Q = WS_C, WS_K = WS_C + 48 * MiB, WS_V = WS_C + 96 * MiB;

__device__ __forceinline__ float silu_f(float v) { return v / (1.f + __expf(-v)); }
__device__ __forceinline__ float sigmoid_f(float v) { return 1.f / (1.f + __expf(-v)); }
__device__ __forceinline__ float gelu_tanh(float v) { const float u = 0.7978845608028654f * (v + 0.044715f * v * v * v); return v / (1.f + __expf(-2.f * u)); }

__device__ __forceinline__ float block_sum_256(float v, float* red) {
    for (int o = 32; o > 0; o >>= 1) v += __shfl_xor(v, o);
    __syncthreads();
    if ((threadIdx.x & 63) == 0) red[threadIdx.x >> 6] = v;
    __syncthreads();
    return red[0] + red[1] + red[2] + red[3];
}
__device__ __forceinline__ float wave_sum(float v) { for (int o = 32; o > 0; o >>= 1) v += __shfl_xor(v, o); return v; }

__device__ __forceinline__ void rope_cs(int pos, int i, float& c, float& s) {
    const double inv = exp(-0.28782313662425575 * (double)i);
    double a = (double)pos * inv;
    const double k = rint(a * 0.15915494309189535);
    a = fma(-k, 6.283185307179586, a); a = fma(-k, 2.4492935982947064e-16, a);
    const float r = (float)a;
    c = __cosf(r); s = __sinf(r);
}

__global__ void nv_mod(const float* __restrict__ c, const float* __restrict__ w_ada, const float* __restrict__ b_ada, float* __restrict__ mod) {
    const int n = blockIdx.x * 256 + threadIdx.x, b = blockIdx.y;
    float acc = b_ada[n];
    for (int k = 0; k < DM; ++k) acc += silu_f(c[b * DM + k]) * w_ada[(size_t)k * MODW + n];
    mod[b * MODW + n] = acc;
}
__global__ void nv_norm_mod(const float* __restrict__ x, const float* __restrict__ g, const float* __restrict__ mod, int which, bf16_t* __restrict__ out) {
    const int t = blockIdx.x * 4 + (threadIdx.x >> 6), lane = threadIdx.x & 63, b = t / SEQ;
    const float* xr = x + (size_t)t * DM;
    float v[16]; float ss = 0.f;
#pragma unroll
    for (int j = 0; j < 16; ++j) { v[j] = xr[lane + 64 * j]; ss += v[j] * v[j]; }
    ss = wave_sum(ss);
    const float rstd = rsqrtf(ss / DM + EPS);
    const float* sh = mod + b * MODW + (which ? 3 * DM : 0); const float* sc = sh + DM;
#pragma unroll
    for (int j = 0; j < 16; ++j) { const int k = lane + 64 * j; out[(size_t)t * DM + k] = f2bf(v[j] * rstd * g[k] * (1.f + sc[k]) + sh[k]); }
}

template <class Epi> __global__ void __launch_bounds__(256) nv_gemm(const bf16_t* __restrict__ A, int lda, const float* __restrict__ W, int ldw, int K, Epi epi) {
    __shared__ float As[16][65]; __shared__ float Bs[16][64];
    const int tid = threadIdx.x, tx = tid & 15, ty = tid >> 4, m0 = blockIdx.y * 64, n0 = blockIdx.x * 64;
    float acc[4][4];
#pragma unroll
    for (int i = 0; i < 4; ++i)
#pragma unroll
        for (int j = 0; j < 4; ++j) acc[i][j] = 0.f;
    for (int k0 = 0; k0 < K; k0 += 16) {
        { const int r = tid >> 2, kk = (tid & 3) * 4; const bf16_t* ap = A + (size_t)(m0 + r) * lda + k0 + kk;
#pragma unroll
          for (int j = 0; j < 4; ++j) As[kk + j][r] = bf2f(ap[j]); }
        { const int kk = tid >> 4, c = (tid & 15) * 4; const float* wp = W + (size_t)(k0 + kk) * ldw + n0 + c;
#pragma unroll
          for (int j = 0; j < 4; ++j) Bs[kk][c + j] = wp[j]; }
        __syncthreads();
#pragma unroll
        for (int kk = 0; kk < 16; ++kk) { float a[4], b[4];
#pragma unroll
            for (int i = 0; i < 4; ++i) a[i] = As[kk][ty * 4 + i];
#pragma unroll
            for (int j = 0; j < 4; ++j) b[j] = Bs[kk][tx * 4 + j];
#pragma unroll
            for (int i = 0; i < 4; ++i)
#pragma unroll
                for (int j = 0; j < 4; ++j) acc[i][j] += a[i] * b[j]; }
        __syncthreads();
    }
#pragma unroll
    for (int i = 0; i < 4; ++i)
#pragma unroll
        for (int j = 0; j < 4; ++j) epi(m0 + ty * 4 + i, n0 + tx * 4 + j, acc[i][j]);
}
struct EpiStoreBf16 { bf16_t* C; int ldc; int pad; __device__ void operator()(int r, int c, float v) const { C[(size_t)r * ldc + c] = f2bf(v); } };
struct EpiOutProj { const float* x; const float* mod; float* out; __device__ void operator()(int r, int c, float v) const { const int b = r / SEQ; out[(size_t)r * DM + c] = x[(size_t)r * DM + c] + mod[b * MODW + 2 * DM + c] * v; } };

__global__ void __launch_bounds__(256) nv_qkv(const bf16_t* __restrict__ proj, const int* __restrict__ positions, const float* __restrict__ q_a_norm, const float* __restrict__ w_q_b,
                                               const float* __restrict__ kv_a_norm, const float* __restrict__ w_kv_b, const float* __restrict__ q_norm, const float* __restrict__ k_norm,
                                               bf16_t* __restrict__ Q, bf16_t* __restrict__ Kb, bf16_t* __restrict__ Vb) {
    __shared__ float qn[QLR], kvn[KVLR], kr[DROPE], qo[NH * DQK], kvo[NH * 256], red[4], cs[64];
    const int t = blockIdx.x, tid = threadIdx.x, b = t / SEQ, s = t % SEQ;
    const bf16_t* pr = proj + (size_t)t * PROJP;
    const float ql = bf2f(pr[C_QLAT + tid]);
    const float sq = block_sum_256(ql * ql, red);
    qn[tid] = ql * rsqrtf(sq / QLR + EPS) * q_a_norm[tid];
    const float kl = tid < KVLR ? bf2f(pr[C_KVLAT + tid]) : 0.f;
    const float skv = block_sum_256(kl * kl, red);
    if (tid < KVLR) kvn[tid] = kl * rsqrtf(skv / KVLR + EPS) * kv_a_norm[tid];
    if (tid < DROPE) kr[tid] = bf2f(pr[C_KROPE + tid]);
    if (tid < 32) { float c, sn; rope_cs(positions[t], tid, c, sn); cs[tid] = c; cs[32 + tid] = sn; }
    __syncthreads();
    for (int j = 0; j < 3; ++j) { const int col = tid + 256 * j; float a = 0.f; for (int k = 0; k < QLR; ++k) a += qn[k] * w_q_b[(size_t)k * (NH * DQK) + col]; qo[col] = a; }
    for (int j = 0; j < 4; ++j) { const int col = tid + 256 * j; float a = 0.f; for (int k = 0; k < KVLR; ++k) a += kvn[k] * w_kv_b[(size_t)k * (NH * 256) + col]; kvo[col] = a; }
    __syncthreads();
    const int h = tid >> 6, lane = tid & 63;
    {
        float v0 = qo[h * DQK + lane], v1 = qo[h * DQK + 64 + lane], v2 = qo[h * DQK + 128 + lane];
        const float rs = rsqrtf(wave_sum(v0 * v0 + v1 * v1 + v2 * v2) / DQK + EPS);
        v0 *= rs * q_norm[lane]; v1 *= rs * q_norm[64 + lane]; v2 *= rs * q_norm[128 + lane];
        const float oth = __shfl_xor(v2, 32); const int i = lane & 31; const float c = cs[i], sn = cs[32 + i];
        const float r2 = lane < 32 ? v2 * c - oth * sn : v2 * c + oth * sn;
        bf16_t* qp = Q + ((size_t)(b * NH + h) * SEQ + s) * DQK;
        qp[lane] = f2bf(v0); qp[64 + lane] = f2bf(v1); qp[128 + lane] = f2bf(r2);
    }
    {
        float v0 = kvo[h * 256 + lane], v1 = kvo[h * 256 + 64 + lane], v2 = kr[lane];
        const float rs = rsqrtf(wave_sum(v0 * v0 + v1 * v1 + v2 * v2) / DQK + EPS);
        v0 *= rs * k_norm[lane]; v1 *= rs * k_norm[64 + lane]; v2 *= rs * k_norm[128 + lane];
        const float oth = __shfl_xor(v2, 32); const int i = lane & 31; const float c = cs[i], sn = cs[32 + i];
        const float r2 = lane < 32 ? v2 * c - oth * sn : v2 * c + oth * sn;
        bf16_t* kp = Kb + ((size_t)(b * NH + h) * SEQ + s) * DQK;
        kp[lane] = f2bf(v0); kp[64 + lane] = f2bf(v1); kp[128 + lane] = f2bf(r2);
        bf16_t* vp = Vb + ((size_t)(b * NH + h) * SEQ + s) * DV;
        vp[lane] = f2bf(kvo[h * 256 + 128 + lane]); vp[64 + lane] = f2bf(kvo[h * 256 + 192 + lane]);
    }
}

__global__ void __launch_bounds__(256) nv_attn(const bf16_t* __restrict__ Q, const bf16_t* __restrict__ Kb, const bf16_t* __restrict__ Vb, bf16_t* __restrict__ mixed) {
    __shared__ float Ks[64][DQK + 4]; __shared__ float Vs[64][DV + 4];
    const int bh = blockIdx.y, qb = gridDim.x - 1 - blockIdx.x, tid = threadIdx.x, row = tid >> 2, part = tid & 3;
    const int qi = qb * 64 + row;
    float q[48], o[32]; float m = -1e30f, l = 0.f;
    { const bf16_t* qp = Q + ((size_t)bh * SEQ + qi) * DQK + part * 48;
#pragma unroll
      for (int d = 0; d < 48; ++d) q[d] = bf2f(qp[d]); }
#pragma unroll
    for (int d = 0; d < 32; ++d) o[d] = 0.f;
    const float scl = 0.07216878364870322f;
    for (int kt = 0; kt <= qb; ++kt) {
        __syncthreads();
        for (int e = tid; e < 64 * DQK; e += 256) { const int r = e / DQK, c = e % DQK; Ks[r][c] = bf2f(Kb[((size_t)bh * SEQ + kt * 64 + r) * DQK + c]); }
        for (int e = tid; e < 64 * DV; e += 256) { const int r = e / DV, c = e % DV; Vs[r][c] = bf2f(Vb[((size_t)bh * SEQ + kt * 64 + r) * DV + c]); }
        __syncthreads();
        for (int j = 0; j < 64; ++j) {
            float sdot = 0.f;
#pragma unroll
            for (int d = 0; d < 48; ++d) sdot += q[d] * Ks[j][part * 48 + d];
            sdot += __shfl_xor(sdot, 1); sdot += __shfl_xor(sdot, 2);
            sdot *= scl;
            if (kt * 64 + j <= qi) {
                const float mn = fmaxf(m, sdot), al = __expf(m - mn), p = __expf(sdot - mn);
                l = l * al + p; m = mn;
#pragma unroll
                for (int d = 0; d < 32; ++d) o[d] = o[d] * al + p * Vs[j][part * 32 + d];
            }
        }
    }
    const int b = bh / NH, h = bh % NH;
    bf16_t* op = mixed + ((size_t)(b * SEQ + qi)) * DM + h * DV + part * 32;
    const float il = 1.f / l;
#pragma unroll
    for (int d = 0; d < 32; ++d) op[d] = f2bf(o[d] * il);
}

__global__ void __launch_bounds__(512) nv_lru_gates(const bf16_t* __restrict__ proj, const int* __restrict__ positions, const float* __restrict__ conv_w, const float* __restrict__ conv_b,
                                                     const float* __restrict__ wa, const float* __restrict__ ba, const float* __restrict__ wx, const float* __restrict__ bx,
                                                     const float* __restrict__ lam, float* __restrict__ A32, float* __restrict__ B32) {
    __shared__ float xc[LRUW];
    const int t = blockIdx.x, c = threadIdx.x, s = t % SEQ;
    float v = conv_b[c];
    for (int j = 0; j < 4; ++j) { const int ss = s - 3 + j; if (ss >= 0) v += conv_w[j * LRUW + c] * bf2f(proj[(size_t)(t - 3 + j) * PROJP + C_XLRU + c]); }
    xc[c] = v;
    __syncthreads();
    const int h = c >> 7, jj = c & 127;
    float ra = ba[c], ri = bx[c];
    for (int i = 0; i < LRUB; ++i) { const float xv = xc[h * LRUB + i]; ra += xv * wa[(size_t)(h * LRUB + i) * LRUB + jj]; ri += xv * wx[(size_t)(h * LRUB + i) * LRUB + jj]; }
    const float r = sigmoid_f(ra), ig = sigmoid_f(ri);
    const float sp = log1pf(__expf(-lam[c]));
    const float log_a = -8.f * r * sp;
    float a = __expf(log_a), mult = sqrtf(fmaxf(1.f - __expf(2.f * log_a), 0.f));
    if (positions[t] == 0) { a = 0.f; mult = 1.f; }
    A32[(size_t)t * LRUW + c] = a; B32[(size_t)t * LRUW + c] = mult * (ig * v);
}
__global__ void nv_lru_scan(float* __restrict__ A32, const float* __restrict__ B32) {
    const int idx = blockIdx.x * blockDim.x + threadIdx.x, b = idx / LRUW, c = idx % LRUW;
    float h = 0.f;
    for (int s0 = 0; s0 < SEQ; s0 += 8) {
        float a[8], bb[8];
#pragma unroll
        for (int j = 0; j < 8; ++j) { const size_t o = ((size_t)(b * SEQ + s0 + j)) * LRUW + c; a[j] = A32[o]; bb[j] = B32[o]; }
#pragma unroll
        for (int j = 0; j < 8; ++j) { h = a[j] * h + bb[j]; A32[((size_t)(b * SEQ + s0 + j)) * LRUW + c] = h; }
    }
}
__global__ void nv_mixnorm(bf16_t* __restrict__ mixed, const float* __restrict__ H32, const bf16_t* __restrict__ proj, const float* __restrict__ g_attn, const float* __restrict__ g_lru) {
    const int t = blockIdx.x * 4 + (threadIdx.x >> 6), lane = threadIdx.x & 63;
    bf16_t* mr = mixed + (size_t)t * DM;
    float v[8], ss = 0.f;
#pragma unroll
    for (int j = 0; j < 8; ++j) { v[j] = bf2f(mr[lane + 64 * j]); ss += v[j] * v[j]; }
    float rs = rsqrtf(wave_sum(ss) / 512.f + EPS);
#pragma unroll
    for (int j = 0; j < 8; ++j) mr[lane + 64 * j] = f2bf(v[j] * rs * g_attn[lane + 64 * j]);
    ss = 0.f;
#pragma unroll
    for (int j = 0; j < 8; ++j) { const int c = lane + 64 * j; v[j] = H32[(size_t)t * LRUW + c] * gelu_tanh(bf2f(proj[(size_t)t * PROJP + C_GLRU + c])); ss += v[j] * v[j]; }
    rs = rsqrtf(wave_sum(ss) / 512.f + EPS);
#pragma unroll
    for (int j = 0; j < 8; ++j) mr[512 + lane + 64 * j] = f2bf(v[j] * rs * g_lru[lane + 64 * j]);
}
__global__ void nv_route(const float* __restrict__ x1, const float* __restrict__ g2, const float* __restrict__ mod, const float* __restrict__ w_rg, const float* __restrict__ b_rg,
                         const float* __restrict__ w_re, const float* __restrict__ b_re, bf16_t* __restrict__ H2, int2* __restrict__ rexp, float2* __restrict__ rw) {
    const int t = blockIdx.x * 4 + (threadIdx.x >> 6), lane = threadIdx.x & 63, b = t / SEQ;
    const float* xr = x1 + (size_t)t * DM;
    float v[16]; float ss = 0.f;
#pragma unroll
    for (int j = 0; j < 16; ++j) { v[j] = xr[lane + 64 * j]; ss += v[j] * v[j]; }
    const float rstd = rsqrtf(wave_sum(ss) / DM + EPS);
    const float* sh = mod + b * MODW + 3 * DM; const float* sc = sh + DM;
#pragma unroll
    for (int j = 0; j < 16; ++j) { const int k = lane + 64 * j; v[j] = v[j] * rstd * g2[k] * (1.f + sc[k]) + sh[k]; H2[(size_t)t * DM + k] = f2bf(v[j]); }
    float gl[NGRP];
#pragma unroll
    for (int g = 0; g < NGRP; ++g) { float a = 0.f;
#pragma unroll
        for (int j = 0; j < 16; ++j) a += v[j] * w_rg[(size_t)(lane + 64 * j) * NGRP + g];
        gl[g] = wave_sum(a) + b_rg[g]; }
    int gi = 0; float gm = gl[0];
#pragma unroll
    for (int g = 1; g < NGRP; ++g) if (gl[g] > gm) { gm = gl[g]; gi = g; }
    float gs = 0.f;
#pragma unroll
    for (int g = 0; g < NGRP; ++g) gs += __expf(gl[g] - gm);
    const float gp = 1.f / gs;
    float m0 = -1e30f, m1 = -1e30f; int e0 = 0, e1 = 0;
    for (int e = 0; e < EPG; ++e) { float a = 0.f;
#pragma unroll
        for (int j = 0; j < 16; ++j) a += v[j] * w_re[(size_t)(lane + 64 * j) * NEXP + gi * EPG + e];
        const float el = wave_sum(a) + b_re[gi * EPG + e];
        if (el > m0) { m1 = m0; e1 = e0; m0 = el; e0 = e; } else if (el > m1) { m1 = el; e1 = e; } }
    const float p1 = __expf(m1 - m0);
    const float w0 = gp / (1.f + p1), w1 = gp * p1 / (1.f + p1);
    if (lane == 0) { rexp[t] = make_int2(gi * EPG + e0, gi * EPG + e1); rw[t] = make_float2(w0, w1); }
}
__global__ void __launch_bounds__(256) nv_moe(const bf16_t* __restrict__ H2, const int2* __restrict__ rexp, const float2* __restrict__ rw, const float* __restrict__ w_gate,
                                               const float* __restrict__ w_up, const float* __restrict__ w_down, const float* __restrict__ mod, float* __restrict__ out) {
    __shared__ float hs[DM], hid[DFF];
    const int t = blockIdx.x, tid = threadIdx.x, b = t / SEQ;
    for (int j = 0; j < 4; ++j) hs[tid + 256 * j] = bf2f(H2[(size_t)t * DM + tid + 256 * j]);
    float y[4] = {0.f, 0.f, 0.f, 0.f};
    const int2 ee = rexp[t]; const float2 ww = rw[t];
    for (int k = 0; k < 2; ++k) {
        const int e = k ? ee.y : ee.x; const float w = k ? ww.y : ww.x;
        __syncthreads();
        const float* wg = w_gate + (size_t)e * DM * DFF; const float* wu = w_up + (size_t)e * DM * DFF;
        float g = 0.f, u = 0.f;
        for (int i = 0; i < DM; ++i) { const float hv = hs[i]; g += hv * wg[(size_t)i * DFF + tid]; u += hv * wu[(size_t)i * DFF + tid]; }
        hid[tid] = silu_f(g) * u;
        __syncthreads();
        const float* wd = w_down + (size_t)e * DFF * DM;
#pragma unroll
        for (int j = 0; j < 4; ++j) { float a = 0.f; for (int f = 0; f < DFF; ++f) a += hid[f] * wd[(size_t)f * DM + tid + 256 * j]; y[j] += w * a; }
    }
#pragma unroll
    for (int j = 0; j < 4; ++j) { const int c = tid + 256 * j; out[(size_t)t * DM + c] += mod[b * MODW + 5 * DM + c] * y[j]; }
}
struct Inputs {
    const float *x, *c; const int* positions;
    const float *w_ada, *b_ada, *norm1_g, *w_in, *q_a_norm, *w_q_b, *kv_a_norm, *w_kv_b, *q_norm, *k_norm, *conv_w, *conv_b, *lru_wa, *lru_ba, *lru_wx, *lru_bx, *lru_lambda,
                *attn_out_norm, *lru_out_norm, *w_out, *norm2_g, *w_rg, *b_rg, *w_re, *b_re, *w_gate, *w_up, *w_down;
};
static Inputs get_inputs(void* const* d_in) {
    Inputs I;
    I.x = (const float*)d_in[0]; I.c = (const float*)d_in[1]; I.positions = (const int*)d_in[2];
    I.w_ada = (const float*)d_in[3]; I.b_ada = (const float*)d_in[4]; I.norm1_g = (const float*)d_in[5];
    I.w_in = (const float*)d_in[6]; I.q_a_norm = (const float*)d_in[7]; I.w_q_b = (const float*)d_in[8];
    I.kv_a_norm = (const float*)d_in[9]; I.w_kv_b = (const float*)d_in[10]; I.q_norm = (const float*)d_in[11];
    I.k_norm = (const float*)d_in[12]; I.conv_w = (const float*)d_in[13]; I.conv_b = (const float*)d_in[14];
    I.lru_wa = (const float*)d_in[15]; I.lru_ba = (const float*)d_in[16]; I.lru_wx = (const float*)d_in[17];
    I.lru_bx = (const float*)d_in[18]; I.lru_lambda = (const float*)d_in[19]; I.attn_out_norm = (const float*)d_in[20];
    I.lru_out_norm = (const float*)d_in[21]; I.w_out = (const float*)d_in[22]; I.norm2_g = (const float*)d_in[23];
    I.w_rg = (const float*)d_in[24]; I.b_rg = (const float*)d_in[25]; I.w_re = (const float*)d_in[26];
    I.b_re = (const float*)d_in[27]; I.w_gate = (const float*)d_in[28]; I.w_up = (const float*)d_in[29];
    I.w_down = (const float*)d_in[30];
    return I;
}
#define GAS __attribute__((address_space(1)))
#define LAS __attribute__((address_space(3)))
typedef unsigned v4u __attribute__((ext_vector_type(4)));
typedef unsigned v2u __attribute__((ext_vector_type(2)));
typedef float f32x4 __attribute__((ext_vector_type(4)));
typedef float f32x16 __attribute__((ext_vector_type(16)));
typedef short bf16x8 __attribute__((ext_vector_type(8)));
typedef short s16x4 __attribute__((ext_vector_type(4)));
typedef GAS unsigned gu32;
#define RLX_AGENT __ATOMIC_RELAXED, __HIP_MEMORY_SCOPE_AGENT
#define LDS_WAIT() asm volatile("s_waitcnt lgkmcnt(0)" ::: "memory")
#define VM_WAIT() asm volatile("s_waitcnt vmcnt(0)" ::: "memory")
__device__ __forceinline__ unsigned pk2(float lo, float hi) { return (unsigned)f2bf(lo) | ((unsigned)f2bf(hi) << 16); }
__device__ __forceinline__ unsigned cvtpk(float lo, float hi) { unsigned r; asm volatile("v_cvt_pk_bf16_f32 %0, %1, %2" : "=v"(r) : "v"(lo), "v"(hi)); return r; }

constexpr size_t WSX_SUMA = 3 * MiB, WSX_SUMB = 5 * MiB;
constexpr size_t WSX_CS = 7 * MiB;
constexpr size_t WSX_WQF = 15 * MiB;
constexpr size_t WSX_WKVF = WSX_WQF + 384 * 1024;
constexpr size_t WSX_WAF = WSX_WKVF + 256 * 1024;
constexpr size_t WSX_WXF = WSX_WAF + 128 * 1024;
constexpr size_t WSX_WRF = WSX_WXF + 128 * 1024;
constexpr size_t WSX_SP = 2 * MiB + 768 * 1024;
constexpr size_t WSX_WIN = 16 * MiB;
constexpr size_t WSX_WOUT = 19 * MiB;
constexpr size_t WSX_W1T = 22 * MiB;
constexpr size_t WSX_W2T = 54 * MiB;
constexpr size_t WSX_A = 72 * MiB;
constexpr size_t WSX_B = 136 * MiB;
constexpr size_t WSX_C = 232 * MiB;
constexpr size_t WSX_D = 360 * MiB;
constexpr size_t WSX_E = 424 * MiB;
constexpr size_t WSX_END = 488 * MiB;
constexpr size_t WSX_Q = WSX_C, WSX_K = WSX_C + 48 * MiB, WSX_V = WSX_C + 96 * MiB;
constexpr size_t WSX_XS = 216 * MiB;
constexpr size_t WSX_HID = WSX_D;
constexpr size_t WSX_ROUTE = 2 * MiB;
constexpr int MAXROWS = 2 * NTOK + NEXP * 255;
constexpr size_t WSX_X1 = 72 * MiB;
constexpr size_t WSX_AO = WSX_A;
constexpr size_t WSX_RPOSF = 71 * MiB + 128 * 1024;
constexpr size_t WSX_SUM8A = 70 * MiB + 576 * 1024, WSX_SUM8B = 70 * MiB + 832 * 1024;
constexpr int CW_BAR = 4096;
constexpr int CW_CNT = 65536;

constexpr int RING_BYTES = 131072, LDSCTL_OFF = RING_BYTES, MISC_OFF = LDSCTL_OFF + 320, LDS_BYTES = 147456;
constexpr int NWAVES = 8;
namespace pg8 {
#define PG8_LAS __attribute__((address_space(3)))
typedef unsigned short bf16_t;
typedef short bf16x8 __attribute__((ext_vector_type(8)));
typedef float f32x4 __attribute__((ext_vector_type(4)));
typedef unsigned u32x4 __attribute__((ext_vector_type(4)));
constexpr int BM = 256, BK = 64, HALF = 128, HTB = HALF * BK * 2  , STAGE_BYTES = 8 * HTB, NXCD = 8, WGM = 8;

__host__ __device__ __forceinline__ int lds_byte(int r, int c) { const int st = (r >> 4) * 2 + (c >> 5), rr = r & 15, cc = c & 31, ob = rr * 64 + cc * 2; return st * 1024 + (ob ^ (((ob >> 9) & 1) << 5)); }
__host__ __device__ __forceinline__ void stage_rc(int b, int& R, int& C) { const int st = b / 1024, sb = b % 1024, swz = sb ^ (((sb >> 9) & 1) << 5); R = (st >> 1) * 16 + swz / 64; C = (st & 1) * 32 + (swz % 64) / 2; }
__host__ __device__ __forceinline__ int perm32(int rho) { const int n = rho >> 4, i = rho & 15; return 8 * (i >> 2) + 4 * n + (i & 3); }

struct Unit { int pm, pn; };
struct Gemm { const bf16_t* A; const bf16_t* Bt; int M, N, K; };

struct StaticOrder {
    int nM, nN, nwg, G, c;
    __host__ __device__ void init(int M, int N, int G_, int c_) { nM = M / BM; nN = N / BM; nwg = nM * nN; G = G_; c = c_; }
    __host__ __device__ bool next(int i, Unit& u) const {
        const long L = (long)i * G + c; if (L >= nwg) return false;
        int wgid = (int)L; { const int q = nwg / NXCD, r = nwg % NXCD, xcd = wgid % NXCD, off = wgid / NXCD; wgid = (xcd < r ? xcd * (q + 1) : r * (q + 1) + (xcd - r) * q) + off; }
        const int nig = WGM * nN, gid = wgid / nig, fm = gid * WGM, gsz = (nM - fm) < WGM ? (nM - fm) : WGM;
        u.pm = fm + ((wgid % nig) % gsz); u.pn = (wgid % nig) / gsz; return true;
    }
    __device__ __forceinline__ void a_ready(const Unit&) const {}
    __device__ __forceinline__ void done(const Unit&) const {}
};

__device__ __forceinline__ unsigned cvt_pk_bf16(float lo, float hi) { unsigned r; asm volatile("v_cvt_pk_bf16_f32 %0, %1, %2" : "=v"(r) : "v"(lo), "v"(hi)); return r; }
typedef float f32x2 __attribute__((ext_vector_type(2)));
__device__ __forceinline__ f32x2 gelu_pk(f32x2 v) {
    const f32x2 av = __builtin_elementwise_abs(v), d = av * 0.2316418882f + 1.0f;
    f32x2 t; t.x = __builtin_amdgcn_rcpf(d.x); t.y = __builtin_amdgcn_rcpf(d.y);
    f32x2 q = t * 0.5307027145f + (-0.7265760135f); q = q * t + 0.7107068705f; q = q * t + (-0.142248368f); q = q * t + 0.127414796f; q = q * t;
    const f32x2 s = (v * v) * (-0.72134752044f);
    f32x2 e; e.x = __builtin_amdgcn_exp2f(s.x); e.y = __builtin_amdgcn_exp2f(s.y);
    const f32x2 m = v * (q * e), r = v - m;
    f32x2 o; o.x = v.x < 0.f ? m.x : r.x; o.y = v.y < 0.f ? m.y : r.y; return o;
}

template <int ACT  > struct EpiBf16 {
    static constexpr bool PERM = true, AFTER_DRAIN = false; static_assert(ACT == 0 || ACT == 1, "EpiBf16: ACT is 0 (none) or 1 (gelu_pk)");
    bf16_t* O; int ldc; const float* bias; int split_cols; size_t split_stride; float scale0;
    __device__ __forceinline__ void operator()(const f32x4 (&acc)[2][2][4][2], const Unit& u, int wr, int wc, int fr, int fq) const {
        const int row0 = u.pm * BM + wr * 64 + fr; int colt = u.pn * BM; bf16_t* base = O;
        float sc = 1.f; if (split_cols) { const int t = colt / split_cols; base += (size_t)t * split_stride; colt -= t * split_cols; if (t == 0) sc = scale0; }
        const int col0 = colt + wc * 32 + 8 * fq, bcol0 = u.pn * BM + wc * 32 + 8 * fq;
        f32x4 bv[2][2];
#pragma unroll
        for (int bj = 0; bj < 2; ++bj)
#pragma unroll
            for (int n = 0; n < 2; ++n) bv[bj][n] = bias ? *(const f32x4*)(bias + bcol0 + bj * HALF + 4 * n) : (f32x4){0.f, 0.f, 0.f, 0.f};
#pragma unroll
        for (int ai = 0; ai < 2; ++ai)
#pragma unroll
            for (int m = 0; m < 4; ++m) { bf16_t* rowp = base + (size_t)(row0 + ai * HALF + m * 16) * ldc + col0;
#pragma unroll
                for (int bj = 0; bj < 2; ++bj) { f32x4 v0 = acc[ai][bj][m][0] + bv[bj][0], v1 = acc[ai][bj][m][1] + bv[bj][1];
                    if (ACT == 1) { f32x2 a = gelu_pk((f32x2){v0[0], v0[1]}), b = gelu_pk((f32x2){v0[2], v0[3]}), c = gelu_pk((f32x2){v1[0], v1[1]}), d = gelu_pk((f32x2){v1[2], v1[3]});
                        v0 = (f32x4){a.x, a.y, b.x, b.y}; v1 = (f32x4){c.x, c.y, d.x, d.y}; }
                    v0 = v0 * sc; v1 = v1 * sc; u32x4 w; w.x = cvt_pk_bf16(v0[0], v0[1]); w.y = cvt_pk_bf16(v0[2], v0[3]); w.z = cvt_pk_bf16(v1[0], v1[1]); w.w = cvt_pk_bf16(v1[2], v1[3]);
                    *(u32x4*)(rowp + bj * HALF) = w; } }
    }
};
struct EpiResid {
    static constexpr bool PERM = true, AFTER_DRAIN = false;
    const float* x; const float* mod; bf16_t* out;
    __device__ __forceinline__ void operator()(const f32x4 (&acc)[2][2][4][2], const Unit& u, int wr, int wc, int fr, int fq) const {
        const int col0 = u.pn * BM + wc * 32 + 8 * fq, b = (u.pm * BM) / 8192;
        f32x4 gv[2][2];
#pragma unroll
        for (int bj = 0; bj < 2; ++bj)
#pragma unroll
            for (int n = 0; n < 2; ++n) gv[bj][n] = *(const f32x4*)(mod + b * 6144 + 2048 + col0 + bj * HALF + n * 4);
#pragma unroll
        for (int ai = 0; ai < 2; ++ai)
#pragma unroll
            for (int m = 0; m < 4; ++m) { const size_t off = (size_t)(u.pm * BM + ai * HALF + wr * 64 + m * 16 + fr) * 1024 + col0;
#pragma unroll
                for (int bj = 0; bj < 2; ++bj) { const f32x4 x0 = *(const f32x4*)(x + off + bj * HALF), x1 = *(const f32x4*)(x + off + bj * HALF + 4);
                    const f32x4 v0 = x0 + gv[bj][0] * acc[ai][bj][m][0], v1 = x1 + gv[bj][1] * acc[ai][bj][m][1];
                    u32x4 w; w.x = cvt_pk_bf16(v0[0], v0[1]); w.y = cvt_pk_bf16(v0[2], v0[3]); w.z = cvt_pk_bf16(v1[0], v1[1]); w.w = cvt_pk_bf16(v1[2], v1[3]);
                    *(u32x4*)(out + off + bj * HALF) = w; } }
    }
};
__device__ __forceinline__ float silu_e(float v) { return v * __builtin_amdgcn_rcpf(1.f + __builtin_amdgcn_exp2f(-1.4426950408889634f * v)); }
struct EpiSiluMul {
    static constexpr bool PERM = true, AFTER_DRAIN = false;
    bf16_t* H;
    __device__ __forceinline__ void operator()(const f32x4 (&acc)[2][2][4][2], const Unit& u, int wr, int wc, int fr, int fq) const {
        const int half = u.pn & 1, col0 = half * 128 + wc * 32 + 8 * fq;
#pragma unroll
        for (int ai = 0; ai < 2; ++ai)
#pragma unroll
            for (int m = 0; m < 4; ++m) { const size_t row = (size_t)(u.pm * BM + ai * HALF + wr * 64 + m * 16 + fr);
                const f32x4 g0 = acc[ai][0][m][0], g1 = acc[ai][0][m][1], u0 = acc[ai][1][m][0], u1 = acc[ai][1][m][1];
                u32x4 w; w.x = cvt_pk_bf16(silu_e(g0[0]) * u0[0], silu_e(g0[1]) * u0[1]); w.y = cvt_pk_bf16(silu_e(g0[2]) * u0[2], silu_e(g0[3]) * u0[3]);
                w.z = cvt_pk_bf16(silu_e(g1[0]) * u1[0], silu_e(g1[1]) * u1[1]); w.w = cvt_pk_bf16(silu_e(g1[2]) * u1[2], silu_e(g1[3]) * u1[3]);
                *(u32x4*)(H + row * 256 + col0) = w; }
    }
};
struct EpiProjT {
    static constexpr bool PERM = true, AFTER_DRAIN = false;
    bf16_t* P;
    __device__ __forceinline__ void operator()(const f32x4 (&acc)[2][2][4][2], const Unit& u, int wr, int wc, int fr, int fq) const {
#pragma unroll
        for (int ai = 0; ai < 2; ++ai)
#pragma unroll
            for (int m = 0; m < 4; ++m) { const int row = u.pm * BM + ai * HALF + wr * 64 + m * 16 + fr;
#pragma unroll
                for (int bj = 0; bj < 2; ++bj) { const int c = (u.pn * BM + bj * HALF + wc * 32 + 8 * fq) >> 3; const f32x4 v0 = acc[ai][bj][m][0], v1 = acc[ai][bj][m][1];
                    u32x4 w; w.x = cvt_pk_bf16(v0[0], v0[1]); w.y = cvt_pk_bf16(v0[2], v0[3]); w.z = cvt_pk_bf16(v1[0], v1[1]); w.w = cvt_pk_bf16(v1[2], v1[3]);
                    *(u32x4*)(P + ((size_t)((row >> 5) * 192 + c) * 32 + (row & 31)) * 8) = w; } }
    }
};
struct EpiYs {
    static constexpr bool PERM = true, AFTER_DRAIN = false;
    bf16_t* Y;
    __device__ __forceinline__ void operator()(const f32x4 (&acc)[2][2][4][2], const Unit& u, int wr, int wc, int fr, int fq) const {
        const int col0 = (u.pn & 3) * BM + wc * 32 + 8 * fq;
#pragma unroll
        for (int ai = 0; ai < 2; ++ai)
#pragma unroll
            for (int m = 0; m < 4; ++m) { bf16_t* rowp = Y + (size_t)(u.pm * BM + ai * HALF + wr * 64 + m * 16 + fr) * 1024 + col0;
#pragma unroll
                for (int bj = 0; bj < 2; ++bj) { const f32x4 v0 = acc[ai][bj][m][0], v1 = acc[ai][bj][m][1];
                    u32x4 w; w.x = cvt_pk_bf16(v0[0], v0[1]); w.y = cvt_pk_bf16(v0[2], v0[3]); w.z = cvt_pk_bf16(v1[0], v1[1]); w.w = cvt_pk_bf16(v1[2], v1[3]);
                    *(u32x4*)(rowp + bj * HALF) = w; } }
    }
};
struct GroupedOrder {
    const __attribute__((address_space(3))) int* tp; int ncol, G, c;
    __device__ __forceinline__ bool next(int i, Unit& u) const {
        const int L = i * G + c, total = tp[32] * ncol; if (L >= total) return false;
        const int rt = L / ncol, ct = L - rt * ncol; int e = 0;
#pragma unroll 1
        for (int j = 1; j < 32; ++j) e += (tp[j] <= rt) ? 1 : 0;
        u.pm = rt; u.pn = e * ncol + ct; return true;
    }
    __device__ __forceinline__ void a_ready(const Unit&) const {}
    __device__ __forceinline__ void done(const Unit&) const {}
};
template <class Epi, class Sched, bool ALIGN_EPI = false, bool SP2 = false>
__device__ __forceinline__ void gemm_phase(PG8_LAS unsigned char* lds, const Gemm g, const Sched& S, const Epi& E) {
    const int tid = threadIdx.x, wid = __builtin_amdgcn_readfirstlane(tid >> 6), lane = tid & 63, wr = wid >> 2, wc = wid & 3, fr = lane & 15, fq = lane >> 4;
    const int K = g.K, nt = K / BK;
    unsigned voffA[2], voffB[2];
#pragma unroll
    for (int i = 0; i < 2; ++i) { int R, C; stage_rc(tid * 16 + i * 8192, R, C); const int Rb = Epi::PERM ? ((R & ~31) + perm32(R & 31)) : R;
        voffA[i] = (unsigned)(R * K + C) * 2u; voffB[i] = (unsigned)(Rb * K + C) * 2u; }
    const size_t kstep = (size_t)(BK * 2);
    const size_t hstep = (size_t)HALF * K * 2;
    const size_t tstep = 2 * hstep;
    const unsigned ldsw = (unsigned)wid * 1024u;
    const int aoff = lds_byte(wr * 64 + fr, fq * 8), boff = lds_byte(wc * 32 + fr, fq * 8);
#define PG8_SA(b, h) (((b) * 2 + (h)) * HTB)
#define PG8_SB(b, h) ((4 + (b) * 2 + (h)) * HTB)
#define PG8_STAGE(bufoff, gbase, voff) do { _Pragma("unroll") for (int _i = 0; _i < 2; ++_i) \
        __builtin_amdgcn_global_load_lds((const unsigned*)((const char*)(gbase) + (voff)[_i]), (PG8_LAS unsigned*)(lds + (bufoff) + ldsw + _i * 8192), 16, 0, 0); } while (0)
#define PG8_LDA(dst, b, h) do { _Pragma("unroll") for (int m = 0; m < 4; ++m) _Pragma("unroll") for (int k = 0; k < 2; ++k) dst[m][k] = *(const PG8_LAS bf16x8*)(lds + PG8_SA(b, h) + aoff + m * 2048 + k * 1024); } while (0)
#define PG8_LDB(dst, b, h) do { _Pragma("unroll") for (int n = 0; n < 2; ++n) _Pragma("unroll") for (int k = 0; k < 2; ++k) dst[n][k] = *(const PG8_LAS bf16x8*)(lds + PG8_SB(b, h) + boff + n * 2048 + k * 1024); } while (0)
#define PG8_MMA(ai, bj, At, Bt) do { __builtin_amdgcn_s_setprio(1); _Pragma("unroll") for (int m = 0; m < 4; ++m) _Pragma("unroll") for (int n = 0; n < 2; ++n) _Pragma("unroll") for (int k = 0; k < 2; ++k) \
        acc[ai][bj][m][n] = __builtin_amdgcn_mfma_f32_16x16x32_bf16(Bt[n][k], At[m][k], acc[ai][bj][m][n], 0, 0, 0); __builtin_amdgcn_s_setprio(0); } while (0)
#define PG8_WAIT_V(n) asm volatile("s_waitcnt vmcnt(" #n ")" ::: "memory")
#define PG8_WAIT_L(n) asm volatile("s_waitcnt lgkmcnt(" #n ")" ::: "memory")
#define PG8_BAR __builtin_amdgcn_s_barrier()
#define PG8_SCHED __builtin_amdgcn_sched_barrier(0)
    Unit cur, nxt; int ui = 0;
    if (!S.next(0, cur)) return;
    f32x4 acc[2][2][4][2];
#pragma unroll
    for (int a = 0; a < 2; ++a)
#pragma unroll
        for (int b = 0; b < 2; ++b)
#pragma unroll
            for (int m = 0; m < 4; ++m)
#pragma unroll
                for (int n = 0; n < 2; ++n) acc[a][b][m][n] = (f32x4){0.f, 0.f, 0.f, 0.f};
    bf16x8 At[4][2], B0[2][2], B1[2][2];
    const char* cA = (const char*)g.A + (size_t)cur.pm * tstep; const char* cB = (const char*)g.Bt + (size_t)cur.pn * tstep;
    S.a_ready(cur);
    if constexpr (SP2) {
        PG8_STAGE(PG8_SB(0, 0), cB, voffB); PG8_STAGE(PG8_SB(0, 1), cB + hstep, voffB); PG8_STAGE(PG8_SA(0, 0), cA, voffA); PG8_STAGE(PG8_SA(0, 1), cA + hstep, voffA);
        if (wr == 1) PG8_BAR;
        PG8_WAIT_V(2); PG8_BAR;
        PG8_STAGE(PG8_SB(1, 0), cB + kstep, voffB); PG8_STAGE(PG8_SA(1, 0), cA + kstep, voffA); PG8_STAGE(PG8_SB(1, 1), cB + hstep + kstep, voffB);
        PG8_WAIT_V(6); PG8_BAR;
    } else {
        PG8_STAGE(PG8_SB(0, 0), cB, voffB); PG8_STAGE(PG8_SA(0, 0), cA, voffA); PG8_STAGE(PG8_SB(0, 1), cB + hstep, voffB); PG8_STAGE(PG8_SA(0, 1), cA + hstep, voffA);
        if (wr == 1) PG8_BAR;
        PG8_WAIT_V(4); PG8_BAR;
        PG8_STAGE(PG8_SB(1, 0), cB + kstep, voffB); PG8_STAGE(PG8_SA(1, 0), cA + kstep, voffA); PG8_STAGE(PG8_SB(1, 1), cB + hstep + kstep, voffB);
        PG8_WAIT_V(6); PG8_BAR;
    }
    for (;;) {
        const bool has_next = S.next(ui + 1, nxt);
        const char* nA = has_next ? (const char*)g.A + (size_t)nxt.pm * tstep : cA; const char* nB = has_next ? (const char*)g.Bt + (size_t)nxt.pn * tstep : cB;
        for (int t = 0; t < nt; t += 2) {
            const bool last = (t == nt - 2);
            const char* a1 = cA + (size_t)(t + 1) * kstep;
            const char* a2 = last ? nA : cA + (size_t)(t + 2) * kstep; const char* b2 = last ? nB : cB + (size_t)(t + 2) * kstep;
            const char* a3 = a2 + kstep; const char* b3 = b2 + kstep;
            if (last && has_next) S.a_ready(nxt);
            if constexpr (SP2) {
            PG8_LDB(B0, 0, 0); PG8_LDB(B1, 0, 1); PG8_SCHED; PG8_LDA(At, 0, 0); PG8_STAGE(PG8_SA(1, 1), a1 + hstep, voffA);
            PG8_WAIT_V(8); PG8_WAIT_L(0); PG8_BAR; PG8_MMA(0, 0, At, B0); PG8_MMA(0, 1, At, B1); PG8_BAR; PG8_SCHED;
            PG8_LDA(At, 0, 1); PG8_STAGE(PG8_SB(0, 0), b2, voffB); PG8_STAGE(PG8_SB(0, 1), b2 + hstep, voffB); PG8_STAGE(PG8_SA(0, 0), a2, voffA);
            PG8_WAIT_V(8); PG8_WAIT_L(0); PG8_BAR; PG8_MMA(1, 0, At, B0); PG8_MMA(1, 1, At, B1); PG8_BAR; PG8_SCHED;
            PG8_LDB(B0, 1, 0); PG8_LDB(B1, 1, 1); PG8_SCHED; PG8_LDA(At, 1, 0); PG8_STAGE(PG8_SA(0, 1), a2 + hstep, voffA);
            PG8_WAIT_V(8); PG8_WAIT_L(0); PG8_BAR; PG8_MMA(0, 0, At, B0); PG8_MMA(0, 1, At, B1); PG8_BAR; PG8_SCHED;
            PG8_LDA(At, 1, 1); PG8_STAGE(PG8_SB(1, 0), b3, voffB); PG8_STAGE(PG8_SB(1, 1), b3 + hstep, voffB); PG8_STAGE(PG8_SA(1, 0), a3, voffA);
            PG8_WAIT_V(8); PG8_WAIT_L(0); PG8_BAR; PG8_MMA(1, 0, At, B0); PG8_MMA(1, 1, At, B1); PG8_BAR; PG8_SCHED;
            } else {
            PG8_LDB(B0, 0, 0); PG8_SCHED; PG8_LDA(At, 0, 0); PG8_STAGE(PG8_SA(1, 1), a1 + hstep, voffA);
            PG8_WAIT_L(8); PG8_BAR; PG8_WAIT_L(0); PG8_MMA(0, 0, At, B0); PG8_BAR; PG8_SCHED;
            PG8_LDB(B1, 0, 1); PG8_STAGE(PG8_SB(0, 0), b2, voffB);
            PG8_BAR; PG8_WAIT_L(0); PG8_MMA(0, 1, At, B1); PG8_BAR;
            PG8_LDA(At, 0, 1); PG8_STAGE(PG8_SA(0, 0), a2, voffA);
            PG8_BAR; PG8_WAIT_L(0); PG8_MMA(1, 0, At, B0); PG8_BAR; PG8_SCHED;
            PG8_STAGE(PG8_SB(0, 1), b2 + hstep, voffB);
            PG8_WAIT_V(6); PG8_BAR; PG8_MMA(1, 1, At, B1); PG8_BAR;
            PG8_LDB(B0, 1, 0); PG8_SCHED; PG8_LDA(At, 1, 0); PG8_STAGE(PG8_SA(0, 1), a2 + hstep, voffA);
            PG8_WAIT_L(8); PG8_BAR; PG8_WAIT_L(0); PG8_MMA(0, 0, At, B0); PG8_BAR; PG8_SCHED;
            PG8_LDB(B1, 1, 1); PG8_STAGE(PG8_SB(1, 0), b3, voffB);
            PG8_BAR; PG8_WAIT_L(0); PG8_MMA(0, 1, At, B1); PG8_BAR;
            PG8_LDA(At, 1, 1); PG8_STAGE(PG8_SA(1, 0), a3, voffA);
            PG8_BAR; PG8_WAIT_L(0); PG8_MMA(1, 0, At, B0); PG8_BAR; PG8_SCHED;
            PG8_STAGE(PG8_SB(1, 1), b3 + hstep, voffB);
            PG8_WAIT_V(6); PG8_BAR; PG8_MMA(1, 1, At, B1); PG8_BAR;
            }
        }
        if constexpr (ALIGN_EPI) { if (wr == 0) PG8_BAR; }
        if constexpr (!Epi::AFTER_DRAIN) { E(acc, cur, wr, wc, fr, fq); S.done(cur); }
        if (!has_next) break;
#pragma unroll
        for (int a = 0; a < 2; ++a)
#pragma unroll
            for (int b = 0; b < 2; ++b)
#pragma unroll
                for (int m = 0; m < 4; ++m)
#pragma unroll
                    for (int n = 0; n < 2; ++n) acc[a][b][m][n] = (f32x4){0.f, 0.f, 0.f, 0.f};
        cur = nxt; cA = nA; cB = nB; ++ui;
        if constexpr (ALIGN_EPI) { if (wr == 1) PG8_BAR; }
    }
    PG8_WAIT_V(0);
    if constexpr (!ALIGN_EPI) { if (wr == 0) PG8_BAR; }
    PG8_BAR;
    if constexpr (Epi::AFTER_DRAIN) { E.fused(acc, cur, wr, wc, fr, fq, lds, wid, lane); S.done(cur); }
#undef PG8_SA
#undef PG8_SB
#undef PG8_STAGE
#undef PG8_LDA
#undef PG8_LDB
#undef PG8_MMA
#undef PG8_WAIT_V
#undef PG8_WAIT_L
#undef PG8_BAR
#undef PG8_SCHED
}
}
#define XB_TMO      128
#define XB_XCNT(j)  (256  + 64 * (j))
#define XB_XSUB(j)  (1280 + 64 * (j))
#define XB_XGEN(j)  (2304 + 64 * (j))
#define XB_TOP      3328
#define XB_TOPGEN   3392
#define XCD_BAR_WORDS 3456
#define XB_SPIN_CAP (1u << 18)

__device__ __forceinline__ unsigned xb_ld(unsigned* p)              { return __hip_atomic_load(p, __ATOMIC_RELAXED, __HIP_MEMORY_SCOPE_AGENT); }
__device__ __forceinline__ unsigned xb_add(unsigned* p, unsigned v) { return __hip_atomic_fetch_add(p, v, __ATOMIC_RELAXED, __HIP_MEMORY_SCOPE_AGENT); }
__device__ __forceinline__ unsigned xb_xcc_id() { return (unsigned)__builtin_amdgcn_s_getreg((3 << 11) | 20) & 0xFu; }
#define XB_SPIN(cond, bar) do { unsigned _sp = 0; while (cond) { __builtin_amdgcn_s_sleep(1); \
    if ((++_sp & 255u) == 0u) { if (xb_ld(&(bar)[XB_TMO])) break; if (_sp > XB_SPIN_CAP) { atomicAdd(&(bar)[XB_TMO], 1u); break; } } } } while (0)

struct XcdBarrier {
    unsigned* bar; unsigned x;
    volatile LAS unsigned* st;
};

__device__ __forceinline__ XcdBarrier xcd_barrier_post(unsigned* bar, volatile LAS unsigned* st) {
    XcdBarrier b; b.bar = bar; b.x = xb_xcc_id(); b.st = st;
    if (threadIdx.x == 0) (void)xb_add(&bar[XB_XCNT(b.x)], 1u);
    return b;
}
__device__ __forceinline__ void xcd_barrier_complete(unsigned* bar, unsigned x, unsigned& nloc, unsigned& nx) {
    const unsigned G = gridDim.x * gridDim.y * gridDim.z;
    unsigned sum, cnt, mine, sp = 0u;
    for (;;) {
        sum = 0u; cnt = 0u; mine = 0u;
#pragma unroll
        for (unsigned j = 0; j < 16; ++j) { const unsigned c = xb_ld(&bar[XB_XCNT(j)]); sum += c; cnt += (c > 0u) ? 1u : 0u; mine = (j == x) ? c : mine; }
        if (sum == G) break;
        __builtin_amdgcn_s_sleep(1);
        if ((++sp & 255u) == 0u) { if (xb_ld(&bar[XB_TMO])) break; if (sp > XB_SPIN_CAP) { atomicAdd(&bar[XB_TMO], 1u); break; } }
    }
    nloc = mine > 0u ? mine : 1u; nx = cnt > 0u ? cnt : 1u;
}

__device__ __forceinline__ void xcd_barrier(const XcdBarrier& b) {
    asm volatile("s_waitcnt vmcnt(0)" ::: "memory");
    __syncthreads();
    if (threadIdx.x == 0) {
        unsigned* bar = b.bar;
        __builtin_amdgcn_s_waitcnt(0);
        unsigned nloc = b.st[0], nx = b.st[1];
        if (nloc == 0u) { xcd_barrier_complete(bar, b.x, nloc, nx); b.st[0] = nloc; b.st[1] = nx; }
        const unsigned old = xb_add(&bar[XB_XSUB(b.x)], 1u);
        const unsigned gen = old / nloc;
        if (old + 1u == (gen + 1u) * nloc) {
            __builtin_amdgcn_fence(__ATOMIC_RELEASE, "agent");
            asm volatile("s_waitcnt vmcnt(0)" ::: "memory");
            const unsigned og = xb_add(&bar[XB_TOP], 1u);
            const unsigned tg = og / nx;
            if (og + 1u == (tg + 1u) * nx) xb_add(&bar[XB_TOPGEN], 1u);
            else XB_SPIN(xb_ld(&bar[XB_TOPGEN]) == tg, bar);
            __builtin_amdgcn_fence(__ATOMIC_ACQUIRE, "agent");
            xb_add(&bar[XB_XGEN(b.x)], 1u);
            asm volatile("s_waitcnt vmcnt(0)" ::: "memory");
        } else {
            XB_SPIN(xb_ld(&bar[XB_XGEN(b.x)]) == gen, bar);
            __builtin_amdgcn_fence(__ATOMIC_ACQUIRE, "agent");
            asm volatile("s_waitcnt vmcnt(0)" ::: "memory");
        }
    }
    __syncthreads();
}
struct Args { const void* in[31]; float* out; unsigned char* ws; int ph_lo, ph_hi, li, pad; };
struct Frame {
    LAS unsigned char* lds; volatile LAS unsigned* MISC; gu32* ctl;
    int tid, lane, wave, vcu, G;
    unsigned char* ws; float* out;
};
__device__ __forceinline__ float wave_sum_f(float v) {
#pragma unroll
    for (int o = 1; o < 64; o <<= 1) v += __shfl_xor(v, o);
    return v;
}
__device__ __forceinline__ void p0_transpose_item(const float* W, int K, int N, bf16_t* WT, int row_off, LAS float* scr, int kb, int nb, int lane) {
    const int k0 = 64 * kb, n0 = 32 * nb;
#pragma unroll 8
    for (int i = 0; i < 32; ++i) { const int kk = 2 * i + (lane >> 5); scr[kk * 33 + (lane & 31)] = W[(size_t)(k0 + kk) * N + n0 + (lane & 31)]; }
    LDS_WAIT(); asm volatile("" ::: "memory");
    const int c = lane & 7;
#pragma unroll
    for (int j = 0; j < 4; ++j) { const int n = (lane >> 3) + 8 * j; const LAS float* s = scr + (8 * c) * 33 + n;
        v4u o; o.x = pk2(s[0 * 33], s[1 * 33]); o.y = pk2(s[2 * 33], s[3 * 33]); o.z = pk2(s[4 * 33], s[5 * 33]); o.w = pk2(s[6 * 33], s[7 * 33]);
        *(GAS v4u*)(WT + (size_t)(row_off + n0 + n) * K + k0 + 8 * c) = o; }
    LDS_WAIT(); asm volatile("" ::: "memory");
}
__device__ __forceinline__ int lru_chan(int ks, int hi, int j) { return 32 * (ks >> 1) + 16 * (ks & 1) + 8 * (j >> 2) + 4 * hi + (j & 3); }
__device__ __forceinline__ void phase_prologue(Frame& F, const Inputs& I) {
    if (blockIdx.x < 192) {
        LAS float* sl = (LAS float*)F.lds; LAS float* red = sl + 4096;
        for (int i = ((int)threadIdx.x); i < 4096; i += 512) { const float v = I.c[i]; sl[i] = v / (1.f + __expf(-v)); }
        __syncthreads();
        const int col0 = blockIdx.x * 32, kg = ((int)threadIdx.x) >> 5, col = ((int)threadIdx.x) & 31;
        float a0 = 0.f, a1 = 0.f, a2 = 0.f, a3 = 0.f;
#pragma unroll 8
        for (int i = 0; i < 64; ++i) { const int k = kg + 16 * i; const float w = I.w_ada[(size_t)k * MODW + col0 + col];
            a0 += sl[k] * w; a1 += sl[1024 + k] * w; a2 += sl[2048 + k] * w; a3 += sl[3072 + k] * w; }
        red[(kg * 4 + 0) * 32 + col] = a0; red[(kg * 4 + 1) * 32 + col] = a1; red[(kg * 4 + 2) * 32 + col] = a2; red[(kg * 4 + 3) * 32 + col] = a3;
        __syncthreads();
        if (((int)threadIdx.x) < 128) { const int b = ((int)threadIdx.x) >> 5, c = ((int)threadIdx.x) & 31; float s = I.b_ada[col0 + c];
            for (int g = 0; g < 16; ++g) s += red[(g * 4 + b) * 32 + c];
            ((float*)(F.ws + WS_MOD))[b * MODW + col0 + c] = s; }
        __syncthreads();
    }
    {
        LAS float* scr = (LAS float*)(F.lds + F.wave * 16384);
        const int gw = F.vcu * NWAVES + F.wave, NGW = F.G * NWAVES;
        bf16_t* WIN = (bf16_t*)(F.ws + WSX_WIN); bf16_t* WOUT = (bf16_t*)(F.ws + WSX_WOUT); bf16_t* W1T = (bf16_t*)(F.ws + WSX_W1T); bf16_t* W2T = (bf16_t*)(F.ws + WSX_W2T);
        constexpr int I_IN = 16 * 46, I_OUT = 16 * 32, I_G = 32 * 16 * 8, I_D = 32 * 4 * 32, NIT = I_IN + I_OUT + 2 * I_G + I_D;
        for (int it = gw; it < NIT; it += NGW) {
            int r = it;
            if (r < I_IN) { p0_transpose_item(I.w_in, 1024, NPROJ, WIN, 0, scr, r / 46, r % 46, ((int)(threadIdx.x & 63))); continue; } r -= I_IN;
            if (r < I_OUT) { p0_transpose_item(I.w_out, 1024, 1024, WOUT, 0, scr, r / 32, r % 32, ((int)(threadIdx.x & 63))); continue; } r -= I_OUT;
            if (r < 2 * I_G) { const int up = r >= I_G ? 1 : 0; if (up) r -= I_G; const int e = r >> 7, kb = (r >> 3) & 15, nb = r & 7, n0 = 32 * nb;
                p0_transpose_item((up ? I.w_up : I.w_gate) + (size_t)e * 1024 * 256, 1024, 256, W1T, e * 512 + (n0 >> 7) * 256 + (n0 & 127) - n0 + up * 128, scr, kb, nb, ((int)(threadIdx.x & 63))); continue; } r -= 2 * I_G;
            { const int e = r >> 7, kb = (r >> 5) & 3, nb = r & 31; p0_transpose_item(I.w_down + (size_t)e * 256 * 1024, 256, 1024, W2T, e * 1024, scr, kb, nb, ((int)(threadIdx.x & 63))); }
        }
    }
    {
        const int gt = blockIdx.x * 512 + ((int)threadIdx.x), NGT = F.G * 512;
        v4u* WQF = (v4u*)(F.ws + WSX_WQF); v4u* WKVF = (v4u*)(F.ws + WSX_WKVF); v4u* WAF = (v4u*)(F.ws + WSX_WAF); v4u* WXF = (v4u*)(F.ws + WSX_WXF); v4u* WRF = (v4u*)(F.ws + WSX_WRF);
        constexpr int NQ = 4 * 6 * 16 * 64, NKV = 4 * 8 * 8 * 64, NA = 4 * 4 * 8 * 64, NR = 2 * 64 * 64, NZ = 64 * 1024 / 8, NTOT = NQ + NKV + 2 * NA + NR + NZ;
        for (int g = gt; g < NTOT; g += NGT) {
            int r = g; float v[8];
            if (r < NQ) { const int lane = r & 63, ks = (r >> 6) & 15, hn = r >> 10, h = hn / 6, nb = hn % 6, hi = lane >> 5, r32 = lane & 31;
#pragma unroll
                for (int j = 0; j < 8; ++j) { const int k = 16 * ks + 8 * hi + j; v[j] = I.w_q_b[(size_t)k * 768 + h * 192 + 32 * nb + r32] * I.q_a_norm[k]; }
                WQF[r] = (v4u){pk2(v[0], v[1]), pk2(v[2], v[3]), pk2(v[4], v[5]), pk2(v[6], v[7])}; continue; } r -= NQ;
            if (r < NKV) { const int lane = r & 63, ks = (r >> 6) & 7, hn = r >> 9, h = hn >> 3, nb = hn & 7, hi = lane >> 5, r32 = lane & 31;
#pragma unroll
                for (int j = 0; j < 8; ++j) { const int k = 16 * ks + 8 * hi + j; v[j] = I.w_kv_b[(size_t)k * 1024 + h * 256 + 32 * nb + r32] * I.kv_a_norm[k]; }
                WKVF[r] = (v4u){pk2(v[0], v[1]), pk2(v[2], v[3]), pk2(v[4], v[5]), pk2(v[6], v[7])}; continue; } r -= NKV;
            if (r < 2 * NA) { const int x = r >= NA ? 1 : 0; if (x) r -= NA; const int lane = r & 63, ks = (r >> 6) & 7, hn = r >> 9, h = hn >> 2, nb = hn & 3, hi = lane >> 5, r32 = lane & 31;
                const float* W = x ? I.lru_wx : I.lru_wa;
#pragma unroll
                for (int j = 0; j < 8; ++j) v[j] = W[(size_t)(h * 128 + lru_chan(ks, hi, j)) * 128 + 32 * nb + r32];
                (x ? WXF : WAF)[r] = (v4u){pk2(v[0], v[1]), pk2(v[2], v[3]), pk2(v[4], v[5]), pk2(v[6], v[7])}; continue; } r -= 2 * NA;
            if (r < NR) { const int lane = r & 63, ks = (r >> 6) & 63, nb = r >> 12, hi = lane >> 5, n = 32 * nb + (lane & 31);
#pragma unroll
                for (int j = 0; j < 8; ++j) { const int k = 16 * ks + 8 * hi + j; v[j] = n < 4 ? I.w_rg[k * 4 + n] : (n < 36 ? I.w_re[k * 32 + n - 4] : 0.f); }
                WRF[r] = (v4u){pk2(v[0], v[1]), pk2(v[2], v[3]), pk2(v[4], v[5]), pk2(v[6], v[7])}; continue; } r -= NR;
            ((v4u*)(F.ws + WSX_WIN + (size_t)NPROJ * 1024 * 2))[r] = (v4u){0u, 0u, 0u, 0u};
        }
        if (gt < 512) ((float*)(F.ws + WSX_SP))[gt] = log1pf(__expf(-I.lru_lambda[gt]));
        float* CS = (float*)(F.ws + WSX_CS);
        for (int g = gt; g < NTOK * 32; g += NGT) { const int t = g >> 5, i = g & 31; float c, s; rope_cs(I.positions[t], i, c, s); CS[t * 64 + i] = c; CS[t * 64 + 32 + i] = s; }
    }
}
__device__ __forceinline__ void phase_xn(Frame& F, const Inputs& I) {
    LAS float* Gs = (LAS float*)F.lds; LAS float* Ss = Gs + 4096;
    const float* mod = (const float*)(F.ws + WS_MOD);
#pragma unroll
    for (int i = ((int)threadIdx.x); i < 4096; i += 512) { const int b = i >> 10, k = i & 1023; Gs[i] = I.norm1_g[k] * (1.f + mod[b * MODW + 1024 + k]); Ss[i] = mod[b * MODW + k]; }
    __syncthreads();
    bf16_t* XN = (bf16_t*)(F.ws + WSX_A);
    const int gw = F.vcu * NWAVES + F.wave, NGW = F.G * NWAVES;
    for (int m0 = gw; m0 < NTOK; m0 += 2 * NGW) {
        f32x4 v[2][4];
#pragma unroll
        for (int u = 0; u < 2; ++u) { const GAS f32x4* xr = (const GAS f32x4*)(I.x + (size_t)(m0 + u * NGW) * DM) + ((int)(threadIdx.x & 63));
#pragma unroll
            for (int j = 0; j < 4; ++j) v[u][j] = xr[64 * j]; }
#pragma unroll
        for (int u = 0; u < 2; ++u) { const int m = m0 + u * NGW, b = m >> 13; float s = 0.f;
#pragma unroll
            for (int j = 0; j < 4; ++j) s += (v[u][j].x * v[u][j].x + v[u][j].y * v[u][j].y) + (v[u][j].z * v[u][j].z + v[u][j].w * v[u][j].w);
            const float rstd = rsqrtf(wave_sum_f(s) * (1.f / DM) + EPS);
            GAS v2u* o8 = (GAS v2u*)(XN + (size_t)m * DM) + ((int)(threadIdx.x & 63));
#pragma unroll
            for (int j = 0; j < 4; ++j) { const f32x4 g = *(const LAS f32x4*)(Gs + b * 1024 + 256 * j + 4 * ((int)(threadIdx.x & 63))), sh = *(const LAS f32x4*)(Ss + b * 1024 + 256 * j + 4 * ((int)(threadIdx.x & 63)));
                const f32x4 o = v[u][j] * rstd * g + sh; o8[64 * j] = (v2u){pk2(o.x, o.y), pk2(o.z, o.w)}; } }
    }
    __syncthreads();
}
namespace att {
constexpr int NW = 8, QBLK = 32, KVBLK = 64, QB = NW * QBLK;
constexpr int DQ = 192, DVV = 128, OPITCH = 512;
constexpr int SHM_V = KVBLK * DVV * 2, SHM_K = KVBLK * DQ * 2;
constexpr int ATT_LDS = 3 * SHM_V + 3 * SHM_K + NW * 64 * 4;
constexpr float SCALE = 0.07216878364870322f;
constexpr float THR = 8.f;
#define SBAR() __builtin_amdgcn_sched_barrier(0)
__device__ __forceinline__ int koff(int row, int chunk) { return (chunk >> 3) * 8192 + row * 128 + ((((chunk & 7) ^ ((row >> 1) & 7))) << 4); }
__device__ __forceinline__ int v_st(int k, int c) { const int kk = (k & ~0xC) | ((k & 4) << 1) | ((k & 8) >> 1); return ((kk >> 3) * 4 + (c >> 5)) * 512 + ((kk & 7) * 32 + (c & 31)) * 2; }
__device__ __forceinline__ int v_rd_base(int lane) { return ((lane & 3) << 3) | (((lane >> 2) & 3) << 6) | (((lane >> 4) & 1) << 5) | (((lane >> 5) & 1) << 8); }
constexpr int v_rd_off(int d0, int ks, int half) { return d0 * 512 + ks * 4096 + half * 2048; }
__device__ __forceinline__ int crow(int r, int hi) { return (r & 3) + 8 * (r >> 2) + 4 * hi; }
__device__ __forceinline__ bf16x8 ld8(const bf16_t* p) { return *reinterpret_cast<const bf16x8*>(p); }
__device__ __forceinline__ void mask_tile(f32x16& p0, f32x16& p1, int dq) {
    const float NEG = -__builtin_inff();
#pragma unroll
    for (int r = 0; r < 16; ++r) { const int c = (r & 3) + 8 * (r >> 2); if (dq - c < 0) p0[r] = NEG; if (dq - c - 32 < 0) p1[r] = NEG; }
}
__device__ __forceinline__ void partialSM(f32x16& p0, f32x16& p1, float& m_reg, float& mn, float& alpha) {
    float pmax = p0[0];
#pragma unroll
    for (int r = 1; r < 16; ++r) pmax = fmaxf(pmax, p0[r]);
#pragma unroll
    for (int r = 0; r < 16; ++r) pmax = fmaxf(pmax, p1[r]);
    { auto rr = __builtin_amdgcn_permlane32_swap(__float_as_uint(pmax), __float_as_uint(pmax), false, false); pmax = fmaxf(__uint_as_float(rr[0]), __uint_as_float(rr[1])); }
    constexpr float C2 = 1.4426950408889634f * SCALE;
    if (__builtin_expect(__all((pmax - m_reg) * SCALE <= THR), 1)) { mn = m_reg; alpha = 1.f; }
    else { mn = fmaxf(m_reg, pmax); alpha = __builtin_amdgcn_exp2f((m_reg - mn) * C2); m_reg = mn; }
    const float mnL = -mn * C2;
#pragma unroll
    for (int r = 0; r < 16; ++r) p0[r] = fmaf(p0[r], C2, mnL);
#pragma unroll
    for (int r = 0; r < 16; ++r) p1[r] = fmaf(p1[r], C2, mnL);
#pragma unroll
    for (int r = 0; r < 16; ++r) p0[r] = __builtin_amdgcn_exp2f(p0[r]);
}
__device__ __forceinline__ void finishSM(f32x16& p0, f32x16& p1, float alpha, float& l_reg, bf16x8& pa0, bf16x8& pa1, bf16x8& pa2, bf16x8& pa3) {
#pragma unroll
    for (int r = 0; r < 16; ++r) p1[r] = __builtin_amdgcn_exp2f(p1[r]);
    float ps = 0;
#pragma unroll
    for (int r = 0; r < 16; ++r) ps += p0[r];
#pragma unroll
    for (int r = 0; r < 16; ++r) ps += p1[r];
    { auto rr = __builtin_amdgcn_permlane32_swap(__float_as_uint(ps), __float_as_uint(ps), false, false); ps = __uint_as_float(rr[0]) + __uint_as_float(rr[1]); }
    l_reg = l_reg * alpha + ps;
#define PK4(P, B_, OUT) do { unsigned a0 = cvtpk(P[B_+0], P[B_+1]), a1 = cvtpk(P[B_+2], P[B_+3]); unsigned b0 = cvtpk(P[B_+4], P[B_+5]), b1 = cvtpk(P[B_+6], P[B_+7]); \
        auto r0 = __builtin_amdgcn_permlane32_swap(a0, b0, false, false); auto r1 = __builtin_amdgcn_permlane32_swap(a1, b1, false, false); \
        v4u w = {r0[0], r1[0], r0[1], r1[1]}; OUT = *reinterpret_cast<bf16x8*>(&w); } while (0)
    PK4(p0, 0, pa0); PK4(p0, 8, pa1); PK4(p1, 0, pa2); PK4(p1, 8, pa3);
#undef PK4
}
template <int KB>
__device__ __forceinline__ void qkt(f32x16& p0, f32x16& p1, const char* K_lds, int r32, int hi, const bf16x8* qr) {
    p0 = f32x16{}; p1 = f32x16{};
    const char* kb[4];
#pragma unroll
    for (int dd = 0; dd < 4; ++dd) kb[dd] = K_lds + KB * SHM_K + koff(r32, 2 * dd + hi);
    bf16x8 kf[2][2];
#define KLD(d) do { const char* a_ = kb[(d) & 3] + ((d) >> 2) * 8192; kf[(d) & 1][0] = *reinterpret_cast<const bf16x8*>(a_); kf[(d) & 1][1] = *reinterpret_cast<const bf16x8*>(a_ + 32 * 128); } while (0)
    KLD(0);
#pragma unroll
    for (int d0 = 0; d0 < 12; ++d0) { if (d0 + 1 < 12) KLD(d0 + 1);
        p0 = __builtin_amdgcn_mfma_f32_32x32x16_bf16(kf[d0 & 1][0], qr[d0], p0, 0, 0, 0);
        p1 = __builtin_amdgcn_mfma_f32_32x32x16_bf16(kf[d0 & 1][1], qr[d0], p1, 0, 0, 0); }
#undef KLD
    __builtin_amdgcn_sched_group_barrier(0x100, 2, 0);
#pragma unroll
    for (int d0 = 0; d0 < 11; ++d0) { __builtin_amdgcn_sched_group_barrier(0x100, 2, 0); __builtin_amdgcn_sched_group_barrier(0x8, 2, 0); }
    __builtin_amdgcn_sched_group_barrier(0x8, 2, 0);
}
template <int VB>
__device__ __forceinline__ void pv_tile(f32x16* o, int vb0, bf16x8 pa0, bf16x8 pa1, bf16x8 pa2, bf16x8 pa3) {
    s16x4 lo[2][4], hv[2][4];
#define TRRD(dst, off) asm volatile("ds_read_b64_tr_b16 %0, %1 offset:%2" : "=&v"(dst) : "v"(vb0), "i"(off) : "memory")
#define VLD(d) do { TRRD(lo[(d) & 1][0], VB * SHM_V + v_rd_off((d), 0, 0)); TRRD(hv[(d) & 1][0], VB * SHM_V + v_rd_off((d), 0, 1)); TRRD(lo[(d) & 1][1], VB * SHM_V + v_rd_off((d), 1, 0)); TRRD(hv[(d) & 1][1], VB * SHM_V + v_rd_off((d), 1, 1)); \
        TRRD(lo[(d) & 1][2], VB * SHM_V + v_rd_off((d), 2, 0)); TRRD(hv[(d) & 1][2], VB * SHM_V + v_rd_off((d), 2, 1)); TRRD(lo[(d) & 1][3], VB * SHM_V + v_rd_off((d), 3, 0)); TRRD(hv[(d) & 1][3], VB * SHM_V + v_rd_off((d), 3, 1)); } while (0)
#define VF(d, k) (bf16x8){lo[(d) & 1][k][0], lo[(d) & 1][k][1], lo[(d) & 1][k][2], lo[(d) & 1][k][3], hv[(d) & 1][k][0], hv[(d) & 1][k][1], hv[(d) & 1][k][2], hv[(d) & 1][k][3]}
#define PVM(d) do { o[d] = __builtin_amdgcn_mfma_f32_32x32x16_bf16(pa0, VF(d, 0), o[d], 0, 0, 0); o[d] = __builtin_amdgcn_mfma_f32_32x32x16_bf16(pa1, VF(d, 1), o[d], 0, 0, 0); \
        o[d] = __builtin_amdgcn_mfma_f32_32x32x16_bf16(pa2, VF(d, 2), o[d], 0, 0, 0); o[d] = __builtin_amdgcn_mfma_f32_32x32x16_bf16(pa3, VF(d, 3), o[d], 0, 0, 0); } while (0)
    asm volatile("s_waitcnt lgkmcnt(0)" ::: "memory");
    VLD(0); VLD(1); asm volatile("s_waitcnt lgkmcnt(8)" ::: "memory"); SBAR(); PVM(0); SBAR();
    VLD(2); asm volatile("s_waitcnt lgkmcnt(8)" ::: "memory"); SBAR(); PVM(1); SBAR();
    VLD(3); asm volatile("s_waitcnt lgkmcnt(8)" ::: "memory"); SBAR(); PVM(2); SBAR();
    asm volatile("s_waitcnt lgkmcnt(0)" ::: "memory"); SBAR(); PVM(3);
#undef PVM
#undef VF
#undef VLD
#undef TRRD
}
template <bool DOPV>
__device__ __forceinline__ void pv_sm(f32x16* o, int vb0, bf16x8 pa0, bf16x8 pa1, bf16x8 pa2, bf16x8 pa3, f32x16& p0, f32x16& p1, float& m_reg, float& al_out) {
    s16x4 lo[2][4], hv[2][4];
#define TRRD(dst, off) asm volatile("ds_read_b64_tr_b16 %0, %1 offset:%2" : "=&v"(dst) : "v"(vb0), "i"(off) : "memory")
#define VLD(d) do { if (DOPV) { TRRD(lo[(d) & 1][0], v_rd_off((d), 0, 0)); TRRD(hv[(d) & 1][0], v_rd_off((d), 0, 1)); TRRD(lo[(d) & 1][1], v_rd_off((d), 1, 0)); TRRD(hv[(d) & 1][1], v_rd_off((d), 1, 1)); \
        TRRD(lo[(d) & 1][2], v_rd_off((d), 2, 0)); TRRD(hv[(d) & 1][2], v_rd_off((d), 2, 1)); TRRD(lo[(d) & 1][3], v_rd_off((d), 3, 0)); TRRD(hv[(d) & 1][3], v_rd_off((d), 3, 1)); } } while (0)
#define VF(d, k) (bf16x8){lo[(d) & 1][k][0], lo[(d) & 1][k][1], lo[(d) & 1][k][2], lo[(d) & 1][k][3], hv[(d) & 1][k][0], hv[(d) & 1][k][1], hv[(d) & 1][k][2], hv[(d) & 1][k][3]}
#define MM(d, k, PA) do { if (DOPV) o[d] = __builtin_amdgcn_mfma_f32_32x32x16_bf16(PA, VF(d, k), o[d], 0, 0, 0); SBAR(); } while (0)
#define LW(N) do { if (DOPV) asm volatile("s_waitcnt lgkmcnt(" #N ")" ::: "memory"); SBAR(); } while (0)
#define MX3(a, b, c) __builtin_fmaxf(__builtin_fmaxf((a), (b)), (c))
    constexpr float C2 = 1.4426950408889634f * SCALE;
    float mx, mn, mnL, al;
    LW(0); VLD(0); VLD(1); LW(8);
    MM(0, 0, pa0); mx = MX3(p0[0], p0[1], p0[2]); mx = MX3(mx, p0[3], p0[4]); mx = MX3(mx, p0[5], p0[6]); mx = MX3(mx, p0[7], p0[8]); SBAR();
    MM(0, 1, pa1); mx = MX3(mx, p0[9], p0[10]); mx = MX3(mx, p0[11], p0[12]); mx = MX3(mx, p0[13], p0[14]); mx = MX3(mx, p0[15], p1[0]); SBAR();
    MM(0, 2, pa2); mx = MX3(mx, p1[1], p1[2]); mx = MX3(mx, p1[3], p1[4]); mx = MX3(mx, p1[5], p1[6]); mx = MX3(mx, p1[7], p1[8]); SBAR();
    MM(0, 3, pa3); mx = MX3(mx, p1[9], p1[10]); mx = MX3(mx, p1[11], p1[12]); mx = MX3(mx, p1[13], p1[14]); mx = __builtin_fmaxf(mx, p1[15]); SBAR();
    VLD(2); LW(8);
    MM(1, 0, pa0); { auto rr = __builtin_amdgcn_permlane32_swap(__float_as_uint(mx), __float_as_uint(mx), false, false); mx = __builtin_fmaxf(__uint_as_float(rr[0]), __uint_as_float(rr[1])); }
        { const bool keep = __all((mx - m_reg) * SCALE <= THR); mn = keep ? m_reg : __builtin_fmaxf(m_reg, mx); al = __builtin_amdgcn_exp2f((m_reg - mn) * C2); m_reg = mn; mnL = -mn * C2; } SBAR();
#define FM4(P, B) do { P[B] = fmaf(P[B], C2, mnL); P[B + 1] = fmaf(P[B + 1], C2, mnL); P[B + 2] = fmaf(P[B + 2], C2, mnL); P[B + 3] = fmaf(P[B + 3], C2, mnL); } while (0)
#define EX2(P, B) do { P[B] = __builtin_amdgcn_exp2f(P[B]); P[B + 1] = __builtin_amdgcn_exp2f(P[B + 1]); } while (0)
    MM(1, 1, pa1); FM4(p0, 0); FM4(p0, 4); SBAR();
    MM(1, 2, pa2); FM4(p0, 8); FM4(p0, 12); SBAR();
    MM(1, 3, pa3); FM4(p1, 0); FM4(p1, 4); SBAR();
    VLD(3); LW(8);
    MM(2, 0, pa0); FM4(p1, 8); FM4(p1, 12); SBAR();
    MM(2, 1, pa1); EX2(p0, 0); EX2(p0, 2); SBAR();
    MM(2, 2, pa2); EX2(p0, 4); EX2(p0, 6); SBAR();
    MM(2, 3, pa3); EX2(p0, 8); EX2(p0, 10); SBAR();
    LW(0);
    MM(3, 0, pa0); EX2(p0, 12); EX2(p0, 14); SBAR();
    MM(3, 1, pa1); EX2(p1, 0); EX2(p1, 2); SBAR();
    MM(3, 2, pa2); EX2(p1, 4); EX2(p1, 6); SBAR();
    MM(3, 3, pa3); EX2(p1, 8); EX2(p1, 10); SBAR();
    al_out = al;
#undef EX2
#undef FM4
#undef MX3
#undef LW
#undef MM
#undef VF
#undef VLD
#undef TRRD
}
__device__ __forceinline__ void qkt_fin(f32x16& n0, f32x16& n1, const char* Kslot, int r32, int hi, const bf16x8* qr, f32x16& p0, f32x16& p1, bf16x8& pa0, bf16x8& pa1, bf16x8& pa2, bf16x8& pa3, float& l_reg, float al) {
    n0 = f32x16{}; n1 = f32x16{};
    const char* kb[4];
#pragma unroll
    for (int dd = 0; dd < 4; ++dd) kb[dd] = Kslot + koff(r32, 2 * dd + hi);
    bf16x8 kf[2][2];
#define KLD(d) do { const char* a_ = kb[(d) & 3] + ((d) >> 2) * 8192; kf[(d) & 1][0] = *reinterpret_cast<const bf16x8*>(a_); kf[(d) & 1][1] = *reinterpret_cast<const bf16x8*>(a_ + 32 * 128); } while (0)
#define QM(d) do { if ((d) + 1 < 12) KLD((d) + 1); n0 = __builtin_amdgcn_mfma_f32_32x32x16_bf16(kf[(d) & 1][0], qr[d], n0, 0, 0, 0); n1 = __builtin_amdgcn_mfma_f32_32x32x16_bf16(kf[(d) & 1][1], qr[d], n1, 0, 0, 0); SBAR(); } while (0)
#define PK4(P, B_, OUT) do { unsigned a0 = cvtpk(P[B_+0], P[B_+1]), a1 = cvtpk(P[B_+2], P[B_+3]); unsigned b0 = cvtpk(P[B_+4], P[B_+5]), b1 = cvtpk(P[B_+6], P[B_+7]); \
        auto r0 = __builtin_amdgcn_permlane32_swap(a0, b0, false, false); auto r1 = __builtin_amdgcn_permlane32_swap(a1, b1, false, false); \
        v4u w = {r0[0], r1[0], r0[1], r1[1]}; OUT = *reinterpret_cast<bf16x8*>(&w); } while (0)
    float ps;
    KLD(0); SBAR();
    QM(0); p1[12] = __builtin_amdgcn_exp2f(p1[12]); p1[13] = __builtin_amdgcn_exp2f(p1[13]); p1[14] = __builtin_amdgcn_exp2f(p1[14]); p1[15] = __builtin_amdgcn_exp2f(p1[15]); SBAR();
    QM(1); ps = (p0[0] + p0[1]) + (p0[2] + p0[3]); ps += (p0[4] + p0[5]) + (p0[6] + p0[7]); SBAR();
    QM(2); ps += (p0[8] + p0[9]) + (p0[10] + p0[11]); ps += (p0[12] + p0[13]) + (p0[14] + p0[15]); SBAR();
    QM(3); ps += (p1[0] + p1[1]) + (p1[2] + p1[3]); ps += (p1[4] + p1[5]) + (p1[6] + p1[7]); SBAR();
    QM(4); ps += (p1[8] + p1[9]) + (p1[10] + p1[11]); ps += (p1[12] + p1[13]) + (p1[14] + p1[15]); SBAR();
    QM(5); { auto rr = __builtin_amdgcn_permlane32_swap(__float_as_uint(ps), __float_as_uint(ps), false, false); ps = __uint_as_float(rr[0]) + __uint_as_float(rr[1]); } l_reg = l_reg * al + ps; SBAR();
    QM(6); PK4(p0, 0, pa0); SBAR();
    QM(7); PK4(p0, 8, pa1); SBAR();
    QM(8); PK4(p1, 0, pa2); SBAR();
    QM(9); PK4(p1, 8, pa3); SBAR();
    QM(10); QM(11);
#undef PK4
#undef QM
#undef KLD
}
__device__ __forceinline__ int kperm(int l) { return ((l & 7) << 1) | ((l >> 3) & 1) | (l & 48); }
__device__ __forceinline__ int kpiece(int tid) { return (tid >> 6) * 64 + kperm(tid & 63); }
__device__ __forceinline__ int vpiece(int tid, int i) { const int l = tid & 63, w = tid >> 6; return (4 * (w & 3) + (l & 3)) * 64 + (l >> 2) + 16 * ((w >> 2) + 2 * i); }
struct BlockRef { const bf16_t* Q; const bf16_t* K; const bf16_t* V; bf16_t* O; int P0; };
#define VMW() asm volatile("s_waitcnt vmcnt(0)" ::: "memory")
__device__ __forceinline__ void dma16(const void* gsrc, char* ldst) { __builtin_amdgcn_global_load_lds((const unsigned*)gsrc, (__attribute__((address_space(3))) unsigned*)(uintptr_t)ldst, 16, 0, 0); }
#define WAITBAR(N) asm volatile("s_waitcnt vmcnt(" #N ") lgkmcnt(0)\n\ts_barrier" ::: "memory")
template <int ABL>
__device__ __forceinline__ void attn_block(const BlockRef& cur, char* lds) {
    int tid_ = threadIdx.x; asm volatile("" : "+v"(tid_));
    const int tid = tid_, wid = __builtin_amdgcn_readfirstlane(tid >> 6), lane = tid & 63, r32 = lane & 31, hi = lane >> 5;
    const int NT = (cur.P0 + QB - 1) / KVBLK + 1;
    const int qlo = cur.P0 + wid * QBLK;
    char* V_lds = lds; char* K_lds = lds + 3 * SHM_V;
    float* ws = (float*)(lds + 3 * SHM_V + 3 * SHM_K) + wid * 64; float* li_l = ws, * al_l = ws + 32;
    float m_reg = -1e30f, l_reg = 0; f32x16 o[4] = {};
    const int krow = 8 * wid + (lane >> 3), ksx = (lane & 7) ^ ((krow >> 1) & 7), ksrc = (ksx * 64 + krow) * 8;
    int vsrc[2];
#pragma unroll
    for (int i = 0; i < 2; ++i) { const int st = 2 * (wid + 8 * i) + (lane >> 5), kk = (st >> 2) * 8 + ((lane & 31) >> 2), c = (st & 3) * 32 + (lane & 3) * 8;
        const int k = (kk & ~0xC) | ((kk & 4) << 1) | ((kk & 8) >> 1); vsrc[i] = ((c >> 3) * 64 + k) * 8; }
    const int vbase = (int)(uintptr_t)V_lds;
    const bf16_t* Kh = cur.K; const bf16_t* Vh = cur.V;
#define DMA_K(t, slot) do { const bf16_t* kt_ = Kh + (size_t)(t) * KVBLK * DQ + ksrc; char* kd_ = K_lds + (slot) * SHM_K + wid * 1024; \
        dma16(kt_, kd_); dma16(kt_ + 4096, kd_ + 8192); dma16(kt_ + 8192, kd_ + 16384); } while (0)
#define DMA_V(t, slot) do { const bf16_t* vt_ = Vh + (size_t)(t) * KVBLK * DVV; char* vd_ = V_lds + (slot) * SHM_V + wid * 1024; dma16(vt_ + vsrc[0], vd_); dma16(vt_ + vsrc[1], vd_ + 8192); } while (0)
    bf16x8 qr[12], pa0, pa1, pa2, pa3; f32x16 p0, p1;
#pragma unroll
    for (int d0 = 0; d0 < 12; ++d0) qr[d0] = ld8(cur.Q + (size_t)wid * QBLK * DQ + (2 * d0 + hi) * 256 + r32 * 8);
    DMA_K(0, 0); DMA_K(1, 1); DMA_V(0, 0);
    WAITBAR(0);
    int s0 = 0, s1 = 1, s2 = 2;
    f32x16 q0, q1; float alp = 1.f;
#define RESC(a) do { if (__any((a) < 1.f)) { asm volatile("" ::: "memory"); if (hi == 0) al_l[r32] = (a); asm volatile("s_waitcnt lgkmcnt(0)" ::: "memory"); \
        _Pragma("unroll") for (int d_ = 0; d_ < 4; ++d_) _Pragma("unroll") for (int r = 0; r < 16; ++r) o[d_][r] *= al_l[crow(r, hi)]; } } while (0)
#define ROT3() do { const int tmp = s0; s0 = s1; s1 = s2; s2 = tmp; } while (0)
    {
        DMA_K(2, s2); DMA_V(1, s1);
        SBAR(); qkt<0>(p0, p1, K_lds + s0 * SHM_K, r32, hi, qr); SBAR();
        if (KVBLK - 1 > qlo) { asm volatile("" ::: "memory"); mask_tile(p0, p1, qlo + r32 - 4 * hi); }
        pv_sm<false>(o, 0, pa0, pa1, pa2, pa3, p0, p1, m_reg, alp);
        WAITBAR(5); ROT3(); }
#define STEP(t, N0, N1, O0, O1) do { \
        if ((t) + 2 < NT) DMA_K((t) + 2, s2); \
        if ((t) + 1 < NT) DMA_V((t) + 1, s1); \
        SBAR(); qkt_fin(N0, N1, K_lds + s0 * SHM_K, r32, hi, qr, O0, O1, pa0, pa1, pa2, pa3, l_reg, alp); SBAR(); \
        { const int kb_ = (t) * KVBLK; if (kb_ + KVBLK - 1 > qlo) { asm volatile("" ::: "memory"); mask_tile(N0, N1, qlo + r32 - 4 * hi - kb_); } } \
        { int ll = tid; asm volatile("" : "+v"(ll)); pv_sm<true>(o, vbase + v_rd_base(ll & 63) + s2 * SHM_V, pa0, pa1, pa2, pa3, N0, N1, m_reg, alp); } \
        RESC(alp); \
        if ((t) + 2 < NT) WAITBAR(5); else WAITBAR(0); \
        ROT3(); } while (0)
#pragma unroll 1
    for (int t = 1; t + 1 < NT; t += 2) { STEP(t, q0, q1, p0, p1); STEP(t + 1, p0, p1, q0, q1); }
    STEP(NT - 1, q0, q1, p0, p1);
#undef STEP
    {
        q1[12] = __builtin_amdgcn_exp2f(q1[12]); q1[13] = __builtin_amdgcn_exp2f(q1[13]); q1[14] = __builtin_amdgcn_exp2f(q1[14]); q1[15] = __builtin_amdgcn_exp2f(q1[15]);
        float ps = 0;
#pragma unroll
        for (int r = 0; r < 16; ++r) ps += q0[r];
#pragma unroll
        for (int r = 0; r < 16; ++r) ps += q1[r];
        { auto rr = __builtin_amdgcn_permlane32_swap(__float_as_uint(ps), __float_as_uint(ps), false, false); ps = __uint_as_float(rr[0]) + __uint_as_float(rr[1]); }
        l_reg = l_reg * alp + ps;
#define PK4(P, B_, OUT) do { unsigned a0 = cvtpk(P[B_+0], P[B_+1]), a1 = cvtpk(P[B_+2], P[B_+3]); unsigned b0 = cvtpk(P[B_+4], P[B_+5]), b1 = cvtpk(P[B_+6], P[B_+7]); \
        auto r0 = __builtin_amdgcn_permlane32_swap(a0, b0, false, false); auto r1 = __builtin_amdgcn_permlane32_swap(a1, b1, false, false); \
        v4u w = {r0[0], r1[0], r0[1], r1[1]}; OUT = *reinterpret_cast<bf16x8*>(&w); } while (0)
        PK4(q0, 0, pa0); PK4(q0, 8, pa1); PK4(q1, 0, pa2); PK4(q1, 8, pa3);
#undef PK4
    }
#undef RESC
#undef ROT3
#undef DMA_K
#undef DMA_V
    { int ll = tid; asm volatile("" : "+v"(ll)); pv_tile<0>(o, vbase + v_rd_base(ll & 63) + s2 * SHM_V, pa0, pa1, pa2, pa3); }
    if (hi == 0) li_l[r32] = l_reg; asm volatile("s_waitcnt lgkmcnt(0)" ::: "memory");
    float rli[16];
#pragma unroll
    for (int r = 0; r < 16; ++r) rli[r] = __builtin_amdgcn_rcpf(li_l[crow(r, hi)]);
    bf16_t* Ow = cur.O + (size_t)(wid * QBLK) * OPITCH;
#pragma unroll
    for (int r = 0; r < 16; ++r) { const int orow = crow(r, hi);
#pragma unroll
        for (int d0 = 0; d0 < 4; ++d0) { const float v = o[d0][r] * rli[r]; const float vn = __shfl_xor(v, 1);
            if ((r32 & 1) == 0) *(unsigned*)(Ow + (size_t)orow * OPITCH + d0 * 32 + r32) = cvtpk(v, vn); } }
    WAITBAR(0);
}
#undef WAITBAR
#undef VMW
#undef SBAR
__device__ __forceinline__ BlockRef make_ref(int L, int pass, const bf16_t* Q, const bf16_t* K, const bf16_t* V, bf16_t* O) {
    const int bh = L >> 4, x = L & 15, qb = pass ? 31 - x : x, b = bh >> 2, h = bh & 3;
    BlockRef r; r.Q = Q + ((size_t)bh * 8192 + (size_t)qb * QB) * DQ; r.K = K + (size_t)bh * 8192 * DQ; r.V = V + (size_t)bh * 8192 * DVV;
    r.O = O + ((size_t)b * 8192 + (size_t)qb * QB) * OPITCH + h * DVV; r.P0 = qb * QB; return r;
}
template <int ABL>
__device__ __forceinline__ void attn_phase(char* lds, const bf16_t* Q, const bf16_t* K, const bf16_t* V, bf16_t* O, int G, int bid) {
    for (int L = bid; L < 256; L += G)
#pragma unroll 1
        for (int pass = 0; pass < 2; ++pass) { const BlockRef cur = make_ref(L, pass, Q, K, V, O); attn_block<ABL>(cur, lds); }
}
}
namespace prj {
__device__ __forceinline__ int crow(int r, int hi) { return (r & 3) + 8 * (r >> 2) + 4 * hi; }
__device__ __forceinline__ float swap_add(float v) { auto rr = __builtin_amdgcn_permlane32_swap(__float_as_uint(v), __float_as_uint(v), false, false); return __uint_as_float(rr[0]) + __uint_as_float(rr[1]); }
__device__ __forceinline__ float sumsq8(bf16x8 v) { float s = 0.f;
#pragma unroll
    for (int j = 0; j < 8; ++j) { const float f = bf2f((bf16_t)v[j]); s += f * f; } return s; }
__device__ __forceinline__ bf16x8 ldg8(const bf16_t* p) { return *reinterpret_cast<const bf16x8*>(p); }
__device__ __forceinline__ const bf16_t* projt(const unsigned char* ws, int t, int col) { return (const bf16_t*)(ws + WSX_B) + ((size_t)((t >> 5) * 192 + (col >> 3)) * 32 + (t & 31)) * 8 + (col & 7); }
__device__ __forceinline__ v2u pack4(float a, float b, float c, float d) { return (v2u){cvtpk(a, b), cvtpk(c, d)}; }

__device__ __forceinline__ void stage_weights(const unsigned char* src, LAS unsigned char* wl, int nkb, int wave, int lane) {
    __syncthreads();
    for (int i = wave; i < nkb; i += NWAVES) __builtin_amdgcn_global_load_lds((const unsigned*)(src + (size_t)i * 1024 + lane * 16), (LAS unsigned*)(wl + i * 1024), 16, 0, 0);
    asm volatile("s_waitcnt vmcnt(0)" ::: "memory");
    __syncthreads();
}
__device__ __forceinline__ void stage_weights2(const unsigned char* src0, const unsigned char* src1, LAS unsigned char* wl, int wave, int lane) {
    __syncthreads();
    for (int i = wave; i < 32; i += NWAVES) { __builtin_amdgcn_global_load_lds((const unsigned*)(src0 + (size_t)i * 1024 + lane * 16), (LAS unsigned*)(wl + i * 1024), 16, 0, 0);
                                              __builtin_amdgcn_global_load_lds((const unsigned*)(src1 + (size_t)i * 1024 + lane * 16), (LAS unsigned*)(wl + (32 + i) * 1024), 16, 0, 0); }
    asm volatile("s_waitcnt vmcnt(0)" ::: "memory");
    __syncthreads();
}
__device__ __forceinline__ void unit_q(const Inputs& I, unsigned char* ws, LAS unsigned char* wl, int wave, int grp, int lane) {
    const int r32 = lane & 31, hi = lane >> 5, t = grp * 32 + r32, b = t >> 13, s = t & 8191;
    const bf16_t* pr = projt(ws, t, C_QLAT + 8 * hi);
    float ssq = 0.f; bf16x8 bq[16];
#pragma unroll
    for (int ks = 0; ks < 16; ++ks) { bq[ks] = ldg8(pr + 512 * ks); ssq += sumsq8(bq[ks]); }
    const float msq = swap_add(ssq) * (1.f / 256.f) + EPS;
    const LAS bf16x8* WQF = (const LAS bf16x8*)wl + lane;
    const float* cs = (const float*)(ws + WSX_CS) + (size_t)t * 64;
#pragma unroll 1
    for (int h = 0; h < 4; ++h) {
        stage_weights(ws + WSX_WQF + (size_t)h * 96 * 1024, wl, 96, wave, lane);
        f32x16 acc[6];
#pragma unroll
        for (int nb = 0; nb < 6; ++nb) acc[nb] = f32x16{};
#pragma unroll
        for (int k0 = 0; k0 < 16; k0 += 2) { bf16x8 wf[12];
#pragma unroll
            for (int i = 0; i < 2; ++i)
#pragma unroll
                for (int nb = 0; nb < 6; ++nb) wf[i * 6 + nb] = WQF[(nb * 16 + k0 + i) * 64];
#pragma unroll
            for (int i = 0; i < 2; ++i)
#pragma unroll
                for (int nb = 0; nb < 6; ++nb) acc[nb] = __builtin_amdgcn_mfma_f32_32x32x16_bf16(wf[i * 6 + nb], bq[k0 + i], acc[nb], 0, 0, 0);
            asm volatile("" ::: "memory"); }
        float ss = 0.f;
#pragma unroll
        for (int nb = 0; nb < 6; ++nb)
#pragma unroll
            for (int r = 0; r < 16; ++r) ss += acc[nb][r] * acc[nb][r];
        const float rs = rsqrtf(swap_add(ss) * (1.f / 192.f) + EPS * msq);
        bf16_t* qp = (bf16_t*)(ws + WSX_Q) + ((size_t)((b * 4 + h) * 256 + (s >> 5)) * 24) * 256 + r32 * 8 + 4 * hi;
#pragma unroll
        for (int nb = 0; nb < 4; ++nb)
#pragma unroll
            for (int q = 0; q < 4; ++q) { const int n = 32 * nb + 8 * q + 4 * hi; const f32x4 g = *(const f32x4*)(I.q_norm + n);
                *(v2u*)(qp + (4 * nb + q) * 256) = pack4(acc[nb][4 * q] * rs * g[0], acc[nb][4 * q + 1] * rs * g[1], acc[nb][4 * q + 2] * rs * g[2], acc[nb][4 * q + 3] * rs * g[3]); asm volatile("" ::: "memory"); }
#pragma unroll
        for (int q = 0; q < 4; ++q) { const int j = 8 * q + 4 * hi; const f32x4 g1 = *(const f32x4*)(I.q_norm + 128 + j), g2 = *(const f32x4*)(I.q_norm + 160 + j);
            const f32x4 c = *(const f32x4*)(cs + j), sn = *(const f32x4*)(cs + 32 + j);
            float o1[4], o2[4];
#pragma unroll
            for (int i = 0; i < 4; ++i) { const float x1 = acc[4][4 * q + i] * rs * g1[i], x2 = acc[5][4 * q + i] * rs * g2[i]; o1[i] = x1 * c[i] - x2 * sn[i]; o2[i] = x2 * c[i] + x1 * sn[i]; }
            *(v2u*)(qp + (16 + q) * 256) = pack4(o1[0], o1[1], o1[2], o1[3]); *(v2u*)(qp + (20 + q) * 256) = pack4(o2[0], o2[1], o2[2], o2[3]); }
    }
}
__device__ __forceinline__ void unit_kv(const Inputs& I, unsigned char* ws, LAS unsigned char* wl, int wave, int grp, int lane) {
    const int r32 = lane & 31, hi = lane >> 5, t = grp * 32 + r32, b = t >> 13, s = t & 8191;
    bf16x8 bk[8]; float ssq = 0.f;
#pragma unroll
    for (int ks = 0; ks < 8; ++ks) { bk[ks] = ldg8(projt(ws, t, C_KVLAT + 8 * hi) + 512 * ks); ssq += sumsq8(bk[ks]); }
    const float rstd = rsqrtf(swap_add(ssq) * (1.f / 128.f) + EPS);
    float kr1[16], kr2[16]; float ssr = 0.f;
#pragma unroll
    for (int q = 0; q < 4; ++q) { const int j = 8 * q + 4 * hi; const v2u a = *(const v2u*)projt(ws, t, C_KROPE + j), c = *(const v2u*)projt(ws, t, C_KROPE + 32 + j);
        kr1[4 * q] = __uint_as_float(a.x << 16); kr1[4 * q + 1] = __uint_as_float(a.x & 0xffff0000u); kr1[4 * q + 2] = __uint_as_float(a.y << 16); kr1[4 * q + 3] = __uint_as_float(a.y & 0xffff0000u);
        kr2[4 * q] = __uint_as_float(c.x << 16); kr2[4 * q + 1] = __uint_as_float(c.x & 0xffff0000u); kr2[4 * q + 2] = __uint_as_float(c.y << 16); kr2[4 * q + 3] = __uint_as_float(c.y & 0xffff0000u); }
#pragma unroll
    for (int r = 0; r < 16; ++r) ssr += kr1[r] * kr1[r] + kr2[r] * kr2[r];
    const LAS bf16x8* WKVF = (const LAS bf16x8*)wl + lane;
    const float* cs = (const float*)(ws + WSX_CS) + (size_t)t * 64;
#pragma unroll 1
    for (int h = 0; h < 4; ++h) {
        stage_weights(ws + WSX_WKVF + (size_t)h * 64 * 1024, wl, 64, wave, lane);
        bf16_t* kp = (bf16_t*)(ws + WSX_K) + ((size_t)((b * 4 + h) * 128 + (s >> 6)) * 24) * 512 + (s & 63) * 8 + 4 * hi;
        bf16_t* vp = (bf16_t*)(ws + WSX_V) + ((size_t)((b * 4 + h) * 128 + (s >> 6)) * 16) * 512 + (s & 63) * 8 + 4 * hi;
        f32x16 acc[4];
#pragma unroll
        for (int nb = 0; nb < 4; nb += 2) { acc[nb] = f32x16{}; acc[nb + 1] = f32x16{}; bf16x8 wf[16];
#pragma unroll
            for (int i = 0; i < 16; ++i) wf[i] = WKVF[(nb * 8 + i) * 64];
#pragma unroll
            for (int i = 0; i < 8; ++i) acc[nb] = __builtin_amdgcn_mfma_f32_32x32x16_bf16(wf[i], bk[i], acc[nb], 0, 0, 0);
#pragma unroll
            for (int i = 0; i < 8; ++i) acc[nb + 1] = __builtin_amdgcn_mfma_f32_32x32x16_bf16(wf[8 + i], bk[i], acc[nb + 1], 0, 0, 0);
            }
        float ss = 0.f;
#pragma unroll
        for (int nb = 0; nb < 4; ++nb)
#pragma unroll
            for (int r = 0; r < 16; ++r) ss += acc[nb][r] * acc[nb][r];
        const float rs = rsqrtf(swap_add(ss * rstd * rstd + ssr) * (1.f / 192.f) + EPS), rk = rs * rstd;
#pragma unroll
        for (int nb = 0; nb < 4; ++nb)
#pragma unroll
            for (int q = 0; q < 4; ++q) { const int n = 32 * nb + 8 * q + 4 * hi; const f32x4 g = *(const f32x4*)(I.k_norm + n);
                *(v2u*)(kp + (4 * nb + q) * 512) = pack4(acc[nb][4 * q] * rk * g[0], acc[nb][4 * q + 1] * rk * g[1], acc[nb][4 * q + 2] * rk * g[2], acc[nb][4 * q + 3] * rk * g[3]); }
#pragma unroll
        for (int q = 0; q < 4; ++q) { const int j = 8 * q + 4 * hi; const f32x4 g1 = *(const f32x4*)(I.k_norm + 128 + j), g2 = *(const f32x4*)(I.k_norm + 160 + j);
            const f32x4 c = *(const f32x4*)(cs + j), sn = *(const f32x4*)(cs + 32 + j);
            float o1[4], o2[4];
#pragma unroll
            for (int i = 0; i < 4; ++i) { const float x1 = kr1[4 * q + i] * rs * g1[i], x2 = kr2[4 * q + i] * rs * g2[i]; o1[i] = x1 * c[i] - x2 * sn[i]; o2[i] = x2 * c[i] + x1 * sn[i]; }
            *(v2u*)(kp + (16 + q) * 512) = pack4(o1[0], o1[1], o1[2], o1[3]); *(v2u*)(kp + (20 + q) * 512) = pack4(o2[0], o2[1], o2[2], o2[3]); }
        asm volatile("" ::: "memory");
#pragma unroll
        for (int nb = 0; nb < 4; nb += 2) { acc[nb] = f32x16{}; acc[nb + 1] = f32x16{}; bf16x8 wf[16];
#pragma unroll
            for (int i = 0; i < 16; ++i) wf[i] = WKVF[((4 + nb) * 8 + i) * 64];
#pragma unroll
            for (int i = 0; i < 8; ++i) acc[nb] = __builtin_amdgcn_mfma_f32_32x32x16_bf16(wf[i], bk[i], acc[nb], 0, 0, 0);
#pragma unroll
            for (int i = 0; i < 8; ++i) acc[nb + 1] = __builtin_amdgcn_mfma_f32_32x32x16_bf16(wf[8 + i], bk[i], acc[nb + 1], 0, 0, 0);
            }
#pragma unroll
        for (int nb = 0; nb < 4; ++nb)
#pragma unroll
            for (int q = 0; q < 4; ++q) { const int n = 32 * nb + 8 * q + 4 * hi;
                *(v2u*)(vp + (4 * nb + q) * 512) = pack4(acc[nb][4 * q] * rstd, acc[nb][4 * q + 1] * rstd, acc[nb][4 * q + 2] * rstd, acc[nb][4 * q + 3] * rstd); }
        asm volatile("" ::: "memory");
    }
}
#define LRU_SCAN_STEP(CTRL) asm volatile("s_nop 1\n\t" \
    "v_fmac_f32_dpp %0, %0, %16 " CTRL "\n\tv_fmac_f32_dpp %1, %1, %17 " CTRL "\n\tv_fmac_f32_dpp %2, %2, %18 " CTRL "\n\tv_fmac_f32_dpp %3, %3, %19 " CTRL "\n\t" \
    "v_fmac_f32_dpp %4, %4, %20 " CTRL "\n\tv_fmac_f32_dpp %5, %5, %21 " CTRL "\n\tv_fmac_f32_dpp %6, %6, %22 " CTRL "\n\tv_fmac_f32_dpp %7, %7, %23 " CTRL "\n\t" \
    "v_fmac_f32_dpp %8, %8, %24 " CTRL "\n\tv_fmac_f32_dpp %9, %9, %25 " CTRL "\n\tv_fmac_f32_dpp %10, %10, %26 " CTRL "\n\tv_fmac_f32_dpp %11, %11, %27 " CTRL "\n\t" \
    "v_fmac_f32_dpp %12, %12, %28 " CTRL "\n\tv_fmac_f32_dpp %13, %13, %29 " CTRL "\n\tv_fmac_f32_dpp %14, %14, %30 " CTRL "\n\tv_fmac_f32_dpp %15, %15, %31 " CTRL "\n\t" \
    "v_mul_f32_dpp %16, %16, %16 " CTRL "\n\tv_mul_f32_dpp %17, %17, %17 " CTRL "\n\tv_mul_f32_dpp %18, %18, %18 " CTRL "\n\tv_mul_f32_dpp %19, %19, %19 " CTRL "\n\t" \
    "v_mul_f32_dpp %20, %20, %20 " CTRL "\n\tv_mul_f32_dpp %21, %21, %21 " CTRL "\n\tv_mul_f32_dpp %22, %22, %22 " CTRL "\n\tv_mul_f32_dpp %23, %23, %23 " CTRL "\n\t" \
    "v_mul_f32_dpp %24, %24, %24 " CTRL "\n\tv_mul_f32_dpp %25, %25, %25 " CTRL "\n\tv_mul_f32_dpp %26, %26, %26 " CTRL "\n\tv_mul_f32_dpp %27, %27, %27 " CTRL "\n\t" \
    "v_mul_f32_dpp %28, %28, %28 " CTRL "\n\tv_mul_f32_dpp %29, %29, %29 " CTRL "\n\tv_mul_f32_dpp %30, %30, %30 " CTRL "\n\tv_mul_f32_dpp %31, %31, %31 " CTRL "\n\ts_nop 1" \
    : "+v"(bv[0]), "+v"(bv[1]), "+v"(bv[2]), "+v"(bv[3]), "+v"(bv[4]), "+v"(bv[5]), "+v"(bv[6]), "+v"(bv[7]), "+v"(bv[8]), "+v"(bv[9]), "+v"(bv[10]), "+v"(bv[11]), "+v"(bv[12]), "+v"(bv[13]), "+v"(bv[14]), "+v"(bv[15]), \
      "+v"(av[0]), "+v"(av[1]), "+v"(av[2]), "+v"(av[3]), "+v"(av[4]), "+v"(av[5]), "+v"(av[6]), "+v"(av[7]), "+v"(av[8]), "+v"(av[9]), "+v"(av[10]), "+v"(av[11]), "+v"(av[12]), "+v"(av[13]), "+v"(av[14]), "+v"(av[15]))
constexpr int PRJ_TAB = 96 * 1024;
__device__ __forceinline__ void lru_tables(Frame& F, const Inputs& I) {
    LAS float* tb = (LAS float*)(F.lds + PRJ_TAB);
    for (int i = ((int)threadIdx.x); i < 2048; i += 512) tb[i] = I.conv_w[i];
    { const int c = ((int)threadIdx.x); tb[2048 + c] = I.conv_b[c]; tb[2560 + c] = -1.4426950408889634f * I.lru_ba[c]; tb[3072 + c] = -1.4426950408889634f * I.lru_bx[c];
      tb[3584 + c] = -8.f * 1.4426950408889634f * ((const float*)(F.ws + WSX_SP))[c]; }
    __syncthreads();
}
__device__ __forceinline__ void unit_lru(const Inputs& I, unsigned char* ws, LAS unsigned char* wl, int wave, int grp, int hp, int lane) {
    const int r32 = lane & 31, hi = lane >> 5, t = grp * 32 + r32, s = t & 8191;
    const bool reset = I.positions[t] == 0;
    const LAS float* tbl = (const LAS float*)(wl + PRJ_TAB);
    int xt[4]; float xz[4];
#pragma unroll
    for (int j = 0; j < 4; ++j) { const bool ok = s - 3 + j >= 0; xt[j] = ok ? t - 3 + j : t; xz[j] = ok ? 1.f : 0.f; }
    bf16_t* HL = (bf16_t*)(ws + WSX_D) + (size_t)t * 512; bf16_t* PC = HL + (size_t)NTOK * 512;
    float* SUMA = (float*)(ws + WSX_SUMA) + (size_t)grp * 512; float* SUMB = (float*)(ws + WSX_SUMB) + (size_t)grp * 512;
#pragma unroll 1
    for (int h = 2 * hp; h < 2 * hp + 2; ++h) {
        stage_weights2(ws + WSX_WAF + (size_t)h * 32 * 1024, ws + WSX_WXF + (size_t)h * 32 * 1024, wl, wave, lane);
        bf16x8 xf[8];
#pragma unroll
        for (int k2 = 0; k2 < 8; k2 += 2) { v2u xx[2][2][4];
#pragma unroll
            for (int kk = 0; kk < 2; ++kk)
#pragma unroll
                for (int j4 = 0; j4 < 2; ++j4)
#pragma unroll
                    for (int j = 0; j < 4; ++j) xx[kk][j4][j] = *(const v2u*)projt(ws, xt[j], C_XLRU + 128 * h + 32 * ((k2 + kk) >> 1) + 16 * ((k2 + kk) & 1) + 8 * j4 + 4 * hi);
#pragma unroll
            for (int kk = 0; kk < 2; ++kk) { unsigned w[4];
#pragma unroll
                for (int j4 = 0; j4 < 2; ++j4) { const int C = 128 * h + 32 * ((k2 + kk) >> 1) + 16 * ((k2 + kk) & 1) + 8 * j4 + 4 * hi;
                    f32x4 v = *(const LAS f32x4*)(tbl + 2048 + C);
#pragma unroll
                    for (int j = 0; j < 4; ++j) { const v2u x = xx[kk][j4][j]; const f32x4 cw = *(const LAS f32x4*)(tbl + j * 512 + C) * xz[j];
                        v[0] += cw[0] * __uint_as_float(x.x << 16); v[1] += cw[1] * __uint_as_float(x.x & 0xffff0000u); v[2] += cw[2] * __uint_as_float(x.y << 16); v[3] += cw[3] * __uint_as_float(x.y & 0xffff0000u); }
                    w[2 * j4] = cvtpk(v[0], v[1]); w[2 * j4 + 1] = cvtpk(v[2], v[3]); }
                v4u ww = {w[0], w[1], w[2], w[3]}; xf[k2 + kk] = *reinterpret_cast<bf16x8*>(&ww); }
            asm volatile("" ::: "memory"); }
        const LAS bf16x8* WAF = (const LAS bf16x8*)wl + lane; const LAS bf16x8* WXF = (const LAS bf16x8*)(wl + 32 * 1024) + lane;
#pragma unroll
        for (int nb = 0; nb < 4; ++nb) {
            f32x16 aa = f32x16{}, bb = f32x16{};
            { bf16x8 wf[16];
#pragma unroll
              for (int i = 0; i < 8; ++i) { wf[i] = WAF[(nb * 8 + i) * 64]; wf[8 + i] = WXF[(nb * 8 + i) * 64]; }
#pragma unroll
              for (int i = 0; i < 8; ++i) aa = __builtin_amdgcn_mfma_f32_32x32x16_bf16(wf[i], xf[i], aa, 0, 0, 0);
#pragma unroll
              for (int i = 0; i < 8; ++i) bb = __builtin_amdgcn_mfma_f32_32x32x16_bf16(wf[8 + i], xf[i], bb, 0, 0, 0);
              }
            float av[16], bv[16];
#pragma unroll
            for (int q = 0; q < 4; ++q) { const int C = 128 * h + 32 * nb + 8 * q + 4 * hi;
                const f32x4 ba = *(const LAS f32x4*)(tbl + 2560 + C), bx = *(const LAS f32x4*)(tbl + 3072 + C), sp = *(const LAS f32x4*)(tbl + 3584 + C);
#pragma unroll
                for (int i = 0; i < 4; ++i) { const int r = 4 * q + i;
                    const float rg = __builtin_amdgcn_rcpf(1.f + __builtin_amdgcn_exp2f(fmaf(aa[r], -1.4426950408889634f, ba[i])));
                    const float ig = __builtin_amdgcn_rcpf(1.f + __builtin_amdgcn_exp2f(fmaf(bb[r], -1.4426950408889634f, bx[i])));
                    float a = __builtin_amdgcn_exp2f(rg * sp[i]), mult = __builtin_amdgcn_sqrtf(fmaxf(fmaf(-a, a, 1.f), 0.f));
                    if (reset) { a = 0.f; mult = 1.f; }
                    const float xc = bf2f((bf16_t)xf[2 * nb + (r >> 3)][4 * ((r >> 2) & 1) + (r & 3)]);
                    av[r] = a; bv[r] = mult * ig * xc; } }
            LRU_SCAN_STEP("row_shr:1 row_mask:0xf bank_mask:0xf"); LRU_SCAN_STEP("row_shr:2 row_mask:0xf bank_mask:0xf"); LRU_SCAN_STEP("row_shr:4 row_mask:0xf bank_mask:0xf");
            LRU_SCAN_STEP("row_shr:8 row_mask:0xf bank_mask:0xf"); LRU_SCAN_STEP("row_bcast:15 row_mask:0xa bank_mask:0xf");
#pragma unroll
            for (int q = 0; q < 4; ++q) { const int C = 128 * h + 32 * nb + 8 * q + 4 * hi;
                *(v2u*)(HL + C) = pack4(bv[4 * q], bv[4 * q + 1], bv[4 * q + 2], bv[4 * q + 3]);
                *(v2u*)(PC + C) = pack4(av[4 * q], av[4 * q + 1], av[4 * q + 2], av[4 * q + 3]);
                if (r32 == 31) { *(f32x4*)(SUMA + C) = (f32x4){av[4 * q], av[4 * q + 1], av[4 * q + 2], av[4 * q + 3]};
                                 *(f32x4*)(SUMB + C) = (f32x4){bv[4 * q], bv[4 * q + 1], bv[4 * q + 2], bv[4 * q + 3]}; } }
            asm volatile("" ::: "memory");
        }
        asm volatile("s_waitcnt vmcnt(0)" ::: "memory"); __syncthreads();
        if (threadIdx.x < 128) { const int C = 128 * h + threadIdx.x, g0 = (grp >> 3) << 3; float A = 1.f, B = 0.f;
#pragma unroll
            for (int w = 0; w < 8; ++w) { const float a = __hip_atomic_load((float*)(ws + WSX_SUMA) + (size_t)(g0 + w) * 512 + C, __ATOMIC_RELAXED, __HIP_MEMORY_SCOPE_AGENT), b = __hip_atomic_load((float*)(ws + WSX_SUMB) + (size_t)(g0 + w) * 512 + C, __ATOMIC_RELAXED, __HIP_MEMORY_SCOPE_AGENT);
                B = a * B + b; A = a * A; }
            ((float*)(ws + WSX_SUM8A))[(size_t)(grp >> 3) * 512 + C] = A; ((float*)(ws + WSX_SUM8B))[(size_t)(grp >> 3) * 512 + C] = B; }
    }
}
__device__ __forceinline__ void phase_proj(Frame& F, const Inputs& I, int kmask) {
    LAS unsigned char* wl = F.lds;
    lru_tables(F, I);
    const int b = F.vcu, G = F.G;
    if (kmask & 2) for (int u = b; u < 256; u += G) unit_lru(I, F.ws, wl, F.wave, (u >> 1) * 8 + F.wave, u & 1, ((int)(threadIdx.x & 63)));
    asm volatile("" ::: "memory");
    if (kmask & 1) for (int u = b; u < 128; u += G) unit_q(I, F.ws, wl, F.wave, u * 8 + F.wave, ((int)(threadIdx.x & 63)));
    asm volatile("" ::: "memory");
    if (kmask & 4) for (int u = (G == 256 ? b - 128 : b); u < 128; u += G) if (u >= 0) unit_kv(I, F.ws, wl, F.wave, u * 8 + F.wave, ((int)(threadIdx.x & 63)));
    __syncthreads();
}
__device__ __forceinline__ float gelu_t(float v) { const float u = 0.7978845608028654f * (v + 0.044715f * v * v * v); return v / (1.f + __expf(-2.f * u)); }
__device__ __forceinline__ void unpack8(v4u w, float* f) {
    f[0] = __uint_as_float(w.x << 16); f[1] = __uint_as_float(w.x & 0xffff0000u); f[2] = __uint_as_float(w.y << 16); f[3] = __uint_as_float(w.y & 0xffff0000u);
    f[4] = __uint_as_float(w.z << 16); f[5] = __uint_as_float(w.z & 0xffff0000u); f[6] = __uint_as_float(w.w << 16); f[7] = __uint_as_float(w.w & 0xffff0000u); }
__device__ __forceinline__ void phase_mix(Frame& F, const Inputs& I) {
    LAS float* carry = (LAS float*)F.lds;
    const float* SUMA = (const float*)(F.ws + WSX_SUMA); const float* SUMB = (const float*)(F.ws + WSX_SUMB);
    const bf16_t* HL = (const bf16_t*)(F.ws + WSX_D); const bf16_t* PC = HL + (size_t)NTOK * 512;
    const bf16_t* PROJ = (const bf16_t*)(F.ws + WSX_B); bf16_t* MIXED = (bf16_t*)(F.ws + WSX_E); const bf16_t* AO = (const bf16_t*)(F.ws + WSX_AO);
    const int nper = 1024 / F.G;
    const int c0 = F.vcu * nper, bfirst = (c0 >> 8) << 8;
    {
        float h = 0.f; const int c = ((int)threadIdx.x); const int tb = c0 >> 3, tb0 = (tb >> 5) << 5;
        const float* S8A = (const float*)(F.ws + WSX_SUM8A); const float* S8B = (const float*)(F.ws + WSX_SUM8B);
        for (int k = tb0; k < tb; k += 8) { float a[8], bq[8];
#pragma unroll
            for (int i = 0; i < 8; ++i) { const int kk = k + i < tb ? k + i : tb0; a[i] = S8A[(size_t)kk * 512 + c]; bq[i] = S8B[(size_t)kk * 512 + c]; }
#pragma unroll
            for (int i = 0; i < 8; ++i) if (k + i < tb) h = a[i] * h + bq[i]; }
        for (int k = tb << 3; k < c0; k += 4) { float a[4], bq[4];
#pragma unroll
            for (int i = 0; i < 4; ++i) { a[i] = SUMA[(size_t)(k + i) * 512 + c]; bq[i] = SUMB[(size_t)(k + i) * 512 + c]; }
#pragma unroll
            for (int i = 0; i < 4; ++i) h = a[i] * h + bq[i]; }
        carry[c] = h; }
    __syncthreads();
    const int C = 8 * ((int)(threadIdx.x & 63));
    const f32x4 g0 = *(const f32x4*)(I.lru_out_norm + C), g1 = *(const f32x4*)(I.lru_out_norm + C + 4), q0 = *(const f32x4*)(I.attn_out_norm + C), q1 = *(const f32x4*)(I.attn_out_norm + C + 4);
    for (int k = c0; k < c0 + nper; ++k) {
        const int tb = k * 32 + F.wave * 4;
        v4u hl4[4], pc4[4], gg4[4], at4[4];
#pragma unroll
        for (int rr = 0; rr < 4; ++rr) { const size_t t = tb + rr; hl4[rr] = *(const v4u*)(HL + t * 512 + C); pc4[rr] = *(const v4u*)(PC + t * 512 + C);
            gg4[rr] = *(const v4u*)projt(F.ws, (int)t, C_GLRU + C); at4[rr] = *(const v4u*)(AO + t * 512 + C); }
        float cy[8]; *(f32x4*)cy = *(const LAS f32x4*)(carry + C); *(f32x4*)(cy + 4) = *(const LAS f32x4*)(carry + C + 4);
        float hl[8];
#pragma unroll
        for (int rr = 0; rr < 4; ++rr) { const size_t t = tb + rr;
            float a[8], p[8], g[8], v[8];
            unpack8(hl4[rr], a); unpack8(pc4[rr], p); unpack8(gg4[rr], g);
            float ss = 0.f;
#pragma unroll
            for (int j = 0; j < 8; ++j) { hl[j] = a[j] + p[j] * cy[j]; v[j] = hl[j] * gelu_t(g[j]); ss += v[j] * v[j]; }
            float rs = rsqrtf(wave_sum_f(ss) * (1.f / 512.f) + EPS);
            *(v4u*)(MIXED + t * 1024 + 512 + C) = (v4u){cvtpk(v[0] * rs * g0[0], v[1] * rs * g0[1]), cvtpk(v[2] * rs * g0[2], v[3] * rs * g0[3]), cvtpk(v[4] * rs * g1[0], v[5] * rs * g1[1]), cvtpk(v[6] * rs * g1[2], v[7] * rs * g1[3])};
            unpack8(at4[rr], a); ss = 0.f;
#pragma unroll
            for (int j = 0; j < 8; ++j) ss += a[j] * a[j];
            rs = rsqrtf(wave_sum_f(ss) * (1.f / 512.f) + EPS);
            *(v4u*)(MIXED + t * 1024 + C) = (v4u){cvtpk(a[0] * rs * q0[0], a[1] * rs * q0[1]), cvtpk(a[2] * rs * q0[2], a[3] * rs * q0[3]), cvtpk(a[4] * rs * q1[0], a[5] * rs * q1[1]), cvtpk(a[6] * rs * q1[2], a[7] * rs * q1[3])};
        }
        __syncthreads();
        if (F.wave == 7) {
#pragma unroll
            for (int j = 0; j < 8; ++j) carry[8 * ((int)(threadIdx.x & 63)) + j] = hl[j]; }
        __syncthreads();
    }
}
}
namespace moe {
constexpr size_t WSX_RSTD = WSX_ROUTE + 800 * 1024;
constexpr size_t WSX_BB = WSX_ROUTE + 960 * 1024;
constexpr size_t WSX_WRFB = 70 * MiB;
constexpr size_t WSX_RBIAS = 70 * MiB + 512 * 1024;
constexpr int TP_OFF = LDSCTL_OFF + 512;
__device__ __forceinline__ int route_expert_of_n(int n) { const int a = (n >> 4) & 1, b = (n >> 3) & 1, h = (n >> 2) & 1, c = n & 3; return 8 * (2 * a + h) + 4 * b + c; }
__device__ __forceinline__ void router_fold(Frame& F, const Inputs& I) {
    const float* mod = (const float*)(F.ws + WS_MOD);
    const int gt = blockIdx.x * 512 + ((int)threadIdx.x), NGT = F.G * 512;
    v4u* WRFB = (v4u*)(F.ws + WSX_WRFB);
    for (int g = gt; g < 4 * 2 * 64 * 64; g += NGT) {
        const int lane = g & 63, ks = (g >> 6) & 63, nb = (g >> 12) & 1, b = g >> 13, hi = lane >> 5, n = lane & 31; float v[8];
#pragma unroll
        for (int j = 0; j < 8; ++j) { const int k = 16 * ks + 8 * hi + j; const float gg = I.norm2_g[k] * (1.f + mod[b * MODW + 4096 + k]);
            const float w = nb == 0 ? I.w_re[k * 32 + route_expert_of_n(n)] : (n < 4 ? I.w_rg[k * 4 + n] : 0.f); v[j] = w * gg; }
        WRFB[g] = (v4u){pk2(v[0], v[1]), pk2(v[2], v[3]), pk2(v[4], v[5]), pk2(v[6], v[7])};
    }
    {
        const int gw = blockIdx.x * NWAVES + F.wave;
        if (gw < 4 * 64) { const int b = gw >> 6, n = gw & 63; float s = 0.f;
            if (n < 36) { const int e = n < 32 ? route_expert_of_n(n) : n - 32; const float* W = n < 32 ? I.w_re + e : I.w_rg + e; const int ld = n < 32 ? 32 : 4;
                for (int k = ((int)(threadIdx.x & 63)); k < 1024; k += 64) s += mod[b * MODW + 3072 + k] * W[k * ld];
                s = wave_sum_f(s) + (n < 32 ? I.b_re[e] : I.b_rg[e]); }
            if (((int)(threadIdx.x & 63)) == 0) ((float*)(F.ws + WSX_RBIAS))[gw] = s; } }
}
__device__ __forceinline__ float swap_other(float v) { auto rr = __builtin_amdgcn_permlane32_swap(__float_as_uint(v), __float_as_uint(v), false, false); return (threadIdx.x & 32) ? __uint_as_float(rr[0]) : __uint_as_float(rr[1]); }
__device__ __forceinline__ void phase_route(Frame& F) {
    LAS int* lcnt = (LAS int*)(F.lds);
    if (((int)threadIdx.x) < 32) lcnt[((int)threadIdx.x)] = 0;
    __syncthreads();
    const bf16_t* x1 = (const bf16_t*)(F.ws + WSX_X1);
    int2* rexp = (int2*)(F.ws + WSX_ROUTE); float2* rw = (float2*)(F.ws + WSX_ROUTE + 256 * 1024); int2* rpos = (int2*)(F.ws + WSX_ROUTE + 512 * 1024);
    float* RSTD = (float*)(F.ws + WSX_RSTD);
    const int lane = ((int)(threadIdx.x & 63)), r32 = lane & 31, hi = lane >> 5;
    for (int grp = F.wave * F.G + blockIdx.x; grp < 1024; grp += F.G * NWAVES) {
        const int t = grp * 32 + r32, b = t >> 13;
        const bf16_t* xr = x1 + (size_t)t * DM + 8 * hi;
        const bf16x8* WF = (const bf16x8*)(F.ws + WSX_WRFB) + (size_t)b * 2 * 64 * 64 + lane;
        f32x16 a0 = f32x16{}, a1 = f32x16{}; float ss = 0.f;
#pragma unroll 8
        for (int ks = 0; ks < 64; ++ks) { const bf16x8 xb = *(const bf16x8*)(xr + 16 * ks);
#pragma unroll
            for (int j = 0; j < 8; ++j) { const float f = bf2f((bf16_t)xb[j]); ss += f * f; }
            a0 = __builtin_amdgcn_mfma_f32_32x32x16_bf16(WF[ks * 64], xb, a0, 0, 0, 0);
            a1 = __builtin_amdgcn_mfma_f32_32x32x16_bf16(WF[(64 + ks) * 64], xb, a1, 0, 0, 0); }
        { auto rr = __builtin_amdgcn_permlane32_swap(__float_as_uint(ss), __float_as_uint(ss), false, false); ss = __uint_as_float(rr[0]) + __uint_as_float(rr[1]); }
        const float rstd = rsqrtf(ss * (1.f / DM) + EPS);
        const float* rb = (const float*)(F.ws + WSX_RBIAS) + b * 64;
        float gl0 = a1[0] * rstd + rb[32], gl1 = a1[1] * rstd + rb[33], gl2 = a1[2] * rstd + rb[34], gl3 = a1[3] * rstd + rb[35];
        int gi = 0; float gm = gl0; if (gl1 > gm) { gm = gl1; gi = 1; } if (gl2 > gm) { gm = gl2; gi = 2; } if (gl3 > gm) { gm = gl3; gi = 3; }
        float gp = 1.f / (__expf(gl0 - gm) + __expf(gl1 - gm) + __expf(gl2 - gm) + __expf(gl3 - gm));
        { const float og = swap_other(__int_as_float(gi)), op = swap_other(gp); if (hi) { gi = __float_as_int(og); gp = op; } }
        const bool owner = (gi & 1) == hi; const int hsel = gi >> 1;
        float m0 = -3e38f, m1 = -3e38f; int e0 = 0, e1 = 0;
#pragma unroll
        for (int i = 0; i < 8; ++i) { const int n = 16 * hsel + 8 * (i >> 2) + 4 * hi + (i & 3);
            const float el = (hsel ? a0[8 + i] : a0[i]) * rstd + rb[n];
            if (el > m0) { m1 = m0; e1 = e0; m0 = el; e0 = i; } else if (el > m1) { m1 = el; e1 = i; } }
        if (owner) {
            const float p1 = __expf(m1 - m0); const int E0 = gi * 8 + e0, E1 = gi * 8 + e1;
            rexp[t] = make_int2(E0, E1); rw[t] = make_float2(gp / (1.f + p1), gp * p1 / (1.f + p1));
            const int k0 = __hip_atomic_fetch_add(lcnt + E0, 1, __ATOMIC_RELAXED, __HIP_MEMORY_SCOPE_WORKGROUP), k1 = __hip_atomic_fetch_add(lcnt + E1, 1, __ATOMIC_RELAXED, __HIP_MEMORY_SCOPE_WORKGROUP);
            rpos[t] = make_int2((int)(blockIdx.x << 16) | k0, (int)(blockIdx.x << 16) | k1);
            RSTD[t] = rstd; }
    }
    __syncthreads();
    if (((int)threadIdx.x) < 32) { const int n = lcnt[((int)threadIdx.x)]; int base = 0;
        if (n > 0) base = (int)__hip_atomic_fetch_add((unsigned*)(F.ctl + CW_CNT + 64 * ((int)threadIdx.x)), (unsigned)n, __ATOMIC_RELAXED, __HIP_MEMORY_SCOPE_AGENT);
        ((int*)(F.ws + WSX_BB))[blockIdx.x * 32 + ((int)threadIdx.x)] = base; }
    __syncthreads();
}
__device__ __forceinline__ void moe_tables(Frame& F) {
    LAS int* tp = (LAS int*)(F.lds + TP_OFF);
    if (((int)threadIdx.x) < 32) tp[64 + ((int)threadIdx.x)] = (int)__hip_atomic_load((unsigned*)(F.ctl + CW_CNT + 64 * ((int)threadIdx.x)), __ATOMIC_RELAXED, __HIP_MEMORY_SCOPE_AGENT);
    __syncthreads();
    if (((int)threadIdx.x) == 0) { int acc = 0; for (int e = 0; e < 32; ++e) { tp[e] = acc; acc += (tp[64 + e] + 255) >> 8; } tp[32] = acc; }
    __syncthreads();
}
__device__ __forceinline__ void phase_sort(Frame& F, const Inputs& I) {
    LAS float* Gs = (LAS float*)F.lds; LAS float* Ss = Gs + 4096;
    const float* mod = (const float*)(F.ws + WS_MOD);
#pragma unroll
    for (int i = ((int)threadIdx.x); i < 4096; i += 512) { const int b = i >> 10, k = i & 1023; Gs[i] = I.norm2_g[k] * (1.f + mod[b * MODW + 4096 + k]); Ss[i] = mod[b * MODW + 3072 + k]; }
    moe_tables(F);
    const LAS int* tp = (const LAS int*)(F.lds + TP_OFF);
    const int2* rexp = (const int2*)(F.ws + WSX_ROUTE); const int2* rpos = (const int2*)(F.ws + WSX_ROUTE + 512 * 1024); int2* rposF = (int2*)(F.ws + WSX_RPOSF);
    const float* RSTD = (const float*)(F.ws + WSX_RSTD); const int* BB = (const int*)(F.ws + WSX_BB);
    bf16_t* XS = (bf16_t*)(F.ws + WSX_XS);
    const int gw = F.vcu * NWAVES + F.wave, NGW = F.G * NWAVES;
    for (int m0 = gw; m0 < NTOK; m0 += 4 * NGW) {
        v4u xv[4][2]; int2 ee[4], pp[4]; float rstd[4]; int pos0[4], pos1[4];
        const int ln = ((int)(threadIdx.x & 63));
#pragma unroll
        for (int u = 0; u < 4; ++u) { const int m = m0 + u * NGW; ee[u] = rexp[m]; pp[u] = rpos[m]; rstd[u] = RSTD[m];
            const GAS v4u* xr = (const GAS v4u*)((const bf16_t*)(F.ws + WSX_X1) + (size_t)m * DM) + ln;
            xv[u][0] = xr[0]; xv[u][1] = xr[64]; }
#pragma unroll
        for (int u = 0; u < 4; ++u) { pos0[u] = tp[ee[u].x] * 256 + BB[(pp[u].x >> 16) * 32 + ee[u].x] + (pp[u].x & 0xffff); pos1[u] = tp[ee[u].y] * 256 + BB[(pp[u].y >> 16) * 32 + ee[u].y] + (pp[u].y & 0xffff); }
#pragma unroll
        for (int u = 0; u < 4; ++u) { const int m = m0 + u * NGW, b = m >> 13;
            GAS v4u* o0 = (GAS v4u*)(XS + (size_t)pos0[u] * DM) + ln; GAS v4u* o1 = (GAS v4u*)(XS + (size_t)pos1[u] * DM) + ln;
#pragma unroll
            for (int j = 0; j < 2; ++j) { float f[8]; prj::unpack8(xv[u][j], f); const int k0 = 512 * j + 8 * ln;
                const f32x4 g0 = *(const LAS f32x4*)(Gs + b * 1024 + k0), g1 = *(const LAS f32x4*)(Gs + b * 1024 + k0 + 4), s0 = *(const LAS f32x4*)(Ss + b * 1024 + k0), s1 = *(const LAS f32x4*)(Ss + b * 1024 + k0 + 4);
                const float r = rstd[u];
                const v4u w = {cvtpk(f[0] * r * g0[0] + s0[0], f[1] * r * g0[1] + s0[1]), cvtpk(f[2] * r * g0[2] + s0[2], f[3] * r * g0[3] + s0[3]),
                               cvtpk(f[4] * r * g1[0] + s1[0], f[5] * r * g1[1] + s1[1]), cvtpk(f[6] * r * g1[2] + s1[2], f[7] * r * g1[3] + s1[3])};
                o0[64 * j] = w; o1[64 * j] = w; }
            if (ln == 0) rposF[m] = make_int2(pos0[u], pos1[u]); }
    }
    __syncthreads();
}
__device__ __forceinline__ void phase_combine(Frame& F) {
    const float* mod = (const float*)(F.ws + WS_MOD);
    const float2* rw = (const float2*)(F.ws + WSX_ROUTE + 256 * 1024); const int2* rpos = (const int2*)(F.ws + WSX_RPOSF);
    const bf16_t* YS = (const bf16_t*)(F.ws + WSX_XS);
    const int gw = F.vcu * NWAVES + F.wave, NGW = F.G * NWAVES;
    for (int m0 = gw; m0 < NTOK; m0 += 4 * NGW) {
        int2 pp[4]; float2 ww[4]; v2u xv[4][4]; v2u ya[4][4], yb[4][4];
        const int ln = ((int)(threadIdx.x & 63));
#pragma unroll
        for (int u = 0; u < 4; ++u) { const int m = m0 + u * NGW; pp[u] = rpos[m]; ww[u] = rw[m];
            const GAS v2u* xr = (const GAS v2u*)((const bf16_t*)(F.ws + WSX_X1) + (size_t)m * DM) + ln;
#pragma unroll
            for (int j = 0; j < 4; ++j) xv[u][j] = xr[64 * j]; }
#pragma unroll
        for (int u = 0; u < 4; ++u) { const GAS v2u* y0 = (const GAS v2u*)(YS + (size_t)pp[u].x * DM) + ln; const GAS v2u* y1 = (const GAS v2u*)(YS + (size_t)pp[u].y * DM) + ln;
#pragma unroll
            for (int j = 0; j < 4; ++j) { ya[u][j] = y0[64 * j]; yb[u][j] = y1[64 * j]; } }
#pragma unroll
        for (int u = 0; u < 4; ++u) { const int m = m0 + u * NGW, b = m >> 13; GAS f32x4* xr = (GAS f32x4*)(F.out + (size_t)m * DM) + ln; const float* g2 = mod + b * MODW + 5120 + 4 * ln;
#pragma unroll
            for (int j = 0; j < 4; ++j) { const v2u a = ya[u][j], c = yb[u][j], xx = xv[u][j]; const f32x4 g = *(const f32x4*)(g2 + 256 * j); const float w0 = ww[u].x, w1 = ww[u].y;
                f32x4 y; y[0] = w0 * __uint_as_float(a.x << 16) + w1 * __uint_as_float(c.x << 16); y[1] = w0 * __uint_as_float(a.x & 0xffff0000u) + w1 * __uint_as_float(c.x & 0xffff0000u);
                y[2] = w0 * __uint_as_float(a.y << 16) + w1 * __uint_as_float(c.y << 16); y[3] = w0 * __uint_as_float(a.y & 0xffff0000u) + w1 * __uint_as_float(c.y & 0xffff0000u);
                const f32x4 xf = {__uint_as_float(xx.x << 16), __uint_as_float(xx.x & 0xffff0000u), __uint_as_float(xx.y << 16), __uint_as_float(xx.y & 0xffff0000u)};
                xr[64 * j] = xf + g * y; } }
    }
}
}
#ifndef SEAM_TWICE
#define SEAM_TWICE 0
#endif
__device__ __forceinline__ Inputs load_inputs(const Args& args) {
    Inputs I; const void* const* p = args.in;
    I.x = (const float*)p[0]; I.c = (const float*)p[1]; I.positions = (const int*)p[2]; I.w_ada = (const float*)p[3]; I.b_ada = (const float*)p[4]; I.norm1_g = (const float*)p[5];
    I.w_in = (const float*)p[6]; I.q_a_norm = (const float*)p[7]; I.w_q_b = (const float*)p[8]; I.kv_a_norm = (const float*)p[9]; I.w_kv_b = (const float*)p[10]; I.q_norm = (const float*)p[11];
    I.k_norm = (const float*)p[12]; I.conv_w = (const float*)p[13]; I.conv_b = (const float*)p[14]; I.lru_wa = (const float*)p[15]; I.lru_ba = (const float*)p[16]; I.lru_wx = (const float*)p[17];
    I.lru_bx = (const float*)p[18]; I.lru_lambda = (const float*)p[19]; I.attn_out_norm = (const float*)p[20]; I.lru_out_norm = (const float*)p[21]; I.w_out = (const float*)p[22];
    I.norm2_g = (const float*)p[23]; I.w_rg = (const float*)p[24]; I.b_rg = (const float*)p[25]; I.w_re = (const float*)p[26]; I.b_re = (const float*)p[27]; I.w_gate = (const float*)p[28];
    I.w_up = (const float*)p[29]; I.w_down = (const float*)p[30]; return I;
}
__global__ void __launch_bounds__(NWAVES * 64, 2) mega_fwd(Args args) {
    extern __shared__ __attribute__((aligned(16))) unsigned char lds[];
    Frame F;
    F.lds = (LAS unsigned char*)lds; F.MISC = (volatile LAS unsigned*)(F.lds + MISC_OFF);
    F.wave = __builtin_amdgcn_readfirstlane(threadIdx.x >> 6);
    F.G = gridDim.x; { const int bx = blockIdx.x; F.vcu = (F.G % 8 == 0) ? (bx % 8) * (F.G / 8) + bx / 8 : bx; }
    F.ws = args.ws; F.out = args.out; F.ctl = (gu32*)(args.ws + WS_CTL);
    for (int u = ((int)threadIdx.x); u < (LDS_BYTES - LDSCTL_OFF) / 4; u += NWAVES * 64) ((LAS unsigned*)(F.lds + LDSCTL_OFF))[u] = 0u;
    __syncthreads();
    XcdBarrier bar = xcd_barrier_post((unsigned*)(F.ctl + CW_BAR) + args.li * XCD_BAR_WORDS, F.MISC + 8);
    const int lo = args.ph_lo, hi = args.ph_hi;
constexpr int REPS[12] = {1,1,1,1,1,1,1,1,1,1,1,1};
#define IN(k) (lo <= (k) && (k) < hi)
#define SEAM(k) do { if (IN(k) && IN((k) + 1)) { xcd_barrier(bar); if (SEAM_TWICE) xcd_barrier(bar); } } while (0)
    if (IN(0)) for (int rep_ = 0; rep_ < REPS[0]; ++rep_) { const Inputs I = load_inputs(args); (void)I; phase_prologue(F, I); } SEAM(0);
    if (IN(1)) for (int rep_ = 0; rep_ < REPS[1]; ++rep_) { const Inputs I = load_inputs(args); (void)I; moe::router_fold(F, I); phase_xn(F, I); } SEAM(1);
    if (IN(2)) for (int rep_ = 0; rep_ < REPS[2]; ++rep_) { const Inputs I = load_inputs(args); (void)I;
        pg8::Gemm g{(const bf16_t*)(F.ws + WSX_A), (const bf16_t*)(F.ws + WSX_WIN), NTOK, PROJP, DM}; pg8::StaticOrder S; S.init(NTOK, PROJP, F.G, (int)blockIdx.x);
        pg8::EpiProjT E{(bf16_t*)(F.ws + WSX_B)};
        pg8::gemm_phase<pg8::EpiProjT, pg8::StaticOrder, true, true>(F.lds, g, S, E);
    } SEAM(2);
    if (IN(3)) for (int rep_ = 0; rep_ < REPS[3]; ++rep_) { const Inputs I = load_inputs(args); (void)I; prj::phase_proj(F, I, args.pad); } SEAM(3);
    if (IN(4)) for (int rep_ = 0; rep_ < REPS[4]; ++rep_) { const Inputs I = load_inputs(args); (void)I;
#ifndef ATT_ABL
#define ATT_ABL 0
#endif
        if (ATT_ABL == 0 || args.pad == 7) att::attn_phase<0>((char*)lds, (const bf16_t*)(F.ws + WSX_Q), (const bf16_t*)(F.ws + WSX_K), (const bf16_t*)(F.ws + WSX_V), (bf16_t*)(F.ws + WSX_AO), F.G, F.vcu);
        else att::attn_phase<ATT_ABL>((char*)lds, (const bf16_t*)(F.ws + WSX_Q), (const bf16_t*)(F.ws + WSX_K), (const bf16_t*)(F.ws + WSX_V), (bf16_t*)(F.ws + WSX_AO), F.G, F.vcu);
    } SEAM(4);
    if (IN(5)) for (int rep_ = 0; rep_ < REPS[5]; ++rep_) { const Inputs I = load_inputs(args); (void)I; prj::phase_mix(F, I); } SEAM(5);
    if (IN(6)) for (int rep_ = 0; rep_ < REPS[6]; ++rep_) { const Inputs I = load_inputs(args); (void)I;
        pg8::Gemm g{(const bf16_t*)(F.ws + WSX_E), (const bf16_t*)(F.ws + WSX_WOUT), NTOK, DM, DM}; pg8::StaticOrder S; S.init(NTOK, DM, F.G, (int)blockIdx.x);
        pg8::EpiResid E{I.x, (const float*)(F.ws + WS_MOD), (bf16_t*)(F.ws + WSX_X1)};
        pg8::gemm_phase<pg8::EpiResid, pg8::StaticOrder, true, true>(F.lds, g, S, E);
    } SEAM(6);
    if (IN(7)) for (int rep_ = 0; rep_ < REPS[7]; ++rep_) { const Inputs I = load_inputs(args); (void)I; moe::phase_route(F); } SEAM(7);
    if (IN(8)) for (int rep_ = 0; rep_ < REPS[8]; ++rep_) { const Inputs I = load_inputs(args); (void)I; moe::phase_sort(F, I); } SEAM(8);
    if (IN(9)) for (int rep_ = 0; rep_ < REPS[9]; ++rep_) { const Inputs I = load_inputs(args); (void)I;
        if (!IN(8)) moe::moe_tables(F);
        pg8::Gemm g{(const bf16_t*)(F.ws + WSX_XS), (const bf16_t*)(F.ws + WSX_W1T), MAXROWS, 0, DM};
        pg8::GroupedOrder S{(const LAS int*)(F.lds + moe::TP_OFF), 2, F.G, (int)blockIdx.x};
        pg8::EpiSiluMul E{(bf16_t*)(F.ws + WSX_HID)};
        pg8::gemm_phase<pg8::EpiSiluMul, pg8::GroupedOrder, true, true>(F.lds, g, S, E);
    } SEAM(9);
    if (IN(10)) for (int rep_ = 0; rep_ < REPS[10]; ++rep_) { const Inputs I = load_inputs(args); (void)I;
        if (!IN(8)) moe::moe_tables(F);
        int kk2 = DFF; asm volatile("" : "+s"(kk2));
        pg8::Gemm g{(const bf16_t*)(F.ws + WSX_HID), (const bf16_t*)(F.ws + WSX_W2T), MAXROWS, 0, kk2};
        pg8::GroupedOrder S{(const LAS int*)(F.lds + moe::TP_OFF), 4, F.G, (int)blockIdx.x};
        pg8::EpiYs E{(bf16_t*)(F.ws + WSX_XS)};
        pg8::gemm_phase<pg8::EpiYs, pg8::GroupedOrder, true, true>(F.lds, g, S, E);
    } SEAM(10);
    if (IN(11)) for (int rep_ = 0; rep_ < REPS[11]; ++rep_) { const Inputs I = load_inputs(args); (void)I; moe::phase_combine(F); }
#undef IN
#undef SEAM
}
static int g_grid = 0;
static bool mega_setup() {
    if (g_grid) return g_grid > 0;
    int dev = 0, cus = 0, per_cu = 0;
    if (hipGetDevice(&dev) != hipSuccess || hipDeviceGetAttribute(&cus, hipDeviceAttributeMultiprocessorCount, dev) != hipSuccess) { g_grid = -1; return false; }
    if (hipFuncSetAttribute((const void*)mega_fwd, hipFuncAttributeMaxDynamicSharedMemorySize, LDS_BYTES) != hipSuccess) { fprintf(stderr, "hipFuncSetAttribute failed\n"); g_grid = -1; return false; }
    if (hipOccupancyMaxActiveBlocksPerMultiprocessor(&per_cu, (const void*)mega_fwd, NWAVES * 64, LDS_BYTES) != hipSuccess || per_cu < 1) { fprintf(stderr, "occupancy query: %d\n", per_cu); (void)hipGetLastError(); g_grid = -1; return false; }
    g_grid = cus;
    return true;
}
static void mega_launch(void* const* d_in, void* d_out, void* d_ws, hipStream_t stream, int lo, int hi, int li, int knob = 7) {
    Args a{}; for (int i = 0; i < 31; ++i) a.in[i] = d_in[i];
    a.out = (float*)d_out; a.ws = (unsigned char*)d_ws; a.ph_lo = lo; a.ph_hi = hi; a.li = li; a.pad = knob;
    hipLaunchKernelGGL(mega_fwd, dim3(g_grid), dim3(NWAVES * 64), LDS_BYTES, stream, a);
}
extern "C" void kernel_launch(void* const* d_in, const int* in_sizes, int n_in, void* d_out, int out_size, void* d_ws, size_t ws_size, hipStream_t stream) {
    if (n_in != 31 || ws_size < WSX_END || out_size != NTOK * DM) { fprintf(stderr, "kernel_launch: unexpected shapes n_in=%d ws=%zu out=%d\n", n_in, ws_size, out_size); return; }
    if (!mega_setup()) return;
    const Inputs I = get_inputs(d_in);
    char* ws = (char*)d_ws; float* out = (float*)d_out;
    float* mod = (float*)(ws + WS_MOD);
    int2* rexp = (int2*)(ws + WSX_ROUTE); float2* rw = (float2*)(ws + WSX_ROUTE + 256 * 1024);
    bf16_t* XN = (bf16_t*)(ws + WSX_A); bf16_t* H2 = (bf16_t*)(ws + WSX_A);
    bf16_t* PROJ = (bf16_t*)(ws + WSX_B);
    bf16_t* MIXED = (bf16_t*)(ws + WSX_E);
    (void)XN; (void)mod;
    hipMemsetAsync(ws + WS_CTL, 0, 1 * MiB, stream);
    mega_launch(d_in, d_out, d_ws, stream, 0, 12, 0);
}
```

```cpp
#include <hip/hip_runtime.h>
#include <cstdio>
#include <cstdint>
#include <cmath>
constexpr int NB = 4, SEQ = 8192, DM = 1024, NTOK = NB * SEQ;
constexpr int NH = 4, DQK = 192, DNOPE = 128, DROPE = 64, DV = 128;
constexpr int QLR = 256, KVLR = 128, LRUW = 512, LRUH = 4, LRUB = 128;
constexpr int NPROJ = 1472, PROJP = 1536;
constexpr int C_QLAT = 0, C_KVLAT = 256, C_KROPE = 384, C_XLRU = 448, C_GLRU = 960;
constexpr int NEXP = 32, NGRP = 4, EPG = 8, DFF = 256;
constexpr float EPS = 1e-6f;
constexpr int MODW = 6 * DM;

typedef unsigned short bf16_t;
__device__ __forceinline__ float bf2f(bf16_t v) { return __uint_as_float(((unsigned)v) << 16); }
__device__ __forceinline__ bf16_t f2bf(float f) { unsigned u = __float_as_uint(f); return (bf16_t)((u + 0x7fffu + ((u >> 16) & 1u)) >> 16); }

constexpr size_t MiB = 1u << 20;
constexpr size_t WS_CTL = 0;
constexpr size_t WS_MOD = 1 * MiB;
constexpr size_t WS_ROUTE = 2 * MiB;
constexpr size_t WS_A = 64 * MiB;
constexpr size_t WS_B = 128 * MiB;
constexpr size_t WS_C = 224 * MiB;
constexpr size_t WS_D = 352 * MiB;
constexpr size_t WS_E = 416 * MiB;
constexpr size_t WS_END = 480 * MiB;
constexpr size_t WS_Q = WS_C, WS_K = WS_C + 48 * MiB, WS_V = WS_C + 96 * MiB;

__device__ __forceinline__ float silu_f(float v) { return v / (1.f + __expf(-v)); }
__device__ __forceinline__ float sigmoid_f(float v) { return 1.f / (1.f + __expf(-v)); }
__device__ __forceinline__ float gelu_tanh(float v) { const float u = 0.7978845608028654f * (v + 0.044715f * v * v * v); return v / (1.f + __expf(-2.f * u)); }

__device__ __forceinline__ float block_sum_256(float v, float* red) {
    for (int o = 32; o > 0; o >>= 1) v += __shfl_xor(v, o);
    __syncthreads();
    if ((threadIdx.x & 63) == 0) red[threadIdx.x >> 6] = v;
    __syncthreads();
    return red[0] + red[1] + red[2] + red[3];
}
__device__ __forceinline__ float wave_sum(float v) { for (int o = 32; o > 0; o >>= 1) v += __shfl_xor(v, o); return v; }

__device__ __forceinline__ void rope_cs(int pos, int i, float& c, float& s) {
    const double inv = exp(-0.28782313662425575 * (double)i);
    double a = (double)pos * inv;
    const double k = rint(a * 0.15915494309189535);
    a = fma(-k, 6.283185307179586, a); a = fma(-k, 2.4492935982947064e-16, a);
    const float r = (float)a;
    c = __cosf(r); s = __sinf(r);
}

struct Inputs {
    const float *x, *c; const int* positions;
    const float *w_ada, *b_ada, *norm1_g, *w_in, *q_a_norm, *w_q_b, *kv_a_norm, *w_kv_b, *q_norm, *k_norm, *conv_w, *conv_b, *lru_wa, *lru_ba, *lru_wx, *lru_bx, *lru_lambda,
                *attn_out_norm, *lru_out_norm, *w_out, *norm2_g, *w_rg, *b_rg, *w_re, *b_re, *w_gate, *w_up, *w_down;
};
static Inputs get_inputs(void* const* d_in) {
    Inputs I;
    I.x = (const float*)d_in[0]; I.c = (const float*)d_in[1]; I.positions = (const int*)d_in[2];
    I.w_ada = (const float*)d_in[3]; I.b_ada = (const float*)d_in[4]; I.norm1_g = (const float*)d_in[5];
    I.w_in = (const float*)d_in[6]; I.q_a_norm = (const float*)d_in[7]; I.w_q_b = (const float*)d_in[8];
    I.kv_a_norm = (const float*)d_in[9]; I.w_kv_b = (const float*)d_in[10]; I.q_norm = (const float*)d_in[11];
    I.k_norm = (const float*)d_in[12]; I.conv_w = (const float*)d_in[13]; I.conv_b = (const float*)d_in[14];
    I.lru_wa = (const float*)d_in[15]; I.lru_ba = (const float*)d_in[16]; I.lru_wx = (const float*)d_in[17];
    I.lru_bx = (const float*)d_in[18]; I.lru_lambda = (const float*)d_in[19]; I.attn_out_norm = (const float*)d_in[20];
    I.lru_out_norm = (const float*)d_in[21]; I.w_out = (const float*)d_in[22]; I.norm2_g = (const float*)d_in[23];
    I.w_rg = (const float*)d_in[24]; I.b_rg = (const float*)d_in[25]; I.w_re = (const float*)d_in[26];
    I.b_re = (const float*)d_in[27]; I.w_gate = (const float*)d_in[28]; I.w_up = (const float*)d_in[29];
    I.w_down = (const float*)d_in[30];
    return I;
}
#define GAS __attribute__((address_space(1)))
#define LAS __attribute__((address_space(3)))
typedef unsigned v4u __attribute__((ext_vector_type(4)));
typedef unsigned v2u __attribute__((ext_vector_type(2)));
typedef float f32x4 __attribute__((ext_vector_type(4)));
typedef float f32x16 __attribute__((ext_vector_type(16)));
typedef short bf16x8 __attribute__((ext_vector_type(8)));
typedef short s16x4 __attribute__((ext_vector_type(4)));
typedef GAS unsigned gu32;
#define RLX_AGENT __ATOMIC_RELAXED, __HIP_MEMORY_SCOPE_AGENT
#define LDS_WAIT() asm volatile("s_waitcnt lgkmcnt(0)" ::: "memory")
#define VM_WAIT() asm volatile("s_waitcnt vmcnt(0)" ::: "memory")
__device__ __forceinline__ unsigned pk2(float lo, float hi) { return (unsigned)f2bf(lo) | ((unsigned)f2bf(hi) << 16); }
__device__ __forceinline__ unsigned cvtpk(float lo, float hi) { unsigned r; asm volatile("v_cvt_pk_bf16_f32 %0, %1, %2" : "=v"(r) : "v"(lo), "v"(hi)); return r; }

constexpr size_t WSX_SUMA = 3 * MiB, WSX_SUMB = 5 * MiB;
constexpr size_t WSX_CS = 7 * MiB;
constexpr size_t WSX_WQF = 15 * MiB;
constexpr size_t WSX_WKVF = WSX_WQF + 384 * 1024;
constexpr size_t WSX_WAF = WSX_WKVF + 256 * 1024;
constexpr size_t WSX_WXF = WSX_WAF + 128 * 1024;
constexpr size_t WSX_WRF = WSX_WXF + 128 * 1024;
constexpr size_t WSX_SP = 2 * MiB + 768 * 1024;
constexpr size_t WSX_WIN = 16 * MiB;
constexpr size_t WSX_WOUT = 19 * MiB;
constexpr size_t WSX_W1T = 22 * MiB;
constexpr size_t WSX_W2T = 54 * MiB;
constexpr size_t WSX_A = 72 * MiB;
constexpr size_t WSX_B = 136 * MiB;
constexpr size_t WSX_C = 232 * MiB;
constexpr size_t WSX_D = 360 * MiB;
constexpr size_t WSX_E = 424 * MiB;
constexpr size_t WSX_END = 488 * MiB;
constexpr size_t WSX_Q = WSX_C, WSX_K = WSX_C + 48 * MiB, WSX_V = WSX_C + 96 * MiB;
constexpr size_t WSX_XS = 216 * MiB;
constexpr size_t WSX_HID = WSX_D;
constexpr size_t WSX_ROUTE = 2 * MiB;
constexpr int MAXROWS = 2 * NTOK + NEXP * 255;
constexpr size_t WSX_X1 = 72 * MiB;
constexpr size_t WSX_AO = WSX_A;
constexpr size_t WSX_RPOSF = 71 * MiB + 128 * 1024;
constexpr size_t WSX_SUM8A = 70 * MiB + 576 * 1024, WSX_SUM8B = 70 * MiB + 832 * 1024;
constexpr int CW_BAR = 4096;
constexpr int CW_CNT = 65536;

constexpr int RING_BYTES = 131072, LDSCTL_OFF = RING_BYTES, MISC_OFF = LDSCTL_OFF + 320, LDS_BYTES = 147456;
constexpr int NWAVES = 8;
namespace pg8 {
#define PG8_LAS __attribute__((address_space(3)))
typedef unsigned short bf16_t;
typedef short bf16x8 __attribute__((ext_vector_type(8)));
typedef float f32x4 __attribute__((ext_vector_type(4)));
typedef unsigned u32x4 __attribute__((ext_vector_type(4)));
constexpr int BM = 256, BK = 64, HALF = 128, HTB = HALF * BK * 2  , STAGE_BYTES = 8 * HTB, NXCD = 8, WGM = 8;

__host__ __device__ __forceinline__ int lds_byte(int r, int c) { const int st = (r >> 4) * 2 + (c >> 5), rr = r & 15, cc = c & 31, ob = rr * 64 + cc * 2; return st * 1024 + (ob ^ (((ob >> 9) & 1) << 5)); }
__host__ __device__ __forceinline__ void stage_rc(int b, int& R, int& C) { const int st = b / 1024, sb = b % 1024, swz = sb ^ (((sb >> 9) & 1) << 5); R = (st >> 1) * 16 + swz / 64; C = (st & 1) * 32 + (swz % 64) / 2; }
__host__ __device__ __forceinline__ int perm32(int rho) { const int n = rho >> 4, i = rho & 15; return 8 * (i >> 2) + 4 * n + (i & 3); }

struct Unit { int pm, pn; };
struct Gemm { const bf16_t* A; const bf16_t* Bt; int M, N, K; };

struct StaticOrder {
    int nM, nN, nwg, G, c;
    __host__ __device__ void init(int M, int N, int G_, int c_) { nM = M / BM; nN = N / BM; nwg = nM * nN; G = G_; c = c_; }
    __host__ __device__ bool next(int i, Unit& u) const {
        const long L = (long)i * G + c; if (L >= nwg) return false;
        int wgid = (int)L; { const int q = nwg / NXCD, r = nwg % NXCD, xcd = wgid % NXCD, off = wgid / NXCD; wgid = (xcd < r ? xcd * (q + 1) : r * (q + 1) + (xcd - r) * q) + off; }
        const int nig = WGM * nN, gid = wgid / nig, fm = gid * WGM, gsz = (nM - fm) < WGM ? (nM - fm) : WGM;
        u.pm = fm + ((wgid % nig) % gsz); u.pn = (wgid % nig) / gsz; return true;
    }
    __device__ __forceinline__ void a_ready(const Unit&) const {}
    __device__ __forceinline__ void done(const Unit&) const {}
};

__device__ __forceinline__ unsigned cvt_pk_bf16(float lo, float hi) { unsigned r; asm volatile("v_cvt_pk_bf16_f32 %0, %1, %2" : "=v"(r) : "v"(lo), "v"(hi)); return r; }
typedef float f32x2 __attribute__((ext_vector_type(2)));
__device__ __forceinline__ f32x2 gelu_pk(f32x2 v) {
    const f32x2 av = __builtin_elementwise_abs(v), d = av * 0.2316418882f + 1.0f;
    f32x2 t; t.x = __builtin_amdgcn_rcpf(d.x); t.y = __builtin_amdgcn_rcpf(d.y);
    f32x2 q = t * 0.5307027145f + (-0.7265760135f); q = q * t + 0.7107068705f; q = q * t + (-0.142248368f); q = q * t + 0.127414796f; q = q * t;
    const f32x2 s = (v * v) * (-0.72134752044f);
    f32x2 e; e.x = __builtin_amdgcn_exp2f(s.x); e.y = __builtin_amdgcn_exp2f(s.y);
    const f32x2 m = v * (q * e), r = v - m;
    f32x2 o; o.x = v.x < 0.f ? m.x : r.x; o.y = v.y < 0.f ? m.y : r.y; return o;
}

template <int ACT  > struct EpiBf16 {
    static constexpr bool PERM = true, AFTER_DRAIN = false; static_assert(ACT == 0 || ACT == 1, "EpiBf16: ACT is 0 (none) or 1 (gelu_pk)");
    bf16_t* O; int ldc; const float* bias; int split_cols; size_t split_stride; float scale0;
    __device__ __forceinline__ void operator()(const f32x4 (&acc)[2][2][4][2], const Unit& u, int wr, int wc, int fr, int fq) const {
        const int row0 = u.pm * BM + wr * 64 + fr; int colt = u.pn * BM; bf16_t* base = O;
        float sc = 1.f; if (split_cols) { const int t = colt / split_cols; base += (size_t)t * split_stride; colt -= t * split_cols; if (t == 0) sc = scale0; }
        const int col0 = colt + wc * 32 + 8 * fq, bcol0 = u.pn * BM + wc * 32 + 8 * fq;
        f32x4 bv[2][2];
#pragma unroll
        for (int bj = 0; bj < 2; ++bj)
#pragma unroll
            for (int n = 0; n < 2; ++n) bv[bj][n] = bias ? *(const f32x4*)(bias + bcol0 + bj * HALF + 4 * n) : (f32x4){0.f, 0.f, 0.f, 0.f};
#pragma unroll
        for (int ai = 0; ai < 2; ++ai)
#pragma unroll
            for (int m = 0; m < 4; ++m) { bf16_t* rowp = base + (size_t)(row0 + ai * HALF + m * 16) * ldc + col0;
#pragma unroll
                for (int bj = 0; bj < 2; ++bj) { f32x4 v0 = acc[ai][bj][m][0] + bv[bj][0], v1 = acc[ai][bj][m][1] + bv[bj][1];
                    if (ACT == 1) { f32x2 a = gelu_pk((f32x2){v0[0], v0[1]}), b = gelu_pk((f32x2){v0[2], v0[3]}), c = gelu_pk((f32x2){v1[0], v1[1]}), d = gelu_pk((f32x2){v1[2], v1[3]});
                        v0 = (f32x4){a.x, a.y, b.x, b.y}; v1 = (f32x4){c.x, c.y, d.x, d.y}; }
                    v0 = v0 * sc; v1 = v1 * sc; u32x4 w; w.x = cvt_pk_bf16(v0[0], v0[1]); w.y = cvt_pk_bf16(v0[2], v0[3]); w.z = cvt_pk_bf16(v1[0], v1[1]); w.w = cvt_pk_bf16(v1[2], v1[3]);
                    *(u32x4*)(rowp + bj * HALF) = w; } }
    }
};
struct EpiResid {
    static constexpr bool PERM = true, AFTER_DRAIN = false;
    const float* x; const float* mod; bf16_t* out;
    __device__ __forceinline__ void operator()(const f32x4 (&acc)[2][2][4][2], const Unit& u, int wr, int wc, int fr, int fq) const {
        const int col0 = u.pn * BM + wc * 32 + 8 * fq, b = (u.pm * BM) / 8192;
        f32x4 gv[2][2];
#pragma unroll
        for (int bj = 0; bj < 2; ++bj)
#pragma unroll
            for (int n = 0; n < 2; ++n) gv[bj][n] = *(const f32x4*)(mod + b * 6144 + 2048 + col0 + bj * HALF + n * 4);
#pragma unroll
        for (int ai = 0; ai < 2; ++ai)
#pragma unroll
            for (int m = 0; m < 4; ++m) { const size_t off = (size_t)(u.pm * BM + ai * HALF + wr * 64 + m * 16 + fr) * 1024 + col0;
#pragma unroll
                for (int bj = 0; bj < 2; ++bj) { const f32x4 x0 = *(const f32x4*)(x + off + bj * HALF), x1 = *(const f32x4*)(x + off + bj * HALF + 4);
                    const f32x4 v0 = x0 + gv[bj][0] * acc[ai][bj][m][0], v1 = x1 + gv[bj][1] * acc[ai][bj][m][1];
                    u32x4 w; w.x = cvt_pk_bf16(v0[0], v0[1]); w.y = cvt_pk_bf16(v0[2], v0[3]); w.z = cvt_pk_bf16(v1[0], v1[1]); w.w = cvt_pk_bf16(v1[2], v1[3]);
                    *(u32x4*)(out + off + bj * HALF) = w; } }
    }
};
__device__ __forceinline__ float silu_e(float v) { return v * __builtin_amdgcn_rcpf(1.f + __builtin_amdgcn_exp2f(-1.4426950408889634f * v)); }
struct EpiSiluMul {
    static constexpr bool PERM = true, AFTER_DRAIN = false;
    bf16_t* H;
    __device__ __forceinline__ void operator()(const f32x4 (&acc)[2][2][4][2], const Unit& u, int wr, int wc, int fr, int fq) const {
        const int half = u.pn & 1, col0 = half * 128 + wc * 32 + 8 * fq;
#pragma unroll
        for (int ai = 0; ai < 2; ++ai)
#pragma unroll
            for (int m = 0; m < 4; ++m) { const size_t row = (size_t)(u.pm * BM + ai * HALF + wr * 64 + m * 16 + fr);
                const f32x4 g0 = acc[ai][0][m][0], g1 = acc[ai][0][m][1], u0 = acc[ai][1][m][0], u1 = acc[ai][1][m][1];
                u32x4 w; w.x = cvt_pk_bf16(silu_e(g0[0]) * u0[0], silu_e(g0[1]) * u0[1]); w.y = cvt_pk_bf16(silu_e(g0[2]) * u0[2], silu_e(g0[3]) * u0[3]);
                w.z = cvt_pk_bf16(silu_e(g1[0]) * u1[0], silu_e(g1[1]) * u1[1]); w.w = cvt_pk_bf16(silu_e(g1[2]) * u1[2], silu_e(g1[3]) * u1[3]);
                *(u32x4*)(H + row * 256 + col0) = w; }
    }
};
struct EpiProjT {
    static constexpr bool PERM = true, AFTER_DRAIN = false;
    bf16_t* P;
    __device__ __forceinline__ void operator()(const f32x4 (&acc)[2][2][4][2], const Unit& u, int wr, int wc, int fr, int fq) const {
#pragma unroll
        for (int ai = 0; ai < 2; ++ai)
#pragma unroll
            for (int m = 0; m < 4; ++m) { const int row = u.pm * BM + ai * HALF + wr * 64 + m * 16 + fr;
#pragma unroll
                for (int bj = 0; bj < 2; ++bj) { const int c = (u.pn * BM + bj * HALF + wc * 32 + 8 * fq) >> 3; const f32x4 v0 = acc[ai][bj][m][0], v1 = acc[ai][bj][m][1];
                    u32x4 w; w.x = cvt_pk_bf16(v0[0], v0[1]); w.y = cvt_pk_bf16(v0[2], v0[3]); w.z = cvt_pk_bf16(v1[0], v1[1]); w.w = cvt_pk_bf16(v1[2], v1[3]);
                    *(u32x4*)(P + ((size_t)((row >> 5) * 192 + c) * 32 + (row & 31)) * 8) = w; } }
    }
};
struct EpiYs {
    static constexpr bool PERM = true, AFTER_DRAIN = false;
    bf16_t* Y;
    __device__ __forceinline__ void operator()(const f32x4 (&acc)[2][2][4][2], const Unit& u, int wr, int wc, int fr, int fq) const {
        const int col0 = (u.pn & 3) * BM + wc * 32 + 8 * fq;
#pragma unroll
        for (int ai = 0; ai < 2; ++ai)
#pragma unroll
            for (int m = 0; m < 4; ++m) { bf16_t* rowp = Y + (size_t)(u.pm * BM + ai * HALF + wr * 64 + m * 16 + fr) * 1024 + col0;
#pragma unroll
                for (int bj = 0; bj < 2; ++bj) { const f32x4 v0 = acc[ai][bj][m][0], v1 = acc[ai][bj][m][1];
                    u32x4 w; w.x = cvt_pk_bf16(v0[0], v0[1]); w.y = cvt_pk_bf16(v0[2], v0[3]); w.z = cvt_pk_bf16(v1[0], v1[1]); w.w = cvt_pk_bf16(v1[2], v1[3]);
                    *(u32x4*)(rowp + bj * HALF) = w; } }
    }
};
struct GroupedOrder {
    const __attribute__((address_space(3))) int* tp; int ncol, G, c;
    __device__ __forceinline__ bool next(int i, Unit& u) const {
        const int L = i * G + c, total = tp[32] * ncol; if (L >= total) return false;
        const int rt = L / ncol, ct = L - rt * ncol; int e = 0;
#pragma unroll 1
        for (int j = 1; j < 32; ++j) e += (tp[j] <= rt) ? 1 : 0;
        u.pm = rt; u.pn = e * ncol + ct; return true;
    }
    __device__ __forceinline__ void a_ready(const Unit&) const {}
    __device__ __forceinline__ void done(const Unit&) const {}
};
template <class Epi, class Sched, bool ALIGN_EPI = false, bool SP2 = false>
__device__ __forceinline__ void gemm_phase(PG8_LAS unsigned char* lds, const Gemm g, const Sched& S, const Epi& E) {
    const int tid = threadIdx.x, wid = __builtin_amdgcn_readfirstlane(tid >> 6), lane = tid & 63, wr = wid >> 2, wc = wid & 3, fr = lane & 15, fq = lane >> 4;
    const int K = g.K, nt = K / BK;
    unsigned voffA[2], voffB[2];
#pragma unroll
    for (int i = 0; i < 2; ++i) { int R, C; stage_rc(tid * 16 + i * 8192, R, C); const int Rb = Epi::PERM ? ((R & ~31) + perm32(R & 31)) : R;
        voffA[i] = (unsigned)(R * K + C) * 2u; voffB[i] = (unsigned)(Rb * K + C) * 2u; }
    const size_t kstep = (size_t)(BK * 2);
    const size_t hstep = (size_t)HALF * K * 2;
    const size_t tstep = 2 * hstep;
    const unsigned ldsw = (unsigned)wid * 1024u;
    const int aoff = lds_byte(wr * 64 + fr, fq * 8), boff = lds_byte(wc * 32 + fr, fq * 8);
#define PG8_SA(b, h) (((b) * 2 + (h)) * HTB)
#define PG8_SB(b, h) ((4 + (b) * 2 + (h)) * HTB)
#define PG8_STAGE(bufoff, gbase, voff) do { _Pragma("unroll") for (int _i = 0; _i < 2; ++_i) \
        __builtin_amdgcn_global_load_lds((const unsigned*)((const char*)(gbase) + (voff)[_i]), (PG8_LAS unsigned*)(lds + (bufoff) + ldsw + _i * 8192), 16, 0, 0); } while (0)
#define PG8_LDA(dst, b, h) do { _Pragma("unroll") for (int m = 0; m < 4; ++m) _Pragma("unroll") for (int k = 0; k < 2; ++k) dst[m][k] = *(const PG8_LAS bf16x8*)(lds + PG8_SA(b, h) + aoff + m * 2048 + k * 1024); } while (0)
#define PG8_LDB(dst, b, h) do { _Pragma("unroll") for (int n = 0; n < 2; ++n) _Pragma("unroll") for (int k = 0; k < 2; ++k) dst[n][k] = *(const PG8_LAS bf16x8*)(lds + PG8_SB(b, h) + boff + n * 2048 + k * 1024); } while (0)
#define PG8_MMA(ai, bj, At, Bt) do { __builtin_amdgcn_s_setprio(1); _Pragma("unroll") for (int m = 0; m < 4; ++m) _Pragma("unroll") for (int n = 0; n < 2; ++n) _Pragma("unroll") for (int k = 0; k < 2; ++k) \
        acc[ai][bj][m][n] = __builtin_amdgcn_mfma_f32_16x16x32_bf16(Bt[n][k], At[m][k], acc[ai][bj][m][n], 0, 0, 0); __builtin_amdgcn_s_setprio(0); } while (0)
#define PG8_WAIT_V(n) asm volatile("s_waitcnt vmcnt(" #n ")" ::: "memory")
#define PG8_WAIT_L(n) asm volatile("s_waitcnt lgkmcnt(" #n ")" ::: "memory")
#define PG8_BAR __builtin_amdgcn_s_barrier()
#define PG8_SCHED __builtin_amdgcn_sched_barrier(0)
    Unit cur, nxt; int ui = 0;
    if (!S.next(0, cur)) return;
    f32x4 acc[2][2][4][2];
#pragma unroll
    for (int a = 0; a < 2; ++a)
#pragma unroll
        for (int b = 0; b < 2; ++b)
#pragma unroll
            for (int m = 0; m < 4; ++m)
#pragma unroll
                for (int n = 0; n < 2; ++n) acc[a][b][m][n] = (f32x4){0.f, 0.f, 0.f, 0.f};
    bf16x8 At[4][2], B0[2][2], B1[2][2];
    const char* cA = (const char*)g.A + (size_t)cur.pm * tstep; const char* cB = (const char*)g.Bt + (size_t)cur.pn * tstep;
    S.a_ready(cur);
    if constexpr (SP2) {
        PG8_STAGE(PG8_SB(0, 0), cB, voffB); PG8_STAGE(PG8_SB(0, 1), cB + hstep, voffB); PG8_STAGE(PG8_SA(0, 0), cA, voffA); PG8_STAGE(PG8_SA(0, 1), cA + hstep, voffA);
        if (wr == 1) PG8_BAR;
        PG8_WAIT_V(2); PG8_BAR;
        PG8_STAGE(PG8_SB(1, 0), cB + kstep, voffB); PG8_STAGE(PG8_SA(1, 0), cA + kstep, voffA); PG8_STAGE(PG8_SB(1, 1), cB + hstep + kstep, voffB);
        PG8_WAIT_V(6); PG8_BAR;
    } else {
        PG8_STAGE(PG8_SB(0, 0), cB, voffB); PG8_STAGE(PG8_SA(0, 0), cA, voffA); PG8_STAGE(PG8_SB(0, 1), cB + hstep, voffB); PG8_STAGE(PG8_SA(0, 1), cA + hstep, voffA);
        if (wr == 1) PG8_BAR;
        PG8_WAIT_V(4); PG8_BAR;
        PG8_STAGE(PG8_SB(1, 0), cB + kstep, voffB); PG8_STAGE(PG8_SA(1, 0), cA + kstep, voffA); PG8_STAGE(PG8_SB(1, 1), cB + hstep + kstep, voffB);
        PG8_WAIT_V(6); PG8_BAR;
    }
    for (;;) {
        const bool has_next = S.next(ui + 1, nxt);
        const char* nA = has_next ? (const char*)g.A + (size_t)nxt.pm * tstep : cA; const char* nB = has_next ? (const char*)g.Bt + (size_t)nxt.pn * tstep : cB;
        for (int t = 0; t < nt; t += 2) {
            const bool last = (t == nt - 2);
            const char* a1 = cA + (size_t)(t + 1) * kstep;
            const char* a2 = last ? nA : cA + (size_t)(t + 2) * kstep; const char* b2 = last ? nB : cB + (size_t)(t + 2) * kstep;
            const char* a3 = a2 + kstep; const char* b3 = b2 + kstep;
            if (last && has_next) S.a_ready(nxt);
            if constexpr (SP2) {
            PG8_LDB(B0, 0, 0); PG8_LDB(B1, 0, 1); PG8_SCHED; PG8_LDA(At, 0, 0); PG8_STAGE(PG8_SA(1, 1), a1 + hstep, voffA);
            PG8_WAIT_V(8); PG8_WAIT_L(0); PG8_BAR; PG8_MMA(0, 0, At, B0); PG8_MMA(0, 1, At, B1); PG8_BAR; PG8_SCHED;
            PG8_LDA(At, 0, 1); PG8_STAGE(PG8_SB(0, 0), b2, voffB); PG8_STAGE(PG8_SB(0, 1), b2 + hstep, voffB); PG8_STAGE(PG8_SA(0, 0), a2, voffA);
            PG8_WAIT_V(8); PG8_WAIT_L(0); PG8_BAR; PG8_MMA(1, 0, At, B0); PG8_MMA(1, 1, At, B1); PG8_BAR; PG8_SCHED;
            PG8_LDB(B0, 1, 0); PG8_LDB(B1, 1, 1); PG8_SCHED; PG8_LDA(At, 1, 0); PG8_STAGE(PG8_SA(0, 1), a2 + hstep, voffA);
            PG8_WAIT_V(8); PG8_WAIT_L(0); PG8_BAR; PG8_MMA(0, 0, At, B0); PG8_MMA(0, 1, At, B1); PG8_BAR; PG8_SCHED;
            PG8_LDA(At, 1, 1); PG8_STAGE(PG8_SB(1, 0), b3, voffB); PG8_STAGE(PG8_SB(1, 1), b3 + hstep, voffB); PG8_STAGE(PG8_SA(1, 0), a3, voffA);
            PG8_WAIT_V(8); PG8_WAIT_L(0); PG8_BAR; PG8_MMA(1, 0, At, B0); PG8_MMA(1, 1, At, B1); PG8_BAR; PG8_SCHED;
            } else {
            PG8_LDB(B0, 0, 0); PG8_SCHED; PG8_LDA(At, 0, 0); PG8_STAGE(PG8_SA(1, 1), a1 + hstep, voffA);
            PG8_WAIT_L(8); PG8_BAR; PG8_WAIT_L(0); PG8_MMA(0, 0, At, B0); PG8_BAR; PG8_SCHED;
            PG8_LDB(B1, 0, 1); PG8_STAGE(PG8_SB(0, 0), b2, voffB);
            PG8_BAR; PG8_WAIT_L(0); PG8_MMA(0, 1, At, B1); PG8_BAR;
            PG8_LDA(At, 0, 1); PG8_STAGE(PG8_SA(0, 0), a2, voffA);
            PG8_BAR; PG8_WAIT_L(0); PG8_MMA(1, 0, At, B0); PG8_BAR; PG8_SCHED;
            PG8_STAGE(PG8_SB(0, 1), b2 + hstep, voffB);
            PG8_WAIT_V(6); PG8_BAR; PG8_MMA(1, 1, At, B1); PG8_BAR;
            PG8_LDB(B0, 1, 0); PG8_SCHED; PG8_LDA(At, 1, 0); PG8_STAGE(PG8_SA(0, 1), a2 + hstep, voffA);
            PG8_WAIT_L(8); PG8_BAR; PG8_WAIT_L(0); PG8_MMA(0, 0, At, B0); PG8_BAR; PG8_SCHED;
            PG8_LDB(B1, 1, 1); PG8_STAGE(PG8_SB(1, 0), b3, voffB);
            PG8_BAR; PG8_WAIT_L(0); PG8_MMA(0, 1, At, B1); PG8_BAR;
            PG8_LDA(At, 1, 1); PG8_STAGE(PG8_SA(1, 0), a3, voffA);
            PG8_BAR; PG8_WAIT_L(0); PG8_MMA(1, 0, At, B0); PG8_BAR; PG8_SCHED;
            PG8_STAGE(PG8_SB(1, 1), b3 + hstep, voffB);
            PG8_WAIT_V(6); PG8_BAR; PG8_MMA(1, 1, At, B1); PG8_BAR;
            }
        }
        if constexpr (ALIGN_EPI) { if (wr == 0) PG8_BAR; }
        if constexpr (!Epi::AFTER_DRAIN) { E(acc, cur, wr, wc, fr, fq); S.done(cur); }
        if (!has_next) break;
#pragma unroll
        for (int a = 0; a < 2; ++a)
#pragma unroll
            for (int b = 0; b < 2; ++b)
#pragma unroll
                for (int m = 0; m < 4; ++m)
#pragma unroll
                    for (int n = 0; n < 2; ++n) acc[a][b][m][n] = (f32x4){0.f, 0.f, 0.f, 0.f};
        cur = nxt; cA = nA; cB = nB; ++ui;
        if constexpr (ALIGN_EPI) { if (wr == 1) PG8_BAR; }
    }
    PG8_WAIT_V(0);
    if constexpr (!ALIGN_EPI) { if (wr == 0) PG8_BAR; }
    PG8_BAR;
    if constexpr (Epi::AFTER_DRAIN) { E.fused(acc, cur, wr, wc, fr, fq, lds, wid, lane); S.done(cur); }
#undef PG8_SA
#undef PG8_SB
#undef PG8_STAGE
#undef PG8_LDA
#undef PG8_LDB
#undef PG8_MMA
#undef PG8_WAIT_V
#undef PG8_WAIT_L
#undef PG8_BAR
#undef PG8_SCHED
}
}
#define XB_TMO      128
#define XB_XCNT(j)  (256  + 64 * (j))
#define XB_XSUB(j)  (1280 + 64 * (j))
#define XB_XGEN(j)  (2304 + 64 * (j))
#define XB_TOP      3328
#define XB_TOPGEN   3392
#define XCD_BAR_WORDS 3456
#define XB_SPIN_CAP (1u << 18)

__device__ __forceinline__ unsigned xb_ld(unsigned* p)              { return __hip_atomic_load(p, __ATOMIC_RELAXED, __HIP_MEMORY_SCOPE_AGENT); }
__device__ __forceinline__ unsigned xb_add(unsigned* p, unsigned v) { return __hip_atomic_fetch_add(p, v, __ATOMIC_RELAXED, __HIP_MEMORY_SCOPE_AGENT); }
__device__ __forceinline__ unsigned xb_xcc_id() { return (unsigned)__builtin_amdgcn_s_getreg((3 << 11) | 20) & 0xFu; }
#define XB_SPIN(cond, bar) do { unsigned _sp = 0; while (cond) { __builtin_amdgcn_s_sleep(1); \
    if ((++_sp & 255u) == 0u) { if (xb_ld(&(bar)[XB_TMO])) break; if (_sp > XB_SPIN_CAP) { atomicAdd(&(bar)[XB_TMO], 1u); break; } } } } while (0)

struct XcdBarrier {
    unsigned* bar; unsigned x;
    volatile LAS unsigned* st;
};

__device__ __forceinline__ XcdBarrier xcd_barrier_post(unsigned* bar, volatile LAS unsigned* st) {
    XcdBarrier b; b.bar = bar; b.x = xb_xcc_id(); b.st = st;
    if (threadIdx.x == 0) (void)xb_add(&bar[XB_XCNT(b.x)], 1u);
    return b;
}
__device__ __forceinline__ void xcd_barrier_complete(unsigned* bar, unsigned x, unsigned& nloc, unsigned& nx) {
    const unsigned G = gridDim.x * gridDim.y * gridDim.z;
    unsigned sum, cnt, mine, sp = 0u;
    for (;;) {
        sum = 0u; cnt = 0u; mine = 0u;
#pragma unroll
        for (unsigned j = 0; j < 16; ++j) { const unsigned c = xb_ld(&bar[XB_XCNT(j)]); sum += c; cnt += (c > 0u) ? 1u : 0u; mine = (j == x) ? c : mine; }
        if (sum == G) break;
        __builtin_amdgcn_s_sleep(1);
        if ((++sp & 255u) == 0u) { if (xb_ld(&bar[XB_TMO])) break; if (sp > XB_SPIN_CAP) { atomicAdd(&bar[XB_TMO], 1u); break; } }
    }
    nloc = mine > 0u ? mine : 1u; nx = cnt > 0u ? cnt : 1u;
}

__device__ __forceinline__ void xcd_barrier(const XcdBarrier& b) {
    asm volatile("s_waitcnt vmcnt(0)" ::: "memory");
    __syncthreads();
    if (threadIdx.x == 0) {
        unsigned* bar = b.bar;
        __builtin_amdgcn_s_waitcnt(0);
        unsigned nloc = b.st[0], nx = b.st[1];
        if (nloc == 0u) { xcd_barrier_complete(bar, b.x, nloc, nx); b.st[0] = nloc; b.st[1] = nx; }
        const unsigned old = xb_add(&bar[XB_XSUB(b.x)], 1u);
        const unsigned gen = old / nloc;
        if (old + 1u == (gen + 1u) * nloc) {
            __builtin_amdgcn_fence(__ATOMIC_RELEASE, "agent");
            asm volatile("s_waitcnt vmcnt(0)" ::: "memory");
            const unsigned og = xb_add(&bar[XB_TOP], 1u);
            const unsigned tg = og / nx;
            if (og + 1u == (tg + 1u) * nx) xb_add(&bar[XB_TOPGEN], 1u);
            else XB_SPIN(xb_ld(&bar[XB_TOPGEN]) == tg, bar);
            __builtin_amdgcn_fence(__ATOMIC_ACQUIRE, "agent");
            xb_add(&bar[XB_XGEN(b.x)], 1u);
            asm volatile("s_waitcnt vmcnt(0)" ::: "memory");
        } else {
            XB_SPIN(xb_ld(&bar[XB_XGEN(b.x)]) == gen, bar);
            __builtin_amdgcn_fence(__ATOMIC_ACQUIRE, "agent");
            asm volatile("s_waitcnt vmcnt(0)" ::: "memory");
        }
    }
    __syncthreads();
}
struct Args { const void* in[31]; float* out; unsigned char* ws; int ph_lo, ph_hi, li, pad; };
struct Frame {
    LAS unsigned char* lds; volatile LAS unsigned* MISC; gu32* ctl;
    int tid, lane, wave, vcu, G;
    unsigned char* ws; float* out;
};
__device__ __forceinline__ float wave_sum_f(float v) {
#pragma unroll
    for (int o = 1; o < 64; o <<= 1) v += __shfl_xor(v, o);
    return v;
}
__device__ __forceinline__ void p0_transpose_item(const float* W, int K, int N, bf16_t* WT, int row_off, LAS float* scr, int kb, int nb, int lane) {
    const int k0 = 64 * kb, n0 = 32 * nb;
#pragma unroll 8
    for (int i = 0; i < 32; ++i) { const int kk = 2 * i + (lane >> 5); scr[kk * 33 + (lane & 31)] = W[(size_t)(k0 + kk) * N + n0 + (lane & 31)]; }
    LDS_WAIT(); asm volatile("" ::: "memory");
    const int c = lane & 7;
#pragma unroll
    for (int j = 0; j < 4; ++j) { const int n = (lane >> 3) + 8 * j; const LAS float* s = scr + (8 * c) * 33 + n;
        v4u o; o.x = pk2(s[0 * 33], s[1 * 33]); o.y = pk2(s[2 * 33], s[3 * 33]); o.z = pk2(s[4 * 33], s[5 * 33]); o.w = pk2(s[6 * 33], s[7 * 33]);
        *(GAS v4u*)(WT + (size_t)(row_off + n0 + n) * K + k0 + 8 * c) = o; }
    LDS_WAIT(); asm volatile("" ::: "memory");
}
__device__ __forceinline__ int lru_chan(int ks, int hi, int j) { return 32 * (ks >> 1) + 16 * (ks & 1) + 8 * (j >> 2) + 4 * hi + (j & 3); }
__device__ __forceinline__ void phase_prologue(Frame& F, const Inputs& I) {
    if (blockIdx.x < 192) {
        LAS float* sl = (LAS float*)F.lds; LAS float* red = sl + 4096;
        for (int i = ((int)threadIdx.x); i < 4096; i += 512) { const float v = I.c[i]; sl[i] = v / (1.f + __expf(-v)); }
        __syncthreads();
        const int col0 = blockIdx.x * 32, kg = ((int)threadIdx.x) >> 5, col = ((int)threadIdx.x) & 31;
        float a0 = 0.f, a1 = 0.f, a2 = 0.f, a3 = 0.f;
#pragma unroll 8
        for (int i = 0; i < 64; ++i) { const int k = kg + 16 * i; const float w = I.w_ada[(size_t)k * MODW + col0 + col];
            a0 += sl[k] * w; a1 += sl[1024 + k] * w; a2 += sl[2048 + k] * w; a3 += sl[3072 + k] * w; }
        red[(kg * 4 + 0) * 32 + col] = a0; red[(kg * 4 + 1) * 32 + col] = a1; red[(kg * 4 + 2) * 32 + col] = a2; red[(kg * 4 + 3) * 32 + col] = a3;
        __syncthreads();
        if (((int)threadIdx.x) < 128) { const int b = ((int)threadIdx.x) >> 5, c = ((int)threadIdx.x) & 31; float s = I.b_ada[col0 + c];
            for (int g = 0; g < 16; ++g) s += red[(g * 4 + b) * 32 + c];
            ((float*)(F.ws + WS_MOD))[b * MODW + col0 + c] = s; }
        __syncthreads();
    }
    {
        LAS float* scr = (LAS float*)(F.lds + F.wave * 16384);
        const int gw = F.vcu * NWAVES + F.wave, NGW = F.G * NWAVES;
        bf16_t* WIN = (bf16_t*)(F.ws + WSX_WIN); bf16_t* WOUT = (bf16_t*)(F.ws + WSX_WOUT); bf16_t* W1T = (bf16_t*)(F.ws + WSX_W1T); bf16_t* W2T = (bf16_t*)(F.ws + WSX_W2T);
        constexpr int I_IN = 16 * 46, I_OUT = 16 * 32, I_G = 32 * 16 * 8, I_D = 32 * 4 * 32, NIT = I_IN + I_OUT + 2 * I_G + I_D;
        for (int it = gw; it < NIT; it += NGW) {
            int r = it;
            if (r < I_IN) { p0_transpose_item(I.w_in, 1024, NPROJ, WIN, 0, scr, r / 46, r % 46, ((int)(threadIdx.x & 63))); continue; } r -= I_IN;
            if (r < I_OUT) { p0_transpose_item(I.w_out, 1024, 1024, WOUT, 0, scr, r / 32, r % 32, ((int)(threadIdx.x & 63))); continue; } r -= I_OUT;
            if (r < 2 * I_G) { const int up = r >= I_G ? 1 : 0; if (up) r -= I_G; const int e = r >> 7, kb = (r >> 3) & 15, nb = r & 7, n0 = 32 * nb;
                p0_transpose_item((up ? I.w_up : I.w_gate) + (size_t)e * 1024 * 256, 1024, 256, W1T, e * 512 + (n0 >> 7) * 256 + (n0 & 127) - n0 + up * 128, scr, kb, nb, ((int)(threadIdx.x & 63))); continue; } r -= 2 * I_G;
            { const int e = r >> 7, kb = (r >> 5) & 3, nb = r & 31; p0_transpose_item(I.w_down + (size_t)e * 256 * 1024, 256, 1024, W2T, e * 1024, scr, kb, nb, ((int)(threadIdx.x & 63))); }
        }
    }
    {
        const int gt = blockIdx.x * 512 + ((int)threadIdx.x), NGT = F.G * 512;
        v4u* WQF = (v4u*)(F.ws + WSX_WQF); v4u* WKVF = (v4u*)(F.ws + WSX_WKVF); v4u* WAF = (v4u*)(F.ws + WSX_WAF); v4u* WXF = (v4u*)(F.ws + WSX_WXF); v4u* WRF = (v4u*)(F.ws + WSX_WRF);
        constexpr int NQ = 4 * 6 * 16 * 64, NKV = 4 * 8 * 8 * 64, NA = 4 * 4 * 8 * 64, NR = 2 * 64 * 64, NZ = 64 * 1024 / 8, NTOT = NQ + NKV + 2 * NA + NR + NZ;
        for (int g = gt; g < NTOT; g += NGT) {
            int r = g; float v[8];
            if (r < NQ) { const int lane = r & 63, ks = (r >> 6) & 15, hn = r >> 10, h = hn / 6, nb = hn % 6, hi = lane >> 5, r32 = lane & 31;
#pragma unroll
                for (int j = 0; j < 8; ++j) { const int k = 16 * ks + 8 * hi + j; v[j] = I.w_q_b[(size_t)k * 768 + h * 192 + 32 * nb + r32] * I.q_a_norm[k]; }
                WQF[r] = (v4u){pk2(v[0], v[1]), pk2(v[2], v[3]), pk2(v[4], v[5]), pk2(v[6], v[7])}; continue; } r -= NQ;
            if (r < NKV) { const int lane = r & 63, ks = (r >> 6) & 7, hn = r >> 9, h = hn >> 3, nb = hn & 7, hi = lane >> 5, r32 = lane & 31;
#pragma unroll
                for (int j = 0; j < 8; ++j) { const int k = 16 * ks + 8 * hi + j; v[j] = I.w_kv_b[(size_t)k * 1024 + h * 256 + 32 * nb + r32] * I.kv_a_norm[k]; }
                WKVF[r] = (v4u){pk2(v[0], v[1]), pk2(v[2], v[3]), pk2(v[4], v[5]), pk2(v[6], v[7])}; continue; } r -= NKV;
            if (r < 2 * NA) { const int x = r >= NA ? 1 : 0; if (x) r -= NA; const int lane = r & 63, ks = (r >> 6) & 7, hn = r >> 9, h = hn >> 2, nb = hn & 3, hi = lane >> 5, r32 = lane & 31;
                const float* W = x ? I.lru_wx : I.lru_wa;
#pragma unroll
                for (int j = 0; j < 8; ++j) v[j] = W[(size_t)(h * 128 + lru_chan(ks, hi, j)) * 128 + 32 * nb + r32];
                (x ? WXF : WAF)[r] = (v4u){pk2(v[0], v[1]), pk2(v[2], v[3]), pk2(v[4], v[5]), pk2(v[6], v[7])}; continue; } r -= 2 * NA;
            if (r < NR) { const int lane = r & 63, ks = (r >> 6) & 63, nb = r >> 12, hi = lane >> 5, n = 32 * nb + (lane & 31);
#pragma unroll
                for (int j = 0; j < 8; ++j) { const int k = 16 * ks + 8 * hi + j; v[j] = n < 4 ? I.w_rg[k * 4 + n] : (n < 36 ? I.w_re[k * 32 + n - 4] : 0.f); }
                WRF[r] = (v4u){pk2(v[0], v[1]), pk2(v[2], v[3]), pk2(v[4], v[5]), pk2(v[6], v[7])}; continue; } r -= NR;
            ((v4u*)(F.ws + WSX_WIN + (size_t)NPROJ * 1024 * 2))[r] = (v4u){0u, 0u, 0u, 0u};
        }
        if (gt < 512) ((float*)(F.ws + WSX_SP))[gt] = log1pf(__expf(-I.lru_lambda[gt]));
        float* CS = (float*)(F.ws + WSX_CS);
        for (int g = gt; g < NTOK * 32; g += NGT) { const int t = g >> 5, i = g & 31; float c, s; rope_cs(I.positions[t], i, c, s); CS[t * 64 + i] = c; CS[t * 64 + 32 + i] = s; }
    }
}
__device__ __forceinline__ void phase_xn(Frame& F, const Inputs& I) {
    LAS float* Gs = (LAS float*)F.lds; LAS float* Ss = Gs + 4096;
    const float* mod = (const float*)(F.ws + WS_MOD);
#pragma unroll
    for (int i = ((int)threadIdx.x); i < 4096; i += 512) { const int b = i >> 10, k = i & 1023; Gs[i] = I.norm1_g[k] * (1.f + mod[b * MODW + 1024 + k]); Ss[i] = mod[b * MODW + k]; }
    __syncthreads();
    bf16_t* XN = (bf16_t*)(F.ws + WSX_A);
    const int gw = F.vcu * NWAVES + F.wave, NGW = F.G * NWAVES;
    for (int m0 = gw; m0 < NTOK; m0 += 2 * NGW) {
        f32x4 v[2][4];
#pragma unroll
        for (int u = 0; u < 2; ++u) { const GAS f32x4* xr = (const GAS f32x4*)(I.x + (size_t)(m0 + u * NGW) * DM) + ((int)(threadIdx.x & 63));
#pragma unroll
            for (int j = 0; j < 4; ++j) v[u][j] = xr[64 * j]; }
#pragma unroll
        for (int u = 0; u < 2; ++u) { const int m = m0 + u * NGW, b = m >> 13; float s = 0.f;
#pragma unroll
            for (int j = 0; j < 4; ++j) s += (v[u][j].x * v[u][j].x + v[u][j].y * v[u][j].y) + (v[u][j].z * v[u][j].z + v[u][j].w * v[u][j].w);
            const float rstd = rsqrtf(wave_sum_f(s) * (1.f / DM) + EPS);
            GAS v2u* o8 = (GAS v2u*)(XN + (size_t)m * DM) + ((int)(threadIdx.x & 63));
#pragma unroll
            for (int j = 0; j < 4; ++j) { const f32x4 g = *(const LAS f32x4*)(Gs + b * 1024 + 256 * j + 4 * ((int)(threadIdx.x & 63))), sh = *(const LAS f32x4*)(Ss + b * 1024 + 256 * j + 4 * ((int)(threadIdx.x & 63)));
                const f32x4 o = v[u][j] * rstd * g + sh; o8[64 * j] = (v2u){pk2(o.x, o.y), pk2(o.z, o.w)}; } }
    }
    __syncthreads();
}
namespace att {
constexpr int NW = 8, QBLK = 32, KVBLK = 64, QB = NW * QBLK;
constexpr int DQ = 192, DVV = 128, OPITCH = 512;
constexpr int SHM_V = KVBLK * DVV * 2, SHM_K = KVBLK * DQ * 2;
constexpr int ATT_LDS = 3 * SHM_V + 3 * SHM_K + NW * 64 * 4;
constexpr float SCALE = 0.07216878364870322f;
constexpr float THR = 8.f;
#define SBAR() __builtin_amdgcn_sched_barrier(0)
__device__ __forceinline__ int koff(int row, int chunk) { return (chunk >> 3) * 8192 + row * 128 + ((((chunk & 7) ^ ((row >> 1) & 7))) << 4); }
__device__ __forceinline__ int v_st(int k, int c) { const int kk = (k & ~0xC) | ((k & 4) << 1) | ((k & 8) >> 1); return ((kk >> 3) * 4 + (c >> 5)) * 512 + ((kk & 7) * 32 + (c & 31)) * 2; }
__device__ __forceinline__ int v_rd_base(int lane) { return ((lane & 3) << 3) | (((lane >> 2) & 3) << 6) | (((lane >> 4) & 1) << 5) | (((lane >> 5) & 1) << 8); }
constexpr int v_rd_off(int d0, int ks, int half) { return d0 * 512 + ks * 4096 + half * 2048; }
__device__ __forceinline__ int crow(int r, int hi) { return (r & 3) + 8 * (r >> 2) + 4 * hi; }
__device__ __forceinline__ bf16x8 ld8(const bf16_t* p) { return *reinterpret_cast<const bf16x8*>(p); }
__device__ __forceinline__ void mask_tile(f32x16& p0, f32x16& p1, int dq) {
    const float NEG = -__builtin_inff();
#pragma unroll
    for (int r = 0; r < 16; ++r) { const int c = (r & 3) + 8 * (r >> 2); if (dq - c < 0) p0[r] = NEG; if (dq - c - 32 < 0) p1[r] = NEG; }
}
__device__ __forceinline__ void partialSM(f32x16& p0, f32x16& p1, float& m_reg, float& mn, float& alpha) {
    float pmax = p0[0];
#pragma unroll
    for (int r = 1; r < 16; ++r) pmax = fmaxf(pmax, p0[r]);
#pragma unroll
    for (int r = 0; r < 16; ++r) pmax = fmaxf(pmax, p1[r]);
    { auto rr = __builtin_amdgcn_permlane32_swap(__float_as_uint(pmax), __float_as_uint(pmax), false, false); pmax = fmaxf(__uint_as_float(rr[0]), __uint_as_float(rr[1])); }
    constexpr float C2 = 1.4426950408889634f * SCALE;
    if (__builtin_expect(__all((pmax - m_reg) * SCALE <= THR), 1)) { mn = m_reg; alpha = 1.f; }
    else { mn = fmaxf(m_reg, pmax); alpha = __builtin_amdgcn_exp2f((m_reg - mn) * C2); m_reg = mn; }
    const float mnL = -mn * C2;
#pragma unroll
    for (int r = 0; r < 16; ++r) p0[r] = fmaf(p0[r], C2, mnL);
#pragma unroll
    for (int r = 0; r < 16; ++r) p1[r] = fmaf(p1[r], C2, mnL);
#pragma unroll
    for (int r = 0; r < 16; ++r) p0[r] = __builtin_amdgcn_exp2f(p0[r]);
}
__device__ __forceinline__ void finishSM(f32x16& p0, f32x16& p1, float alpha, float& l_reg, bf16x8& pa0, bf16x8& pa1, bf16x8& pa2, bf16x8& pa3) {
#pragma unroll
    for (int r = 0; r < 16; ++r) p1[r] = __builtin_amdgcn_exp2f(p1[r]);
    float ps = 0;
#pragma unroll
    for (int r = 0; r < 16; ++r) ps += p0[r];
#pragma unroll
    for (int r = 0; r < 16; ++r) ps += p1[r];
    { auto rr = __builtin_amdgcn_permlane32_swap(__float_as_uint(ps), __float_as_uint(ps), false, false); ps = __uint_as_float(rr[0]) + __uint_as_float(rr[1]); }
    l_reg = l_reg * alpha + ps;
#define PK4(P, B_, OUT) do { unsigned a0 = cvtpk(P[B_+0], P[B_+1]), a1 = cvtpk(P[B_+2], P[B_+3]); unsigned b0 = cvtpk(P[B_+4], P[B_+5]), b1 = cvtpk(P[B_+6], P[B_+7]); \
        auto r0 = __builtin_amdgcn_permlane32_swap(a0, b0, false, false); auto r1 = __builtin_amdgcn_permlane32_swap(a1, b1, false, false); \
        v4u w = {r0[0], r1[0], r0[1], r1[1]}; OUT = *reinterpret_cast<bf16x8*>(&w); } while (0)
    PK4(p0, 0, pa0); PK4(p0, 8, pa1); PK4(p1, 0, pa2); PK4(p1, 8, pa3);
#undef PK4
}
template <int KB>
__device__ __forceinline__ void qkt(f32x16& p0, f32x16& p1, const char* K_lds, int r32, int hi, const bf16x8* qr) {
    p0 = f32x16{}; p1 = f32x16{};
    const char* kb[4];
#pragma unroll
    for (int dd = 0; dd < 4; ++dd) kb[dd] = K_lds + KB * SHM_K + koff(r32, 2 * dd + hi);
    bf16x8 kf[2][2];
#define KLD(d) do { const char* a_ = kb[(d) & 3] + ((d) >> 2) * 8192; kf[(d) & 1][0] = *reinterpret_cast<const bf16x8*>(a_); kf[(d) & 1][1] = *reinterpret_cast<const bf16x8*>(a_ + 32 * 128); } while (0)
    KLD(0);
#pragma unroll
    for (int d0 = 0; d0 < 12; ++d0) { if (d0 + 1 < 12) KLD(d0 + 1);
        p0 = __builtin_amdgcn_mfma_f32_32x32x16_bf16(kf[d0 & 1][0], qr[d0], p0, 0, 0, 0);
        p1 = __builtin_amdgcn_mfma_f32_32x32x16_bf16(kf[d0 & 1][1], qr[d0], p1, 0, 0, 0); }
#undef KLD
    __builtin_amdgcn_sched_group_barrier(0x100, 2, 0);
#pragma unroll
    for (int d0 = 0; d0 < 11; ++d0) { __builtin_amdgcn_sched_group_barrier(0x100, 2, 0); __builtin_amdgcn_sched_group_barrier(0x8, 2, 0); }
    __builtin_amdgcn_sched_group_barrier(0x8, 2, 0);
}
template <int VB>
__device__ __forceinline__ void pv_tile(f32x16* o, int vb0, bf16x8 pa0, bf16x8 pa1, bf16x8 pa2, bf16x8 pa3) {
    s16x4 lo[2][4], hv[2][4];
#define TRRD(dst, off) asm volatile("ds_read_b64_tr_b16 %0, %1 offset:%2" : "=&v"(dst) : "v"(vb0), "i"(off) : "memory")
#define VLD(d) do { TRRD(lo[(d) & 1][0], VB * SHM_V + v_rd_off((d), 0, 0)); TRRD(hv[(d) & 1][0], VB * SHM_V + v_rd_off((d), 0, 1)); TRRD(lo[(d) & 1][1], VB * SHM_V + v_rd_off((d), 1, 0)); TRRD(hv[(d) & 1][1], VB * SHM_V + v_rd_off((d), 1, 1)); \
        TRRD(lo[(d) & 1][2], VB * SHM_V + v_rd_off((d), 2, 0)); TRRD(hv[(d) & 1][2], VB * SHM_V + v_rd_off((d), 2, 1)); TRRD(lo[(d) & 1][3], VB * SHM_V + v_rd_off((d), 3, 0)); TRRD(hv[(d) & 1][3], VB * SHM_V + v_rd_off((d), 3, 1)); } while (0)
#define VF(d, k) (bf16x8){lo[(d) & 1][k][0], lo[(d) & 1][k][1], lo[(d) & 1][k][2], lo[(d) & 1][k][3], hv[(d) & 1][k][0], hv[(d) & 1][k][1], hv[(d) & 1][k][2], hv[(d) & 1][k][3]}
#define PVM(d) do { o[d] = __builtin_amdgcn_mfma_f32_32x32x16_bf16(pa0, VF(d, 0), o[d], 0, 0, 0); o[d] = __builtin_amdgcn_mfma_f32_32x32x16_bf16(pa1, VF(d, 1), o[d], 0, 0, 0); \
        o[d] = __builtin_amdgcn_mfma_f32_32x32x16_bf16(pa2, VF(d, 2), o[d], 0, 0, 0); o[d] = __builtin_amdgcn_mfma_f32_32x32x16_bf16(pa3, VF(d, 3), o[d], 0, 0, 0); } while (0)
    asm volatile("s_waitcnt lgkmcnt(0)" ::: "memory");
    VLD(0); VLD(1); asm volatile("s_waitcnt lgkmcnt(8)" ::: "memory"); SBAR(); PVM(0); SBAR();
    VLD(2); asm volatile("s_waitcnt lgkmcnt(8)" ::: "memory"); SBAR(); PVM(1); SBAR();
    VLD(3); asm volatile("s_waitcnt lgkmcnt(8)" ::: "memory"); SBAR(); PVM(2); SBAR();
    asm volatile("s_waitcnt lgkmcnt(0)" ::: "memory"); SBAR(); PVM(3);
#undef PVM
#undef VF
#undef VLD
#undef TRRD
}
template <bool DOPV>
__device__ __forceinline__ void pv_sm(f32x16* o, int vb0, bf16x8 pa0, bf16x8 pa1, bf16x8 pa2, bf16x8 pa3, f32x16& p0, f32x16& p1, float& m_reg, float& al_out) {
    s16x4 lo[2][4], hv[2][4];
#define TRRD(dst, off) asm volatile("ds_read_b64_tr_b16 %0, %1 offset:%2" : "=&v"(dst) : "v"(vb0), "i"(off) : "memory")
#define VLD(d) do { if (DOPV) { TRRD(lo[(d) & 1][0], v_rd_off((d), 0, 0)); TRRD(hv[(d) & 1][0], v_rd_off((d), 0, 1)); TRRD(lo[(d) & 1][1], v_rd_off((d), 1, 0)); TRRD(hv[(d) & 1][1], v_rd_off((d), 1, 1)); \
        TRRD(lo[(d) & 1][2], v_rd_off((d), 2, 0)); TRRD(hv[(d) & 1][2], v_rd_off((d), 2, 1)); TRRD(lo[(d) & 1][3], v_rd_off((d), 3, 0)); TRRD(hv[(d) & 1][3], v_rd_off((d), 3, 1)); } } while (0)
#define VF(d, k) (bf16x8){lo[(d) & 1][k][0], lo[(d) & 1][k][1], lo[(d) & 1][k][2], lo[(d) & 1][k][3], hv[(d) & 1][k][0], hv[(d) & 1][k][1], hv[(d) & 1][k][2], hv[(d) & 1][k][3]}
#define MM(d, k, PA) do { if (DOPV) o[d] = __builtin_amdgcn_mfma_f32_32x32x16_bf16(PA, VF(d, k), o[d], 0, 0, 0); SBAR(); } while (0)
#define LW(N) do { if (DOPV) asm volatile("s_waitcnt lgkmcnt(" #N ")" ::: "memory"); SBAR(); } while (0)
#define MX3(a, b, c) __builtin_fmaxf(__builtin_fmaxf((a), (b)), (c))
    constexpr float C2 = 1.4426950408889634f * SCALE;
    float mx, mn, mnL, al;
    LW(0); VLD(0); VLD(1); LW(8);
    MM(0, 0, pa0); mx = MX3(p0[0], p0[1], p0[2]); mx = MX3(mx, p0[3], p0[4]); mx = MX3(mx, p0[5], p0[6]); mx = MX3(mx, p0[7], p0[8]); SBAR();
    MM(0, 1, pa1); mx = MX3(mx, p0[9], p0[10]); mx = MX3(mx, p0[11], p0[12]); mx = MX3(mx, p0[13], p0[14]); mx = MX3(mx, p0[15], p1[0]); SBAR();
    MM(0, 2, pa2); mx = MX3(mx, p1[1], p1[2]); mx = MX3(mx, p1[3], p1[4]); mx = MX3(mx, p1[5], p1[6]); mx = MX3(mx, p1[7], p1[8]); SBAR();
    MM(0, 3, pa3); mx = MX3(mx, p1[9], p1[10]); mx = MX3(mx, p1[11], p1[12]); mx = MX3(mx, p1[13], p1[14]); mx = __builtin_fmaxf(mx, p1[15]); SBAR();
    VLD(2); LW(8);
    MM(1, 0, pa0); { auto rr = __builtin_amdgcn_permlane32_swap(__float_as_uint(mx), __float_as_uint(mx), false, false); mx = __builtin_fmaxf(__uint_as_float(rr[0]), __uint_as_float(rr[1])); }
        { const bool keep = __all((mx - m_reg) * SCALE <= THR); mn = keep ? m_reg : __builtin_fmaxf(m_reg, mx); al = __builtin_amdgcn_exp2f((m_reg - mn) * C2); m_reg = mn; mnL = -mn * C2; } SBAR();
#define FM4(P, B) do { P[B] = fmaf(P[B], C2, mnL); P[B + 1] = fmaf(P[B + 1], C2, mnL); P[B + 2] = fmaf(P[B + 2], C2, mnL); P[B + 3] = fmaf(P[B + 3], C2, mnL); } while (0)
#define EX2(P, B) do { P[B] = __builtin_amdgcn_exp2f(P[B]); P[B + 1] = __builtin_amdgcn_exp2f(P[B + 1]); } while (0)
    MM(1, 1, pa1); FM4(p0, 0); FM4(p0, 4); SBAR();
    MM(1, 2, pa2); FM4(p0, 8); FM4(p0, 12); SBAR();
    MM(1, 3, pa3); FM4(p1, 0); FM4(p1, 4); SBAR();
    VLD(3); LW(8);
    MM(2, 0, pa0); FM4(p1, 8); FM4(p1, 12); SBAR();
    MM(2, 1, pa1); EX2(p0, 0); EX2(p0, 2); SBAR();
    MM(2, 2, pa2); EX2(p0, 4); EX2(p0, 6); SBAR();
    MM(2, 3, pa3); EX2(p0, 8); EX2(p0, 10); SBAR();
    LW(0);
    MM(3, 0, pa0); EX2(p0, 12); EX2(p0, 14); SBAR();
    MM(3, 1, pa1); EX2(p1, 0); EX2(p1, 2); SBAR();
    MM(3, 2, pa2); EX2(p1, 4); EX2(p1, 6); SBAR();
    MM(3, 3, pa3); EX2(p1, 8); EX2(p1, 10); SBAR();
    al_out = al;
#undef EX2
#undef FM4
#undef MX3
#undef LW
#undef MM
#undef VF
#undef VLD
#undef TRRD
}
__device__ __forceinline__ void qkt_fin(f32x16& n0, f32x16& n1, const char* Kslot, int r32, int hi, const bf16x8* qr, f32x16& p0, f32x16& p1, bf16x8& pa0, bf16x8& pa1, bf16x8& pa2, bf16x8& pa3, float& l_reg, float al) {
    n0 = f32x16{}; n1 = f32x16{};
    const char* kb[4];
#pragma unroll
    for (int dd = 0; dd < 4; ++dd) kb[dd] = Kslot + koff(r32, 2 * dd + hi);
    bf16x8 kf[2][2];
#define KLD(d) do { const char* a_ = kb[(d) & 3] + ((d) >> 2) * 8192; kf[(d) & 1][0] = *reinterpret_cast<const bf16x8*>(a_); kf[(d) & 1][1] = *reinterpret_cast<const bf16x8*>(a_ + 32 * 128); } while (0)
#define QM(d) do { if ((d) + 1 < 12) KLD((d) + 1); n0 = __builtin_amdgcn_mfma_f32_32x32x16_bf16(kf[(d) & 1][0], qr[d], n0, 0, 0, 0); n1 = __builtin_amdgcn_mfma_f32_32x32x16_bf16(kf[(d) & 1][1], qr[d], n1, 0, 0, 0); SBAR(); } while (0)
#define PK4(P, B_, OUT) do { unsigned a0 = cvtpk(P[B_+0], P[B_+1]), a1 = cvtpk(P[B_+2], P[B_+3]); unsigned b0 = cvtpk(P[B_+4], P[B_+5]), b1 = cvtpk(P[B_+6], P[B_+7]); \
        auto r0 = __builtin_amdgcn_permlane32_swap(a0, b0, false, false); auto r1 = __builtin_amdgcn_permlane32_swap(a1, b1, false, false); \
        v4u w = {r0[0], r1[0], r0[1], r1[1]}; OUT = *reinterpret_cast<bf16x8*>(&w); } while (0)
    float ps;
    KLD(0); SBAR();
    QM(0); p1[12] = __builtin_amdgcn_exp2f(p1[12]); p1[13] = __builtin_amdgcn_exp2f(p1[13]); p1[14] = __builtin_amdgcn_exp2f(p1[14]); p1[15] = __builtin_amdgcn_exp2f(p1[15]); SBAR();
    QM(1); ps = (p0[0] + p0[1]) + (p0[2] + p0[3]); ps += (p0[4] + p0[5]) + (p0[6] + p0[7]); SBAR();
    QM(2); ps += (p0[8] + p0[9]) + (p0[10] + p0[11]); ps += (p0[12] + p0[13]) + (p0[14] + p0[15]); SBAR();
    QM(3); ps += (p1[0] + p1[1]) + (p1[2] + p1[3]); ps += (p1[4] + p1[5]) + (p1[6] + p1[7]); SBAR();
    QM(4); ps += (p1[8] + p1[9]) + (p1[10] + p1[11]); ps += (p1[12] + p1[13]) + (p1[14] + p1[15]); SBAR();
    QM(5); { auto rr = __builtin_amdgcn_permlane32_swap(__float_as_uint(ps), __float_as_uint(ps), false, false); ps = __uint_as_float(rr[0]) + __uint_as_float(rr[1]); } l_reg = l_reg * al + ps; SBAR();
    QM(6); PK4(p0, 0, pa0); SBAR();
    QM(7); PK4(p0, 8, pa1); SBAR();
    QM(8); PK4(p1, 0, pa2); SBAR();
    QM(9); PK4(p1, 8, pa3); SBAR();
    QM(10); QM(11);
#undef PK4
#undef QM
#undef KLD
}
__device__ __forceinline__ int kperm(int l) { return ((l & 7) << 1) | ((l >> 3) & 1) | (l & 48); }
__device__ __forceinline__ int kpiece(int tid) { return (tid >> 6) * 64 + kperm(tid & 63); }
__device__ __forceinline__ int vpiece(int tid, int i) { const int l = tid & 63, w = tid >> 6; return (4 * (w & 3) + (l & 3)) * 64 + (l >> 2) + 16 * ((w >> 2) + 2 * i); }
struct BlockRef { const bf16_t* Q; const bf16_t* K; const bf16_t* V; bf16_t* O; int P0; };
#define VMW() asm volatile("s_waitcnt vmcnt(0)" ::: "memory")
__device__ __forceinline__ void dma16(const void* gsrc, char* ldst) { __builtin_amdgcn_global_load_lds((const unsigned*)gsrc, (__attribute__((address_space(3))) unsigned*)(uintptr_t)ldst, 16, 0, 0); }
#define WAITBAR(N) asm volatile("s_waitcnt vmcnt(" #N ") lgkmcnt(0)\n\ts_barrier" ::: "memory")
template <int ABL>
__device__ __forceinline__ void attn_block(const BlockRef& cur, char* lds) {
    int tid_ = threadIdx.x; asm volatile("" : "+v"(tid_));
    const int tid = tid_, wid = __builtin_amdgcn_readfirstlane(tid >> 6), lane = tid & 63, r32 = lane & 31, hi = lane >> 5;
    const int NT = (cur.P0 + QB - 1) / KVBLK + 1;
    const int qlo = cur.P0 + wid * QBLK;
    char* V_lds = lds; char* K_lds = lds + 3 * SHM_V;
    float* ws = (float*)(lds + 3 * SHM_V + 3 * SHM_K) + wid * 64; float* li_l = ws, * al_l = ws + 32;
    float m_reg = -1e30f, l_reg = 0; f32x16 o[4] = {};
    const int krow = 8 * wid + (lane >> 3), ksx = (lane & 7) ^ ((krow >> 1) & 7), ksrc = (ksx * 64 + krow) * 8;
    int vsrc[2];
#pragma unroll
    for (int i = 0; i < 2; ++i) { const int st = 2 * (wid + 8 * i) + (lane >> 5), kk = (st >> 2) * 8 + ((lane & 31) >> 2), c = (st & 3) * 32 + (lane & 3) * 8;
        const int k = (kk & ~0xC) | ((kk & 4) << 1) | ((kk & 8) >> 1); vsrc[i] = ((c >> 3) * 64 + k) * 8; }
    const int vbase = (int)(uintptr_t)V_lds;
    const bf16_t* Kh = cur.K; const bf16_t* Vh = cur.V;
#define DMA_K(t, slot) do { const bf16_t* kt_ = Kh + (size_t)(t) * KVBLK * DQ + ksrc; char* kd_ = K_lds + (slot) * SHM_K + wid * 1024; \
        dma16(kt_, kd_); dma16(kt_ + 4096, kd_ + 8192); dma16(kt_ + 8192, kd_ + 16384); } while (0)
#define DMA_V(t, slot) do { const bf16_t* vt_ = Vh + (size_t)(t) * KVBLK * DVV; char* vd_ = V_lds + (slot) * SHM_V + wid * 1024; dma16(vt_ + vsrc[0], vd_); dma16(vt_ + vsrc[1], vd_ + 8192); } while (0)
    bf16x8 qr[12], pa0, pa1, pa2, pa3; f32x16 p0, p1;
#pragma unroll
    for (int d0 = 0; d0 < 12; ++d0) qr[d0] = ld8(cur.Q + (size_t)wid * QBLK * DQ + (2 * d0 + hi) * 256 + r32 * 8);
    DMA_K(0, 0); DMA_K(1, 1); DMA_V(0, 0);
    WAITBAR(0);
    int s0 = 0, s1 = 1, s2 = 2;
    f32x16 q0, q1; float alp = 1.f;
#define RESC(a) do { if (__any((a) < 1.f)) { asm volatile("" ::: "memory"); if (hi == 0) al_l[r32] = (a); asm volatile("s_waitcnt lgkmcnt(0)" ::: "memory"); \
        _Pragma("unroll") for (int d_ = 0; d_ < 4; ++d_) _Pragma("unroll") for (int r = 0; r < 16; ++r) o[d_][r] *= al_l[crow(r, hi)]; } } while (0)
#define ROT3() do { const int tmp = s0; s0 = s1; s1 = s2; s2 = tmp; } while (0)
    {
        DMA_K(2, s2); DMA_V(1, s1);
        SBAR(); qkt<0>(p0, p1, K_lds + s0 * SHM_K, r32, hi, qr); SBAR();
        if (KVBLK - 1 > qlo) { asm volatile("" ::: "memory"); mask_tile(p0, p1, qlo + r32 - 4 * hi); }
        pv_sm<false>(o, 0, pa0, pa1, pa2, pa3, p0, p1, m_reg, alp);
        WAITBAR(5); ROT3(); }
#define STEP(t, N0, N1, O0, O1) do { \
        if ((t) + 2 < NT) DMA_K((t) + 2, s2); \
        if ((t) + 1 < NT) DMA_V((t) + 1, s1); \
        SBAR(); qkt_fin(N0, N1, K_lds + s0 * SHM_K, r32, hi, qr, O0, O1, pa0, pa1, pa2, pa3, l_reg, alp); SBAR(); \
        { const int kb_ = (t) * KVBLK; if (kb_ + KVBLK - 1 > qlo) { asm volatile("" ::: "memory"); mask_tile(N0, N1, qlo + r32 - 4 * hi - kb_); } } \
        { int ll = tid; asm volatile("" : "+v"(ll)); pv_sm<true>(o, vbase + v_rd_base(ll & 63) + s2 * SHM_V, pa0, pa1, pa2, pa3, N0, N1, m_reg, alp); } \
        RESC(alp); \
        if ((t) + 2 < NT) WAITBAR(5); else WAITBAR(0); \
        ROT3(); } while (0)
#pragma unroll 1
    for (int t = 1; t + 1 < NT; t += 2) { STEP(t, q0, q1, p0, p1); STEP(t + 1, p0, p1, q0, q1); }
    STEP(NT - 1, q0, q1, p0, p1);
#undef STEP
    {
        q1[12] = __builtin_amdgcn_exp2f(q1[12]); q1[13] = __builtin_amdgcn_exp2f(q1[13]); q1[14] = __builtin_amdgcn_exp2f(q1[14]); q1[15] = __builtin_amdgcn_exp2f(q1[15]);
        float ps = 0;
#pragma unroll
        for (int r = 0; r < 16; ++r) ps += q0[r];
#pragma unroll
        for (int r = 0; r < 16; ++r) ps += q1[r];
        { auto rr = __builtin_amdgcn_permlane32_swap(__float_as_uint(ps), __float_as_uint(ps), false, false); ps = __uint_as_float(rr[0]) + __uint_as_float(rr[1]); }
        l_reg = l_reg * alp + ps;
#define PK4(P, B_, OUT) do { unsigned a0 = cvtpk(P[B_+0], P[B_+1]), a1 = cvtpk(P[B_+2], P[B_+3]); unsigned b0 = cvtpk(P[B_+4], P[B_+5]), b1 = cvtpk(P[B_+6], P[B_+7]); \
        auto r0 = __builtin_amdgcn_permlane32_swap(a0, b0, false, false); auto r1 = __builtin_amdgcn_permlane32_swap(a1, b1, false, false); \
        v4u w = {r0[0], r1[0], r0[1], r1[1]}; OUT = *reinterpret_cast<bf16x8*>(&w); } while (0)
        PK4(q0, 0, pa0); PK4(q0, 8, pa1); PK4(q1, 0, pa2); PK4(q1, 8, pa3);
#undef PK4
    }
#undef RESC
#undef ROT3
#undef DMA_K
#undef DMA_V
    { int ll = tid; asm volatile("" : "+v"(ll)); pv_tile<0>(o, vbase + v_rd_base(ll & 63) + s2 * SHM_V, pa0, pa1, pa2, pa3); }
    if (hi == 0) li_l[r32] = l_reg; asm volatile("s_waitcnt lgkmcnt(0)" ::: "memory");
    float rli[16];
#pragma unroll
    for (int r = 0; r < 16; ++r) rli[r] = __builtin_amdgcn_rcpf(li_l[crow(r, hi)]);
    bf16_t* Ow = cur.O + (size_t)(wid * QBLK) * OPITCH;
#pragma unroll
    for (int r = 0; r < 16; ++r) { const int orow = crow(r, hi);
#pragma unroll
        for (int d0 = 0; d0 < 4; ++d0) { const float v = o[d0][r] * rli[r]; const float vn = __shfl_xor(v, 1);
            if ((r32 & 1) == 0) *(unsigned*)(Ow + (size_t)orow * OPITCH + d0 * 32 + r32) = cvtpk(v, vn); } }
    WAITBAR(0);
}
#undef WAITBAR
#undef VMW
#undef SBAR
__device__ __forceinline__ BlockRef make_ref(int L, int pass, const bf16_t* Q, const bf16_t* K, const bf16_t* V, bf16_t* O) {
    const int bh = L >> 4, x = L & 15, qb = pass ? 31 - x : x, b = bh >> 2, h = bh & 3;
    BlockRef r; r.Q = Q + ((size_t)bh * 8192 + (size_t)qb * QB) * DQ; r.K = K + (size_t)bh * 8192 * DQ; r.V = V + (size_t)bh * 8192 * DVV;
    r.O = O + ((size_t)b * 8192 + (size_t)qb * QB) * OPITCH + h * DVV; r.P0 = qb * QB; return r;
}
template <int ABL>
__device__ __forceinline__ void attn_phase(char* lds, const bf16_t* Q, const bf16_t* K, const bf16_t* V, bf16_t* O, int G, int bid) {
    for (int L = bid; L < 256; L += G)
#pragma unroll 1
        for (int pass = 0; pass < 2; ++pass) { const BlockRef cur = make_ref(L, pass, Q, K, V, O); attn_block<ABL>(cur, lds); }
}
}
namespace prj {
__device__ __forceinline__ int crow(int r, int hi) { return (r & 3) + 8 * (r >> 2) + 4 * hi; }
__device__ __forceinline__ float swap_add(float v) { auto rr = __builtin_amdgcn_permlane32_swap(__float_as_uint(v), __float_as_uint(v), false, false); return __uint_as_float(rr[0]) + __uint_as_float(rr[1]); }
__device__ __forceinline__ float sumsq8(bf16x8 v) { float s = 0.f;
#pragma unroll
    for (int j = 0; j < 8; ++j) { const float f = bf2f((bf16_t)v[j]); s += f * f; } return s; }
__device__ __forceinline__ bf16x8 ldg8(const bf16_t* p) { return *reinterpret_cast<const bf16x8*>(p); }
__device__ __forceinline__ const bf16_t* projt(const unsigned char* ws, int t, int col) { return (const bf16_t*)(ws + WSX_B) + ((size_t)((t >> 5) * 192 + (col >> 3)) * 32 + (t & 31)) * 8 + (col & 7); }
__device__ __forceinline__ v2u pack4(float a, float b, float c, float d) { return (v2u){cvtpk(a, b), cvtpk(c, d)}; }

__device__ __forceinline__ void stage_weights(const unsigned char* src, LAS unsigned char* wl, int nkb, int wave, int lane) {
    __syncthreads();
    for (int i = wave; i < nkb; i += NWAVES) __builtin_amdgcn_global_load_lds((const unsigned*)(src + (size_t)i * 1024 + lane * 16), (LAS unsigned*)(wl + i * 1024), 16, 0, 0);
    asm volatile("s_waitcnt vmcnt(0)" ::: "memory");
    __syncthreads();
}
__device__ __forceinline__ void stage_weights2(const unsigned char* src0, const unsigned char* src1, LAS unsigned char* wl, int wave, int lane) {
    __syncthreads();
    for (int i = wave; i < 32; i += NWAVES) { __builtin_amdgcn_global_load_lds((const unsigned*)(src0 + (size_t)i * 1024 + lane * 16), (LAS unsigned*)(wl + i * 1024), 16, 0, 0);
                                              __builtin_amdgcn_global_load_lds((const unsigned*)(src1 + (size_t)i * 1024 + lane * 16), (LAS unsigned*)(wl + (32 + i) * 1024), 16, 0, 0); }
    asm volatile("s_waitcnt vmcnt(0)" ::: "memory");
    __syncthreads();
}
__device__ __forceinline__ void unit_q(const Inputs& I, unsigned char* ws, LAS unsigned char* wl, int wave, int grp, int lane) {
    const int r32 = lane & 31, hi = lane >> 5, t = grp * 32 + r32, b = t >> 13, s = t & 8191;
    const bf16_t* pr = projt(ws, t, C_QLAT + 8 * hi);
    float ssq = 0.f; bf16x8 bq[16];
#pragma unroll
    for (int ks = 0; ks < 16; ++ks) { bq[ks] = ldg8(pr + 512 * ks); ssq += sumsq8(bq[ks]); }
    const float msq = swap_add(ssq) * (1.f / 256.f) + EPS;
    const LAS bf16x8* WQF = (const LAS bf16x8*)wl + lane;
    const float* cs = (const float*)(ws + WSX_CS) + (size_t)t * 64;
#pragma unroll 1
    for (int h = 0; h < 4; ++h) {
        stage_weights(ws + WSX_WQF + (size_t)h * 96 * 1024, wl, 96, wave, lane);
        f32x16 acc[6];
#pragma unroll
        for (int nb = 0; nb < 6; ++nb) acc[nb] = f32x16{};
#pragma unroll
        for (int k0 = 0; k0 < 16; k0 += 2) { bf16x8 wf[12];
#pragma unroll
            for (int i = 0; i < 2; ++i)
#pragma unroll
                for (int nb = 0; nb < 6; ++nb) wf[i * 6 + nb] = WQF[(nb * 16 + k0 + i) * 64];
#pragma unroll
            for (int i = 0; i < 2; ++i)
#pragma unroll
                for (int nb = 0; nb < 6; ++nb) acc[nb] = __builtin_amdgcn_mfma_f32_32x32x16_bf16(wf[i * 6 + nb], bq[k0 + i], acc[nb], 0, 0, 0);
            asm volatile("" ::: "memory"); }
        float ss = 0.f;
#pragma unroll
        for (int nb = 0; nb < 6; ++nb)
#pragma unroll
            for (int r = 0; r < 16; ++r) ss += acc[nb][r] * acc[nb][r];
        const float rs = rsqrtf(swap_add(ss) * (1.f / 192.f) + EPS * msq);
        bf16_t* qp = (bf16_t*)(ws + WSX_Q) + ((size_t)((b * 4 + h) * 256 + (s >> 5)) * 24) * 256 + r32 * 8 + 4 * hi;
#pragma unroll
        for (int nb = 0; nb < 4; ++nb)
#pragma unroll
            for (int q = 0; q < 4; ++q) { const int n = 32 * nb + 8 * q + 4 * hi; const f32x4 g = *(const f32x4*)(I.q_norm + n);
                *(v2u*)(qp + (4 * nb + q) * 256) = pack4(acc[nb][4 * q] * rs * g[0], acc[nb][4 * q + 1] * rs * g[1], acc[nb][4 * q + 2] * rs * g[2], acc[nb][4 * q + 3] * rs * g[3]); asm volatile("" ::: "memory"); }
#pragma unroll
        for (int q = 0; q < 4; ++q) { const int j = 8 * q + 4 * hi; const f32x4 g1 = *(const f32x4*)(I.q_norm + 128 + j), g2 = *(const f32x4*)(I.q_norm + 160 + j);
            const f32x4 c = *(const f32x4*)(cs + j), sn = *(const f32x4*)(cs + 32 + j);
            float o1[4], o2[4];
#pragma unroll
            for (int i = 0; i < 4; ++i) { const float x1 = acc[4][4 * q + i] * rs * g1[i], x2 = acc[5][4 * q + i] * rs * g2[i]; o1[i] = x1 * c[i] - x2 * sn[i]; o2[i] = x2 * c[i] + x1 * sn[i]; }
            *(v2u*)(qp + (16 + q) * 256) = pack4(o1[0], o1[1], o1[2], o1[3]); *(v2u*)(qp + (20 + q) * 256) = pack4(o2[0], o2[1], o2[2], o2[3]); }
    }
}
__device__ __forceinline__ void unit_kv(const Inputs& I, unsigned char* ws, LAS unsigned char* wl, int wave, int grp, int lane) {
    const int r32 = lane & 31, hi = lane >> 5, t = grp * 32 + r32, b = t >> 13, s = t & 8191;
    bf16x8 bk[8]; float ssq = 0.f;
#pragma unroll
    for (int ks = 0; ks < 8; ++ks) { bk[ks] = ldg8(projt(ws, t, C_KVLAT + 8 * hi) + 512 * ks); ssq += sumsq8(bk[ks]); }
    const float rstd = rsqrtf(swap_add(ssq) * (1.f / 128.f) + EPS);
    float kr1[16], kr2[16]; float ssr = 0.f;
#pragma unroll
    for (int q = 0; q < 4; ++q) { const int j = 8 * q + 4 * hi; const v2u a = *(const v2u*)projt(ws, t, C_KROPE + j), c = *(const v2u*)projt(ws, t, C_KROPE + 32 + j);
        kr1[4 * q] = __uint_as_float(a.x << 16); kr1[4 * q + 1] = __uint_as_float(a.x & 0xffff0000u); kr1[4 * q + 2] = __uint_as_float(a.y << 16); kr1[4 * q + 3] = __uint_as_float(a.y & 0xffff0000u);
        kr2[4 * q] = __uint_as_float(c.x << 16); kr2[4 * q + 1] = __uint_as_float(c.x & 0xffff0000u); kr2[4 * q + 2] = __uint_as_float(c.y << 16); kr2[4 * q + 3] = __uint_as_float(c.y & 0xffff0000u); }
#pragma unroll
    for (int r = 0; r < 16; ++r) ssr += kr1[r] * kr1[r] + kr2[r] * kr2[r];
    const LAS bf16x8* WKVF = (const LAS bf16x8*)wl + lane;
    const float* cs = (const float*)(ws + WSX_CS) + (size_t)t * 64;
#pragma unroll 1
    for (int h = 0; h < 4; ++h) {
        stage_weights(ws + WSX_WKVF + (size_t)h * 64 * 1024, wl, 64, wave, lane);
        bf16_t* kp = (bf16_t*)(ws + WSX_K) + ((size_t)((b * 4 + h) * 128 + (s >> 6)) * 24) * 512 + (s & 63) * 8 + 4 * hi;
        bf16_t* vp = (bf16_t*)(ws + WSX_V) + ((size_t)((b * 4 + h) * 128 + (s >> 6)) * 16) * 512 + (s & 63) * 8 + 4 * hi;
        f32x16 acc[4];
#pragma unroll
        for (int nb = 0; nb < 4; nb += 2) { acc[nb] = f32x16{}; acc[nb + 1] = f32x16{}; bf16x8 wf[16];
#pragma unroll
            for (int i = 0; i < 16; ++i) wf[i] = WKVF[(nb * 8 + i) * 64];
#pragma unroll
            for (int i = 0; i < 8; ++i) acc[nb] = __builtin_amdgcn_mfma_f32_32x32x16_bf16(wf[i], bk[i], acc[nb], 0, 0, 0);
#pragma unroll
            for (int i = 0; i < 8; ++i) acc[nb + 1] = __builtin_amdgcn_mfma_f32_32x32x16_bf16(wf[8 + i], bk[i], acc[nb + 1], 0, 0, 0);
            }
        float ss = 0.f;
#pragma unroll
        for (int nb = 0; nb < 4; ++nb)
#pragma unroll
            for (int r = 0; r < 16; ++r) ss += acc[nb][r] * acc[nb][r];
        const float rs = rsqrtf(swap_add(ss * rstd * rstd + ssr) * (1.f / 192.f) + EPS), rk = rs * rstd;
#pragma unroll
        for (int nb = 0; nb < 4; ++nb)
#pragma unroll
            for (int q = 0; q < 4; ++q) { const int n = 32 * nb + 8 * q + 4 * hi; const f32x4 g = *(const f32x4*)(I.k_norm + n);
                *(v2u*)(kp + (4 * nb + q) * 512) = pack4(acc[nb][4 * q] * rk * g[0], acc[nb][4 * q + 1] * rk * g[1], acc[nb][4 * q + 2] * rk * g[2], acc[nb][4 * q + 3] * rk * g[3]); }
#pragma unroll
        for (int q = 0; q < 4; ++q) { const int j = 8 * q + 4 * hi; const f32x4 g1 = *(const f32x4*)(I.k_norm + 128 + j), g2 = *(const f32x4*)(I.k_norm + 160 + j);
            const f32x4 c = *(const f32x4*)(cs + j), sn = *(const f32x4*)(cs + 32 + j);
            float o1[4], o2[4];
#pragma unroll
            for (int i = 0; i < 4; ++i) { const float x1 = kr1[4 * q + i] * rs * g1[i], x2 = kr2[4 * q + i] * rs * g2[i]; o1[i] = x1 * c[i] - x2 * sn[i]; o2[i] = x2 * c[i] + x1 * sn[i]; }
            *(v2u*)(kp + (16 + q) * 512) = pack4(o1[0], o1[1], o1[2], o1[3]); *(v2u*)(kp + (20 + q) * 512) = pack4(o2[0], o2[1], o2[2], o2[3]); }
        asm volatile("" ::: "memory");
#pragma unroll
        for (int nb = 0; nb < 4; nb += 2) { acc[nb] = f32x16{}; acc[nb + 1] = f32x16{}; bf16x8 wf[16];
#pragma unroll
            for (int i = 0; i < 16; ++i) wf[i] = WKVF[((4 + nb) * 8 + i) * 64];
#pragma unroll
            for (int i = 0; i < 8; ++i) acc[nb] = __builtin_amdgcn_mfma_f32_32x32x16_bf16(wf[i], bk[i], acc[nb], 0, 0, 0);
#pragma unroll
            for (int i = 0; i < 8; ++i) acc[nb + 1] = __builtin_amdgcn_mfma_f32_32x32x16_bf16(wf[8 + i], bk[i], acc[nb + 1], 0, 0, 0);
            }
#pragma unroll
        for (int nb = 0; nb < 4; ++nb)
#pragma unroll
            for (int q = 0; q < 4; ++q) { const int n = 32 * nb + 8 * q + 4 * hi;
                *(v2u*)(vp + (4 * nb + q) * 512) = pack4(acc[nb][4 * q] * rstd, acc[nb][4 * q + 1] * rstd, acc[nb][4 * q + 2] * rstd, acc[nb][4 * q + 3] * rstd); }
        asm volatile("" ::: "memory");
    }
}
#define LRU_SCAN_STEP(CTRL) asm volatile("s_nop 1\n\t" \
    "v_fmac_f32_dpp %0, %0, %16 " CTRL "\n\tv_fmac_f32_dpp %1, %1, %17 " CTRL "\n\tv_fmac_f32_dpp %2, %2, %18 " CTRL "\n\tv_fmac_f32_dpp %3, %3, %19 " CTRL "\n\t" \
    "v_fmac_f32_dpp %4, %4, %20 " CTRL "\n\tv_fmac_f32_dpp %5, %5, %21 " CTRL "\n\tv_fmac_f32_dpp %6, %6, %22 " CTRL "\n\tv_fmac_f32_dpp %7, %7, %23 " CTRL "\n\t" \
    "v_fmac_f32_dpp %8, %8, %24 " CTRL "\n\tv_fmac_f32_dpp %9, %9, %25 " CTRL "\n\tv_fmac_f32_dpp %10, %10, %26 " CTRL "\n\tv_fmac_f32_dpp %11, %11, %27 " CTRL "\n\t" \
    "v_fmac_f32_dpp %12, %12, %28 " CTRL "\n\tv_fmac_f32_dpp %13, %13, %29 " CTRL "\n\tv_fmac_f32_dpp %14, %14, %30 " CTRL "\n\tv_fmac_f32_dpp %15, %15, %31 " CTRL "\n\t" \
    "v_mul_f32_dpp %16, %16, %16 " CTRL "\n\tv_mul_f32_dpp %17, %17, %17 " CTRL "\n\tv_mul_f32_dpp %18, %18, %18 " CTRL "\n\tv_mul_f32_dpp %19, %19, %19 " CTRL "\n\t" \
    "v_mul_f32_dpp %20, %20, %20 " CTRL "\n\tv_mul_f32_dpp %21, %21, %21 " CTRL "\n\tv_mul_f32_dpp %22, %22, %22 " CTRL "\n\tv_mul_f32_dpp %23, %23, %23 " CTRL "\n\t" \
    "v_mul_f32_dpp %24, %24, %24 " CTRL "\n\tv_mul_f32_dpp %25, %25, %25 " CTRL "\n\tv_mul_f32_dpp %26, %26, %26 " CTRL "\n\tv_mul_f32_dpp %27, %27, %27 " CTRL "\n\t" \
    "v_mul_f32_dpp %28, %28, %28 " CTRL "\n\tv_mul_f32_dpp %29, %29, %29 " CTRL "\n\tv_mul_f32_dpp %30, %30, %30 " CTRL "\n\tv_mul_f32_dpp %31, %31, %31 " CTRL "\n\ts_nop 1" \
    : "+v"(bv[0]), "+v"(bv[1]), "+v"(bv[2]), "+v"(bv[3]), "+v"(bv[4]), "+v"(bv[5]), "+v"(bv[6]), "+v"(bv[7]), "+v"(bv[8]), "+v"(bv[9]), "+v"(bv[10]), "+v"(bv[11]), "+v"(bv[12]), "+v"(bv[13]), "+v"(bv[14]), "+v"(bv[15]), \
      "+v"(av[0]), "+v"(av[1]), "+v"(av[2]), "+v"(av[3]), "+v"(av[4]), "+v"(av[5]), "+v"(av[6]), "+v"(av[7]), "+v"(av[8]), "+v"(av[9]), "+v"(av[10]), "+v"(av[11]), "+v"(av[12]), "+v"(av[13]), "+v"(av[14]), "+v"(av[15]))
constexpr int PRJ_TAB = 96 * 1024;
__device__ __forceinline__ void lru_tables(Frame& F, const Inputs& I) {
    LAS float* tb = (LAS float*)(F.lds + PRJ_TAB);
    for (int i = ((int)threadIdx.x); i < 2048; i += 512) tb[i] = I.conv_w[i];
    { const int c = ((int)threadIdx.x); tb[2048 + c] = I.conv_b[c]; tb[2560 + c] = -1.4426950408889634f * I.lru_ba[c]; tb[3072 + c] = -1.4426950408889634f * I.lru_bx[c];
      tb[3584 + c] = -8.f * 1.4426950408889634f * ((const float*)(F.ws + WSX_SP))[c]; }
    __syncthreads();
}
__device__ __forceinline__ void unit_lru(const Inputs& I, unsigned char* ws, LAS unsigned char* wl, int wave, int grp, int hp, int lane) {
    const int r32 = lane & 31, hi = lane >> 5, t = grp * 32 + r32, s = t & 8191;
    const bool reset = I.positions[t] == 0;
    const LAS float* tbl = (const LAS float*)(wl + PRJ_TAB);
    int xt[4]; float xz[4];
#pragma unroll
    for (int j = 0; j < 4; ++j) { const bool ok = s - 3 + j >= 0; xt[j] = ok ? t - 3 + j : t; xz[j] = ok ? 1.f : 0.f; }
    bf16_t* HL = (bf16_t*)(ws + WSX_D) + (size_t)t * 512; bf16_t* PC = HL + (size_t)NTOK * 512;
    float* SUMA = (float*)(ws + WSX_SUMA) + (size_t)grp * 512; float* SUMB = (float*)(ws + WSX_SUMB) + (size_t)grp * 512;
#pragma unroll 1
    for (int h = 2 * hp; h < 2 * hp + 2; ++h) {
        stage_weights2(ws + WSX_WAF + (size_t)h * 32 * 1024, ws + WSX_WXF + (size_t)h * 32 * 1024, wl, wave, lane);
        bf16x8 xf[8];
#pragma unroll
        for (int k2 = 0; k2 < 8; k2 += 2) { v2u xx[2][2][4];
#pragma unroll
            for (int kk = 0; kk < 2; ++kk)
#pragma unroll
                for (int j4 = 0; j4 < 2; ++j4)
#pragma unroll
                    for (int j = 0; j < 4; ++j) xx[kk][j4][j] = *(const v2u*)projt(ws, xt[j], C_XLRU + 128 * h + 32 * ((k2 + kk) >> 1) + 16 * ((k2 + kk) & 1) + 8 * j4 + 4 * hi);
#pragma unroll
            for (int kk = 0; kk < 2; ++kk) { unsigned w[4];
#pragma unroll
                for (int j4 = 0; j4 < 2; ++j4) { const int C = 128 * h + 32 * ((k2 + kk) >> 1) + 16 * ((k2 + kk) & 1) + 8 * j4 + 4 * hi;
                    f32x4 v = *(const LAS f32x4*)(tbl + 2048 + C);
#pragma unroll
                    for (int j = 0; j < 4; ++j) { const v2u x = xx[kk][j4][j]; const f32x4 cw = *(const LAS f32x4*)(tbl + j * 512 + C) * xz[j];
                        v[0] += cw[0] * __uint_as_float(x.x << 16); v[1] += cw[1] * __uint_as_float(x.x & 0xffff0000u); v[2] += cw[2] * __uint_as_float(x.y << 16); v[3] += cw[3] * __uint_as_float(x.y & 0xffff0000u); }
                    w[2 * j4] = cvtpk(v[0], v[1]); w[2 * j4 + 1] = cvtpk(v[2], v[3]); }
                v4u ww = {w[0], w[1], w[2], w[3]}; xf[k2 + kk] = *reinterpret_cast<bf16x8*>(&ww); }
            asm volatile("" ::: "memory"); }
        const LAS bf16x8* WAF = (const LAS bf16x8*)wl + lane; const LAS bf16x8* WXF = (const LAS bf16x8*)(wl + 32 * 1024) + lane;
#pragma unroll
        for (int nb = 0; nb < 4; ++nb) {
            f32x16 aa = f32x16{}, bb = f32x16{};
            { bf16x8 wf[16];
#pragma unroll
              for (int i = 0; i < 8; ++i) { wf[i] = WAF[(nb * 8 + i) * 64]; wf[8 + i] = WXF[(nb * 8 + i) * 64]; }
#pragma unroll
              for (int i = 0; i < 8; ++i) aa = __builtin_amdgcn_mfma_f32_32x32x16_bf16(wf[i], xf[i], aa, 0, 0, 0);
#pragma unroll
              for (int i = 0; i < 8; ++i) bb = __builtin_amdgcn_mfma_f32_32x32x16_bf16(wf[8 + i], xf[i], bb, 0, 0, 0);
              }
            float av[16], bv[16];
#pragma unroll
            for (int q = 0; q < 4; ++q) { const int C = 128 * h + 32 * nb + 8 * q + 4 * hi;
                const f32x4 ba = *(const LAS f32x4*)(tbl + 2560 + C), bx = *(const LAS f32x4*)(tbl + 3072 + C), sp = *(const LAS f32x4*)(tbl + 3584 + C);
#pragma unroll
                for (int i = 0; i < 4; ++i) { const int r = 4 * q + i;
                    const float rg = __builtin_amdgcn_rcpf(1.f + __builtin_amdgcn_exp2f(fmaf(aa[r], -1.4426950408889634f, ba[i])));
                    const float ig = __builtin_amdgcn_rcpf(1.f + __builtin_amdgcn_exp2f(fmaf(bb[r], -1.4426950408889634f, bx[i])));
                    float a = __builtin_amdgcn_exp2f(rg * sp[i]), mult = __builtin_amdgcn_sqrtf(fmaxf(fmaf(-a, a, 1.f), 0.f));
                    if (reset) { a = 0.f; mult = 1.f; }
                    const float xc = bf2f((bf16_t)xf[2 * nb + (r >> 3)][4 * ((r >> 2) & 1) + (r & 3)]);
                    av[r] = a; bv[r] = mult * ig * xc; } }
            LRU_SCAN_STEP("row_shr:1 row_mask:0xf bank_mask:0xf"); LRU_SCAN_STEP("row_shr:2 row_mask:0xf bank_mask:0xf"); LRU_SCAN_STEP("row_shr:4 row_mask:0xf bank_mask:0xf");
            LRU_SCAN_STEP("row_shr:8 row_mask:0xf bank_mask:0xf"); LRU_SCAN_STEP("row_bcast:15 row_mask:0xa bank_mask:0xf");
#pragma unroll
            for (int q = 0; q < 4; ++q) { const int C = 128 * h + 32 * nb + 8 * q + 4 * hi;
                *(v2u*)(HL + C) = pack4(bv[4 * q], bv[4 * q + 1], bv[4 * q + 2], bv[4 * q + 3]);
                *(v2u*)(PC + C) = pack4(av[4 * q], av[4 * q + 1], av[4 * q + 2], av[4 * q + 3]);
                if (r32 == 31) { *(f32x4*)(SUMA + C) = (f32x4){av[4 * q], av[4 * q + 1], av[4 * q + 2], av[4 * q + 3]};
                                 *(f32x4*)(SUMB + C) = (f32x4){bv[4 * q], bv[4 * q + 1], bv[4 * q + 2], bv[4 * q + 3]}; } }
            asm volatile("" ::: "memory");
        }
        asm volatile("s_waitcnt vmcnt(0)" ::: "memory"); __syncthreads();
        if (threadIdx.x < 128) { const int C = 128 * h + threadIdx.x, g0 = (grp >> 3) << 3; float A = 1.f, B = 0.f;
#pragma unroll
            for (int w = 0; w < 8; ++w) { const float a = __hip_atomic_load((float*)(ws + WSX_SUMA) + (size_t)(g0 + w) * 512 + C, __ATOMIC_RELAXED, __HIP_MEMORY_SCOPE_AGENT), b = __hip_atomic_load((float*)(ws + WSX_SUMB) + (size_t)(g0 + w) * 512 + C, __ATOMIC_RELAXED, __HIP_MEMORY_SCOPE_AGENT);
                B = a * B + b; A = a * A; }
            ((float*)(ws + WSX_SUM8A))[(size_t)(grp >> 3) * 512 + C] = A; ((float*)(ws + WSX_SUM8B))[(size_t)(grp >> 3) * 512 + C] = B; }
    }
}
__device__ __forceinline__ void phase_proj(Frame& F, const Inputs& I, int kmask) {
    LAS unsigned char* wl = F.lds;
    lru_tables(F, I);
    const int b = F.vcu, G = F.G;
    if (kmask & 2) for (int u = b; u < 256; u += G) unit_lru(I, F.ws, wl, F.wave, (u >> 1) * 8 + F.wave, u & 1, ((int)(threadIdx.x & 63)));
    asm volatile("" ::: "memory");
    if (kmask & 1) for (int u = b; u < 128; u += G) unit_q(I, F.ws, wl, F.wave, u * 8 + F.wave, ((int)(threadIdx.x & 63)));
    asm volatile("" ::: "memory");
    if (kmask & 4) for (int u = (G == 256 ? b - 128 : b); u < 128; u += G) if (u >= 0) unit_kv(I, F.ws, wl, F.wave, u * 8 + F.wave, ((int)(threadIdx.x & 63)));
    __syncthreads();
}
__device__ __forceinline__ float gelu_t(float v) { const float u = 0.7978845608028654f * (v + 0.044715f * v * v * v); return v / (1.f + __expf(-2.f * u)); }
__device__ __forceinline__ void unpack8(v4u w, float* f) {
    f[0] = __uint_as_float(w.x << 16); f[1] = __uint_as_float(w.x & 0xffff0000u); f[2] = __uint_as_float(w.y << 16); f[3] = __uint_as_float(w.y & 0xffff0000u);
    f[4] = __uint_as_float(w.z << 16); f[5] = __uint_as_float(w.z & 0xffff0000u); f[6] = __uint_as_float(w.w << 16); f[7] = __uint_as_float(w.w & 0xffff0000u); }
__device__ __forceinline__ void phase_mix(Frame& F, const Inputs& I) {
    LAS float* carry = (LAS float*)F.lds;
    const float* SUMA = (const float*)(F.ws + WSX_SUMA); const float* SUMB = (const float*)(F.ws + WSX_SUMB);
    const bf16_t* HL = (const bf16_t*)(F.ws + WSX_D); const bf16_t* PC = HL + (size_t)NTOK * 512;
    const bf16_t* PROJ = (const bf16_t*)(F.ws + WSX_B); bf16_t* MIXED = (bf16_t*)(F.ws + WSX_E); const bf16_t* AO = (const bf16_t*)(F.ws + WSX_AO);
    const int nper = 1024 / F.G;
    const int c0 = F.vcu * nper, bfirst = (c0 >> 8) << 8;
    {
        float h = 0.f; const int c = ((int)threadIdx.x); const int tb = c0 >> 3, tb0 = (tb >> 5) << 5;
        const float* S8A = (const float*)(F.ws + WSX_SUM8A); const float* S8B = (const float*)(F.ws + WSX_SUM8B);
        for (int k = tb0; k < tb; k += 8) { float a[8], bq[8];
#pragma unroll
            for (int i = 0; i < 8; ++i) { const int kk = k + i < tb ? k + i : tb0; a[i] = S8A[(size_t)kk * 512 + c]; bq[i] = S8B[(size_t)kk * 512 + c]; }
#pragma unroll
            for (int i = 0; i < 8; ++i) if (k + i < tb) h = a[i] * h + bq[i]; }
        for (int k = tb << 3; k < c0; k += 4) { float a[4], bq[4];
#pragma unroll
            for (int i = 0; i < 4; ++i) { a[i] = SUMA[(size_t)(k + i) * 512 + c]; bq[i] = SUMB[(size_t)(k + i) * 512 + c]; }
#pragma unroll
            for (int i = 0; i < 4; ++i) h = a[i] * h + bq[i]; }
        carry[c] = h; }
    __syncthreads();
    const int C = 8 * ((int)(threadIdx.x & 63));
    const f32x4 g0 = *(const f32x4*)(I.lru_out_norm + C), g1 = *(const f32x4*)(I.lru_out_norm + C + 4), q0 = *(const f32x4*)(I.attn_out_norm + C), q1 = *(const f32x4*)(I.attn_out_norm + C + 4);
    for (int k = c0; k < c0 + nper; ++k) {
        const int tb = k * 32 + F.wave * 4;
        v4u hl4[4], pc4[4], gg4[4], at4[4];
#pragma unroll
        for (int rr = 0; rr < 4; ++rr) { const size_t t = tb + rr; hl4[rr] = *(const v4u*)(HL + t * 512 + C); pc4[rr] = *(const v4u*)(PC + t * 512 + C);
            gg4[rr] = *(const v4u*)projt(F.ws, (int)t, C_GLRU + C); at4[rr] = *(const v4u*)(AO + t * 512 + C); }
        float cy[8]; *(f32x4*)cy = *(const LAS f32x4*)(carry + C); *(f32x4*)(cy + 4) = *(const LAS f32x4*)(carry + C + 4);
        float hl[8];
#pragma unroll
        for (int rr = 0; rr < 4; ++rr) { const size_t t = tb + rr;
            float a[8], p[8], g[8], v[8];
            unpack8(hl4[rr], a); unpack8(pc4[rr], p); unpack8(gg4[rr], g);
            float ss = 0.f;
#pragma unroll
            for (int j = 0; j < 8; ++j) { hl[j] = a[j] + p[j] * cy[j]; v[j] = hl[j] * gelu_t(g[j]); ss += v[j] * v[j]; }
            float rs = rsqrtf(wave_sum_f(ss) * (1.f / 512.f) + EPS);
            *(v4u*)(MIXED + t * 1024 + 512 + C) = (v4u){cvtpk(v[0] * rs * g0[0], v[1] * rs * g0[1]), cvtpk(v[2] * rs * g0[2], v[3] * rs * g0[3]), cvtpk(v[4] * rs * g1[0], v[5] * rs * g1[1]), cvtpk(v[6] * rs * g1[2], v[7] * rs * g1[3])};
            unpack8(at4[rr], a); ss = 0.f;
#pragma unroll
            for (int j = 0; j < 8; ++j) ss += a[j] * a[j];
            rs = rsqrtf(wave_sum_f(ss) * (1.f / 512.f) + EPS);
            *(v4u*)(MIXED + t * 1024 + C) = (v4u){cvtpk(a[0] * rs * q0[0], a[1] * rs * q0[1]), cvtpk(a[2] * rs * q0[2], a[3] * rs * q0[3]), cvtpk(a[4] * rs * q1[0], a[5] * rs * q1[1]), cvtpk(a[6] * rs * q1[2], a[7] * rs * q1[3])};
        }
        __syncthreads();
        if (F.wave == 7) {
#pragma unroll
            for (int j = 0; j < 8; ++j) carry[8 * ((int)(threadIdx.x & 63)) + j] = hl[j]; }
        __syncthreads();
    }
}
}
namespace moe {
constexpr size_t WSX_RSTD = WSX_ROUTE + 800 * 1024;
constexpr size_t WSX_BB = WSX_ROUTE + 960 * 1024;
constexpr size_t WSX_WRFB = 70 * MiB;
constexpr size_t WSX_RBIAS = 70 * MiB + 512 * 1024;
constexpr int TP_OFF = LDSCTL_OFF + 512;
__device__ __forceinline__ int route_expert_of_n(int n) { const int a = (n >> 4) & 1, b = (n >> 3) & 1, h = (n >> 2) & 1, c = n & 3; return 8 * (2 * a + h) + 4 * b + c; }
__device__ __forceinline__ void router_fold(Frame& F, const Inputs& I) {
    const float* mod = (const float*)(F.ws + WS_MOD);
    const int gt = blockIdx.x * 512 + ((int)threadIdx.x), NGT = F.G * 512;
    v4u* WRFB = (v4u*)(F.ws + WSX_WRFB);
    for (int g = gt; g < 4 * 2 * 64 * 64; g += NGT) {
        const int lane = g & 63, ks = (g >> 6) & 63, nb = (g >> 12) & 1, b = g >> 13, hi = lane >> 5, n = lane & 31; float v[8];
#pragma unroll
        for (int j = 0; j < 8; ++j) { const int k = 16 * ks + 8 * hi + j; const float gg = I.norm2_g[k] * (1.f + mod[b * MODW + 4096 + k]);
            const float w = nb == 0 ? I.w_re[k * 32 + route_expert_of_n(n)] : (n < 4 ? I.w_rg[k * 4 + n] : 0.f); v[j] = w * gg; }
        WRFB[g] = (v4u){pk2(v[0], v[1]), pk2(v[2], v[3]), pk2(v[4], v[5]), pk2(v[6], v[7])};
    }
    {
        const int gw = blockIdx.x * NWAVES + F.wave;
        if (gw < 4 * 64) { const int b = gw >> 6, n = gw & 63; float s = 0.f;
            if (n < 36) { const int e = n < 32 ? route_expert_of_n(n) : n - 32; const float* W = n < 32 ? I.w_re + e : I.w_rg + e; const int ld = n < 32 ? 32 : 4;
                for (int k = ((int)(threadIdx.x & 63)); k < 1024; k += 64) s += mod[b * MODW + 3072 + k] * W[k * ld];
                s = wave_sum_f(s) + (n < 32 ? I.b_re[e] : I.b_rg[e]); }
            if (((int)(threadIdx.x & 63)) == 0) ((float*)(F.ws + WSX_RBIAS))[gw] = s; } }
}
__device__ __forceinline__ float swap_other(float v) { auto rr = __builtin_amdgcn_permlane32_swap(__float_as_uint(v), __float_as_uint(v), false, false); return (threadIdx.x & 32) ? __uint_as_float(rr[0]) : __uint_as_float(rr[1]); }
__device__ __forceinline__ void phase_route(Frame& F) {
    LAS int* lcnt = (LAS int*)(F.lds);
    if (((int)threadIdx.x) < 32) lcnt[((int)threadIdx.x)] = 0;
    __syncthreads();
    const bf16_t* x1 = (const bf16_t*)(F.ws + WSX_X1);
    int2* rexp = (int2*)(F.ws + WSX_ROUTE); float2* rw = (float2*)(F.ws + WSX_ROUTE + 256 * 1024); int2* rpos = (int2*)(F.ws + WSX_ROUTE + 512 * 1024);
    float* RSTD = (float*)(F.ws + WSX_RSTD);
    const int lane = ((int)(threadIdx.x & 63)), r32 = lane & 31, hi = lane >> 5;
    for (int grp = F.wave * F.G + blockIdx.x; grp < 1024; grp += F.G * NWAVES) {
        const int t = grp * 32 + r32, b = t >> 13;
        const bf16_t* xr = x1 + (size_t)t * DM + 8 * hi;
        const bf16x8* WF = (const bf16x8*)(F.ws + WSX_WRFB) + (size_t)b * 2 * 64 * 64 + lane;
        f32x16 a0 = f32x16{}, a1 = f32x16{}; float ss = 0.f;
#pragma unroll 8
        for (int ks = 0; ks < 64; ++ks) { const bf16x8 xb = *(const bf16x8*)(xr + 16 * ks);
#pragma unroll
            for (int j = 0; j < 8; ++j) { const float f = bf2f((bf16_t)xb[j]); ss += f * f; }
            a0 = __builtin_amdgcn_mfma_f32_32x32x16_bf16(WF[ks * 64], xb, a0, 0, 0, 0);
            a1 = __builtin_amdgcn_mfma_f32_32x32x16_bf16(WF[(64 + ks) * 64], xb, a1, 0, 0, 0); }
        { auto rr = __builtin_amdgcn_permlane32_swap(__float_as_uint(ss), __float_as_uint(ss), false, false); ss = __uint_as_float(rr[0]) + __uint_as_float(rr[1]); }
        const float rstd = rsqrtf(ss * (1.f / DM) + EPS);
        const float* rb = (const float*)(F.ws + WSX_RBIAS) + b * 64;
        float gl0 = a1[0] * rstd + rb[32], gl1 = a1[1] * rstd + rb[33], gl2 = a1[2] * rstd + rb[34], gl3 = a1[3] * rstd + rb[35];
        int gi = 0; float gm = gl0; if (gl1 > gm) { gm = gl1; gi = 1; } if (gl2 > gm) { gm = gl2; gi = 2; } if (gl3 > gm) { gm = gl3; gi = 3; }
        float gp = 1.f / (__expf(gl0 - gm) + __expf(gl1 - gm) + __expf(gl2 - gm) + __expf(gl3 - gm));
        { const float og = swap_other(__int_as_float(gi)), op = swap_other(gp); if (hi) { gi = __float_as_int(og); gp = op; } }
        const bool owner = (gi & 1) == hi; const int hsel = gi >> 1;
        float m0 = -3e38f, m1 = -3e38f; int e0 = 0, e1 = 0;
#pragma unroll
        for (int i = 0; i < 8; ++i) { const int n = 16 * hsel + 8 * (i >> 2) + 4 * hi + (i & 3);
            const float el = (hsel ? a0[8 + i] : a0[i]) * rstd + rb[n];
            if (el > m0) { m1 = m0; e1 = e0; m0 = el; e0 = i; } else if (el > m1) { m1 = el; e1 = i; } }
        if (owner) {
            const float p1 = __expf(m1 - m0); const int E0 = gi * 8 + e0, E1 = gi * 8 + e1;
            rexp[t] = make_int2(E0, E1); rw[t] = make_float2(gp / (1.f + p1), gp * p1 / (1.f + p1));
            const int k0 = __hip_atomic_fetch_add(lcnt + E0, 1, __ATOMIC_RELAXED, __HIP_MEMORY_SCOPE_WORKGROUP), k1 = __hip_atomic_fetch_add(lcnt + E1, 1, __ATOMIC_RELAXED, __HIP_MEMORY_SCOPE_WORKGROUP);
            rpos[t] = make_int2((int)(blockIdx.x << 16) | k0, (int)(blockIdx.x << 16) | k1);
            RSTD[t] = rstd; }
    }
    __syncthreads();
    if (((int)threadIdx.x) < 32) { const int n = lcnt[((int)threadIdx.x)]; int base = 0;
        if (n > 0) base = (int)__hip_atomic_fetch_add((unsigned*)(F.ctl + CW_CNT + 64 * ((int)threadIdx.x)), (unsigned)n, __ATOMIC_RELAXED, __HIP_MEMORY_SCOPE_AGENT);
        ((int*)(F.ws + WSX_BB))[blockIdx.x * 32 + ((int)threadIdx.x)] = base; }
    __syncthreads();
}
__device__ __forceinline__ void moe_tables(Frame& F) {
    LAS int* tp = (LAS int*)(F.lds + TP_OFF);
    if (((int)threadIdx.x) < 32) tp[64 + ((int)threadIdx.x)] = (int)__hip_atomic_load((unsigned*)(F.ctl + CW_CNT + 64 * ((int)threadIdx.x)), __ATOMIC_RELAXED, __HIP_MEMORY_SCOPE_AGENT);
    __syncthreads();
    if (((int)threadIdx.x) == 0) { int acc = 0; for (int e = 0; e < 32; ++e) { tp[e] = acc; acc += (tp[64 + e] + 255) >> 8; } tp[32] = acc; }
    __syncthreads();
}
__device__ __forceinline__ void phase_sort(Frame& F, const Inputs& I) {
    LAS float* Gs = (LAS float*)F.lds; LAS float* Ss = Gs + 4096;
    const float* mod = (const float*)(F.ws + WS_MOD);
#pragma unroll
    for (int i = ((int)threadIdx.x); i < 4096; i += 512) { const int b = i >> 10, k = i & 1023; Gs[i] = I.norm2_g[k] * (1.f + mod[b * MODW + 4096 + k]); Ss[i] = mod[b * MODW + 3072 + k]; }
    moe_tables(F);
    const LAS int* tp = (const LAS int*)(F.lds + TP_OFF);
    const int2* rexp = (const int2*)(F.ws + WSX_ROUTE); const int2* rpos = (const int2*)(F.ws + WSX_ROUTE + 512 * 1024); int2* rposF = (int2*)(F.ws + WSX_RPOSF);
    const float* RSTD = (const float*)(F.ws + WSX_RSTD); const int* BB = (const int*)(F.ws + WSX_BB);
    bf16_t* XS = (bf16_t*)(F.ws + WSX_XS);
    const int gw = F.vcu * NWAVES + F.wave, NGW = F.G * NWAVES;
    for (int m0 = gw; m0 < NTOK; m0 += 4 * NGW) {
        v4u xv[4][2]; int2 ee[4], pp[4]; float rstd[4]; int pos0[4], pos1[4];
        const int ln = ((int)(threadIdx.x & 63));
#pragma unroll
        for (int u = 0; u < 4; ++u) { const int m = m0 + u * NGW; ee[u] = rexp[m]; pp[u] = rpos[m]; rstd[u] = RSTD[m];
            const GAS v4u* xr = (const GAS v4u*)((const bf16_t*)(F.ws + WSX_X1) + (size_t)m * DM) + ln;
            xv[u][0] = xr[0]; xv[u][1] = xr[64]; }
#pragma unroll
        for (int u = 0; u < 4; ++u) { pos0[u] = tp[ee[u].x] * 256 + BB[(pp[u].x >> 16) * 32 + ee[u].x] + (pp[u].x & 0xffff); pos1[u] = tp[ee[u].y] * 256 + BB[(pp[u].y >> 16) * 32 + ee[u].y] + (pp[u].y & 0xffff); }
#pragma unroll
        for (int u = 0; u < 4; ++u) { const int m = m0 + u * NGW, b = m >> 13;
            GAS v4u* o0 = (GAS v4u*)(XS + (size_t)pos0[u] * DM) + ln; GAS v4u* o1 = (GAS v4u*)(XS + (size_t)pos1[u] * DM) + ln;
#pragma unroll
            for (int j = 0; j < 2; ++j) { float f[8]; prj::unpack8(xv[u][j], f); const int k0 = 512 * j + 8 * ln;
                const f32x4 g0 = *(const LAS f32x4*)(Gs + b * 1024 + k0), g1 = *(const LAS f32x4*)(Gs + b * 1024 + k0 + 4), s0 = *(const LAS f32x4*)(Ss + b * 1024 + k0), s1 = *(const LAS f32x4*)(Ss + b * 1024 + k0 + 4);
                const float r = rstd[u];
                const v4u w = {cvtpk(f[0] * r * g0[0] + s0[0], f[1] * r * g0[1] + s0[1]), cvtpk(f[2] * r * g0[2] + s0[2], f[3] * r * g0[3] + s0[3]),
                               cvtpk(f[4] * r * g1[0] + s1[0], f[5] * r * g1[1] + s1[1]), cvtpk(f[6] * r * g1[2] + s1[2], f[7] * r * g1[3] + s1[3])};
                o0[64 * j] = w; o1[64 * j] = w; }
            if (ln == 0) rposF[m] = make_int2(pos0[u], pos1[u]); }
    }
    __syncthreads();
}
__device__ __forceinline__ void phase_combine(Frame& F) {
    const float* mod = (const float*)(F.ws + WS_MOD);
    const float2* rw = (const float2*)(F.ws + WSX_ROUTE + 256 * 1024); const int2* rpos = (const int2*)(F.ws + WSX_RPOSF);
    const bf16_t* YS = (const bf16_t*)(F.ws + WSX_XS);
    const int gw = F.vcu * NWAVES + F.wave, NGW = F.G * NWAVES;
    for (int m0 = gw; m0 < NTOK; m0 += 4 * NGW) {
        int2 pp[4]; float2 ww[4]; v2u xv[4][4]; v2u ya[4][4], yb[4][4];
        const int ln = ((int)(threadIdx.x & 63));
#pragma unroll
        for (int u = 0; u < 4; ++u) { const int m = m0 + u * NGW; pp[u] = rpos[m]; ww[u] = rw[m];
            const GAS v2u* xr = (const GAS v2u*)((const bf16_t*)(F.ws + WSX_X1) + (size_t)m * DM) + ln;
#pragma unroll
            for (int j = 0; j < 4; ++j) xv[u][j] = xr[64 * j]; }
#pragma unroll
        for (int u = 0; u < 4; ++u) { const GAS v2u* y0 = (const GAS v2u*)(YS + (size_t)pp[u].x * DM) + ln; const GAS v2u* y1 = (const GAS v2u*)(YS + (size_t)pp[u].y * DM) + ln;
#pragma unroll
            for (int j = 0; j < 4; ++j) { ya[u][j] = y0[64 * j]; yb[u][j] = y1[64 * j]; } }
#pragma unroll
        for (int u = 0; u < 4; ++u) { const int m = m0 + u * NGW, b = m >> 13; GAS f32x4* xr = (GAS f32x4*)(F.out + (size_t)m * DM) + ln; const float* g2 = mod + b * MODW + 5120 + 4 * ln;
#pragma unroll
            for (int j = 0; j < 4; ++j) { const v2u a = ya[u][j], c = yb[u][j], xx = xv[u][j]; const f32x4 g = *(const f32x4*)(g2 + 256 * j); const float w0 = ww[u].x, w1 = ww[u].y;
                f32x4 y; y[0] = w0 * __uint_as_float(a.x << 16) + w1 * __uint_as_float(c.x << 16); y[1] = w0 * __uint_as_float(a.x & 0xffff0000u) + w1 * __uint_as_float(c.x & 0xffff0000u);
                y[2] = w0 * __uint_as_float(a.y << 16) + w1 * __uint_as_float(c.y << 16); y[3] = w0 * __uint_as_float(a.y & 0xffff0000u) + w1 * __uint_as_float(c.y & 0xffff0000u);
                const f32x4 xf = {__uint_as_float(xx.x << 16), __uint_as_float(xx.x & 0xffff0000u), __uint_as_float(xx.y << 16), __uint_as_float(xx.y & 0xffff0000u)};
                xr[64 * j] = xf + g * y; } }
    }
}
}
#ifndef SEAM_TWICE
#define SEAM_TWICE 0
#endif
__device__ __forceinline__ Inputs load_inputs(const Args& args) {
    Inputs I; const void* const* p = args.in;
    I.x = (const float*)p[0]; I.c = (const float*)p[1]; I.positions = (const int*)p[2]; I.w_ada = (const float*)p[3]; I.b_ada = (const float*)p[4]; I.norm1_g = (const float*)p[5];
    I.w_in = (const float*)p[6]; I.q_a_norm = (const float*)p[7]; I.w_q_b = (const float*)p[8]; I.kv_a_norm = (const float*)p[9]; I.w_kv_b = (const float*)p[10]; I.q_norm = (const float*)p[11];
    I.k_norm = (const float*)p[12]; I.conv_w = (const float*)p[13]; I.conv_b = (const float*)p[14]; I.lru_wa = (const float*)p[15]; I.lru_ba = (const float*)p[16]; I.lru_wx = (const float*)p[17];
    I.lru_bx = (const float*)p[18]; I.lru_lambda = (const float*)p[19]; I.attn_out_norm = (const float*)p[20]; I.lru_out_norm = (const float*)p[21]; I.w_out = (const float*)p[22];
    I.norm2_g = (const float*)p[23]; I.w_rg = (const float*)p[24]; I.b_rg = (const float*)p[25]; I.w_re = (const float*)p[26]; I.b_re = (const float*)p[27]; I.w_gate = (const float*)p[28];
    I.w_up = (const float*)p[29]; I.w_down = (const float*)p[30]; return I;
}
__global__ void __launch_bounds__(NWAVES * 64, 2) mega_fwd(Args args) {
    extern __shared__ __attribute__((aligned(16))) unsigned char lds[];
    Frame F;
    F.lds = (LAS unsigned char*)lds; F.MISC = (volatile LAS unsigned*)(F.lds + MISC_OFF);
    F.wave = __builtin_amdgcn_readfirstlane(threadIdx.x >> 6);
    F.G = gridDim.x; { const int bx = blockIdx.x; F.vcu = (F.G % 8 == 0) ? (bx % 8) * (F.G / 8) + bx / 8 : bx; }
    F.ws = args.ws; F.out = args.out; F.ctl = (gu32*)(args.ws + WS_CTL);
    for (int u = ((int)threadIdx.x); u < (LDS_BYTES - LDSCTL_OFF) / 4; u += NWAVES * 64) ((LAS unsigned*)(F.lds + LDSCTL_OFF))[u] = 0u;
    __syncthreads();
    XcdBarrier bar = xcd_barrier_post((unsigned*)(F.ctl + CW_BAR) + args.li * XCD_BAR_WORDS, F.MISC + 8);
    const int lo = args.ph_lo, hi = args.ph_hi;
constexpr int REPS[12] = {1,1,1,1,1,1,1,1,1,1,1,1};
#define IN(k) (lo <= (k) && (k) < hi)
#define SEAM(k) do { if (IN(k) && IN((k) + 1)) { xcd_barrier(bar); if (SEAM_TWICE) xcd_barrier(bar); } } while (0)
    if (IN(0)) for (int rep_ = 0; rep_ < REPS[0]; ++rep_) { const Inputs I = load_inputs(args); (void)I; phase_prologue(F, I); } SEAM(0);
    if (IN(1)) for (int rep_ = 0; rep_ < REPS[1]; ++rep_) { const Inputs I = load_inputs(args); (void)I; moe::router_fold(F, I); phase_xn(F, I); } SEAM(1);
    if (IN(2)) for (int rep_ = 0; rep_ < REPS[2]; ++rep_) { const Inputs I = load_inputs(args); (void)I;
        pg8::Gemm g{(const bf16_t*)(F.ws + WSX_A), (const bf16_t*)(F.ws + WSX_WIN), NTOK, PROJP, DM}; pg8::StaticOrder S; S.init(NTOK, PROJP, F.G, (int)blockIdx.x);
        pg8::EpiProjT E{(bf16_t*)(F.ws + WSX_B)};
        pg8::gemm_phase<pg8::EpiProjT, pg8::StaticOrder, true, true>(F.lds, g, S, E);
    } SEAM(2);
    if (IN(3)) for (int rep_ = 0; rep_ < REPS[3]; ++rep_) { const Inputs I = load_inputs(args); (void)I; prj::phase_proj(F, I, args.pad); } SEAM(3);
    if (IN(4)) for (int rep_ = 0; rep_ < REPS[4]; ++rep_) { const Inputs I = load_inputs(args); (void)I;
#ifndef ATT_ABL
#define ATT_ABL 0
#endif
        if (ATT_ABL == 0 || args.pad == 7) att::attn_phase<0>((char*)lds, (const bf16_t*)(F.ws + WSX_Q), (const bf16_t*)(F.ws + WSX_K), (const bf16_t*)(F.ws + WSX_V), (bf16_t*)(F.ws + WSX_AO), F.G, F.vcu);
        else att::attn_phase<ATT_ABL>((char*)lds, (const bf16_t*)(F.ws + WSX_Q), (const bf16_t*)(F.ws + WSX_K), (const bf16_t*)(F.ws + WSX_V), (bf16_t*)(F.ws + WSX_AO), F.G, F.vcu);
    } SEAM(4);
    if (IN(5)) for (int rep_ = 0; rep_ < REPS[5]; ++rep_) { const Inputs I = load_inputs(args); (void)I; prj::phase_mix(F, I); } SEAM(5);
    if (IN(6)) for (int rep_ = 0; rep_ < REPS[6]; ++rep_) { const Inputs I = load_inputs(args); (void)I;
        pg8::Gemm g{(const bf16_t*)(F.ws + WSX_E), (const bf16_t*)(F.ws + WSX_WOUT), NTOK, DM, DM}; pg8::StaticOrder S; S.init(NTOK, DM, F.G, (int)blockIdx.x);
        pg8::EpiResid E{I.x, (const float*)(F.ws + WS_MOD), (bf16_t*)(F.ws + WSX_X1)};
        pg8::gemm_phase<pg8::EpiResid, pg8::StaticOrder, true, true>(F.lds, g, S, E);
    } SEAM(6);
    if (IN(7)) for (int rep_ = 0; rep_ < REPS[7]; ++rep_) { const Inputs I = load_inputs(args); (void)I; moe::phase_route(F); } SEAM(7);
    if (IN(8)) for (int rep_ = 0; rep_ < REPS[8]; ++rep_) { const Inputs I = load_inputs(args); (void)I; moe::phase_sort(F, I); } SEAM(8);
    if (IN(9)) for (int rep_ = 0; rep_ < REPS[9]; ++rep_) { const Inputs I = load_inputs(args); (void)I;
        if (!IN(8)) moe::moe_tables(F);
        pg8::Gemm g{(const bf16_t*)(F.ws + WSX_XS), (const bf16_t*)(F.ws + WSX_W1T), MAXROWS, 0, DM};
        pg8::GroupedOrder S{(const LAS int*)(F.lds + moe::TP_OFF), 2, F.G, (int)blockIdx.x};
        pg8::EpiSiluMul E{(bf16_t*)(F.ws + WSX_HID)};
        pg8::gemm_phase<pg8::EpiSiluMul, pg8::GroupedOrder, true, true>(F.lds, g, S, E);
    } SEAM(9);
    if (IN(10)) for (int rep_ = 0; rep_ < REPS[10]; ++rep_) { const Inputs I = load_inputs(args); (void)I;
        if (!IN(8)) moe::moe_tables(F);
        int kk2 = DFF; asm volatile("" : "+s"(kk2));
        pg8::Gemm g{(const bf16_t*)(F.ws + WSX_HID), (const bf16_t*)(F.ws + WSX_W2T), MAXROWS, 0, kk2};
        pg8::GroupedOrder S{(const LAS int*)(F.lds + moe::TP_OFF), 4, F.G, (int)blockIdx.x};
        pg8::EpiYs E{(bf16_t*)(F.ws + WSX_XS)};
        pg8::gemm_phase<pg8::EpiYs, pg8::GroupedOrder, true, true>(F.lds, g, S, E);
    } SEAM(10);
    if (IN(11)) for (int rep_ = 0; rep_ < REPS[11]; ++rep_) { const Inputs I = load_inputs(args); (void)I; moe::phase_combine(F); }
#undef IN
#undef SEAM
}
static int g_grid = 0;
static bool mega_setup() {
    if (g_grid) return g_grid > 0;
    int dev = 0, cus = 0, per_cu = 0;
    if (hipGetDevice(&dev) != hipSuccess || hipDeviceGetAttribute(&cus, hipDeviceAttributeMultiprocessorCount, dev) != hipSuccess) { g_grid = -1; return false; }
    if (hipFuncSetAttribute((const void*)mega_fwd, hipFuncAttributeMaxDynamicSharedMemorySize, LDS_BYTES) != hipSuccess) { fprintf(stderr, "hipFuncSetAttribute failed\n"); g_grid = -1; return false; }
    if (hipOccupancyMaxActiveBlocksPerMultiprocessor(&per_cu, (const void*)mega_fwd, NWAVES * 64, LDS_BYTES) != hipSuccess || per_cu < 1) { fprintf(stderr, "occupancy query: %d\n", per_cu); (void)hipGetLastError(); g_grid = -1; return false; }
    g_grid = cus;
    return true;
}
static void mega_launch(void* const* d_in, void* d_out, void* d_ws, hipStream_t stream, int lo, int hi, int li, int knob = 7) {
    Args a{}; for (int i = 0; i < 31; ++i) a.in[i] = d_in[i];
    a.out = (float*)d_out; a.ws = (unsigned char*)d_ws; a.ph_lo = lo; a.ph_hi = hi; a.li = li; a.pad = knob;
    hipLaunchKernelGGL(mega_fwd, dim3(g_grid), dim3(NWAVES * 64), LDS_BYTES, stream, a);
}
extern "C" void kernel_launch(void* const* d_in, const int* in_sizes, int n_in, void* d_out, int out_size, void* d_ws, size_t ws_size, hipStream_t stream) {
    if (n_in != 31 || ws_size < WSX_END || out_size != NTOK * DM) { fprintf(stderr, "kernel_launch: unexpected shapes n_in=%d ws=%zu out=%d\n", n_in, ws_size, out_size); return; }
    if (!mega_setup()) return;
    char* ws = (char*)d_ws;
    (void)hipMemsetAsync(ws + WS_CTL, 0, 1 * MiB, stream);
    mega_launch(d_in, d_out, d_ws, stream, 0, 12, 0);
}
```

```cpp
#include <hip/hip_runtime.h>
#include <cstdio>
#include <cstdint>
#include <cmath>
constexpr int NB = 4, SEQ = 8192, DM = 1024, NTOK = NB * SEQ;
constexpr int NH = 4, DQK = 192, DNOPE = 128, DROPE = 64, DV = 128;
constexpr int QLR = 256, KVLR = 128, LRUW = 512, LRUH = 4, LRUB = 128;
constexpr int NPROJ = 1472, PROJP = 1536;
constexpr int C_QLAT = 0, C_KVLAT = 256, C_KROPE = 384, C_XLRU = 448, C_GLRU = 960;
constexpr int NEXP = 32, NGRP = 4, EPG = 8, DFF = 256;
constexpr float EPS = 1e-6f;
constexpr int MODW = 6 * DM;

typedef unsigned short bf16_t;
__device__ __forceinline__ float bf2f(bf16_t v) { return __uint_as_float(((unsigned)v) << 16); }
__device__ __forceinline__ bf16_t f2bf(float f) { unsigned u = __float_as_uint(f); return (bf16_t)((u + 0x7fffu + ((u >> 16) & 1u)) >> 16); }

constexpr size_t MiB = 1u << 20;
constexpr size_t WS_CTL = 0;
constexpr size_t WS_MOD = 1 * MiB;
constexpr size_t WS_ROUTE = 2 * MiB;
constexpr size_t WS_A = 64 * MiB;
constexpr size_t WS_B = 128 * MiB;
constexpr size_t WS_C = 224 * MiB;
constexpr size_t WS_D = 352 * MiB;
constexpr size_t WS_E = 416 * MiB;
constexpr size_t WS_END = 480 * MiB;
constexpr size_t WS_Q = WS_C, WS_K = WS_C + 48 * MiB, WS_V = WS_C + 96 * MiB;

__device__ __forceinline__ float silu_f(float v) { return v / (1.f + __expf(-v)); }
__device__ __forceinline__ float sigmoid_f(float v) { return 1.f / (1.f + __expf(-v)); }
__device__ __forceinline__ float gelu_tanh(float v) { const float u = 0.7978845608028654f * (v + 0.044715f * v * v * v); return v / (1.f + __expf(-2.f * u)); }

__device__ __forceinline__ float block_sum_256(float v, float* red) {
    for (int o = 32; o > 0; o >>= 1) v += __shfl_xor(v, o);
    __syncthreads();
    if ((threadIdx.x & 63) == 0) red[threadIdx.x >> 6] = v;
    __syncthreads();
    return red[0] + red[1] + red[2] + red[3];
}
__device__ __forceinline__ float wave_sum(float v) { for (int o = 32; o > 0; o >>= 1) v += __shfl_xor(v, o); return v; }

__device__ __forceinline__ void rope_cs(int pos, int i, float& c, float& s) {
    const double inv = exp(-0.28782313662425575 * (double)i);
    double a = (double)pos * inv;
    const double k = rint(a * 0.15915494309189535);
    a = fma(-k, 6.283185307179586, a); a = fma(-k, 2.4492935982947064e-16, a);
    const float r = (float)a;
    c = __cosf(r); s = __sinf(r);
}

struct Inputs {
    const float *x, *c; const int* positions;
    const float *w_ada, *b_ada, *norm1_g, *w_in, *q_a_norm, *w_q_b, *kv_a_norm, *w_kv_b, *q_norm, *k_norm, *conv_w, *conv_b, *lru_wa, *lru_ba, *lru_wx, *lru_bx, *lru_lambda,
                *attn_out_norm, *lru_out_norm, *w_out, *norm2_g, *w_rg, *b_rg, *w_re, *b_re, *w_gate, *w_up, *w_down;
};
static Inputs get_inputs(void* const* d_in) {
    Inputs I;
    I.x = (const float*)d_in[0]; I.c = (const float*)d_in[1]; I.positions = (const int*)d_in[2];
    I.w_ada = (const float*)d_in[3]; I.b_ada = (const float*)d_in[4]; I.norm1_g = (const float*)d_in[5];
    I.w_in = (const float*)d_in[6]; I.q_a_norm = (const float*)d_in[7]; I.w_q_b = (const float*)d_in[8];
    I.kv_a_norm = (const float*)d_in[9]; I.w_kv_b = (const float*)d_in[10]; I.q_norm = (const float*)d_in[11];
    I.k_norm = (const float*)d_in[12]; I.conv_w = (const float*)d_in[13]; I.conv_b = (const float*)d_in[14];
    I.lru_wa = (const float*)d_in[15]; I.lru_ba = (const float*)d_in[16]; I.lru_wx = (const float*)d_in[17];
    I.lru_bx = (const float*)d_in[18]; I.lru_lambda = (const float*)d_in[19]; I.attn_out_norm = (const float*)d_in[20];
    I.lru_out_norm = (const float*)d_in[21]; I.w_out = (const float*)d_in[22]; I.norm2_g = (const float*)d_in[23];
    I.w_rg = (const float*)d_in[24]; I.b_rg = (const float*)d_in[25]; I.w_re = (const float*)d_in[26];
    I.b_re = (const float*)d_in[27]; I.w_gate = (const float*)d_in[28]; I.w_up = (const float*)d_in[29];
    I.w_down = (const float*)d_in[30];
    return I;
}
#define GAS __attribute__((address_space(1)))
#define LAS __attribute__((address_space(3)))
typedef unsigned v4u __attribute__((ext_vector_type(4)));
typedef unsigned v2u __attribute__((ext_vector_type(2)));
typedef float f32x4 __attribute__((ext_vector_type(4)));
typedef float f32x16 __attribute__((ext_vector_type(16)));
typedef short bf16x8 __attribute__((ext_vector_type(8)));
typedef short s16x4 __attribute__((ext_vector_type(4)));
typedef GAS unsigned gu32;
#define RLX_AGENT __ATOMIC_RELAXED, __HIP_MEMORY_SCOPE_AGENT
#define LDS_WAIT() asm volatile("s_waitcnt lgkmcnt(0)" ::: "memory")
#define VM_WAIT() asm volatile("s_waitcnt vmcnt(0)" ::: "memory")
__device__ __forceinline__ unsigned pk2(float lo, float hi) { return (unsigned)f2bf(lo) | ((unsigned)f2bf(hi) << 16); }
__device__ __forceinline__ unsigned cvtpk(float lo, float hi) { unsigned r; asm volatile("v_cvt_pk_bf16_f32 %0, %1, %2" : "=v"(r) : "v"(lo), "v"(hi)); return r; }

constexpr size_t WSX_SUMA = 3 * MiB, WSX_SUMB = 5 * MiB;
constexpr size_t WSX_CS = 7 * MiB;
constexpr size_t WSX_WQF = 15 * MiB;
constexpr size_t WSX_WKVF = WSX_WQF + 384 * 1024;
constexpr size_t WSX_WAF = WSX_WKVF + 256 * 1024;
constexpr size_t WSX_WXF = WSX_WAF + 128 * 1024;
constexpr size_t WSX_WRF = WSX_WXF + 128 * 1024;
constexpr size_t WSX_SP = 2 * MiB + 768 * 1024;
constexpr size_t WSX_WIN = 16 * MiB;
constexpr size_t WSX_WOUT = 19 * MiB;
constexpr size_t WSX_W1T = 22 * MiB;
constexpr size_t WSX_W2T = 54 * MiB;
constexpr size_t WSX_A = 72 * MiB;
constexpr size_t WSX_B = 136 * MiB;
constexpr size_t WSX_C = 232 * MiB;
constexpr size_t WSX_D = 360 * MiB;
constexpr size_t WSX_E = 424 * MiB;
constexpr size_t WSX_END = 488 * MiB;
constexpr size_t WSX_Q = WSX_C, WSX_K = WSX_C + 48 * MiB, WSX_V = WSX_C + 96 * MiB;
constexpr size_t WSX_XS = 216 * MiB;
constexpr size_t WSX_HID = WSX_D;
constexpr size_t WSX_ROUTE = 2 * MiB;
constexpr int MAXROWS = 2 * NTOK + NEXP * 255;
constexpr size_t WSX_X1 = 72 * MiB;
constexpr size_t WSX_AO = WSX_A;
constexpr size_t WSX_RPOSF = 71 * MiB + 128 * 1024;
constexpr size_t WSX_SUM8A = 70 * MiB + 576 * 1024, WSX_SUM8B = 70 * MiB + 832 * 1024;
constexpr int CW_BAR = 4096;
constexpr int CW_CNT = 65536;

constexpr int RING_BYTES = 131072, LDSCTL_OFF = RING_BYTES, MISC_OFF = LDSCTL_OFF + 320, LDS_BYTES = 147456;
constexpr int NWAVES = 8;
namespace pg8 {
#define PG8_LAS __attribute__((address_space(3)))
typedef unsigned short bf16_t;
typedef short bf16x8 __attribute__((ext_vector_type(8)));
typedef float f32x4 __attribute__((ext_vector_type(4)));
typedef unsigned u32x4 __attribute__((ext_vector_type(4)));
constexpr int BM = 256, BK = 64, HALF = 128, HTB = HALF * BK * 2  , STAGE_BYTES = 8 * HTB, NXCD = 8, WGM = 8;

__host__ __device__ __forceinline__ int lds_byte(int r, int c) { const int st = (r >> 4) * 2 + (c >> 5), rr = r & 15, cc = c & 31, ob = rr * 64 + cc * 2; return st * 1024 + (ob ^ (((ob >> 9) & 1) << 5)); }
__host__ __device__ __forceinline__ void stage_rc(int b, int& R, int& C) { const int st = b / 1024, sb = b % 1024, swz = sb ^ (((sb >> 9) & 1) << 5); R = (st >> 1) * 16 + swz / 64; C = (st & 1) * 32 + (swz % 64) / 2; }
__host__ __device__ __forceinline__ int perm32(int rho) { const int n = rho >> 4, i = rho & 15; return 8 * (i >> 2) + 4 * n + (i & 3); }

struct Unit { int pm, pn; };
struct Gemm { const bf16_t* A; const bf16_t* Bt; int M, N, K; };

struct StaticOrder {
    int nM, nN, nwg, G, c;
    __host__ __device__ void init(int M, int N, int G_, int c_) { nM = M / BM; nN = N / BM; nwg = nM * nN; G = G_; c = c_; }
    __host__ __device__ bool next(int i, Unit& u) const {
        const long L = (long)i * G + c; if (L >= nwg) return false;
        int wgid = (int)L; { const int q = nwg / NXCD, r = nwg % NXCD, xcd = wgid % NXCD, off = wgid / NXCD; wgid = (xcd < r ? xcd * (q + 1) : r * (q + 1) + (xcd - r) * q) + off; }
        const int nig = WGM * nN, gid = wgid / nig, fm = gid * WGM, gsz = (nM - fm) < WGM ? (nM - fm) : WGM;
        u.pm = fm + ((wgid % nig) % gsz); u.pn = (wgid % nig) / gsz; return true;
    }
    __device__ __forceinline__ void a_ready(const Unit&) const {}
    __device__ __forceinline__ void done(const Unit&) const {}
};

__device__ __forceinline__ unsigned cvt_pk_bf16(float lo, float hi) { unsigned r; asm volatile("v_cvt_pk_bf16_f32 %0, %1, %2" : "=v"(r) : "v"(lo), "v"(hi)); return r; }
typedef float f32x2 __attribute__((ext_vector_type(2)));
__device__ __forceinline__ f32x2 gelu_pk(f32x2 v) {
    const f32x2 av = __builtin_elementwise_abs(v), d = av * 0.2316418882f + 1.0f;
    f32x2 t; t.x = __builtin_amdgcn_rcpf(d.x); t.y = __builtin_amdgcn_rcpf(d.y);
    f32x2 q = t * 0.5307027145f + (-0.7265760135f); q = q * t + 0.7107068705f; q = q * t + (-0.142248368f); q = q * t + 0.127414796f; q = q * t;
    const f32x2 s = (v * v) * (-0.72134752044f);
    f32x2 e; e.x = __builtin_amdgcn_exp2f(s.x); e.y = __builtin_amdgcn_exp2f(s.y);
    const f32x2 m = v * (q * e), r = v - m;
    f32x2 o; o.x = v.x < 0.f ? m.x : r.x; o.y = v.y < 0.f ? m.y : r.y; return o;
}

template <int ACT  > struct EpiBf16 {
    static constexpr bool PERM = true, AFTER_DRAIN = false; static_assert(ACT == 0 || ACT == 1, "EpiBf16: ACT is 0 (none) or 1 (gelu_pk)");
    bf16_t* O; int ldc; const float* bias; int split_cols; size_t split_stride; float scale0;
    __device__ __forceinline__ void operator()(const f32x4 (&acc)[2][2][4][2], const Unit& u, int wr, int wc, int fr, int fq) const {
        const int row0 = u.pm * BM + wr * 64 + fr; int colt = u.pn * BM; bf16_t* base = O;
        float sc = 1.f; if (split_cols) { const int t = colt / split_cols; base += (size_t)t * split_stride; colt -= t * split_cols; if (t == 0) sc = scale0; }
        const int col0 = colt + wc * 32 + 8 * fq, bcol0 = u.pn * BM + wc * 32 + 8 * fq;
        f32x4 bv[2][2];
#pragma unroll
        for (int bj = 0; bj < 2; ++bj)
#pragma unroll
            for (int n = 0; n < 2; ++n) bv[bj][n] = bias ? *(const f32x4*)(bias + bcol0 + bj * HALF + 4 * n) : (f32x4){0.f, 0.f, 0.f, 0.f};
#pragma unroll
        for (int ai = 0; ai < 2; ++ai)
#pragma unroll
            for (int m = 0; m < 4; ++m) { bf16_t* rowp = base + (size_t)(row0 + ai * HALF + m * 16) * ldc + col0;
#pragma unroll
                for (int bj = 0; bj < 2; ++bj) { f32x4 v0 = acc[ai][bj][m][0] + bv[bj][0], v1 = acc[ai][bj][m][1] + bv[bj][1];
                    if (ACT == 1) { f32x2 a = gelu_pk((f32x2){v0[0], v0[1]}), b = gelu_pk((f32x2){v0[2], v0[3]}), c = gelu_pk((f32x2){v1[0], v1[1]}), d = gelu_pk((f32x2){v1[2], v1[3]});
                        v0 = (f32x4){a.x, a.y, b.x, b.y}; v1 = (f32x4){c.x, c.y, d.x, d.y}; }
                    v0 = v0 * sc; v1 = v1 * sc; u32x4 w; w.x = cvt_pk_bf16(v0[0], v0[1]); w.y = cvt_pk_bf16(v0[2], v0[3]); w.z = cvt_pk_bf16(v1[0], v1[1]); w.w = cvt_pk_bf16(v1[2], v1[3]);
                    *(u32x4*)(rowp + bj * HALF) = w; } }
    }
};
struct EpiResid {
    static constexpr bool PERM = true, AFTER_DRAIN = false;
    const float* x; const float* mod; bf16_t* out;
    __device__ __forceinline__ void operator()(const f32x4 (&acc)[2][2][4][2], const Unit& u, int wr, int wc, int fr, int fq) const {
        const int col0 = u.pn * BM + wc * 32 + 8 * fq, b = (u.pm * BM) / 8192;
        f32x4 gv[2][2];
#pragma unroll
        for (int bj = 0; bj < 2; ++bj)
#pragma unroll
            for (int n = 0; n < 2; ++n) gv[bj][n] = *(const f32x4*)(mod + b * 6144 + 2048 + col0 + bj * HALF + n * 4);
#pragma unroll
        for (int ai = 0; ai < 2; ++ai)
#pragma unroll
            for (int m = 0; m < 4; ++m) { const size_t off = (size_t)(u.pm * BM + ai * HALF + wr * 64 + m * 16 + fr) * 1024 + col0;
#pragma unroll
                for (int bj = 0; bj < 2; ++bj) { const f32x4 x0 = *(const f32x4*)(x + off + bj * HALF), x1 = *(const f32x4*)(x + off + bj * HALF + 4);
                    const f32x4 v0 = x0 + gv[bj][0] * acc[ai][bj][m][0], v1 = x1 + gv[bj][1] * acc[ai][bj][m][1];
                    u32x4 w; w.x = cvt_pk_bf16(v0[0], v0[1]); w.y = cvt_pk_bf16(v0[2], v0[3]); w.z = cvt_pk_bf16(v1[0], v1[1]); w.w = cvt_pk_bf16(v1[2], v1[3]);
                    *(u32x4*)(out + off + bj * HALF) = w; } }
    }
};
__device__ __forceinline__ float silu_e(float v) { return v * __builtin_amdgcn_rcpf(1.f + __builtin_amdgcn_exp2f(-1.4426950408889634f * v)); }
struct EpiSiluMul {
    static constexpr bool PERM = true, AFTER_DRAIN = false;
    bf16_t* H;
    __device__ __forceinline__ void operator()(const f32x4 (&acc)[2][2][4][2], const Unit& u, int wr, int wc, int fr, int fq) const {
        const int half = u.pn & 1, col0 = half * 128 + wc * 32 + 8 * fq;
#pragma unroll
        for (int ai = 0; ai < 2; ++ai)
#pragma unroll
            for (int m = 0; m < 4; ++m) { const size_t row = (size_t)(u.pm * BM + ai * HALF + wr * 64 + m * 16 + fr);
                const f32x4 g0 = acc[ai][0][m][0], g1 = acc[ai][0][m][1], u0 = acc[ai][1][m][0], u1 = acc[ai][1][m][1];
                u32x4 w; w.x = cvt_pk_bf16(silu_e(g0[0]) * u0[0], silu_e(g0[1]) * u0[1]); w.y = cvt_pk_bf16(silu_e(g0[2]) * u0[2], silu_e(g0[3]) * u0[3]);
                w.z = cvt_pk_bf16(silu_e(g1[0]) * u1[0], silu_e(g1[1]) * u1[1]); w.w = cvt_pk_bf16(silu_e(g1[2]) * u1[2], silu_e(g1[3]) * u1[3]);
                *(u32x4*)(H + row * 256 + col0) = w; }
    }
};
struct EpiProjT {
    static constexpr bool PERM = true, AFTER_DRAIN = false;
    bf16_t* P;
    __device__ __forceinline__ void operator()(const f32x4 (&acc)[2][2][4][2], const Unit& u, int wr, int wc, int fr, int fq) const {
#pragma unroll
        for (int ai = 0; ai < 2; ++ai)
#pragma unroll
            for (int m = 0; m < 4; ++m) { const int row = u.pm * BM + ai * HALF + wr * 64 + m * 16 + fr;
#pragma unroll
                for (int bj = 0; bj < 2; ++bj) { const int c = (u.pn * BM + bj * HALF + wc * 32 + 8 * fq) >> 3; const f32x4 v0 = acc[ai][bj][m][0], v1 = acc[ai][bj][m][1];
                    u32x4 w; w.x = cvt_pk_bf16(v0[0], v0[1]); w.y = cvt_pk_bf16(v0[2], v0[3]); w.z = cvt_pk_bf16(v1[0], v1[1]); w.w = cvt_pk_bf16(v1[2], v1[3]);
                    *(u32x4*)(P + ((size_t)((row >> 5) * 192 + c) * 32 + (row & 31)) * 8) = w; } }
    }
};
struct EpiYs {
    static constexpr bool PERM = true, AFTER_DRAIN = false;
    bf16_t* Y;
    __device__ __forceinline__ void operator()(const f32x4 (&acc)[2][2][4][2], const Unit& u, int wr, int wc, int fr, int fq) const {
        const int col0 = (u.pn & 3) * BM + wc * 32 + 8 * fq;
#pragma unroll
        for (int ai = 0; ai < 2; ++ai)
#pragma unroll
            for (int m = 0; m < 4; ++m) { bf16_t* rowp = Y + (size_t)(u.pm * BM + ai * HALF + wr * 64 + m * 16 + fr) * 1024 + col0;
#pragma unroll
                for (int bj = 0; bj < 2; ++bj) { const f32x4 v0 = acc[ai][bj][m][0], v1 = acc[ai][bj][m][1];
                    u32x4 w; w.x = cvt_pk_bf16(v0[0], v0[1]); w.y = cvt_pk_bf16(v0[2], v0[3]); w.z = cvt_pk_bf16(v1[0], v1[1]); w.w = cvt_pk_bf16(v1[2], v1[3]);
                    *(u32x4*)(rowp + bj * HALF) = w; } }
    }
};
struct GroupedOrder {
    const __attribute__((address_space(3))) int* tp; int ncol, G, c;
    __device__ __forceinline__ bool next(int i, Unit& u) const {
        const int L = i * G + c, total = tp[32] * ncol; if (L >= total) return false;
        const int rt = L / ncol, ct = L - rt * ncol; int e = 0;
#pragma unroll 1
        for (int j = 1; j < 32; ++j) e += (tp[j] <= rt) ? 1 : 0;
        u.pm = rt; u.pn = e * ncol + ct; return true;
    }
    __device__ __forceinline__ void a_ready(const Unit&) const {}
    __device__ __forceinline__ void done(const Unit&) const {}
};
template <class Epi, class Sched, bool ALIGN_EPI = false, bool SP2 = false>
__device__ __forceinline__ void gemm_phase(PG8_LAS unsigned char* lds, const Gemm g, const Sched& S, const Epi& E) {
    const int tid = threadIdx.x, wid = __builtin_amdgcn_readfirstlane(tid >> 6), lane = tid & 63, wr = wid >> 2, wc = wid & 3, fr = lane & 15, fq = lane >> 4;
    const int K = g.K, nt = K / BK;
    unsigned voffA[2], voffB[2];
#pragma unroll
    for (int i = 0; i < 2; ++i) { int R, C; stage_rc(tid * 16 + i * 8192, R, C); const int Rb = Epi::PERM ? ((R & ~31) + perm32(R & 31)) : R;
        voffA[i] = (unsigned)(R * K + C) * 2u; voffB[i] = (unsigned)(Rb * K + C) * 2u; }
    const size_t kstep = (size_t)(BK * 2);
    const size_t hstep = (size_t)HALF * K * 2;
    const size_t tstep = 2 * hstep;
    const unsigned ldsw = (unsigned)wid * 1024u;
    const int aoff = lds_byte(wr * 64 + fr, fq * 8), boff = lds_byte(wc * 32 + fr, fq * 8);
#define PG8_SA(b, h) (((b) * 2 + (h)) * HTB)
#define PG8_SB(b, h) ((4 + (b) * 2 + (h)) * HTB)
#define PG8_STAGE(bufoff, gbase, voff) do { _Pragma("unroll") for (int _i = 0; _i < 2; ++_i) \
        __builtin_amdgcn_global_load_lds((const unsigned*)((const char*)(gbase) + (voff)[_i]), (PG8_LAS unsigned*)(lds + (bufoff) + ldsw + _i * 8192), 16, 0, 0); } while (0)
#define PG8_LDA(dst, b, h) do { _Pragma("unroll") for (int m = 0; m < 4; ++m) _Pragma("unroll") for (int k = 0; k < 2; ++k) dst[m][k] = *(const PG8_LAS bf16x8*)(lds + PG8_SA(b, h) + aoff + m * 2048 + k * 1024); } while (0)
#define PG8_LDB(dst, b, h) do { _Pragma("unroll") for (int n = 0; n < 2; ++n) _Pragma("unroll") for (int k = 0; k < 2; ++k) dst[n][k] = *(const PG8_LAS bf16x8*)(lds + PG8_SB(b, h) + boff + n * 2048 + k * 1024); } while (0)
#define PG8_MMA(ai, bj, At, Bt) do { __builtin_amdgcn_s_setprio(1); _Pragma("unroll") for (int m = 0; m < 4; ++m) _Pragma("unroll") for (int n = 0; n < 2; ++n) _Pragma("unroll") for (int k = 0; k < 2; ++k) \
        acc[ai][bj][m][n] = __builtin_amdgcn_mfma_f32_16x16x32_bf16(Bt[n][k], At[m][k], acc[ai][bj][m][n], 0, 0, 0); __builtin_amdgcn_s_setprio(0); } while (0)
#define PG8_WAIT_V(n) asm volatile("s_waitcnt vmcnt(" #n ")" ::: "memory")
#define PG8_WAIT_L(n) asm volatile("s_waitcnt lgkmcnt(" #n ")" ::: "memory")
#define PG8_BAR __builtin_amdgcn_s_barrier()
#define PG8_SCHED __builtin_amdgcn_sched_barrier(0)
    Unit cur, nxt; int ui = 0;
    if (!S.next(0, cur)) return;
    f32x4 acc[2][2][4][2];
#pragma unroll
    for (int a = 0; a < 2; ++a)
#pragma unroll
        for (int b = 0; b < 2; ++b)
#pragma unroll
            for (int m = 0; m < 4; ++m)
#pragma unroll
                for (int n = 0; n < 2; ++n) acc[a][b][m][n] = (f32x4){0.f, 0.f, 0.f, 0.f};
    bf16x8 At[4][2], B0[2][2], B1[2][2];
    const char* cA = (const char*)g.A + (size_t)cur.pm * tstep; const char* cB = (const char*)g.Bt + (size_t)cur.pn * tstep;
    S.a_ready(cur);
    if constexpr (SP2) {
        PG8_STAGE(PG8_SB(0, 0), cB, voffB); PG8_STAGE(PG8_SB(0, 1), cB + hstep, voffB); PG8_STAGE(PG8_SA(0, 0), cA, voffA); PG8_STAGE(PG8_SA(0, 1), cA + hstep, voffA);
        if (wr == 1) PG8_BAR;
        PG8_WAIT_V(2); PG8_BAR;
        PG8_STAGE(PG8_SB(1, 0), cB + kstep, voffB); PG8_STAGE(PG8_SA(1, 0), cA + kstep, voffA); PG8_STAGE(PG8_SB(1, 1), cB + hstep + kstep, voffB);
        PG8_WAIT_V(6); PG8_BAR;
    } else {
        PG8_STAGE(PG8_SB(0, 0), cB, voffB); PG8_STAGE(PG8_SA(0, 0), cA, voffA); PG8_STAGE(PG8_SB(0, 1), cB + hstep, voffB); PG8_STAGE(PG8_SA(0, 1), cA + hstep, voffA);
        if (wr == 1) PG8_BAR;
        PG8_WAIT_V(4); PG8_BAR;
        PG8_STAGE(PG8_SB(1, 0), cB + kstep, voffB); PG8_STAGE(PG8_SA(1, 0), cA + kstep, voffA); PG8_STAGE(PG8_SB(1, 1), cB + hstep + kstep, voffB);
        PG8_WAIT_V(6); PG8_BAR;
    }
    for (;;) {
        const bool has_next = S.next(ui + 1, nxt);
        const char* nA = has_next ? (const char*)g.A + (size_t)nxt.pm * tstep : cA; const char* nB = has_next ? (const char*)g.Bt + (size_t)nxt.pn * tstep : cB;
        for (int t = 0; t < nt; t += 2) {
            const bool last = (t == nt - 2);
            const char* a1 = cA + (size_t)(t + 1) * kstep;
            const char* a2 = last ? nA : cA + (size_t)(t + 2) * kstep; const char* b2 = last ? nB : cB + (size_t)(t + 2) * kstep;
            const char* a3 = a2 + kstep; const char* b3 = b2 + kstep;
            if (last && has_next) S.a_ready(nxt);
            if constexpr (SP2) {
            PG8_LDB(B0, 0, 0); PG8_LDB(B1, 0, 1); PG8_SCHED; PG8_LDA(At, 0, 0); PG8_STAGE(PG8_SA(1, 1), a1 + hstep, voffA);
            PG8_WAIT_V(8); PG8_WAIT_L(0); PG8_BAR; PG8_MMA(0, 0, At, B0); PG8_MMA(0, 1, At, B1); PG8_BAR; PG8_SCHED;
            PG8_LDA(At, 0, 1); PG8_STAGE(PG8_SB(0, 0), b2, voffB); PG8_STAGE(PG8_SB(0, 1), b2 + hstep, voffB); PG8_STAGE(PG8_SA(0, 0), a2, voffA);
            PG8_WAIT_V(8); PG8_WAIT_L(0); PG8_BAR; PG8_MMA(1, 0, At, B0); PG8_MMA(1, 1, At, B1); PG8_BAR; PG8_SCHED;
            PG8_LDB(B0, 1, 0); PG8_LDB(B1, 1, 1); PG8_SCHED; PG8_LDA(At, 1, 0); PG8_STAGE(PG8_SA(0, 1), a2 + hstep, voffA);
            PG8_WAIT_V(8); PG8_WAIT_L(0); PG8_BAR; PG8_MMA(0, 0, At, B0); PG8_MMA(0, 1, At, B1); PG8_BAR; PG8_SCHED;
            PG8_LDA(At, 1, 1); PG8_STAGE(PG8_SB(1, 0), b3, voffB); PG8_STAGE(PG8_SB(1, 1), b3 + hstep, voffB); PG8_STAGE(PG8_SA(1, 0), a3, voffA);
            PG8_WAIT_V(8); PG8_WAIT_L(0); PG8_BAR; PG8_MMA(1, 0, At, B0); PG8_MMA(1, 1, At, B1); PG8_BAR; PG8_SCHED;
            } else {
            PG8_LDB(B0, 0, 0); PG8_SCHED; PG8_LDA(At, 0, 0); PG8_STAGE(PG8_SA(1, 1), a1 + hstep, voffA);
            PG8_WAIT_L(8); PG8_BAR; PG8_WAIT_L(0); PG8_MMA(0, 0, At, B0); PG8_BAR; PG8_SCHED;
            PG8_LDB(B1, 0, 1); PG8_STAGE(PG8_SB(0, 0), b2, voffB);
            PG8_BAR; PG8_WAIT_L(0); PG8_MMA(0, 1, At, B1); PG8_BAR;
            PG8_LDA(At, 0, 1); PG8_STAGE(PG8_SA(0, 0), a2, voffA);
            PG8_BAR; PG8_WAIT_L(0); PG8_MMA(1, 0, At, B0); PG8_BAR; PG8_SCHED;
            PG8_STAGE(PG8_SB(0, 1), b2 + hstep, voffB);
            PG8_WAIT_V(6); PG8_BAR; PG8_MMA(1, 1, At, B1); PG8_BAR;
            PG8_LDB(B0, 1, 0); PG8_SCHED; PG8_LDA(At, 1, 0); PG8_STAGE(PG8_SA(0, 1), a2 + hstep, voffA);
            PG8_WAIT_L(8); PG8_BAR; PG8_WAIT_L(0); PG8_MMA(0, 0, At, B0); PG8_BAR; PG8_SCHED;
            PG8_LDB(B1, 1, 1); PG8_STAGE(PG8_SB(1, 0), b3, voffB);
            PG8_BAR; PG8_WAIT_L(0); PG8_MMA(0, 1, At, B1); PG8_BAR;
            PG8_LDA(At, 1, 1); PG8_STAGE(PG8_SA(1, 0), a3, voffA);
            PG8_BAR; PG8_WAIT_L(0); PG8_MMA(1, 0, At, B0); PG8_BAR; PG8_SCHED;
            PG8_STAGE(PG8_SB(1, 1), b3 + hstep, voffB);
            PG8_WAIT_V(6); PG8_BAR; PG8_MMA(1, 1, At, B1); PG8_BAR;
            }
        }
        if constexpr (ALIGN_EPI) { if (wr == 0) PG8_BAR; }
        if constexpr (!Epi::AFTER_DRAIN) { E(acc, cur, wr, wc, fr, fq); S.done(cur); }
        if (!has_next) break;
#pragma unroll
        for (int a = 0; a < 2; ++a)
#pragma unroll
            for (int b = 0; b < 2; ++b)
#pragma unroll
                for (int m = 0; m < 4; ++m)
#pragma unroll
                    for (int n = 0; n < 2; ++n) acc[a][b][m][n] = (f32x4){0.f, 0.f, 0.f, 0.f};
        cur = nxt; cA = nA; cB = nB; ++ui;
        if constexpr (ALIGN_EPI) { if (wr == 1) PG8_BAR; }
    }
    PG8_WAIT_V(0);
    if constexpr (!ALIGN_EPI) { if (wr == 0) PG8_BAR; }
    PG8_BAR;
    if constexpr (Epi::AFTER_DRAIN) { E.fused(acc, cur, wr, wc, fr, fq, lds, wid, lane); S.done(cur); }
#undef PG8_SA
#undef PG8_SB
#undef PG8_STAGE
#undef PG8_LDA
#undef PG8_LDB
#undef PG8_MMA
#undef PG8_WAIT_V
#undef PG8_WAIT_L
#undef PG8_BAR
#undef PG8_SCHED
}
}
#define XB_TMO      128
#define XB_XCNT(j)  (256  + 64 * (j))
#define XB_XSUB(j)  (1280 + 64 * (j))
#define XB_XGEN(j)  (2304 + 64 * (j))
#define XB_TOP      3328
#define XB_TOPGEN   3392
#define XCD_BAR_WORDS 3456
#define XB_SPIN_CAP (1u << 18)

__device__ __forceinline__ unsigned xb_ld(unsigned* p)              { return __hip_atomic_load(p, __ATOMIC_RELAXED, __HIP_MEMORY_SCOPE_AGENT); }
__device__ __forceinline__ unsigned xb_add(unsigned* p, unsigned v) { return __hip_atomic_fetch_add(p, v, __ATOMIC_RELAXED, __HIP_MEMORY_SCOPE_AGENT); }
__device__ __forceinline__ unsigned xb_xcc_id() { return (unsigned)__builtin_amdgcn_s_getreg((3 << 11) | 20) & 0xFu; }
#define XB_SPIN(cond, bar) do { unsigned _sp = 0; while (cond) { __builtin_amdgcn_s_sleep(1); \
    if ((++_sp & 255u) == 0u) { if (xb_ld(&(bar)[XB_TMO])) break; if (_sp > XB_SPIN_CAP) { atomicAdd(&(bar)[XB_TMO], 1u); break; } } } } while (0)

struct XcdBarrier {
    unsigned* bar; unsigned x;
    volatile LAS unsigned* st;
};

__device__ __forceinline__ XcdBarrier xcd_barrier_post(unsigned* bar, volatile LAS unsigned* st) {
    XcdBarrier b; b.bar = bar; b.x = xb_xcc_id(); b.st = st;
    if (threadIdx.x == 0) (void)xb_add(&bar[XB_XCNT(b.x)], 1u);
    return b;
}
__device__ __forceinline__ void xcd_barrier_complete(unsigned* bar, unsigned x, unsigned& nloc, unsigned& nx) {
    const unsigned G = gridDim.x * gridDim.y * gridDim.z;
    unsigned sum, cnt, mine, sp = 0u;
    for (;;) {
        sum = 0u; cnt = 0u; mine = 0u;
#pragma unroll
        for (unsigned j = 0; j < 16; ++j) { const unsigned c = xb_ld(&bar[XB_XCNT(j)]); sum += c; cnt += (c > 0u) ? 1u : 0u; mine = (j == x) ? c : mine; }
        if (sum == G) break;
        __builtin_amdgcn_s_sleep(1);
        if ((++sp & 255u) == 0u) { if (xb_ld(&bar[XB_TMO])) break; if (sp > XB_SPIN_CAP) { atomicAdd(&bar[XB_TMO], 1u); break; } }
    }
    nloc = mine > 0u ? mine : 1u; nx = cnt > 0u ? cnt : 1u;
}

__device__ __forceinline__ void xcd_barrier(const XcdBarrier& b) {
    asm volatile("s_waitcnt vmcnt(0)" ::: "memory");
    __syncthreads();
    if (threadIdx.x == 0) {
        unsigned* bar = b.bar;
        __builtin_amdgcn_s_waitcnt(0);
        unsigned nloc = b.st[0], nx = b.st[1];
        if (nloc == 0u) { xcd_barrier_complete(bar, b.x, nloc, nx); b.st[0] = nloc; b.st[1] = nx; }
        const unsigned old = xb_add(&bar[XB_XSUB(b.x)], 1u);
        const unsigned gen = old / nloc;
        if (old + 1u == (gen + 1u) * nloc) {
            __builtin_amdgcn_fence(__ATOMIC_RELEASE, "agent");
            asm volatile("s_waitcnt vmcnt(0)" ::: "memory");
            const unsigned og = xb_add(&bar[XB_TOP], 1u);
            const unsigned tg = og / nx;
            if (og + 1u == (tg + 1u) * nx) xb_add(&bar[XB_TOPGEN], 1u);
            else XB_SPIN(xb_ld(&bar[XB_TOPGEN]) == tg, bar);
            __builtin_amdgcn_fence(__ATOMIC_ACQUIRE, "agent");
            xb_add(&bar[XB_XGEN(b.x)], 1u);
            asm volatile("s_waitcnt vmcnt(0)" ::: "memory");
        } else {
            XB_SPIN(xb_ld(&bar[XB_XGEN(b.x)]) == gen, bar);
            __builtin_amdgcn_fence(__ATOMIC_ACQUIRE, "agent");
            asm volatile("s_waitcnt vmcnt(0)" ::: "memory");
        }
    }
    __syncthreads();
}
struct Args { const void* in[31]; float* out; unsigned char* ws; int ph_lo, ph_hi, li, pad; };
struct Frame {
    LAS unsigned char* lds; volatile LAS unsigned* MISC; gu32* ctl;
    int tid, lane, wave, vcu, G;
    unsigned char* ws; float* out;
};
__device__ __forceinline__ float wave_sum_f(float v) {
#pragma unroll
    for (int o = 1; o < 64; o <<= 1) v += __shfl_xor(v, o);
    return v;
}
__device__ __forceinline__ void p0_transpose_item(const float* W, int K, int N, bf16_t* WT, int row_off, LAS float* scr, int kb, int nb, int lane) {
    const int k0 = 64 * kb, n0 = 32 * nb;
#pragma unroll 8
    for (int i = 0; i < 32; ++i) { const int kk = 2 * i + (lane >> 5); scr[kk * 33 + (lane & 31)] = W[(size_t)(k0 + kk) * N + n0 + (lane & 31)]; }
    LDS_WAIT(); asm volatile("" ::: "memory");
    const int c = lane & 7;
#pragma unroll
    for (int j = 0; j < 4; ++j) { const int n = (lane >> 3) + 8 * j; const LAS float* s = scr + (8 * c) * 33 + n;
        v4u o; o.x = pk2(s[0 * 33], s[1 * 33]); o.y = pk2(s[2 * 33], s[3 * 33]); o.z = pk2(s[4 * 33], s[5 * 33]); o.w = pk2(s[6 * 33], s[7 * 33]);
        *(GAS v4u*)(WT + (size_t)(row_off + n0 + n) * K + k0 + 8 * c) = o; }
    LDS_WAIT(); asm volatile("" ::: "memory");
}
__device__ __forceinline__ int lru_chan(int ks, int hi, int j) { return 32 * (ks >> 1) + 16 * (ks & 1) + 8 * (j >> 2) + 4 * hi + (j & 3); }
__device__ __forceinline__ void phase_prologue(Frame& F, const Inputs& I) {
    if (blockIdx.x < 192) {
        LAS float* sl = (LAS float*)F.lds; LAS float* red = sl + 4096;
        for (int i = ((int)threadIdx.x); i < 4096; i += 512) { const float v = I.c[i]; sl[i] = v / (1.f + __expf(-v)); }
        __syncthreads();
        const int col0 = blockIdx.x * 32, kg = ((int)threadIdx.x) >> 5, col = ((int)threadIdx.x) & 31;
        float a0 = 0.f, a1 = 0.f, a2 = 0.f, a3 = 0.f;
#pragma unroll 8
        for (int i = 0; i < 64; ++i) { const int k = kg + 16 * i; const float w = I.w_ada[(size_t)k * MODW + col0 + col];
            a0 += sl[k] * w; a1 += sl[1024 + k] * w; a2 += sl[2048 + k] * w; a3 += sl[3072 + k] * w; }
        red[(kg * 4 + 0) * 32 + col] = a0; red[(kg * 4 + 1) * 32 + col] = a1; red[(kg * 4 + 2) * 32 + col] = a2; red[(kg * 4 + 3) * 32 + col] = a3;
        __syncthreads();
        if (((int)threadIdx.x) < 128) { const int b = ((int)threadIdx.x) >> 5, c = ((int)threadIdx.x) & 31; float s = I.b_ada[col0 + c];
            for (int g = 0; g < 16; ++g) s += red[(g * 4 + b) * 32 + c];
            ((float*)(F.ws + WS_MOD))[b * MODW + col0 + c] = s; }
        __syncthreads();
    }
    {
        LAS float* scr = (LAS float*)(F.lds + F.wave * 16384);
        const int gw = F.vcu * NWAVES + F.wave, NGW = F.G * NWAVES;
        bf16_t* WIN = (bf16_t*)(F.ws + WSX_WIN); bf16_t* WOUT = (bf16_t*)(F.ws + WSX_WOUT); bf16_t* W1T = (bf16_t*)(F.ws + WSX_W1T); bf16_t* W2T = (bf16_t*)(F.ws + WSX_W2T);
        constexpr int I_IN = 16 * 46, I_OUT = 16 * 32, I_G = 32 * 16 * 8, I_D = 32 * 4 * 32, NIT = I_IN + I_OUT + 2 * I_G + I_D;
        for (int it = gw; it < NIT; it += NGW) {
            int r = it;
            if (r < I_IN) { p0_transpose_item(I.w_in, 1024, NPROJ, WIN, 0, scr, r / 46, r % 46, ((int)(threadIdx.x & 63))); continue; } r -= I_IN;
            if (r < I_OUT) { p0_transpose_item(I.w_out, 1024, 1024, WOUT, 0, scr, r / 32, r % 32, ((int)(threadIdx.x & 63))); continue; } r -= I_OUT;
            if (r < 2 * I_G) { const int up = r >= I_G ? 1 : 0; if (up) r -= I_G; const int e = r >> 7, kb = (r >> 3) & 15, nb = r & 7, n0 = 32 * nb;
                p0_transpose_item((up ? I.w_up : I.w_gate) + (size_t)e * 1024 * 256, 1024, 256, W1T, e * 512 + (n0 >> 7) * 256 + (n0 & 127) - n0 + up * 128, scr, kb, nb, ((int)(threadIdx.x & 63))); continue; } r -= 2 * I_G;
            { const int e = r >> 7, kb = (r >> 5) & 3, nb = r & 31; p0_transpose_item(I.w_down + (size_t)e * 256 * 1024, 256, 1024, W2T, e * 1024, scr, kb, nb, ((int)(threadIdx.x & 63))); }
        }
    }
    {
        const int gt = blockIdx.x * 512 + ((int)threadIdx.x), NGT = F.G * 512;
        v4u* WQF = (v4u*)(F.ws + WSX_WQF); v4u* WKVF = (v4u*)(F.ws + WSX_WKVF); v4u* WAF = (v4u*)(F.ws + WSX_WAF); v4u* WXF = (v4u*)(F.ws + WSX_WXF); v4u* WRF = (v4u*)(F.ws + WSX_WRF);
        constexpr int NQ = 4 * 6 * 16 * 64, NKV = 4 * 8 * 8 * 64, NA = 4 * 4 * 8 * 64, NR = 2 * 64 * 64, NZ = 64 * 1024 / 8, NTOT = NQ + NKV + 2 * NA + NR + NZ;
        for (int g = gt; g < NTOT; g += NGT) {
            int r = g; float v[8];
            if (r < NQ) { const int lane = r & 63, ks = (r >> 6) & 15, hn = r >> 10, h = hn / 6, nb = hn % 6, hi = lane >> 5, r32 = lane & 31;
#pragma unroll
                for (int j = 0; j < 8; ++j) { const int k = 16 * ks + 8 * hi + j; v[j] = I.w_q_b[(size_t)k * 768 + h * 192 + 32 * nb + r32] * I.q_a_norm[k]; }
                WQF[r] = (v4u){pk2(v[0], v[1]), pk2(v[2], v[3]), pk2(v[4], v[5]), pk2(v[6], v[7])}; continue; } r -= NQ;
            if (r < NKV) { const int lane = r & 63, ks = (r >> 6) & 7, hn = r >> 9, h = hn >> 3, nb = hn & 7, hi = lane >> 5, r32 = lane & 31;
#pragma unroll
                for (int j = 0; j < 8; ++j) { const int k = 16 * ks + 8 * hi + j; v[j] = I.w_kv_b[(size_t)k * 1024 + h * 256 + 32 * nb + r32] * I.kv_a_norm[k]; }
                WKVF[r] = (v4u){pk2(v[0], v[1]), pk2(v[2], v[3]), pk2(v[4], v[5]), pk2(v[6], v[7])}; continue; } r -= NKV;
            if (r < 2 * NA) { const int x = r >= NA ? 1 : 0; if (x) r -= NA; const int lane = r & 63, ks = (r >> 6) & 7, hn = r >> 9, h = hn >> 2, nb = hn & 3, hi = lane >> 5, r32 = lane & 31;
                const float* W = x ? I.lru_wx : I.lru_wa;
#pragma unroll
                for (int j = 0; j < 8; ++j) v[j] = W[(size_t)(h * 128 + lru_chan(ks, hi, j)) * 128 + 32 * nb + r32];
                (x ? WXF : WAF)[r] = (v4u){pk2(v[0], v[1]), pk2(v[2], v[3]), pk2(v[4], v[5]), pk2(v[6], v[7])}; continue; } r -= 2 * NA;
            if (r < NR) { const int lane = r & 63, ks = (r >> 6) & 63, nb = r >> 12, hi = lane >> 5, n = 32 * nb + (lane & 31);
#pragma unroll
                for (int j = 0; j < 8; ++j) { const int k = 16 * ks + 8 * hi + j; v[j] = n < 4 ? I.w_rg[k * 4 + n] : (n < 36 ? I.w_re[k * 32 + n - 4] : 0.f); }
                WRF[r] = (v4u){pk2(v[0], v[1]), pk2(v[2], v[3]), pk2(v[4], v[5]), pk2(v[6], v[7])}; continue; } r -= NR;
            ((v4u*)(F.ws + WSX_WIN + (size_t)NPROJ * 1024 * 2))[r] = (v4u){0u, 0u, 0u, 0u};
        }
        if (gt < 512) ((float*)(F.ws + WSX_SP))[gt] = log1pf(__expf(-I.lru_lambda[gt]));
        float* CS = (float*)(F.ws + WSX_CS);
        for (int g = gt; g < NTOK * 32; g += NGT) { const int t = g >> 5, i = g & 31; float c, s; rope_cs(I.positions[t], i, c, s); CS[t * 64 + i] = c; CS[t * 64 + 32 + i] = s; }
    }
}
__device__ __forceinline__ void phase_xn(Frame& F, const Inputs& I) {
    LAS float* Gs = (LAS float*)F.lds; LAS float* Ss = Gs + 4096;
    const float* mod = (const float*)(F.ws + WS_MOD);
#pragma unroll
    for (int i = ((int)threadIdx.x); i < 4096; i += 512) { const int b = i >> 10, k = i & 1023; Gs[i] = I.norm1_g[k] * (1.f + mod[b * MODW + 1024 + k]); Ss[i] = mod[b * MODW + k]; }
    __syncthreads();
    bf16_t* XN = (bf16_t*)(F.ws + WSX_A);
    const int gw = F.vcu * NWAVES + F.wave, NGW = F.G * NWAVES;
    for (int m0 = gw; m0 < NTOK; m0 += 2 * NGW) {
        f32x4 v[2][4];
#pragma unroll
        for (int u = 0; u < 2; ++u) { const GAS f32x4* xr = (const GAS f32x4*)(I.x + (size_t)(m0 + u * NGW) * DM) + ((int)(threadIdx.x & 63));
#pragma unroll
            for (int j = 0; j < 4; ++j) v[u][j] = xr[64 * j]; }
#pragma unroll
        for (int u = 0; u < 2; ++u) { const int m = m0 + u * NGW, b = m >> 13; float s = 0.f;
#pragma unroll
            for (int j = 0; j < 4; ++j) s += (v[u][j].x * v[u][j].x + v[u][j].y * v[u][j].y) + (v[u][j].z * v[u][j].z + v[u][j].w * v[u][j].w);
            const float rstd = rsqrtf(wave_sum_f(s) * (1.f / DM) + EPS);
            GAS v2u* o8 = (GAS v2u*)(XN + (size_t)m * DM) + ((int)(threadIdx.x & 63));
#pragma unroll
            for (int j = 0; j < 4; ++j) { const f32x4 g = *(const LAS f32x4*)(Gs + b * 1024 + 256 * j + 4 * ((int)(threadIdx.x & 63))), sh = *(const LAS f32x4*)(Ss + b * 1024 + 256 * j + 4 * ((int)(threadIdx.x & 63)));
                const f32x4 o = v[u][j] * rstd * g + sh; o8[64 * j] = (v2u){pk2(o.x, o.y), pk2(o.z, o.w)}; } }
    }
    __syncthreads();
}
namespace att {
constexpr int NW = 8, QBLK = 32, KVBLK = 64, QB = NW * QBLK;
constexpr int DQ = 192, DVV = 128, OPITCH = 512;
constexpr int SHM_V = KVBLK * DVV * 2, SHM_K = KVBLK * DQ * 2;
constexpr int ATT_LDS = 3 * SHM_V + 3 * SHM_K + NW * 64 * 4;
constexpr float SCALE = 0.07216878364870322f;
constexpr float QPRE = 0.07216878364870322f * 1.4426950408889634f;
constexpr float THR = 8.f * 1.4426950408889634f;
constexpr float FAST_BOUND = 64.f;
#define SBAR() __builtin_amdgcn_sched_barrier(0)
__device__ __forceinline__ int koff(int row, int chunk) { return (chunk >> 3) * 8192 + row * 128 + ((((chunk & 7) ^ ((row >> 1) & 7))) << 4); }
__device__ __forceinline__ int v_st(int k, int c) { const int kk = (k & ~0xC) | ((k & 4) << 1) | ((k & 8) >> 1); return ((kk >> 3) * 4 + (c >> 5)) * 512 + ((kk & 7) * 32 + (c & 31)) * 2; }
__device__ __forceinline__ int v_rd_base(int lane) { return ((lane & 3) << 3) | (((lane >> 2) & 3) << 6) | (((lane >> 4) & 1) << 5) | (((lane >> 5) & 1) << 8); }
constexpr int v_rd_off(int d0, int ks, int half) { return d0 * 512 + ks * 4096 + half * 2048; }
__device__ __forceinline__ int crow(int r, int hi) { return (r & 3) + 8 * (r >> 2) + 4 * hi; }
__device__ __forceinline__ bf16x8 ld8(const bf16_t* p) { return *reinterpret_cast<const bf16x8*>(p); }
__device__ __forceinline__ void mask_tile(f32x16& p0, f32x16& p1, int dq) {
    const float NEG = -__builtin_inff();
#pragma unroll
    for (int r = 0; r < 16; ++r) { const int c = (r & 3) + 8 * (r >> 2); if (dq - c < 0) p0[r] = NEG; if (dq - c - 32 < 0) p1[r] = NEG; }
}
template <int KB>
__device__ __forceinline__ void qkt(f32x16& p0, f32x16& p1, const char* K_lds, int r32, int hi, const bf16x8* qr) {
    p0 = f32x16{}; p1 = f32x16{};
    const char* kb[4];
#pragma unroll
    for (int dd = 0; dd < 4; ++dd) kb[dd] = K_lds + KB * SHM_K + koff(r32, 2 * dd + hi);
    bf16x8 kf[2][2];
#define KLD(d) do { const char* a_ = kb[(d) & 3] + ((d) >> 2) * 8192; kf[(d) & 1][0] = *reinterpret_cast<const bf16x8*>(a_); kf[(d) & 1][1] = *reinterpret_cast<const bf16x8*>(a_ + 32 * 128); } while (0)
    KLD(0);
#pragma unroll
    for (int d0 = 0; d0 < 12; ++d0) { if (d0 + 1 < 12) KLD(d0 + 1);
        p0 = __builtin_amdgcn_mfma_f32_32x32x16_bf16(kf[d0 & 1][0], qr[d0], p0, 0, 0, 0);
        p1 = __builtin_amdgcn_mfma_f32_32x32x16_bf16(kf[d0 & 1][1], qr[d0], p1, 0, 0, 0); }
#undef KLD
    __builtin_amdgcn_sched_group_barrier(0x100, 2, 0);
#pragma unroll
    for (int d0 = 0; d0 < 11; ++d0) { __builtin_amdgcn_sched_group_barrier(0x100, 2, 0); __builtin_amdgcn_sched_group_barrier(0x8, 2, 0); }
    __builtin_amdgcn_sched_group_barrier(0x8, 2, 0);
}
template <int VB>
__device__ __forceinline__ void pv_tile(f32x16* o, int vb0, bf16x8 pa0, bf16x8 pa1, bf16x8 pa2, bf16x8 pa3) {
    s16x4 lo[2][4], hv[2][4];
#define TRRD(dst, off) asm volatile("ds_read_b64_tr_b16 %0, %1 offset:%2" : "=&v"(dst) : "v"(vb0), "i"(off) : "memory")
#define VLD(d) do { TRRD(lo[(d) & 1][0], VB * SHM_V + v_rd_off((d), 0, 0)); TRRD(hv[(d) & 1][0], VB * SHM_V + v_rd_off((d), 0, 1)); TRRD(lo[(d) & 1][1], VB * SHM_V + v_rd_off((d), 1, 0)); TRRD(hv[(d) & 1][1], VB * SHM_V + v_rd_off((d), 1, 1)); \
        TRRD(lo[(d) & 1][2], VB * SHM_V + v_rd_off((d), 2, 0)); TRRD(hv[(d) & 1][2], VB * SHM_V + v_rd_off((d), 2, 1)); TRRD(lo[(d) & 1][3], VB * SHM_V + v_rd_off((d), 3, 0)); TRRD(hv[(d) & 1][3], VB * SHM_V + v_rd_off((d), 3, 1)); } while (0)
#define VF(d, k) (bf16x8){lo[(d) & 1][k][0], lo[(d) & 1][k][1], lo[(d) & 1][k][2], lo[(d) & 1][k][3], hv[(d) & 1][k][0], hv[(d) & 1][k][1], hv[(d) & 1][k][2], hv[(d) & 1][k][3]}
#define PVM(d) do { o[d] = __builtin_amdgcn_mfma_f32_32x32x16_bf16(pa0, VF(d, 0), o[d], 0, 0, 0); o[d] = __builtin_amdgcn_mfma_f32_32x32x16_bf16(pa1, VF(d, 1), o[d], 0, 0, 0); \
        o[d] = __builtin_amdgcn_mfma_f32_32x32x16_bf16(pa2, VF(d, 2), o[d], 0, 0, 0); o[d] = __builtin_amdgcn_mfma_f32_32x32x16_bf16(pa3, VF(d, 3), o[d], 0, 0, 0); } while (0)
    asm volatile("s_waitcnt lgkmcnt(0)" ::: "memory");
    VLD(0); VLD(1); asm volatile("s_waitcnt lgkmcnt(8)" ::: "memory"); SBAR(); PVM(0); SBAR();
    VLD(2); asm volatile("s_waitcnt lgkmcnt(8)" ::: "memory"); SBAR(); PVM(1); SBAR();
    VLD(3); asm volatile("s_waitcnt lgkmcnt(8)" ::: "memory"); SBAR(); PVM(2); SBAR();
    asm volatile("s_waitcnt lgkmcnt(0)" ::: "memory"); SBAR(); PVM(3);
#undef PVM
#undef VF
#undef VLD
#undef TRRD
}
template <bool DOPV, bool FAST>
__device__ __forceinline__ void pv_sm(f32x16* o, int vb0, bf16x8 pa0, bf16x8 pa1, bf16x8 pa2, bf16x8 pa3, f32x16& p0, f32x16& p1, float& m_reg, float& al_out) {
    s16x4 lo[2][4], hv[2][4];
#define TRRD(dst, off) asm volatile("ds_read_b64_tr_b16 %0, %1 offset:%2" : "=&v"(dst) : "v"(vb0), "i"(off) : "memory")
#define VLD(d) do { if (DOPV) { TRRD(lo[(d) & 1][0], v_rd_off((d), 0, 0)); TRRD(hv[(d) & 1][0], v_rd_off((d), 0, 1)); TRRD(lo[(d) & 1][1], v_rd_off((d), 1, 0)); TRRD(hv[(d) & 1][1], v_rd_off((d), 1, 1)); \
        TRRD(lo[(d) & 1][2], v_rd_off((d), 2, 0)); TRRD(hv[(d) & 1][2], v_rd_off((d), 2, 1)); TRRD(lo[(d) & 1][3], v_rd_off((d), 3, 0)); TRRD(hv[(d) & 1][3], v_rd_off((d), 3, 1)); } } while (0)
#define VF(d, k) (bf16x8){lo[(d) & 1][k][0], lo[(d) & 1][k][1], lo[(d) & 1][k][2], lo[(d) & 1][k][3], hv[(d) & 1][k][0], hv[(d) & 1][k][1], hv[(d) & 1][k][2], hv[(d) & 1][k][3]}
#define MM(d, k, PA) do { if (DOPV) o[d] = __builtin_amdgcn_mfma_f32_32x32x16_bf16(PA, VF(d, k), o[d], 0, 0, 0); SBAR(); } while (0)
#define LW(N) do { if (DOPV) asm volatile("s_waitcnt lgkmcnt(" #N ")" ::: "memory"); SBAR(); } while (0)
#define MX3(a, b, c) __builtin_fmaxf(__builtin_fmaxf((a), (b)), (c))
#define FM4(P, B) do { P[B] += mnL; P[B + 1] += mnL; P[B + 2] += mnL; P[B + 3] += mnL; } while (0)
#define EX2(P, B) do { P[B] = __builtin_amdgcn_exp2f(P[B]); P[B + 1] = __builtin_amdgcn_exp2f(P[B + 1]); } while (0)
    if constexpr (FAST) {
        LW(0); VLD(0); VLD(1); LW(8);
        MM(0, 0, pa0); EX2(p0, 0); SBAR();
        MM(0, 1, pa1); EX2(p0, 2); SBAR();
        MM(0, 2, pa2); EX2(p0, 4); SBAR();
        MM(0, 3, pa3); EX2(p0, 6); SBAR();
        VLD(2); LW(8);
        MM(1, 0, pa0); EX2(p0, 8); SBAR();
        MM(1, 1, pa1); EX2(p0, 10); SBAR();
        MM(1, 2, pa2); EX2(p0, 12); SBAR();
        MM(1, 3, pa3); EX2(p0, 14); SBAR();
        VLD(3); LW(8);
        MM(2, 0, pa0); EX2(p1, 0); SBAR();
        MM(2, 1, pa1); EX2(p1, 2); SBAR();
        MM(2, 2, pa2); EX2(p1, 4); SBAR();
        MM(2, 3, pa3); EX2(p1, 6); SBAR();
        LW(0);
        MM(3, 0, pa0); EX2(p1, 8); SBAR();
        MM(3, 1, pa1); EX2(p1, 10); SBAR();
        MM(3, 2, pa2); EX2(p1, 12); SBAR();
        MM(3, 3, pa3); EX2(p1, 14); SBAR();
    } else {
    float mx, mn, mnL, al;
    LW(0); VLD(0); VLD(1); LW(8);
    MM(0, 0, pa0); mx = MX3(p0[0], p0[1], p0[2]); mx = MX3(mx, p0[3], p0[4]); mx = MX3(mx, p0[5], p0[6]); mx = MX3(mx, p0[7], p0[8]); SBAR();
    MM(0, 1, pa1); mx = MX3(mx, p0[9], p0[10]); mx = MX3(mx, p0[11], p0[12]); mx = MX3(mx, p0[13], p0[14]); mx = MX3(mx, p0[15], p1[0]); SBAR();
    MM(0, 2, pa2); mx = MX3(mx, p1[1], p1[2]); mx = MX3(mx, p1[3], p1[4]); mx = MX3(mx, p1[5], p1[6]); mx = MX3(mx, p1[7], p1[8]); SBAR();
    MM(0, 3, pa3); mx = MX3(mx, p1[9], p1[10]); mx = MX3(mx, p1[11], p1[12]); mx = MX3(mx, p1[13], p1[14]); mx = __builtin_fmaxf(mx, p1[15]); SBAR();
    VLD(2); LW(8);
    MM(1, 0, pa0); { auto rr = __builtin_amdgcn_permlane32_swap(__float_as_uint(mx), __float_as_uint(mx), false, false); mx = __builtin_fmaxf(__uint_as_float(rr[0]), __uint_as_float(rr[1])); }
        { const bool keep = __all(mx - m_reg <= THR); mn = keep ? m_reg : __builtin_fmaxf(m_reg, mx); al = __builtin_amdgcn_exp2f(m_reg - mn); m_reg = mn; mnL = -mn; } SBAR();
    MM(1, 1, pa1); FM4(p0, 0); FM4(p0, 4); SBAR();
    MM(1, 2, pa2); FM4(p0, 8); FM4(p0, 12); SBAR();
    MM(1, 3, pa3); FM4(p1, 0); FM4(p1, 4); SBAR();
    VLD(3); LW(8);
    MM(2, 0, pa0); FM4(p1, 8); FM4(p1, 12); SBAR();
    MM(2, 1, pa1); EX2(p0, 0); EX2(p0, 2); SBAR();
    MM(2, 2, pa2); EX2(p0, 4); EX2(p0, 6); SBAR();
    MM(2, 3, pa3); EX2(p0, 8); EX2(p0, 10); SBAR();
    LW(0);
    MM(3, 0, pa0); EX2(p0, 12); EX2(p0, 14); SBAR();
    MM(3, 1, pa1); EX2(p1, 0); EX2(p1, 2); SBAR();
    MM(3, 2, pa2); EX2(p1, 4); EX2(p1, 6); SBAR();
    MM(3, 3, pa3); EX2(p1, 8); EX2(p1, 10); SBAR();
    al_out = al;
    }
#undef EX2
#undef FM4
#undef MX3
#undef LW
#undef MM
#undef VF
#undef VLD
#undef TRRD
}
template <bool FAST>
__device__ __forceinline__ void qkt_fin(f32x16& n0, f32x16& n1, const char* Kslot, int r32, int hi, const bf16x8* qr, f32x16& p0, f32x16& p1, bf16x8& pa0, bf16x8& pa1, bf16x8& pa2, bf16x8& pa3, float& l_reg, float al) {
    n0 = f32x16{}; n1 = f32x16{};
    const char* kb[4];
#pragma unroll
    for (int dd = 0; dd < 4; ++dd) kb[dd] = Kslot + koff(r32, 2 * dd + hi);
    bf16x8 kf[2][2];
#define KLD(d) do { const char* a_ = kb[(d) & 3] + ((d) >> 2) * 8192; kf[(d) & 1][0] = *reinterpret_cast<const bf16x8*>(a_); kf[(d) & 1][1] = *reinterpret_cast<const bf16x8*>(a_ + 32 * 128); } while (0)
#define QM(d) do { if ((d) + 1 < 12) KLD((d) + 1); n0 = __builtin_amdgcn_mfma_f32_32x32x16_bf16(kf[(d) & 1][0], qr[d], n0, 0, 0, 0); n1 = __builtin_amdgcn_mfma_f32_32x32x16_bf16(kf[(d) & 1][1], qr[d], n1, 0, 0, 0); SBAR(); } while (0)
#define PK4(P, B_, OUT) do { unsigned a0 = cvtpk(P[B_+0], P[B_+1]), a1 = cvtpk(P[B_+2], P[B_+3]); unsigned b0 = cvtpk(P[B_+4], P[B_+5]), b1 = cvtpk(P[B_+6], P[B_+7]); \
        auto r0 = __builtin_amdgcn_permlane32_swap(a0, b0, false, false); auto r1 = __builtin_amdgcn_permlane32_swap(a1, b1, false, false); \
        v4u w = {r0[0], r1[0], r0[1], r1[1]}; OUT = *reinterpret_cast<bf16x8*>(&w); } while (0)
#define DOT4(PA) do { const v4u w_ = *reinterpret_cast<const v4u*>(&PA); asm("v_dot2c_f32_bf16 %0, %2, %1" : "+v"(l_reg) : "v"(w_.x), "i"(0x3F803F80)); asm("v_dot2c_f32_bf16 %0, %2, %1" : "+v"(l_reg) : "v"(w_.y), "i"(0x3F803F80)); \
        asm("v_dot2c_f32_bf16 %0, %2, %1" : "+v"(l_reg) : "v"(w_.z), "i"(0x3F803F80)); asm("v_dot2c_f32_bf16 %0, %2, %1" : "+v"(l_reg) : "v"(w_.w), "i"(0x3F803F80)); } while (0)
    if constexpr (FAST) {
        KLD(0); SBAR();
        QM(0); PK4(p0, 0, pa0); SBAR();
        QM(1); DOT4(pa0); SBAR();
        QM(2); PK4(p0, 8, pa1); SBAR();
        QM(3); DOT4(pa1); SBAR();
        QM(4); PK4(p1, 0, pa2); SBAR();
        QM(5); DOT4(pa2); SBAR();
        QM(6); PK4(p1, 8, pa3); SBAR();
        QM(7); DOT4(pa3); SBAR();
        QM(8); QM(9); QM(10); QM(11);
    } else {
    float ps;
    KLD(0); SBAR();
    QM(0); p1[12] = __builtin_amdgcn_exp2f(p1[12]); p1[13] = __builtin_amdgcn_exp2f(p1[13]); p1[14] = __builtin_amdgcn_exp2f(p1[14]); p1[15] = __builtin_amdgcn_exp2f(p1[15]); SBAR();
    QM(1); ps = (p0[0] + p0[1]) + (p0[2] + p0[3]); ps += (p0[4] + p0[5]) + (p0[6] + p0[7]); SBAR();
    QM(2); ps += (p0[8] + p0[9]) + (p0[10] + p0[11]); ps += (p0[12] + p0[13]) + (p0[14] + p0[15]); SBAR();
    QM(3); ps += (p1[0] + p1[1]) + (p1[2] + p1[3]); ps += (p1[4] + p1[5]) + (p1[6] + p1[7]); SBAR();
    QM(4); ps += (p1[8] + p1[9]) + (p1[10] + p1[11]); ps += (p1[12] + p1[13]) + (p1[14] + p1[15]); SBAR();
    QM(5); { auto rr = __builtin_amdgcn_permlane32_swap(__float_as_uint(ps), __float_as_uint(ps), false, false); ps = __uint_as_float(rr[0]) + __uint_as_float(rr[1]); } l_reg = l_reg * al + ps; SBAR();
    QM(6); PK4(p0, 0, pa0); SBAR();
    QM(7); PK4(p0, 8, pa1); SBAR();
    QM(8); PK4(p1, 0, pa2); SBAR();
    QM(9); PK4(p1, 8, pa3); SBAR();
    QM(10); QM(11);
    }
#undef DOT4
#undef PK4
#undef QM
#undef KLD
}
__device__ __forceinline__ int kperm(int l) { return ((l & 7) << 1) | ((l >> 3) & 1) | (l & 48); }
__device__ __forceinline__ int kpiece(int tid) { return (tid >> 6) * 64 + kperm(tid & 63); }
__device__ __forceinline__ int vpiece(int tid, int i) { const int l = tid & 63, w = tid >> 6; return (4 * (w & 3) + (l & 3)) * 64 + (l >> 2) + 16 * ((w >> 2) + 2 * i); }
struct BlockRef { const bf16_t* Q; const bf16_t* K; const bf16_t* V; bf16_t* O; int P0; };
#define VMW() asm volatile("s_waitcnt vmcnt(0)" ::: "memory")
__device__ __forceinline__ void dma16(const void* gsrc, char* ldst) { __builtin_amdgcn_global_load_lds((const unsigned*)gsrc, (__attribute__((address_space(3))) unsigned*)(uintptr_t)ldst, 16, 0, 0); }
#define WAITBAR(N) asm volatile("s_waitcnt vmcnt(" #N ") lgkmcnt(0)\n\ts_barrier" ::: "memory")
template <bool FAST>
__device__ __forceinline__ void attn_block(const BlockRef& cur, char* lds) {
    int tid_ = threadIdx.x; asm volatile("" : "+v"(tid_));
    const int tid = tid_, wid = __builtin_amdgcn_readfirstlane(tid >> 6), lane = tid & 63, r32 = lane & 31, hi = lane >> 5;
    const int NT = (cur.P0 + QB - 1) / KVBLK + 1;
    const int qlo = cur.P0 + wid * QBLK;
    char* V_lds = lds; char* K_lds = lds + 3 * SHM_V;
    float* ws = (float*)(lds + 3 * SHM_V + 3 * SHM_K) + wid * 64; float* li_l = ws, * al_l = ws + 32;
    float m_reg = -1e30f, l_reg = 0; f32x16 o[4] = {};
    const int krow = 8 * wid + (lane >> 3), ksx = (lane & 7) ^ ((krow >> 1) & 7), ksrc = (ksx * 64 + krow) * 8;
    int vsrc[2];
#pragma unroll
    for (int i = 0; i < 2; ++i) { const int st = 2 * (wid + 8 * i) + (lane >> 5), kk = (st >> 2) * 8 + ((lane & 31) >> 2), c = (st & 3) * 32 + (lane & 3) * 8;
        const int k = (kk & ~0xC) | ((kk & 4) << 1) | ((kk & 8) >> 1); vsrc[i] = ((c >> 3) * 64 + k) * 8; }
    const int vbase = (int)(uintptr_t)V_lds;
    const bf16_t* Kh = cur.K; const bf16_t* Vh = cur.V;
#define DMA_K(t, slot) do { const bf16_t* kt_ = Kh + (size_t)(t) * KVBLK * DQ + ksrc; char* kd_ = K_lds + (slot) * SHM_K + wid * 1024; \
        dma16(kt_, kd_); dma16(kt_ + 4096, kd_ + 8192); dma16(kt_ + 8192, kd_ + 16384); } while (0)
#define DMA_V(t, slot) do { const bf16_t* vt_ = Vh + (size_t)(t) * KVBLK * DVV; char* vd_ = V_lds + (slot) * SHM_V + wid * 1024; dma16(vt_ + vsrc[0], vd_); dma16(vt_ + vsrc[1], vd_ + 8192); } while (0)
    bf16x8 qr[12], pa0, pa1, pa2, pa3; f32x16 p0, p1;
#pragma unroll
    for (int d0 = 0; d0 < 12; ++d0) qr[d0] = ld8(cur.Q + (size_t)wid * QBLK * DQ + (2 * d0 + hi) * 256 + r32 * 8);
    DMA_K(0, 0); DMA_K(1, 1); DMA_V(0, 0);
    WAITBAR(0);
    int s0 = 0, s1 = 1, s2 = 2;
    f32x16 q0, q1; float alp = 1.f;
#define RESC(a) do { if (__any((a) < 1.f)) { asm volatile("" ::: "memory"); if (hi == 0) al_l[r32] = (a); asm volatile("s_waitcnt lgkmcnt(0)" ::: "memory"); \
        _Pragma("unroll") for (int d_ = 0; d_ < 4; ++d_) _Pragma("unroll") for (int r = 0; r < 16; ++r) o[d_][r] *= al_l[crow(r, hi)]; } } while (0)
#define ROT3() do { const int tmp = s0; s0 = s1; s1 = s2; s2 = tmp; } while (0)
    {
        DMA_K(2, s2); DMA_V(1, s1);
        SBAR(); qkt<0>(p0, p1, K_lds + s0 * SHM_K, r32, hi, qr); SBAR();
        if (KVBLK - 1 > qlo) { asm volatile("" ::: "memory"); mask_tile(p0, p1, qlo + r32 - 4 * hi); }
        pv_sm<false, FAST>(o, 0, pa0, pa1, pa2, pa3, p0, p1, m_reg, alp);
        WAITBAR(5); ROT3(); }
#define STEP(t, N0, N1, O0, O1) do { \
        if ((t) + 2 < NT) DMA_K((t) + 2, s2); \
        if ((t) + 1 < NT) DMA_V((t) + 1, s1); \
        SBAR(); qkt_fin<FAST>(N0, N1, K_lds + s0 * SHM_K, r32, hi, qr, O0, O1, pa0, pa1, pa2, pa3, l_reg, alp); SBAR(); \
        { const int kb_ = (t) * KVBLK; if (kb_ + KVBLK - 1 > qlo) { asm volatile("" ::: "memory"); mask_tile(N0, N1, qlo + r32 - 4 * hi - kb_); } } \
        { int ll = tid; asm volatile("" : "+v"(ll)); pv_sm<true, FAST>(o, vbase + v_rd_base(ll & 63) + s2 * SHM_V, pa0, pa1, pa2, pa3, N0, N1, m_reg, alp); } \
        if constexpr (!FAST) RESC(alp); \
        if ((t) + 2 < NT) WAITBAR(5); else WAITBAR(0); \
        ROT3(); } while (0)
#pragma unroll 1
    for (int t = 1; t + 1 < NT; t += 2) { STEP(t, q0, q1, p0, p1); STEP(t + 1, p0, p1, q0, q1); }
    STEP(NT - 1, q0, q1, p0, p1);
#undef STEP
    if constexpr (FAST) {
#define PK4(P, B_, OUT) do { unsigned a0 = cvtpk(P[B_+0], P[B_+1]), a1 = cvtpk(P[B_+2], P[B_+3]); unsigned b0 = cvtpk(P[B_+4], P[B_+5]), b1 = cvtpk(P[B_+6], P[B_+7]); \
        auto r0 = __builtin_amdgcn_permlane32_swap(a0, b0, false, false); auto r1 = __builtin_amdgcn_permlane32_swap(a1, b1, false, false); \
        v4u w = {r0[0], r1[0], r0[1], r1[1]}; OUT = *reinterpret_cast<bf16x8*>(&w); } while (0)
#define DOT4(PA) do { const v4u w_ = *reinterpret_cast<const v4u*>(&PA); asm("v_dot2c_f32_bf16 %0, %2, %1" : "+v"(l_reg) : "v"(w_.x), "i"(0x3F803F80)); asm("v_dot2c_f32_bf16 %0, %2, %1" : "+v"(l_reg) : "v"(w_.y), "i"(0x3F803F80)); \
        asm("v_dot2c_f32_bf16 %0, %2, %1" : "+v"(l_reg) : "v"(w_.z), "i"(0x3F803F80)); asm("v_dot2c_f32_bf16 %0, %2, %1" : "+v"(l_reg) : "v"(w_.w), "i"(0x3F803F80)); } while (0)
        PK4(q0, 0, pa0); PK4(q0, 8, pa1); PK4(q1, 0, pa2); PK4(q1, 8, pa3);
        DOT4(pa0); DOT4(pa1); DOT4(pa2); DOT4(pa3);
#undef DOT4
#undef PK4
        { auto rr = __builtin_amdgcn_permlane32_swap(__float_as_uint(l_reg), __float_as_uint(l_reg), false, false); l_reg = __uint_as_float(rr[0]) + __uint_as_float(rr[1]); }
    } else {
        q1[12] = __builtin_amdgcn_exp2f(q1[12]); q1[13] = __builtin_amdgcn_exp2f(q1[13]); q1[14] = __builtin_amdgcn_exp2f(q1[14]); q1[15] = __builtin_amdgcn_exp2f(q1[15]);
        float ps = 0;
#pragma unroll
        for (int r = 0; r < 16; ++r) ps += q0[r];
#pragma unroll
        for (int r = 0; r < 16; ++r) ps += q1[r];
        { auto rr = __builtin_amdgcn_permlane32_swap(__float_as_uint(ps), __float_as_uint(ps), false, false); ps = __uint_as_float(rr[0]) + __uint_as_float(rr[1]); }
        l_reg = l_reg * alp + ps;
#define PK4(P, B_, OUT) do { unsigned a0 = cvtpk(P[B_+0], P[B_+1]), a1 = cvtpk(P[B_+2], P[B_+3]); unsigned b0 = cvtpk(P[B_+4], P[B_+5]), b1 = cvtpk(P[B_+6], P[B_+7]); \
        auto r0 = __builtin_amdgcn_permlane32_swap(a0, b0, false, false); auto r1 = __builtin_amdgcn_permlane32_swap(a1, b1, false, false); \
        v4u w = {r0[0], r1[0], r0[1], r1[1]}; OUT = *reinterpret_cast<bf16x8*>(&w); } while (0)
        PK4(q0, 0, pa0); PK4(q0, 8, pa1); PK4(q1, 0, pa2); PK4(q1, 8, pa3);
#undef PK4
    }
#undef RESC
#undef ROT3
#undef DMA_K
#undef DMA_V
    { int ll = tid; asm volatile("" : "+v"(ll)); pv_tile<0>(o, vbase + v_rd_base(ll & 63) + s2 * SHM_V, pa0, pa1, pa2, pa3); }
    if (hi == 0) li_l[r32] = l_reg; asm volatile("s_waitcnt lgkmcnt(0)" ::: "memory");
    float rli[16];
#pragma unroll
    for (int r = 0; r < 16; ++r) rli[r] = __builtin_amdgcn_rcpf(li_l[crow(r, hi)]);
    bf16_t* Ow = cur.O + (size_t)(wid * QBLK) * OPITCH;
#pragma unroll
    for (int r = 0; r < 16; ++r) { const int orow = crow(r, hi);
#pragma unroll
        for (int d0 = 0; d0 < 4; ++d0) { const float v = o[d0][r] * rli[r]; const float vn = __shfl_xor(v, 1);
            if ((r32 & 1) == 0) *(unsigned*)(Ow + (size_t)orow * OPITCH + d0 * 32 + r32) = cvtpk(v, vn); } }
    WAITBAR(0);
}
#undef WAITBAR
#undef VMW
#undef SBAR
__device__ __forceinline__ BlockRef make_ref(int L, int pass, const bf16_t* Q, const bf16_t* K, const bf16_t* V, bf16_t* O) {
    const int bh = L >> 4, x = L & 15, qb = pass ? 31 - x : x, b = bh >> 2, h = bh & 3;
    BlockRef r; r.Q = Q + ((size_t)bh * 8192 + (size_t)qb * QB) * DQ; r.K = K + (size_t)bh * 8192 * DQ; r.V = V + (size_t)bh * 8192 * DVV;
    r.O = O + ((size_t)b * 8192 + (size_t)qb * QB) * OPITCH + h * DVV; r.P0 = qb * QB; return r;
}
__device__ __forceinline__ void attn_phase(char* lds, const bf16_t* Q, const bf16_t* K, const bf16_t* V, bf16_t* O, int G, int bid, const float* qn, const float* kn) {
    float gq = 0.f, gk = 0.f;
    for (int i = (int)(threadIdx.x & 63); i < DQ; i += 64) { gq = fmaxf(gq, fabsf(qn[i])); gk = fmaxf(gk, fabsf(kn[i])); }
#pragma unroll
    for (int o = 32; o >= 1; o >>= 1) { gq = fmaxf(gq, __shfl_xor(gq, o)); gk = fmaxf(gk, __shfl_xor(gk, o)); }
    const float bound = QPRE * 192.f * 1.02f * gq * gk;
    const bool fast = __builtin_amdgcn_readfirstlane((int)(bound <= FAST_BOUND)) != 0;
    for (int L = bid; L < 256; L += G)
#pragma unroll 1
        for (int pass = 0; pass < 2; ++pass) { const BlockRef cur = make_ref(L, pass, Q, K, V, O);
            if (fast) attn_block<true>(cur, lds); else attn_block<false>(cur, lds); }
}
}
namespace prj {
__device__ __forceinline__ int crow(int r, int hi) { return (r & 3) + 8 * (r >> 2) + 4 * hi; }
__device__ __forceinline__ float swap_add(float v) { auto rr = __builtin_amdgcn_permlane32_swap(__float_as_uint(v), __float_as_uint(v), false, false); return __uint_as_float(rr[0]) + __uint_as_float(rr[1]); }
__device__ __forceinline__ float sumsq8(bf16x8 v) { float s = 0.f;
#pragma unroll
    for (int j = 0; j < 8; ++j) { const float f = bf2f((bf16_t)v[j]); s += f * f; } return s; }
__device__ __forceinline__ bf16x8 ldg8(const bf16_t* p) { return *reinterpret_cast<const bf16x8*>(p); }
__device__ __forceinline__ const bf16_t* projt(const unsigned char* ws, int t, int col) { return (const bf16_t*)(ws + WSX_B) + ((size_t)((t >> 5) * 192 + (col >> 3)) * 32 + (t & 31)) * 8 + (col & 7); }
__device__ __forceinline__ v2u pack4(float a, float b, float c, float d) { return (v2u){cvtpk(a, b), cvtpk(c, d)}; }

__device__ __forceinline__ void stage_weights(const unsigned char* src, LAS unsigned char* wl, int nkb, int wave, int lane) {
    __syncthreads();
    for (int i = wave; i < nkb; i += NWAVES) __builtin_amdgcn_global_load_lds((const unsigned*)(src + (size_t)i * 1024 + lane * 16), (LAS unsigned*)(wl + i * 1024), 16, 0, 0);
    asm volatile("s_waitcnt vmcnt(0)" ::: "memory");
    __syncthreads();
}
__device__ __forceinline__ void stage_weights2(const unsigned char* src0, const unsigned char* src1, LAS unsigned char* wl, int wave, int lane) {
    __syncthreads();
    for (int i = wave; i < 32; i += NWAVES) { __builtin_amdgcn_global_load_lds((const unsigned*)(src0 + (size_t)i * 1024 + lane * 16), (LAS unsigned*)(wl + i * 1024), 16, 0, 0);
                                              __builtin_amdgcn_global_load_lds((const unsigned*)(src1 + (size_t)i * 1024 + lane * 16), (LAS unsigned*)(wl + (32 + i) * 1024), 16, 0, 0); }
    asm volatile("s_waitcnt vmcnt(0)" ::: "memory");
    __syncthreads();
}
__device__ __forceinline__ void unit_q(const Inputs& I, unsigned char* ws, LAS unsigned char* wl, int wave, int grp, int lane) {
    const int r32 = lane & 31, hi = lane >> 5, t = grp * 32 + r32, b = t >> 13, s = t & 8191;
    const bf16_t* pr = projt(ws, t, C_QLAT + 8 * hi);
    float ssq = 0.f; bf16x8 bq[16];
#pragma unroll
    for (int ks = 0; ks < 16; ++ks) { bq[ks] = ldg8(pr + 512 * ks); ssq += sumsq8(bq[ks]); }
    const float msq = swap_add(ssq) * (1.f / 256.f) + EPS;
    const LAS bf16x8* WQF = (const LAS bf16x8*)wl + lane;
    const float* cs = (const float*)(ws + WSX_CS) + (size_t)t * 64;
#pragma unroll 1
    for (int h = 0; h < 4; ++h) {
        stage_weights(ws + WSX_WQF + (size_t)h * 96 * 1024, wl, 96, wave, lane);
        f32x16 acc[6];
#pragma unroll
        for (int nb = 0; nb < 6; ++nb) acc[nb] = f32x16{};
#pragma unroll
        for (int k0 = 0; k0 < 16; k0 += 2) { bf16x8 wf[12];
#pragma unroll
            for (int i = 0; i < 2; ++i)
#pragma unroll
                for (int nb = 0; nb < 6; ++nb) wf[i * 6 + nb] = WQF[(nb * 16 + k0 + i) * 64];
#pragma unroll
            for (int i = 0; i < 2; ++i)
#pragma unroll
                for (int nb = 0; nb < 6; ++nb) acc[nb] = __builtin_amdgcn_mfma_f32_32x32x16_bf16(wf[i * 6 + nb], bq[k0 + i], acc[nb], 0, 0, 0);
            asm volatile("" ::: "memory"); }
        float ss = 0.f;
#pragma unroll
        for (int nb = 0; nb < 6; ++nb)
#pragma unroll
            for (int r = 0; r < 16; ++r) ss += acc[nb][r] * acc[nb][r];
        const float rs = rsqrtf(swap_add(ss) * (1.f / 192.f) + EPS * msq) * (0.07216878364870322f * 1.4426950408889634f);
        bf16_t* qp = (bf16_t*)(ws + WSX_Q) + ((size_t)((b * 4 + h) * 256 + (s >> 5)) * 24) * 256 + r32 * 8 + 4 * hi;
#pragma unroll
        for (int nb = 0; nb < 4; ++nb)
#pragma unroll
            for (int q = 0; q < 4; ++q) { const int n = 32 * nb + 8 * q + 4 * hi; const f32x4 g = *(const f32x4*)(I.q_norm + n);
                *(v2u*)(qp + (4 * nb + q) * 256) = pack4(acc[nb][4 * q] * rs * g[0], acc[nb][4 * q + 1] * rs * g[1], acc[nb][4 * q + 2] * rs * g[2], acc[nb][4 * q + 3] * rs * g[3]); asm volatile("" ::: "memory"); }
#pragma unroll
        for (int q = 0; q < 4; ++q) { const int j = 8 * q + 4 * hi; const f32x4 g1 = *(const f32x4*)(I.q_norm + 128 + j), g2 = *(const f32x4*)(I.q_norm + 160 + j);
            const f32x4 c = *(const f32x4*)(cs + j), sn = *(const f32x4*)(cs + 32 + j);
            float o1[4], o2[4];
#pragma unroll
            for (int i = 0; i < 4; ++i) { const float x1 = acc[4][4 * q + i] * rs * g1[i], x2 = acc[5][4 * q + i] * rs * g2[i]; o1[i] = x1 * c[i] - x2 * sn[i]; o2[i] = x2 * c[i] + x1 * sn[i]; }
            *(v2u*)(qp + (16 + q) * 256) = pack4(o1[0], o1[1], o1[2], o1[3]); *(v2u*)(qp + (20 + q) * 256) = pack4(o2[0], o2[1], o2[2], o2[3]); }
    }
}
__device__ __forceinline__ void unit_kv(const Inputs& I, unsigned char* ws, LAS unsigned char* wl, int wave, int grp, int lane) {
    const int r32 = lane & 31, hi = lane >> 5, t = grp * 32 + r32, b = t >> 13, s = t & 8191;
    bf16x8 bk[8]; float ssq = 0.f;
#pragma unroll
    for (int ks = 0; ks < 8; ++ks) { bk[ks] = ldg8(projt(ws, t, C_KVLAT + 8 * hi) + 512 * ks); ssq += sumsq8(bk[ks]); }
    const float rstd = rsqrtf(swap_add(ssq) * (1.f / 128.f) + EPS);
    float kr1[16], kr2[16]; float ssr = 0.f;
#pragma unroll
    for (int q = 0; q < 4; ++q) { const int j = 8 * q + 4 * hi; const v2u a = *(const v2u*)projt(ws, t, C_KROPE + j), c = *(const v2u*)projt(ws, t, C_KROPE + 32 + j);
        kr1[4 * q] = __uint_as_float(a.x << 16); kr1[4 * q + 1] = __uint_as_float(a.x & 0xffff0000u); kr1[4 * q + 2] = __uint_as_float(a.y << 16); kr1[4 * q + 3] = __uint_as_float(a.y & 0xffff0000u);
        kr2[4 * q] = __uint_as_float(c.x << 16); kr2[4 * q + 1] = __uint_as_float(c.x & 0xffff0000u); kr2[4 * q + 2] = __uint_as_float(c.y << 16); kr2[4 * q + 3] = __uint_as_float(c.y & 0xffff0000u); }
#pragma unroll
    for (int r = 0; r < 16; ++r) ssr += kr1[r] * kr1[r] + kr2[r] * kr2[r];
    const LAS bf16x8* WKVF = (const LAS bf16x8*)wl + lane;
    const float* cs = (const float*)(ws + WSX_CS) + (size_t)t * 64;
#pragma unroll 1
    for (int h = 0; h < 4; ++h) {
        stage_weights(ws + WSX_WKVF + (size_t)h * 64 * 1024, wl, 64, wave, lane);
        bf16_t* kp = (bf16_t*)(ws + WSX_K) + ((size_t)((b * 4 + h) * 128 + (s >> 6)) * 24) * 512 + (s & 63) * 8 + 4 * hi;
        bf16_t* vp = (bf16_t*)(ws + WSX_V) + ((size_t)((b * 4 + h) * 128 + (s >> 6)) * 16) * 512 + (s & 63) * 8 + 4 * hi;
        f32x16 acc[4];
#pragma unroll
        for (int nb = 0; nb < 4; nb += 2) { acc[nb] = f32x16{}; acc[nb + 1] = f32x16{}; bf16x8 wf[16];
#pragma unroll
            for (int i = 0; i < 16; ++i) wf[i] = WKVF[(nb * 8 + i) * 64];
#pragma unroll
            for (int i = 0; i < 8; ++i) acc[nb] = __builtin_amdgcn_mfma_f32_32x32x16_bf16(wf[i], bk[i], acc[nb], 0, 0, 0);
#pragma unroll
            for (int i = 0; i < 8; ++i) acc[nb + 1] = __builtin_amdgcn_mfma_f32_32x32x16_bf16(wf[8 + i], bk[i], acc[nb + 1], 0, 0, 0);
            }
        float ss = 0.f;
#pragma unroll
        for (int nb = 0; nb < 4; ++nb)
#pragma unroll
            for (int r = 0; r < 16; ++r) ss += acc[nb][r] * acc[nb][r];
        const float rs = rsqrtf(swap_add(ss * rstd * rstd + ssr) * (1.f / 192.f) + EPS), rk = rs * rstd;
#pragma unroll
        for (int nb = 0; nb < 4; ++nb)
#pragma unroll
            for (int q = 0; q < 4; ++q) { const int n = 32 * nb + 8 * q + 4 * hi; const f32x4 g = *(const f32x4*)(I.k_norm + n);
                *(v2u*)(kp + (4 * nb + q) * 512) = pack4(acc[nb][4 * q] * rk * g[0], acc[nb][4 * q + 1] * rk * g[1], acc[nb][4 * q + 2] * rk * g[2], acc[nb][4 * q + 3] * rk * g[3]); }
#pragma unroll
        for (int q = 0; q < 4; ++q) { const int j = 8 * q + 4 * hi; const f32x4 g1 = *(const f32x4*)(I.k_norm + 128 + j), g2 = *(const f32x4*)(I.k_norm + 160 + j);
            const f32x4 c = *(const f32x4*)(cs + j), sn = *(const f32x4*)(cs + 32 + j);
            float o1[4], o2[4];
#pragma unroll
            for (int i = 0; i < 4; ++i) { const float x1 = kr1[4 * q + i] * rs * g1[i], x2 = kr2[4 * q + i] * rs * g2[i]; o1[i] = x1 * c[i] - x2 * sn[i]; o2[i] = x2 * c[i] + x1 * sn[i]; }
            *(v2u*)(kp + (16 + q) * 512) = pack4(o1[0], o1[1], o1[2], o1[3]); *(v2u*)(kp + (20 + q) * 512) = pack4(o2[0], o2[1], o2[2], o2[3]); }
        asm volatile("" ::: "memory");
#pragma unroll
        for (int nb = 0; nb < 4; nb += 2) { acc[nb] = f32x16{}; acc[nb + 1] = f32x16{}; bf16x8 wf[16];
#pragma unroll
            for (int i = 0; i < 16; ++i) wf[i] = WKVF[((4 + nb) * 8 + i) * 64];
#pragma unroll
            for (int i = 0; i < 8; ++i) acc[nb] = __builtin_amdgcn_mfma_f32_32x32x16_bf16(wf[i], bk[i], acc[nb], 0, 0, 0);
#pragma unroll
            for (int i = 0; i < 8; ++i) acc[nb + 1] = __builtin_amdgcn_mfma_f32_32x32x16_bf16(wf[8 + i], bk[i], acc[nb + 1], 0, 0, 0);
            }
#pragma unroll
        for (int nb = 0; nb < 4; ++nb)
#pragma unroll
            for (int q = 0; q < 4; ++q) { const int n = 32 * nb + 8 * q + 4 * hi;
                *(v2u*)(vp + (4 * nb + q) * 512) = pack4(acc[nb][4 * q] * rstd, acc[nb][4 * q + 1] * rstd, acc[nb][4 * q + 2] * rstd, acc[nb][4 * q + 3] * rstd); }
        asm volatile("" ::: "memory");
    }
}
#define LRU_SCAN_STEP(CTRL) asm volatile("s_nop 1\n\t" \
    "v_fmac_f32_dpp %0, %0, %16 " CTRL "\n\tv_fmac_f32_dpp %1, %1, %17 " CTRL "\n\tv_fmac_f32_dpp %2, %2, %18 " CTRL "\n\tv_fmac_f32_dpp %3, %3, %19 " CTRL "\n\t" \
    "v_fmac_f32_dpp %4, %4, %20 " CTRL "\n\tv_fmac_f32_dpp %5, %5, %21 " CTRL "\n\tv_fmac_f32_dpp %6, %6, %22 " CTRL "\n\tv_fmac_f32_dpp %7, %7, %23 " CTRL "\n\t" \
    "v_fmac_f32_dpp %8, %8, %24 " CTRL "\n\tv_fmac_f32_dpp %9, %9, %25 " CTRL "\n\tv_fmac_f32_dpp %10, %10, %26 " CTRL "\n\tv_fmac_f32_dpp %11, %11, %27 " CTRL "\n\t" \
    "v_fmac_f32_dpp %12, %12, %28 " CTRL "\n\tv_fmac_f32_dpp %13, %13, %29 " CTRL "\n\tv_fmac_f32_dpp %14, %14, %30 " CTRL "\n\tv_fmac_f32_dpp %15, %15, %31 " CTRL "\n\t" \
    "v_mul_f32_dpp %16, %16, %16 " CTRL "\n\tv_mul_f32_dpp %17, %17, %17 " CTRL "\n\tv_mul_f32_dpp %18, %18, %18 " CTRL "\n\tv_mul_f32_dpp %19, %19, %19 " CTRL "\n\t" \
    "v_mul_f32_dpp %20, %20, %20 " CTRL "\n\tv_mul_f32_dpp %21, %21, %21 " CTRL "\n\tv_mul_f32_dpp %22, %22, %22 " CTRL "\n\tv_mul_f32_dpp %23, %23, %23 " CTRL "\n\t" \
    "v_mul_f32_dpp %24, %24, %24 " CTRL "\n\tv_mul_f32_dpp %25, %25, %25 " CTRL "\n\tv_mul_f32_dpp %26, %26, %26 " CTRL "\n\tv_mul_f32_dpp %27, %27, %27 " CTRL "\n\t" \
    "v_mul_f32_dpp %28, %28, %28 " CTRL "\n\tv_mul_f32_dpp %29, %29, %29 " CTRL "\n\tv_mul_f32_dpp %30, %30, %30 " CTRL "\n\tv_mul_f32_dpp %31, %31, %31 " CTRL "\n\ts_nop 1" \
    : "+v"(bv[0]), "+v"(bv[1]), "+v"(bv[2]), "+v"(bv[3]), "+v"(bv[4]), "+v"(bv[5]), "+v"(bv[6]), "+v"(bv[7]), "+v"(bv[8]), "+v"(bv[9]), "+v"(bv[10]), "+v"(bv[11]), "+v"(bv[12]), "+v"(bv[13]), "+v"(bv[14]), "+v"(bv[15]), \
      "+v"(av[0]), "+v"(av[1]), "+v"(av[2]), "+v"(av[3]), "+v"(av[4]), "+v"(av[5]), "+v"(av[6]), "+v"(av[7]), "+v"(av[8]), "+v"(av[9]), "+v"(av[10]), "+v"(av[11]), "+v"(av[12]), "+v"(av[13]), "+v"(av[14]), "+v"(av[15]))
constexpr int PRJ_TAB = 96 * 1024;
__device__ __forceinline__ void lru_tables(Frame& F, const Inputs& I) {
    LAS float* tb = (LAS float*)(F.lds + PRJ_TAB);
    for (int i = ((int)threadIdx.x); i < 2048; i += 512) tb[i] = I.conv_w[i];
    { const int c = ((int)threadIdx.x); tb[2048 + c] = I.conv_b[c]; tb[2560 + c] = -1.4426950408889634f * I.lru_ba[c]; tb[3072 + c] = -1.4426950408889634f * I.lru_bx[c];
      tb[3584 + c] = -8.f * 1.4426950408889634f * ((const float*)(F.ws + WSX_SP))[c]; }
    __syncthreads();
}
__device__ __forceinline__ void unit_lru(const Inputs& I, unsigned char* ws, LAS unsigned char* wl, int wave, int grp, int hp, int lane) {
    const int r32 = lane & 31, hi = lane >> 5, t = grp * 32 + r32, s = t & 8191;
    const bool reset = I.positions[t] == 0;
    const LAS float* tbl = (const LAS float*)(wl + PRJ_TAB);
    int xt[4]; float xz[4];
#pragma unroll
    for (int j = 0; j < 4; ++j) { const bool ok = s - 3 + j >= 0; xt[j] = ok ? t - 3 + j : t; xz[j] = ok ? 1.f : 0.f; }
    bf16_t* HL = (bf16_t*)(ws + WSX_D) + (size_t)t * 512; bf16_t* PC = HL + (size_t)NTOK * 512;
    float* SUMA = (float*)(ws + WSX_SUMA) + (size_t)grp * 512; float* SUMB = (float*)(ws + WSX_SUMB) + (size_t)grp * 512;
#pragma unroll 1
    for (int h = 2 * hp; h < 2 * hp + 2; ++h) {
        stage_weights2(ws + WSX_WAF + (size_t)h * 32 * 1024, ws + WSX_WXF + (size_t)h * 32 * 1024, wl, wave, lane);
        bf16x8 xf[8];
#pragma unroll
        for (int k2 = 0; k2 < 8; k2 += 2) { v2u xx[2][2][4];
#pragma unroll
            for (int kk = 0; kk < 2; ++kk)
#pragma unroll
                for (int j4 = 0; j4 < 2; ++j4)
#pragma unroll
                    for (int j = 0; j < 4; ++j) xx[kk][j4][j] = *(const v2u*)projt(ws, xt[j], C_XLRU + 128 * h + 32 * ((k2 + kk) >> 1) + 16 * ((k2 + kk) & 1) + 8 * j4 + 4 * hi);
#pragma unroll
            for (int kk = 0; kk < 2; ++kk) { unsigned w[4];
#pragma unroll
                for (int j4 = 0; j4 < 2; ++j4) { const int C = 128 * h + 32 * ((k2 + kk) >> 1) + 16 * ((k2 + kk) & 1) + 8 * j4 + 4 * hi;
                    f32x4 v = *(const LAS f32x4*)(tbl + 2048 + C);
#pragma unroll
                    for (int j = 0; j < 4; ++j) { const v2u x = xx[kk][j4][j]; const f32x4 cw = *(const LAS f32x4*)(tbl + j * 512 + C) * xz[j];
                        v[0] += cw[0] * __uint_as_float(x.x << 16); v[1] += cw[1] * __uint_as_float(x.x & 0xffff0000u); v[2] += cw[2] * __uint_as_float(x.y << 16); v[3] += cw[3] * __uint_as_float(x.y & 0xffff0000u); }
                    w[2 * j4] = cvtpk(v[0], v[1]); w[2 * j4 + 1] = cvtpk(v[2], v[3]); }
                v4u ww = {w[0], w[1], w[2], w[3]}; xf[k2 + kk] = *reinterpret_cast<bf16x8*>(&ww); }
            asm volatile("" ::: "memory"); }
        const LAS bf16x8* WAF = (const LAS bf16x8*)wl + lane; const LAS bf16x8* WXF = (const LAS bf16x8*)(wl + 32 * 1024) + lane;
#pragma unroll
        for (int nb = 0; nb < 4; ++nb) {
            f32x16 aa = f32x16{}, bb = f32x16{};
            { bf16x8 wf[16];
#pragma unroll
              for (int i = 0; i < 8; ++i) { wf[i] = WAF[(nb * 8 + i) * 64]; wf[8 + i] = WXF[(nb * 8 + i) * 64]; }
#pragma unroll
              for (int i = 0; i < 8; ++i) aa = __builtin_amdgcn_mfma_f32_32x32x16_bf16(wf[i], xf[i], aa, 0, 0, 0);
#pragma unroll
              for (int i = 0; i < 8; ++i) bb = __builtin_amdgcn_mfma_f32_32x32x16_bf16(wf[8 + i], xf[i], bb, 0, 0, 0);
              }
            float av[16], bv[16];
#pragma unroll
            for (int q = 0; q < 4; ++q) { const int C = 128 * h + 32 * nb + 8 * q + 4 * hi;
                const f32x4 ba = *(const LAS f32x4*)(tbl + 2560 + C), bx = *(const LAS f32x4*)(tbl + 3072 + C), sp = *(const LAS f32x4*)(tbl + 3584 + C);
#pragma unroll
                for (int i = 0; i < 4; ++i) { const int r = 4 * q + i;
                    const float rg = __builtin_amdgcn_rcpf(1.f + __builtin_amdgcn_exp2f(fmaf(aa[r], -1.4426950408889634f, ba[i])));
                    const float ig = __builtin_amdgcn_rcpf(1.f + __builtin_amdgcn_exp2f(fmaf(bb[r], -1.4426950408889634f, bx[i])));
                    float a = __builtin_amdgcn_exp2f(rg * sp[i]), mult = __builtin_amdgcn_sqrtf(fmaxf(fmaf(-a, a, 1.f), 0.f));
                    if (reset) { a = 0.f; mult = 1.f; }
                    const float xc = bf2f((bf16_t)xf[2 * nb + (r >> 3)][4 * ((r >> 2) & 1) + (r & 3)]);
                    av[r] = a; bv[r] = mult * ig * xc; } }
            LRU_SCAN_STEP("row_shr:1 row_mask:0xf bank_mask:0xf"); LRU_SCAN_STEP("row_shr:2 row_mask:0xf bank_mask:0xf"); LRU_SCAN_STEP("row_shr:4 row_mask:0xf bank_mask:0xf");
            LRU_SCAN_STEP("row_shr:8 row_mask:0xf bank_mask:0xf"); LRU_SCAN_STEP("row_bcast:15 row_mask:0xa bank_mask:0xf");
#pragma unroll
            for (int q = 0; q < 4; ++q) { const int C = 128 * h + 32 * nb + 8 * q + 4 * hi;
                *(v2u*)(HL + C) = pack4(bv[4 * q], bv[4 * q + 1], bv[4 * q + 2], bv[4 * q + 3]);
                *(v2u*)(PC + C) = pack4(av[4 * q], av[4 * q + 1], av[4 * q + 2], av[4 * q + 3]);
                if (r32 == 31) { *(f32x4*)(SUMA + C) = (f32x4){av[4 * q], av[4 * q + 1], av[4 * q + 2], av[4 * q + 3]};
                                 *(f32x4*)(SUMB + C) = (f32x4){bv[4 * q], bv[4 * q + 1], bv[4 * q + 2], bv[4 * q + 3]}; } }
            asm volatile("" ::: "memory");
        }
        asm volatile("s_waitcnt vmcnt(0)" ::: "memory"); __syncthreads();
        if (threadIdx.x < 128) { const int C = 128 * h + threadIdx.x, g0 = (grp >> 3) << 3; float A = 1.f, B = 0.f;
#pragma unroll
            for (int w = 0; w < 8; ++w) { const float a = __hip_atomic_load((float*)(ws + WSX_SUMA) + (size_t)(g0 + w) * 512 + C, __ATOMIC_RELAXED, __HIP_MEMORY_SCOPE_AGENT), b = __hip_atomic_load((float*)(ws + WSX_SUMB) + (size_t)(g0 + w) * 512 + C, __ATOMIC_RELAXED, __HIP_MEMORY_SCOPE_AGENT);
                B = a * B + b; A = a * A; }
            ((float*)(ws + WSX_SUM8A))[(size_t)(grp >> 3) * 512 + C] = A; ((float*)(ws + WSX_SUM8B))[(size_t)(grp >> 3) * 512 + C] = B; }
    }
}
__device__ __forceinline__ void phase_proj(Frame& F, const Inputs& I, int kmask) {
    LAS unsigned char* wl = F.lds;
    lru_tables(F, I);
    const int b = F.vcu, G = F.G;
    if (kmask & 2) for (int u = b; u < 256; u += G) unit_lru(I, F.ws, wl, F.wave, (u >> 1) * 8 + F.wave, u & 1, ((int)(threadIdx.x & 63)));
    asm volatile("" ::: "memory");
    if (kmask & 1) for (int u = b; u < 128; u += G) unit_q(I, F.ws, wl, F.wave, u * 8 + F.wave, ((int)(threadIdx.x & 63)));
    asm volatile("" ::: "memory");
    if (kmask & 4) for (int u = (G == 256 ? b - 128 : b); u < 128; u += G) if (u >= 0) unit_kv(I, F.ws, wl, F.wave, u * 8 + F.wave, ((int)(threadIdx.x & 63)));
    __syncthreads();
}
__device__ __forceinline__ float gelu_t(float v) { const float u = 0.7978845608028654f * (v + 0.044715f * v * v * v); return v / (1.f + __expf(-2.f * u)); }
__device__ __forceinline__ void unpack8(v4u w, float* f) {
    f[0] = __uint_as_float(w.x << 16); f[1] = __uint_as_float(w.x & 0xffff0000u); f[2] = __uint_as_float(w.y << 16); f[3] = __uint_as_float(w.y & 0xffff0000u);
    f[4] = __uint_as_float(w.z << 16); f[5] = __uint_as_float(w.z & 0xffff0000u); f[6] = __uint_as_float(w.w << 16); f[7] = __uint_as_float(w.w & 0xffff0000u); }
__device__ __forceinline__ void phase_mix(Frame& F, const Inputs& I) {
    LAS float* carry = (LAS float*)F.lds;
    const float* SUMA = (const float*)(F.ws + WSX_SUMA); const float* SUMB = (const float*)(F.ws + WSX_SUMB);
    const bf16_t* HL = (const bf16_t*)(F.ws + WSX_D); const bf16_t* PC = HL + (size_t)NTOK * 512;
    const bf16_t* PROJ = (const bf16_t*)(F.ws + WSX_B); bf16_t* MIXED = (bf16_t*)(F.ws + WSX_E); const bf16_t* AO = (const bf16_t*)(F.ws + WSX_AO);
    const int nper = 1024 / F.G;
    const int c0 = F.vcu * nper, bfirst = (c0 >> 8) << 8;
    {
        float h = 0.f; const int c = ((int)threadIdx.x); const int tb = c0 >> 3, tb0 = (tb >> 5) << 5;
        const float* S8A = (const float*)(F.ws + WSX_SUM8A); const float* S8B = (const float*)(F.ws + WSX_SUM8B);
        for (int k = tb0; k < tb; k += 8) { float a[8], bq[8];
#pragma unroll
            for (int i = 0; i < 8; ++i) { const int kk = k + i < tb ? k + i : tb0; a[i] = S8A[(size_t)kk * 512 + c]; bq[i] = S8B[(size_t)kk * 512 + c]; }
#pragma unroll
            for (int i = 0; i < 8; ++i) if (k + i < tb) h = a[i] * h + bq[i]; }
        for (int k = tb << 3; k < c0; k += 4) { float a[4], bq[4];
#pragma unroll
            for (int i = 0; i < 4; ++i) { a[i] = SUMA[(size_t)(k + i) * 512 + c]; bq[i] = SUMB[(size_t)(k + i) * 512 + c]; }
#pragma unroll
            for (int i = 0; i < 4; ++i) h = a[i] * h + bq[i]; }
        carry[c] = h; }
    __syncthreads();
    const int C = 8 * ((int)(threadIdx.x & 63));
    const f32x4 g0 = *(const f32x4*)(I.lru_out_norm + C), g1 = *(const f32x4*)(I.lru_out_norm + C + 4), q0 = *(const f32x4*)(I.attn_out_norm + C), q1 = *(const f32x4*)(I.attn_out_norm + C + 4);
    for (int k = c0; k < c0 + nper; ++k) {
        const int tb = k * 32 + F.wave * 4;
        v4u hl4[4], pc4[4], gg4[4], at4[4];
#pragma unroll
        for (int rr = 0; rr < 4; ++rr) { const size_t t = tb + rr; hl4[rr] = *(const v4u*)(HL + t * 512 + C); pc4[rr] = *(const v4u*)(PC + t * 512 + C);
            gg4[rr] = *(const v4u*)projt(F.ws, (int)t, C_GLRU + C); at4[rr] = *(const v4u*)(AO + t * 512 + C); }
        float cy[8]; *(f32x4*)cy = *(const LAS f32x4*)(carry + C); *(f32x4*)(cy + 4) = *(const LAS f32x4*)(carry + C + 4);
        float hl[8];
#pragma unroll
        for (int rr = 0; rr < 4; ++rr) { const size_t t = tb + rr;
            float a[8], p[8], g[8], v[8];
            unpack8(hl4[rr], a); unpack8(pc4[rr], p); unpack8(gg4[rr], g);
            float ss = 0.f;
#pragma unroll
            for (int j = 0; j < 8; ++j) { hl[j] = a[j] + p[j] * cy[j]; v[j] = hl[j] * gelu_t(g[j]); ss += v[j] * v[j]; }
            float rs = rsqrtf(wave_sum_f(ss) * (1.f / 512.f) + EPS);
            *(v4u*)(MIXED + t * 1024 + 512 + C) = (v4u){cvtpk(v[0] * rs * g0[0], v[1] * rs * g0[1]), cvtpk(v[2] * rs * g0[2], v[3] * rs * g0[3]), cvtpk(v[4] * rs * g1[0], v[5] * rs * g1[1]), cvtpk(v[6] * rs * g1[2], v[7] * rs * g1[3])};
            unpack8(at4[rr], a); ss = 0.f;
#pragma unroll
            for (int j = 0; j < 8; ++j) ss += a[j] * a[j];
            rs = rsqrtf(wave_sum_f(ss) * (1.f / 512.f) + EPS);
            *(v4u*)(MIXED + t * 1024 + C) = (v4u){cvtpk(a[0] * rs * q0[0], a[1] * rs * q0[1]), cvtpk(a[2] * rs * q0[2], a[3] * rs * q0[3]), cvtpk(a[4] * rs * q1[0], a[5] * rs * q1[1]), cvtpk(a[6] * rs * q1[2], a[7] * rs * q1[3])};
        }
        __syncthreads();
        if (F.wave == 7) {
#pragma unroll
            for (int j = 0; j < 8; ++j) carry[8 * ((int)(threadIdx.x & 63)) + j] = hl[j]; }
        __syncthreads();
    }
}
}
namespace moe {
constexpr size_t WSX_RSTD = WSX_ROUTE + 800 * 1024;
constexpr size_t WSX_BB = WSX_ROUTE + 960 * 1024;
constexpr size_t WSX_WRFB = 70 * MiB;
constexpr size_t WSX_RBIAS = 70 * MiB + 512 * 1024;
constexpr int TP_OFF = LDSCTL_OFF + 512;
__device__ __forceinline__ int route_expert_of_n(int n) { const int a = (n >> 4) & 1, b = (n >> 3) & 1, h = (n >> 2) & 1, c = n & 3; return 8 * (2 * a + h) + 4 * b + c; }
__device__ __forceinline__ void router_fold(Frame& F, const Inputs& I) {
    const float* mod = (const float*)(F.ws + WS_MOD);
    const int gt = blockIdx.x * 512 + ((int)threadIdx.x), NGT = F.G * 512;
    v4u* WRFB = (v4u*)(F.ws + WSX_WRFB);
    for (int g = gt; g < 4 * 2 * 64 * 64; g += NGT) {
        const int lane = g & 63, ks = (g >> 6) & 63, nb = (g >> 12) & 1, b = g >> 13, hi = lane >> 5, n = lane & 31; float v[8];
#pragma unroll
        for (int j = 0; j < 8; ++j) { const int k = 16 * ks + 8 * hi + j; const float gg = I.norm2_g[k] * (1.f + mod[b * MODW + 4096 + k]);
            const float w = nb == 0 ? I.w_re[k * 32 + route_expert_of_n(n)] : (n < 4 ? I.w_rg[k * 4 + n] : 0.f); v[j] = w * gg; }
        WRFB[g] = (v4u){pk2(v[0], v[1]), pk2(v[2], v[3]), pk2(v[4], v[5]), pk2(v[6], v[7])};
    }
    {
        const int gw = blockIdx.x * NWAVES + F.wave;
        if (gw < 4 * 64) { const int b = gw >> 6, n = gw & 63; float s = 0.f;
            if (n < 36) { const int e = n < 32 ? route_expert_of_n(n) : n - 32; const float* W = n < 32 ? I.w_re + e : I.w_rg + e; const int ld = n < 32 ? 32 : 4;
                for (int k = ((int)(threadIdx.x & 63)); k < 1024; k += 64) s += mod[b * MODW + 3072 + k] * W[k * ld];
                s = wave_sum_f(s) + (n < 32 ? I.b_re[e] : I.b_rg[e]); }
            if (((int)(threadIdx.x & 63)) == 0) ((float*)(F.ws + WSX_RBIAS))[gw] = s; } }
}
__device__ __forceinline__ float swap_other(float v) { auto rr = __builtin_amdgcn_permlane32_swap(__float_as_uint(v), __float_as_uint(v), false, false); return (threadIdx.x & 32) ? __uint_as_float(rr[0]) : __uint_as_float(rr[1]); }
__device__ __forceinline__ void phase_route(Frame& F) {
    LAS int* lcnt = (LAS int*)(F.lds);
    if (((int)threadIdx.x) < 32) lcnt[((int)threadIdx.x)] = 0;
    __syncthreads();
    const bf16_t* x1 = (const bf16_t*)(F.ws + WSX_X1);
    int2* rexp = (int2*)(F.ws + WSX_ROUTE); float2* rw = (float2*)(F.ws + WSX_ROUTE + 256 * 1024); int2* rpos = (int2*)(F.ws + WSX_ROUTE + 512 * 1024);
    float* RSTD = (float*)(F.ws + WSX_RSTD);
    const int lane = ((int)(threadIdx.x & 63)), r32 = lane & 31, hi = lane >> 5;
    for (int grp = F.wave * F.G + blockIdx.x; grp < 1024; grp += F.G * NWAVES) {
        const int t = grp * 32 + r32, b = t >> 13;
        const bf16_t* xr = x1 + (size_t)t * DM + 8 * hi;
        const bf16x8* WF = (const bf16x8*)(F.ws + WSX_WRFB) + (size_t)b * 2 * 64 * 64 + lane;
        f32x16 a0 = f32x16{}, a1 = f32x16{}; float ss = 0.f;
#pragma unroll 8
        for (int ks = 0; ks < 64; ++ks) { const bf16x8 xb = *(const bf16x8*)(xr + 16 * ks);
#pragma unroll
            for (int j = 0; j < 8; ++j) { const float f = bf2f((bf16_t)xb[j]); ss += f * f; }
            a0 = __builtin_amdgcn_mfma_f32_32x32x16_bf16(WF[ks * 64], xb, a0, 0, 0, 0);
            a1 = __builtin_amdgcn_mfma_f32_32x32x16_bf16(WF[(64 + ks) * 64], xb, a1, 0, 0, 0); }
        { auto rr = __builtin_amdgcn_permlane32_swap(__float_as_uint(ss), __float_as_uint(ss), false, false); ss = __uint_as_float(rr[0]) + __uint_as_float(rr[1]); }
        const float rstd = rsqrtf(ss * (1.f / DM) + EPS);
        const float* rb = (const float*)(F.ws + WSX_RBIAS) + b * 64;
        float gl0 = a1[0] * rstd + rb[32], gl1 = a1[1] * rstd + rb[33], gl2 = a1[2] * rstd + rb[34], gl3 = a1[3] * rstd + rb[35];
        int gi = 0; float gm = gl0; if (gl1 > gm) { gm = gl1; gi = 1; } if (gl2 > gm) { gm = gl2; gi = 2; } if (gl3 > gm) { gm = gl3; gi = 3; }
        float gp = 1.f / (__expf(gl0 - gm) + __expf(gl1 - gm) + __expf(gl2 - gm) + __expf(gl3 - gm));
        { const float og = swap_other(__int_as_float(gi)), op = swap_other(gp); if (hi) { gi = __float_as_int(og); gp = op; } }
        const bool owner = (gi & 1) == hi; const int hsel = gi >> 1;
        float m0 = -3e38f, m1 = -3e38f; int e0 = 0, e1 = 0;
#pragma unroll
        for (int i = 0; i < 8; ++i) { const int n = 16 * hsel + 8 * (i >> 2) + 4 * hi + (i & 3);
            const float el = (hsel ? a0[8 + i] : a0[i]) * rstd + rb[n];
            if (el > m0) { m1 = m0; e1 = e0; m0 = el; e0 = i; } else if (el > m1) { m1 = el; e1 = i; } }
        if (owner) {
            const float p1 = __expf(m1 - m0); const int E0 = gi * 8 + e0, E1 = gi * 8 + e1;
            rexp[t] = make_int2(E0, E1); rw[t] = make_float2(gp / (1.f + p1), gp * p1 / (1.f + p1));
            const int k0 = __hip_atomic_fetch_add(lcnt + E0, 1, __ATOMIC_RELAXED, __HIP_MEMORY_SCOPE_WORKGROUP), k1 = __hip_atomic_fetch_add(lcnt + E1, 1, __ATOMIC_RELAXED, __HIP_MEMORY_SCOPE_WORKGROUP);
            rpos[t] = make_int2((int)(blockIdx.x << 16) | k0, (int)(blockIdx.x << 16) | k1);
            RSTD[t] = rstd; }
    }
    __syncthreads();
    if (((int)threadIdx.x) < 32) { const int n = lcnt[((int)threadIdx.x)]; int base = 0;
        if (n > 0) base = (int)__hip_atomic_fetch_add((unsigned*)(F.ctl + CW_CNT + 64 * ((int)threadIdx.x)), (unsigned)n, __ATOMIC_RELAXED, __HIP_MEMORY_SCOPE_AGENT);
        ((int*)(F.ws + WSX_BB))[blockIdx.x * 32 + ((int)threadIdx.x)] = base; }
    __syncthreads();
}
__device__ __forceinline__ void moe_tables(Frame& F) {
    LAS int* tp = (LAS int*)(F.lds + TP_OFF);
    if (((int)threadIdx.x) < 32) tp[64 + ((int)threadIdx.x)] = (int)__hip_atomic_load((unsigned*)(F.ctl + CW_CNT + 64 * ((int)threadIdx.x)), __ATOMIC_RELAXED, __HIP_MEMORY_SCOPE_AGENT);
    __syncthreads();
    if (((int)threadIdx.x) == 0) { int acc = 0; for (int e = 0; e < 32; ++e) { tp[e] = acc; acc += (tp[64 + e] + 255) >> 8; } tp[32] = acc; }
    __syncthreads();
}
__device__ __forceinline__ void phase_sort(Frame& F, const Inputs& I) {
    LAS float* Gs = (LAS float*)F.lds; LAS float* Ss = Gs + 4096;
    const float* mod = (const float*)(F.ws + WS_MOD);
#pragma unroll
    for (int i = ((int)threadIdx.x); i < 4096; i += 512) { const int b = i >> 10, k = i & 1023; Gs[i] = I.norm2_g[k] * (1.f + mod[b * MODW + 4096 + k]); Ss[i] = mod[b * MODW + 3072 + k]; }
    moe_tables(F);
    const LAS int* tp = (const LAS int*)(F.lds + TP_OFF);
    const int2* rexp = (const int2*)(F.ws + WSX_ROUTE); const int2* rpos = (const int2*)(F.ws + WSX_ROUTE + 512 * 1024); int2* rposF = (int2*)(F.ws + WSX_RPOSF);
    const float* RSTD = (const float*)(F.ws + WSX_RSTD); const int* BB = (const int*)(F.ws + WSX_BB);
    bf16_t* XS = (bf16_t*)(F.ws + WSX_XS);
    const int gw = F.vcu * NWAVES + F.wave, NGW = F.G * NWAVES;
    for (int m0 = gw; m0 < NTOK; m0 += 4 * NGW) {
        v4u xv[4][2]; int2 ee[4], pp[4]; float rstd[4]; int pos0[4], pos1[4];
        const int ln = ((int)(threadIdx.x & 63));
#pragma unroll
        for (int u = 0; u < 4; ++u) { const int m = m0 + u * NGW; ee[u] = rexp[m]; pp[u] = rpos[m]; rstd[u] = RSTD[m];
            const GAS v4u* xr = (const GAS v4u*)((const bf16_t*)(F.ws + WSX_X1) + (size_t)m * DM) + ln;
            xv[u][0] = xr[0]; xv[u][1] = xr[64]; }
#pragma unroll
        for (int u = 0; u < 4; ++u) { pos0[u] = tp[ee[u].x] * 256 + BB[(pp[u].x >> 16) * 32 + ee[u].x] + (pp[u].x & 0xffff); pos1[u] = tp[ee[u].y] * 256 + BB[(pp[u].y >> 16) * 32 + ee[u].y] + (pp[u].y & 0xffff); }
#pragma unroll
        for (int u = 0; u < 4; ++u) { const int m = m0 + u * NGW, b = m >> 13;
            GAS v4u* o0 = (GAS v4u*)(XS + (size_t)pos0[u] * DM) + ln; GAS v4u* o1 = (GAS v4u*)(XS + (size_t)pos1[u] * DM) + ln;
#pragma unroll
            for (int j = 0; j < 2; ++j) { float f[8]; prj::unpack8(xv[u][j], f); const int k0 = 512 * j + 8 * ln;
                const f32x4 g0 = *(const LAS f32x4*)(Gs + b * 1024 + k0), g1 = *(const LAS f32x4*)(Gs + b * 1024 + k0 + 4), s0 = *(const LAS f32x4*)(Ss + b * 1024 + k0), s1 = *(const LAS f32x4*)(Ss + b * 1024 + k0 + 4);
                const float r = rstd[u];
                const v4u w = {cvtpk(f[0] * r * g0[0] + s0[0], f[1] * r * g0[1] + s0[1]), cvtpk(f[2] * r * g0[2] + s0[2], f[3] * r * g0[3] + s0[3]),
                               cvtpk(f[4] * r * g1[0] + s1[0], f[5] * r * g1[1] + s1[1]), cvtpk(f[6] * r * g1[2] + s1[2], f[7] * r * g1[3] + s1[3])};
                o0[64 * j] = w; o1[64 * j] = w; }
            if (ln == 0) rposF[m] = make_int2(pos0[u], pos1[u]); }
    }
    __syncthreads();
}
__device__ __forceinline__ void phase_combine(Frame& F) {
    const float* mod = (const float*)(F.ws + WS_MOD);
    const float2* rw = (const float2*)(F.ws + WSX_ROUTE + 256 * 1024); const int2* rpos = (const int2*)(F.ws + WSX_RPOSF);
    const bf16_t* YS = (const bf16_t*)(F.ws + WSX_XS);
    const int gw = F.vcu * NWAVES + F.wave, NGW = F.G * NWAVES;
    for (int m0 = gw; m0 < NTOK; m0 += 4 * NGW) {
        int2 pp[4]; float2 ww[4]; v2u xv[4][4]; v2u ya[4][4], yb[4][4];
        const int ln = ((int)(threadIdx.x & 63));
#pragma unroll
        for (int u = 0; u < 4; ++u) { const int m = m0 + u * NGW; pp[u] = rpos[m]; ww[u] = rw[m];
            const GAS v2u* xr = (const GAS v2u*)((const bf16_t*)(F.ws + WSX_X1) + (size_t)m * DM) + ln;
#pragma unroll
            for (int j = 0; j < 4; ++j) xv[u][j] = xr[64 * j]; }
#pragma unroll
        for (int u = 0; u < 4; ++u) { const GAS v2u* y0 = (const GAS v2u*)(YS + (size_t)pp[u].x * DM) + ln; const GAS v2u* y1 = (const GAS v2u*)(YS + (size_t)pp[u].y * DM) + ln;
#pragma unroll
            for (int j = 0; j < 4; ++j) { ya[u][j] = y0[64 * j]; yb[u][j] = y1[64 * j]; } }
#pragma unroll
        for (int u = 0; u < 4; ++u) { const int m = m0 + u * NGW, b = m >> 13; GAS f32x4* xr = (GAS f32x4*)(F.out + (size_t)m * DM) + ln; const float* g2 = mod + b * MODW + 5120 + 4 * ln;
#pragma unroll
            for (int j = 0; j < 4; ++j) { const v2u a = ya[u][j], c = yb[u][j], xx = xv[u][j]; const f32x4 g = *(const f32x4*)(g2 + 256 * j); const float w0 = ww[u].x, w1 = ww[u].y;
                f32x4 y; y[0] = w0 * __uint_as_float(a.x << 16) + w1 * __uint_as_float(c.x << 16); y[1] = w0 * __uint_as_float(a.x & 0xffff0000u) + w1 * __uint_as_float(c.x & 0xffff0000u);
                y[2] = w0 * __uint_as_float(a.y << 16) + w1 * __uint_as_float(c.y << 16); y[3] = w0 * __uint_as_float(a.y & 0xffff0000u) + w1 * __uint_as_float(c.y & 0xffff0000u);
                const f32x4 xf = {__uint_as_float(xx.x << 16), __uint_as_float(xx.x & 0xffff0000u), __uint_as_float(xx.y << 16), __uint_as_float(xx.y & 0xffff0000u)};
                xr[64 * j] = xf + g * y; } }
    }
}
}
#ifndef SEAM_TWICE
#define SEAM_TWICE 0
#endif
__device__ __forceinline__ Inputs load_inputs(const Args& args) {
    Inputs I; const void* const* p = args.in;
    I.x = (const float*)p[0]; I.c = (const float*)p[1]; I.positions = (const int*)p[2]; I.w_ada = (const float*)p[3]; I.b_ada = (const float*)p[4]; I.norm1_g = (const float*)p[5];
    I.w_in = (const float*)p[6]; I.q_a_norm = (const float*)p[7]; I.w_q_b = (const float*)p[8]; I.kv_a_norm = (const float*)p[9]; I.w_kv_b = (const float*)p[10]; I.q_norm = (const float*)p[11];
    I.k_norm = (const float*)p[12]; I.conv_w = (const float*)p[13]; I.conv_b = (const float*)p[14]; I.lru_wa = (const float*)p[15]; I.lru_ba = (const float*)p[16]; I.lru_wx = (const float*)p[17];
    I.lru_bx = (const float*)p[18]; I.lru_lambda = (const float*)p[19]; I.attn_out_norm = (const float*)p[20]; I.lru_out_norm = (const float*)p[21]; I.w_out = (const float*)p[22];
    I.norm2_g = (const float*)p[23]; I.w_rg = (const float*)p[24]; I.b_rg = (const float*)p[25]; I.w_re = (const float*)p[26]; I.b_re = (const float*)p[27]; I.w_gate = (const float*)p[28];
    I.w_up = (const float*)p[29]; I.w_down = (const float*)p[30]; return I;
}
__global__ void __launch_bounds__(NWAVES * 64, 2) mega_fwd(Args args) {
    extern __shared__ __attribute__((aligned(16))) unsigned char lds[];
    Frame F;
    F.lds = (LAS unsigned char*)lds; F.MISC = (volatile LAS unsigned*)(F.lds + MISC_OFF);
    F.wave = __builtin_amdgcn_readfirstlane(threadIdx.x >> 6);
    F.G = gridDim.x; { const int bx = blockIdx.x; F.vcu = (F.G % 8 == 0) ? (bx % 8) * (F.G / 8) + bx / 8 : bx; }
    F.ws = args.ws; F.out = args.out; F.ctl = (gu32*)(args.ws + WS_CTL);
    for (int u = ((int)threadIdx.x); u < (LDS_BYTES - LDSCTL_OFF) / 4; u += NWAVES * 64) ((LAS unsigned*)(F.lds + LDSCTL_OFF))[u] = 0u;
    __syncthreads();
    XcdBarrier bar = xcd_barrier_post((unsigned*)(F.ctl + CW_BAR) + args.li * XCD_BAR_WORDS, F.MISC + 8);
    const int lo = args.ph_lo, hi = args.ph_hi;
constexpr int REPS[12] = {1,1,1,1,1,1,1,1,1,1,1,1};
#define IN(k) (lo <= (k) && (k) < hi)
#define SEAM(k) do { if (IN(k) && IN((k) + 1)) { xcd_barrier(bar); if (SEAM_TWICE) xcd_barrier(bar); } } while (0)
    if (IN(0)) for (int rep_ = 0; rep_ < REPS[0]; ++rep_) { const Inputs I = load_inputs(args); (void)I; phase_prologue(F, I); } SEAM(0);
    if (IN(1)) for (int rep_ = 0; rep_ < REPS[1]; ++rep_) { const Inputs I = load_inputs(args); (void)I; moe::router_fold(F, I); phase_xn(F, I); } SEAM(1);
    if (IN(2)) for (int rep_ = 0; rep_ < REPS[2]; ++rep_) { const Inputs I = load_inputs(args); (void)I;
        pg8::Gemm g{(const bf16_t*)(F.ws + WSX_A), (const bf16_t*)(F.ws + WSX_WIN), NTOK, PROJP, DM}; pg8::StaticOrder S; S.init(NTOK, PROJP, F.G, (int)blockIdx.x);
        pg8::EpiProjT E{(bf16_t*)(F.ws + WSX_B)};
        pg8::gemm_phase<pg8::EpiProjT, pg8::StaticOrder, true, true>(F.lds, g, S, E);
    } SEAM(2);
    if (IN(3)) for (int rep_ = 0; rep_ < REPS[3]; ++rep_) { const Inputs I = load_inputs(args); (void)I; prj::phase_proj(F, I, args.pad); } SEAM(3);
    if (IN(4)) for (int rep_ = 0; rep_ < REPS[4]; ++rep_) { const Inputs I = load_inputs(args); (void)I;
        att::attn_phase((char*)lds, (const bf16_t*)(F.ws + WSX_Q), (const bf16_t*)(F.ws + WSX_K), (const bf16_t*)(F.ws + WSX_V), (bf16_t*)(F.ws + WSX_AO), F.G, F.vcu, I.q_norm, I.k_norm);
    } SEAM(4);
    if (IN(5)) for (int rep_ = 0; rep_ < REPS[5]; ++rep_) { const Inputs I = load_inputs(args); (void)I; prj::phase_mix(F, I); } SEAM(5);
    if (IN(6)) for (int rep_ = 0; rep_ < REPS[6]; ++rep_) { const Inputs I = load_inputs(args); (void)I;
        pg8::Gemm g{(const bf16_t*)(F.ws + WSX_E), (const bf16_t*)(F.ws + WSX_WOUT), NTOK, DM, DM}; pg8::StaticOrder S; S.init(NTOK, DM, F.G, (int)blockIdx.x);
        pg8::EpiResid E{I.x, (const float*)(F.ws + WS_MOD), (bf16_t*)(F.ws + WSX_X1)};
        pg8::gemm_phase<pg8::EpiResid, pg8::StaticOrder, true, true>(F.lds, g, S, E);
    } SEAM(6);
    if (IN(7)) for (int rep_ = 0; rep_ < REPS[7]; ++rep_) { const Inputs I = load_inputs(args); (void)I; moe::phase_route(F); } SEAM(7);
    if (IN(8)) for (int rep_ = 0; rep_ < REPS[8]; ++rep_) { const Inputs I = load_inputs(args); (void)I; moe::phase_sort(F, I); } SEAM(8);
    if (IN(9)) for (int rep_ = 0; rep_ < REPS[9]; ++rep_) { const Inputs I = load_inputs(args); (void)I;
        if (!IN(8)) moe::moe_tables(F);
        pg8::Gemm g{(const bf16_t*)(F.ws + WSX_XS), (const bf16_t*)(F.ws + WSX_W1T), MAXROWS, 0, DM};
        pg8::GroupedOrder S{(const LAS int*)(F.lds + moe::TP_OFF), 2, F.G, (int)blockIdx.x};
        pg8::EpiSiluMul E{(bf16_t*)(F.ws + WSX_HID)};
        pg8::gemm_phase<pg8::EpiSiluMul, pg8::GroupedOrder, true, true>(F.lds, g, S, E);
    } SEAM(9);
    if (IN(10)) for (int rep_ = 0; rep_ < REPS[10]; ++rep_) { const Inputs I = load_inputs(args); (void)I;
        if (!IN(8)) moe::moe_tables(F);
        int kk2 = DFF; asm volatile("" : "+s"(kk2));
        pg8::Gemm g{(const bf16_t*)(F.ws + WSX_HID), (const bf16_t*)(F.ws + WSX_W2T), MAXROWS, 0, kk2};
        pg8::GroupedOrder S{(const LAS int*)(F.lds + moe::TP_OFF), 4, F.G, (int)blockIdx.x};
        pg8::EpiYs E{(bf16_t*)(F.ws + WSX_XS)};
        pg8::gemm_phase<pg8::EpiYs, pg8::GroupedOrder, true, true>(F.lds, g, S, E);
    } SEAM(10);
    if (IN(11)) for (int rep_ = 0; rep_ < REPS[11]; ++rep_) { const Inputs I = load_inputs(args); (void)I; moe::phase_combine(F); }
#undef IN
#undef SEAM
}
static int g_grid = 0;
static bool mega_setup() {
    if (g_grid) return g_grid > 0;
    int dev = 0, cus = 0, per_cu = 0;
    if (hipGetDevice(&dev) != hipSuccess || hipDeviceGetAttribute(&cus, hipDeviceAttributeMultiprocessorCount, dev) != hipSuccess) { g_grid = -1; return false; }
    if (hipFuncSetAttribute((const void*)mega_fwd, hipFuncAttributeMaxDynamicSharedMemorySize, LDS_BYTES) != hipSuccess) { fprintf(stderr, "hipFuncSetAttribute failed\n"); g_grid = -1; return false; }
    if (hipOccupancyMaxActiveBlocksPerMultiprocessor(&per_cu, (const void*)mega_fwd, NWAVES * 64, LDS_BYTES) != hipSuccess || per_cu < 1) { fprintf(stderr, "occupancy query: %d\n", per_cu); (void)hipGetLastError(); g_grid = -1; return false; }
    g_grid = cus;
    return true;
}
static void mega_launch(void* const* d_in, void* d_out, void* d_ws, hipStream_t stream, int lo, int hi, int li, int knob = 7) {
    Args a{}; for (int i = 0; i < 31; ++i) a.in[i] = d_in[i];
    a.out = (float*)d_out; a.ws = (unsigned char*)d_ws; a.ph_lo = lo; a.ph_hi = hi; a.li = li; a.pad = knob;
    hipLaunchKernelGGL(mega_fwd, dim3(g_grid), dim3(NWAVES * 64), LDS_BYTES, stream, a);
}
extern "C" void kernel_launch(void* const* d_in, const int* in_sizes, int n_in, void* d_out, int out_size, void* d_ws, size_t ws_size, hipStream_t stream) {
    if (n_in != 31 || ws_size < WSX_END || out_size != NTOK * DM) { fprintf(stderr, "kernel_launch: unexpected shapes n_in=%d ws=%zu out=%d\n", n_in, ws_size, out_size); return; }
    if (!mega_setup()) return;
    char* ws = (char*)d_ws;
    (void)hipMemsetAsync(ws + WS_CTL, 0, 1 * MiB, stream);
    mega_launch(d_in, d_out, d_ws, stream, 0, 12, 0);
}
```
